# Optimizing an MI355X kernel written in HIP

```python
import math
import jax, jax.numpy as jnp
from jax import lax
import numpy as np

D_MODEL = 2048
BATCH = 1
SEQ = 8192
DEPTH = 2
DEC_BATCH = 128
DEC_SEQ = 4
PAST_LEN = 8192
PAGE_SIZE = 128

WINDOW = 128
HD_A = 64
N_HEADS_A = (D_MODEL // 2) // HD_A
N_KV_A = max(1, N_HEADS_A // 8)
W_A = N_HEADS_A * HD_A
Q_BLOCK = WINDOW
HD_B = 128
N_HEADS_B = (D_MODEL // 2) // HD_B
W_B = N_HEADS_B * HD_B
RET_CHUNK = 128
D_MIX = W_A + W_B
D_PROJ = 2 * W_A + 2 * N_KV_A * HD_A + 4 * W_B
ROPE_THETA = 10000.0
EPS = 1e-6

kernel_name = "hymba_swa_sink_retention_step"


def rmsnorm(x, w):
    xf = x.astype(jnp.float32)
    y = xf * lax.rsqrt(jnp.mean(xf * xf, axis=-1, keepdims=True) + EPS)
    return (y * w.astype(jnp.float32)).astype(x.dtype)


def rope(x, pos):
    d = x.shape[-1]
    half = d // 2
    inv = ROPE_THETA ** (-jnp.arange(half, dtype=jnp.float32) / half)
    ang = pos.astype(jnp.float32)[:, None] * inv[None, :]
    cos = jnp.cos(ang)[None, :, None, :]
    sin = jnp.sin(ang)[None, :, None, :]
    xf = x.astype(jnp.float32)
    x1, x2 = xf[..., :half], xf[..., half:]
    return jnp.concatenate([x1 * cos - x2 * sin, x2 * cos + x1 * sin], axis=-1).astype(x.dtype)


def project(x, pos, norm_w, w_in):
    B, T, _ = x.shape
    h = rmsnorm(x, norm_w)
    p = jnp.einsum('btd,de->bte', h, w_in)
    cuts = list(np.cumsum([W_A, N_KV_A * HD_A, N_KV_A * HD_A, W_A, W_B, W_B, W_B]))
    qa, ka, va, ga, qb, kb, vb, gb = jnp.split(p, cuts, axis=-1)
    qa = rope(qa.reshape(B, T, N_HEADS_A, HD_A), pos)
    ka = rope(ka.reshape(B, T, N_KV_A, HD_A), pos)
    va = va.reshape(B, T, N_KV_A, HD_A)
    qb = rope(qb.reshape(B, T, N_HEADS_B, HD_B), pos)
    kb = rope(kb.reshape(B, T, N_HEADS_B, HD_B), pos) * (HD_B ** -0.5)
    vb = vb.reshape(B, T, N_HEADS_B, HD_B)
    return qa, ka, va, ga, qb, kb, vb, gb


def sink_window_attention(q, k, v, q_pos, k_pos, sinks):
    B, N, Tq, H, hd = q.shape
    KV = k.shape[3]
    G = H // KV
    qg = q.reshape(B, N, Tq, KV, G, hd)
    s = jnp.einsum('bnqkgd,bnskd->bnkgqs', qg, k).astype(jnp.float32) * (hd ** -0.5)
    delta = q_pos[:, :, None] - k_pos[:, None, :]
    valid = (k_pos[:, None, :] >= 0) & (delta >= 0) & (delta < WINDOW)
    s = jnp.where(valid[None, :, None, None], s, -jnp.inf)
    sink = sinks.astype(jnp.float32).reshape(1, 1, KV, G, 1, 1)
    m = jnp.maximum(jnp.max(s, axis=-1, keepdims=True), sink)
    e = jnp.exp(s - m)
    denom = jnp.sum(e, axis=-1, keepdims=True) + jnp.exp(sink - m)
    prob = (e / denom).astype(v.dtype)
    o = jnp.einsum('bnkgqs,bnskd->bnqkgd', prob, v)
    return o.reshape(B, N, Tq, H * hd)


def prompt_window_attention(qa, ka, va, sinks):
    B, T, H, hd = qa.shape
    nb = T // Q_BLOCK
    q = qa.reshape(B, nb, Q_BLOCK, H, hd)
    pad = jnp.zeros((B, Q_BLOCK, N_KV_A, hd), ka.dtype)
    kp = jnp.concatenate([pad, ka], axis=1).reshape(B, nb + 1, Q_BLOCK, N_KV_A, hd)
    vp = jnp.concatenate([pad.astype(va.dtype), va], axis=1).reshape(B, nb + 1, Q_BLOCK, N_KV_A, hd)
    k = jnp.concatenate([kp[:, :-1], kp[:, 1:]], axis=2)
    v = jnp.concatenate([vp[:, :-1], vp[:, 1:]], axis=2)
    q_pos = jnp.arange(T, dtype=jnp.int32).reshape(nb, Q_BLOCK)
    kpp = jnp.arange(-Q_BLOCK, T, dtype=jnp.int32).reshape(nb + 1, Q_BLOCK)
    k_pos = jnp.concatenate([kpp[:-1], kpp[1:]], axis=1)
    o = sink_window_attention(q, k, v, q_pos, k_pos, sinks)
    return o.reshape(B, T, H * hd)


def sample_window_attention(qa, ka, va, k_buf, v_buf, sinks):
    B, T, H, hd = qa.shape
    L = k_buf.shape[1]
    k = jnp.concatenate([k_buf.astype(ka.dtype), ka], axis=1)
    v = jnp.concatenate([v_buf.astype(va.dtype), va], axis=1)
    q_pos = (PAST_LEN + jnp.arange(T, dtype=jnp.int32))[None]
    k_pos = jnp.concatenate([PAST_LEN - L + jnp.arange(L, dtype=jnp.int32),
                             PAST_LEN + jnp.arange(T, dtype=jnp.int32)])[None]
    o = sink_window_attention(qa[:, None], k[:, None], v[:, None], q_pos, k_pos, sinks)
    return o.reshape(B, T, H * hd), k[:, -L:], v[:, -L:]


def retention(q, k, v, r0):
    B, T, H, dk = q.shape
    dv = v.shape[-1]
    C = math.gcd(T, RET_CHUNK)
    nc = T // C
    log_g = jnp.log1p(-jnp.exp2(-5.0 - jnp.arange(H, dtype=jnp.float32)))
    qf = q.astype(jnp.float32).reshape(B, nc, C, H, dk)
    kf = k.astype(jnp.float32).reshape(B, nc, C, H, dk)
    vf = v.astype(jnp.float32).reshape(B, nc, C, H, dv)
    idx = jnp.arange(C, dtype=jnp.float32)
    diff = idx[:, None] - idx[None, :]
    dmask = jnp.where(diff >= 0, jnp.exp(log_g[:, None, None] * jnp.maximum(diff, 0.0)), 0.0)
    scores = jnp.einsum('bcnhd,bcmhd->bchnm', qf, kf) * dmask[None, None]
    intra = jnp.einsum('bchnm,bcmhe->bcnhe', scores, vf)
    k_dec = jnp.exp(log_g[None, :] * (C - 1 - idx)[:, None])
    u = jnp.einsum('bcmhd,mh,bcmhe->bchde', kf, k_dec, vf)
    g_chunk = jnp.exp(log_g * C)[None, :, None, None]

    def step(r, u_c):
        return g_chunk * r + u_c, r

    r_fin, r_prev = lax.scan(step, r0.astype(jnp.float32), jnp.moveaxis(u, 1, 0))
    r_prev = jnp.moveaxis(r_prev, 0, 1)
    q_dec = jnp.exp(log_g[None, :] * (idx + 1.0)[:, None])
    inter = jnp.einsum('bcnhd,nh,bchde->bcnhe', qf, q_dec, r_prev)
    return (intra + inter).reshape(B, T, H, dv), r_fin


def head_norm(o, w):
    B, T, H, dv = o.shape
    mu = jnp.mean(o, axis=-1, keepdims=True)
    var = jnp.mean(jnp.square(o - mu), axis=-1, keepdims=True)
    y = ((o - mu) * lax.rsqrt(var + EPS)).reshape(B, T, H * dv)
    return y * w.astype(jnp.float32)


def merge(x, oa, ga, ob, gb, gn_w, w_out):
    ya = oa * jax.nn.silu(ga)
    yb = (head_norm(ob, gn_w) * jax.nn.silu(gb.astype(jnp.float32))).astype(x.dtype)
    y = jnp.concatenate([ya, yb], axis=-1)
    return x + jnp.einsum('bte,ed->btd', y, w_out)


def setup_inputs(seed: int = 0) -> dict:
    key = jax.random.key(seed)
    ks = jax.random.split(key, 11)
    w_buf = min(WINDOW, PAST_LEN)
    f32 = jnp.float32
    return {
        "x_prompt": jax.random.normal(ks[0], (BATCH, SEQ, D_MODEL), f32),
        "x_sample": jax.random.normal(ks[1], (DEC_BATCH, DEC_SEQ, D_MODEL), f32),
        "cache_k_win": jax.random.normal(ks[2], (DEPTH, DEC_BATCH, w_buf, N_KV_A, HD_A), f32),
        "cache_v_win": jax.random.normal(ks[3], (DEPTH, DEC_BATCH, w_buf, N_KV_A, HD_A), f32),
        "state_ret": 0.1 * jax.random.normal(ks[4], (DEPTH, DEC_BATCH, N_HEADS_B, HD_B, HD_B), f32),
        "norm_w": 1.0 + 0.02 * jax.random.normal(ks[5], (DEPTH, D_MODEL), f32),
        "w_in": jax.random.normal(ks[6], (DEPTH, D_MODEL, D_PROJ), f32) * (D_MODEL ** -0.5),
        "attn_sinks": 0.5 * jax.random.normal(ks[7], (DEPTH, N_HEADS_A), f32),
        "ret_norm_w": 1.0 + 0.02 * jax.random.normal(ks[8], (DEPTH, W_B), f32),
        "w_out": jax.random.normal(ks[9], (DEPTH, D_MIX, D_MODEL), f32) * (0.5 * D_MIX ** -0.5),
        "final_norm_w": 1.0 + 0.02 * jax.random.normal(ks[10], (D_MODEL,), f32),
    }


def reference(x_prompt, x_sample, cache_k_win, cache_v_win, state_ret,
              norm_w, w_in, attn_sinks, ret_norm_w, w_out, final_norm_w):
    xp, xs = x_prompt, x_sample
    Bp, Tp, _ = xp.shape
    Ts = xs.shape[1]
    pos_p = jnp.arange(Tp, dtype=jnp.int32)
    pos_s = PAST_LEN + jnp.arange(Ts, dtype=jnp.int32)
    keep_p = min(WINDOW, Tp)
    kp_l, vp_l, rp_l, ks_l, vs_l, rs_l = [], [], [], [], [], []
    for d in range(DEPTH):
        qa, ka, va, ga, qb, kb, vb, gb = project(xp, pos_p, norm_w[d], w_in[d])
        oa = prompt_window_attention(qa, ka, va, attn_sinks[d])
        r0 = jnp.zeros((Bp, N_HEADS_B, HD_B, HD_B), jnp.float32)
        ob, r_fin = retention(qb, kb, vb, r0)
        xp = merge(xp, oa, ga, ob, gb, ret_norm_w[d], w_out[d])
        kp_l.append(ka[:, Tp - keep_p:].astype(cache_k_win.dtype))
        vp_l.append(va[:, Tp - keep_p:].astype(cache_v_win.dtype))
        rp_l.append(r_fin.astype(state_ret.dtype))
        qa, ka, va, ga, qb, kb, vb, gb = project(xs, pos_s, norm_w[d], w_in[d])
        oa, k_new, v_new = sample_window_attention(qa, ka, va, cache_k_win[d], cache_v_win[d], attn_sinks[d])
        ob, r_fin = retention(qb, kb, vb, state_ret[d])
        xs = merge(xs, oa, ga, ob, gb, ret_norm_w[d], w_out[d])
        ks_l.append(k_new.astype(cache_k_win.dtype))
        vs_l.append(v_new.astype(cache_v_win.dtype))
        rs_l.append(r_fin.astype(state_ret.dtype))
    y_prompt = rmsnorm(xp, final_norm_w)
    y_sample = rmsnorm(xs, final_norm_w)
    return (y_prompt, y_sample,
            jnp.stack(kp_l), jnp.stack(vp_l), jnp.stack(rp_l),
            jnp.stack(ks_l), jnp.stack(vs_l), jnp.stack(rs_l))
```

```cpp
#include <hip/hip_runtime.h>
#include <hip/hip_cooperative_groups.h>
#include <cstdio>
#include <cstdint>
namespace cg = cooperative_groups;
namespace pg8 {
#define PG8_LAS __attribute__((address_space(3)))
typedef unsigned short bf16_t;
typedef short bf16x8 __attribute__((ext_vector_type(8)));
typedef float f32x4 __attribute__((ext_vector_type(4)));
typedef unsigned u32x4 __attribute__((ext_vector_type(4)));
constexpr int BM = 256, BK = 64, HALF = 128, HTB = HALF * BK * 2  , STAGE_BYTES = 8 * HTB, NXCD = 8, WGM = 8;

__host__ __device__ __forceinline__ int lds_byte(int r, int c) { const int st = (r >> 4) * 2 + (c >> 5), rr = r & 15, cc = c & 31, ob = rr * 64 + cc * 2; return st * 1024 + (ob ^ (((ob >> 9) & 1) << 5)); }
__host__ __device__ __forceinline__ void stage_rc(int b, int& R, int& C) { const int st = b / 1024, sb = b % 1024, swz = sb ^ (((sb >> 9) & 1) << 5); R = (st >> 1) * 16 + swz / 64; C = (st & 1) * 32 + (swz % 64) / 2; }
__host__ __device__ __forceinline__ int perm32(int rho) { const int n = rho >> 4, i = rho & 15; return 8 * (i >> 2) + 4 * n + (i & 3); }

struct Unit { int pm, pn; };
struct Gemm { const bf16_t* A; const bf16_t* Bt; int M, N, K; };

struct StaticOrder {
    int nM, nN, nwg, G, c;
    __host__ __device__ void init(int M, int N, int G_, int c_) { nM = M / BM; nN = N / BM; nwg = nM * nN; G = G_; c = c_; }
    __host__ __device__ bool next(int i, Unit& u) const {
        const long L = (long)i * G + c; if (L >= nwg) return false;
        int wgid = (int)L; { const int q = nwg / NXCD, r = nwg % NXCD, xcd = wgid % NXCD, off = wgid / NXCD; wgid = (xcd < r ? xcd * (q + 1) : r * (q + 1) + (xcd - r) * q) + off; }
        const int nig = WGM * nN, gid = wgid / nig, fm = gid * WGM, gsz = (nM - fm) < WGM ? (nM - fm) : WGM;
        u.pm = fm + ((wgid % nig) % gsz); u.pn = (wgid % nig) / gsz; return true;
    }
    __device__ __forceinline__ void a_ready(const Unit&) const {}
    __device__ __forceinline__ void done(const Unit&) const {}
};

__device__ __forceinline__ unsigned cvt_pk_bf16(float lo, float hi) { unsigned r; asm volatile("v_cvt_pk_bf16_f32 %0, %1, %2" : "=v"(r) : "v"(lo), "v"(hi)); return r; }
constexpr int T_ = 8192, NPROJ = 6400, DMODEL = 2048;
constexpr size_t O_KP = (size_t)8704 * 2048, O_VP = O_KP + 32768, O_RP = O_VP + 32768, O_KS = O_RP + 262144, O_VS = O_KS + 4194304, O_RS = O_VS + 4194304;

struct EpiProj {
    static constexpr bool PERM = true, AFTER_DRAIN = false;
    bf16_t* P; const float* rss; const float* cosA; const float* sinA; const float* cosB; const float* sinB; float* out; int layer;
    __device__ __forceinline__ void operator()(const f32x4 (&acc)[2][2][4][2], const Unit& u, int wr, int wc, int fr, int fq) const {
        float rv[2][4];
#pragma unroll
        for (int ai = 0; ai < 2; ++ai)
#pragma unroll
            for (int m = 0; m < 4; ++m) rv[ai][m] = rsqrtf(rss[u.pm * BM + ai * HALF + wr * 64 + m * 16 + fr] * (1.0f / 2048.0f) + 1e-6f);
#pragma unroll
        for (int bj = 0; bj < 2; ++bj) {
            const int cb = u.pn * BM + bj * HALF;
            const int c0 = cb + wc * 32 + 8 * fq;
            const int mode = (cb < 1152) ? 1 : ((cb >= 2304 && cb < 4352) ? 2 : 0);
            const int kvmode = (cb == 1024) ? 1 : ((cb == 1152) ? 2 : 0);
#pragma unroll
            for (int ai = 0; ai < 2; ++ai)
#pragma unroll
                for (int m = 0; m < 4; ++m) {
                    const int row = u.pm * BM + ai * HALF + wr * 64 + m * 16 + fr;
                    f32x4 v0 = acc[ai][bj][m][0] * rv[ai][m], v1 = acc[ai][bj][m][1] * rv[ai][m];
                    if (mode) {
                        const int pos = row < T_ ? row : T_ + ((row - T_) & 3);
                        f32x4 c, s;
                        if (mode == 1) { const int i = (c0 & 63) >> 3; c = *(const f32x4*)(cosA + pos * 32 + 4 * i); s = *(const f32x4*)(sinA + pos * 32 + 4 * i); }
                        else { const int i = (c0 & 127) >> 3; c = *(const f32x4*)(cosB + pos * 64 + 4 * i); s = *(const f32x4*)(sinB + pos * 64 + 4 * i); }
                        const f32x4 y0 = v0 * c - v1 * s, y1 = v1 * c + v0 * s; v0 = y0; v1 = y1;
                    }
                    u32x4 w; w.x = cvt_pk_bf16(v0[0], v0[1]); w.y = cvt_pk_bf16(v0[2], v0[3]); w.z = cvt_pk_bf16(v1[0], v1[1]); w.w = cvt_pk_bf16(v1[2], v1[3]);
                    *(u32x4*)(P + (size_t)row * NPROJ + c0) = w;
                    if (kvmode && row >= T_ - 128) {
                        const int kvh = (c0 - cb) >> 6, g0 = c0 & 63;
                        float* dst;
                        if (row < T_) dst = out + (kvmode == 1 ? O_KP : O_VP) + ((size_t)(layer * 128 + (row - (T_ - 128))) * 2 + kvh) * 64;
                        else { const int b = (row - T_) >> 2, t = (row - T_) & 3; dst = out + (kvmode == 1 ? O_KS : O_VS) + ((((size_t)layer * 128 + b) * 128 + 124 + t) * 2 + kvh) * 64; }
                        if (kvmode == 1) { const int i = g0 >> 3; *(f32x4*)(dst + 4 * i) = v0; *(f32x4*)(dst + 4 * i + 32) = v1; }
                        else { *(f32x4*)(dst + g0) = v0; *(f32x4*)(dst + g0 + 4) = v1; }
                    }
                }
        }
    }
};

struct EpiRes {
    static constexpr bool PERM = true, AFTER_DRAIN = false;
    const float* base_p; const float* base_s; float* outx; bf16_t* xa; float* rss;
    __device__ __forceinline__ void operator()(const f32x4 (&acc)[2][2][4][2], const Unit& u, int wr, int wc, int fr, int fq) const {
#pragma unroll
        for (int ai = 0; ai < 2; ++ai)
#pragma unroll
            for (int m = 0; m < 4; ++m) {
                const int row = u.pm * BM + ai * HALF + wr * 64 + m * 16 + fr;
                const float* bp = row < T_ ? base_p + (size_t)row * DMODEL : base_s + (size_t)(row - T_) * DMODEL;
                float ss = 0.f;
#pragma unroll
                for (int bj = 0; bj < 2; ++bj) {
                    const int c0 = u.pn * BM + bj * HALF + wc * 32 + 8 * fq;
                    const f32x4 b0 = *(const f32x4*)(bp + c0), b1 = *(const f32x4*)(bp + c0 + 4);
                    const f32x4 v0 = acc[ai][bj][m][0] + b0, v1 = acc[ai][bj][m][1] + b1;
                    *(f32x4*)(outx + (size_t)row * DMODEL + c0) = v0; *(f32x4*)(outx + (size_t)row * DMODEL + c0 + 4) = v1;
                    if (xa) { u32x4 w; w.x = cvt_pk_bf16(v0[0], v0[1]); w.y = cvt_pk_bf16(v0[2], v0[3]); w.z = cvt_pk_bf16(v1[0], v1[1]); w.w = cvt_pk_bf16(v1[2], v1[3]);
                        *(u32x4*)(xa + (size_t)row * DMODEL + c0) = w; }
                    ss += (v0[0] * v0[0] + v0[1] * v0[1]) + (v0[2] * v0[2] + v0[3] * v0[3]) + (v1[0] * v1[0] + v1[1] * v1[1]) + (v1[2] * v1[2] + v1[3] * v1[3]);
                }
                ss += __shfl_xor(ss, 16); ss += __shfl_xor(ss, 32);
                if (fq == 0) atomicAdd(rss + row, ss);
            }
    }
};

template <class Epi, class Sched, bool ALIGN_EPI = false, bool SP2 = false>
__device__ __forceinline__ void gemm_phase(PG8_LAS unsigned char* lds, const Gemm g, const Sched& S, const Epi& E) {
    const int tid = threadIdx.x, wid = __builtin_amdgcn_readfirstlane(tid >> 6), lane = tid & 63, wr = wid >> 2, wc = wid & 3, fr = lane & 15, fq = lane >> 4;
    const int K = g.K, nt = K / BK;
    unsigned voffA[2], voffB[2];
#pragma unroll
    for (int i = 0; i < 2; ++i) { int R, C; stage_rc(tid * 16 + i * 8192, R, C); const int Rb = Epi::PERM ? ((R & ~31) + perm32(R & 31)) : R;
        voffA[i] = (unsigned)(R * K + C) * 2u; voffB[i] = (unsigned)(Rb * K + C) * 2u; }
    const size_t kstep = (size_t)(BK * 2);
    const size_t hstep = (size_t)HALF * K * 2;
    const size_t tstep = 2 * hstep;
    const unsigned ldsw = (unsigned)wid * 1024u;
    const int aoff = lds_byte(wr * 64 + fr, fq * 8), boff = lds_byte(wc * 32 + fr, fq * 8);
#define PG8_SA(b, h) (((b) * 2 + (h)) * HTB)
#define PG8_SB(b, h) ((4 + (b) * 2 + (h)) * HTB)
#define PG8_STAGE(bufoff, gbase, voff) do { _Pragma("unroll") for (int _i = 0; _i < 2; ++_i) \
        __builtin_amdgcn_global_load_lds((const unsigned*)((const char*)(gbase) + (voff)[_i]), (PG8_LAS unsigned*)(lds + (bufoff) + ldsw + _i * 8192), 16, 0, 0); } while (0)
#define PG8_LDA(dst, b, h) do { _Pragma("unroll") for (int m = 0; m < 4; ++m) _Pragma("unroll") for (int k = 0; k < 2; ++k) dst[m][k] = *(const PG8_LAS bf16x8*)(lds + PG8_SA(b, h) + aoff + m * 2048 + k * 1024); } while (0)
#define PG8_LDB(dst, b, h) do { _Pragma("unroll") for (int n = 0; n < 2; ++n) _Pragma("unroll") for (int k = 0; k < 2; ++k) dst[n][k] = *(const PG8_LAS bf16x8*)(lds + PG8_SB(b, h) + boff + n * 2048 + k * 1024); } while (0)
#define PG8_MMA(ai, bj, At, Bt) do { __builtin_amdgcn_s_setprio(1); _Pragma("unroll") for (int m = 0; m < 4; ++m) _Pragma("unroll") for (int n = 0; n < 2; ++n) _Pragma("unroll") for (int k = 0; k < 2; ++k) \
        acc[ai][bj][m][n] = __builtin_amdgcn_mfma_f32_16x16x32_bf16(Bt[n][k], At[m][k], acc[ai][bj][m][n], 0, 0, 0); __builtin_amdgcn_s_setprio(0); } while (0)
#define PG8_WAIT_V(n) asm volatile("s_waitcnt vmcnt(" #n ")" ::: "memory")
#define PG8_WAIT_L(n) asm volatile("s_waitcnt lgkmcnt(" #n ")" ::: "memory")
#define PG8_BAR __builtin_amdgcn_s_barrier()
#define PG8_SCHED __builtin_amdgcn_sched_barrier(0)
    Unit cur, nxt; int ui = 0;
    if (!S.next(0, cur)) return;
    f32x4 acc[2][2][4][2];
#pragma unroll
    for (int a = 0; a < 2; ++a)
#pragma unroll
        for (int b = 0; b < 2; ++b)
#pragma unroll
            for (int m = 0; m < 4; ++m)
#pragma unroll
                for (int n = 0; n < 2; ++n) acc[a][b][m][n] = (f32x4){0.f, 0.f, 0.f, 0.f};
    bf16x8 At[4][2], B0[2][2], B1[2][2];
    const char* cA = (const char*)g.A + (size_t)cur.pm * tstep; const char* cB = (const char*)g.Bt + (size_t)cur.pn * tstep;
    S.a_ready(cur);
    if constexpr (SP2) {
        PG8_STAGE(PG8_SB(0, 0), cB, voffB); PG8_STAGE(PG8_SB(0, 1), cB + hstep, voffB); PG8_STAGE(PG8_SA(0, 0), cA, voffA); PG8_STAGE(PG8_SA(0, 1), cA + hstep, voffA);
        if (wr == 1) PG8_BAR;
        PG8_WAIT_V(2); PG8_BAR;
        PG8_STAGE(PG8_SB(1, 0), cB + kstep, voffB); PG8_STAGE(PG8_SA(1, 0), cA + kstep, voffA); PG8_STAGE(PG8_SB(1, 1), cB + hstep + kstep, voffB);
        PG8_WAIT_V(6); PG8_BAR;
    } else {
        PG8_STAGE(PG8_SB(0, 0), cB, voffB); PG8_STAGE(PG8_SA(0, 0), cA, voffA); PG8_STAGE(PG8_SB(0, 1), cB + hstep, voffB); PG8_STAGE(PG8_SA(0, 1), cA + hstep, voffA);
        if (wr == 1) PG8_BAR;
        PG8_WAIT_V(4); PG8_BAR;
        PG8_STAGE(PG8_SB(1, 0), cB + kstep, voffB); PG8_STAGE(PG8_SA(1, 0), cA + kstep, voffA); PG8_STAGE(PG8_SB(1, 1), cB + hstep + kstep, voffB);
        PG8_WAIT_V(6); PG8_BAR;
    }
    for (;;) {
        const bool has_next = S.next(ui + 1, nxt);
        const char* nA = has_next ? (const char*)g.A + (size_t)nxt.pm * tstep : cA; const char* nB = has_next ? (const char*)g.Bt + (size_t)nxt.pn * tstep : cB;
        for (int t = 0; t < nt; t += 2) {
            const bool last = (t == nt - 2);
            const char* a1 = cA + (size_t)(t + 1) * kstep;
            const char* a2 = last ? nA : cA + (size_t)(t + 2) * kstep; const char* b2 = last ? nB : cB + (size_t)(t + 2) * kstep;
            const char* a3 = a2 + kstep; const char* b3 = b2 + kstep;
            if (last && has_next) S.a_ready(nxt);
            if constexpr (SP2) {
            PG8_LDB(B0, 0, 0); PG8_LDB(B1, 0, 1); PG8_SCHED; PG8_LDA(At, 0, 0); PG8_STAGE(PG8_SA(1, 1), a1 + hstep, voffA);
            PG8_WAIT_V(8); PG8_WAIT_L(0); PG8_BAR; PG8_MMA(0, 0, At, B0); PG8_MMA(0, 1, At, B1); PG8_BAR; PG8_SCHED;
            PG8_LDA(At, 0, 1); PG8_STAGE(PG8_SB(0, 0), b2, voffB); PG8_STAGE(PG8_SB(0, 1), b2 + hstep, voffB); PG8_STAGE(PG8_SA(0, 0), a2, voffA);
            PG8_WAIT_V(8); PG8_WAIT_L(0); PG8_BAR; PG8_MMA(1, 0, At, B0); PG8_MMA(1, 1, At, B1); PG8_BAR; PG8_SCHED;
            PG8_LDB(B0, 1, 0); PG8_LDB(B1, 1, 1); PG8_SCHED; PG8_LDA(At, 1, 0); PG8_STAGE(PG8_SA(0, 1), a2 + hstep, voffA);
            PG8_WAIT_V(8); PG8_WAIT_L(0); PG8_BAR; PG8_MMA(0, 0, At, B0); PG8_MMA(0, 1, At, B1); PG8_BAR; PG8_SCHED;
            PG8_LDA(At, 1, 1); PG8_STAGE(PG8_SB(1, 0), b3, voffB); PG8_STAGE(PG8_SB(1, 1), b3 + hstep, voffB); PG8_STAGE(PG8_SA(1, 0), a3, voffA);
            PG8_WAIT_V(8); PG8_WAIT_L(0); PG8_BAR; PG8_MMA(1, 0, At, B0); PG8_MMA(1, 1, At, B1); PG8_BAR; PG8_SCHED;
            } else {
            PG8_LDB(B0, 0, 0); PG8_SCHED; PG8_LDA(At, 0, 0); PG8_STAGE(PG8_SA(1, 1), a1 + hstep, voffA);
            PG8_WAIT_L(8); PG8_BAR; PG8_WAIT_L(0); PG8_MMA(0, 0, At, B0); PG8_BAR; PG8_SCHED;
            PG8_LDB(B1, 0, 1); PG8_STAGE(PG8_SB(0, 0), b2, voffB);
            PG8_BAR; PG8_WAIT_L(0); PG8_MMA(0, 1, At, B1); PG8_BAR;
            PG8_LDA(At, 0, 1); PG8_STAGE(PG8_SA(0, 0), a2, voffA);
            PG8_BAR; PG8_WAIT_L(0); PG8_MMA(1, 0, At, B0); PG8_BAR; PG8_SCHED;
            PG8_STAGE(PG8_SB(0, 1), b2 + hstep, voffB);
            PG8_WAIT_V(6); PG8_BAR; PG8_MMA(1, 1, At, B1); PG8_BAR;
            PG8_LDB(B0, 1, 0); PG8_SCHED; PG8_LDA(At, 1, 0); PG8_STAGE(PG8_SA(0, 1), a2 + hstep, voffA);
            PG8_WAIT_L(8); PG8_BAR; PG8_WAIT_L(0); PG8_MMA(0, 0, At, B0); PG8_BAR; PG8_SCHED;
            PG8_LDB(B1, 1, 1); PG8_STAGE(PG8_SB(1, 0), b3, voffB);
            PG8_BAR; PG8_WAIT_L(0); PG8_MMA(0, 1, At, B1); PG8_BAR;
            PG8_LDA(At, 1, 1); PG8_STAGE(PG8_SA(1, 0), a3, voffA);
            PG8_BAR; PG8_WAIT_L(0); PG8_MMA(1, 0, At, B0); PG8_BAR; PG8_SCHED;
            PG8_STAGE(PG8_SB(1, 1), b3 + hstep, voffB);
            PG8_WAIT_V(6); PG8_BAR; PG8_MMA(1, 1, At, B1); PG8_BAR;
            }
        }
        if constexpr (ALIGN_EPI) { if (wr == 0) PG8_BAR; }
        if constexpr (!Epi::AFTER_DRAIN) { E(acc, cur, wr, wc, fr, fq); S.done(cur); }
        if (!has_next) break;
#pragma unroll
        for (int a = 0; a < 2; ++a)
#pragma unroll
            for (int b = 0; b < 2; ++b)
#pragma unroll
                for (int m = 0; m < 4; ++m)
#pragma unroll
                    for (int n = 0; n < 2; ++n) acc[a][b][m][n] = (f32x4){0.f, 0.f, 0.f, 0.f};
        cur = nxt; cA = nA; cB = nB; ++ui;
        if constexpr (ALIGN_EPI) { if (wr == 1) PG8_BAR; }
    }
    PG8_WAIT_V(0);
    if constexpr (!ALIGN_EPI) { if (wr == 0) PG8_BAR; }
    PG8_BAR;
    if constexpr (Epi::AFTER_DRAIN) { E.fused(acc, cur, wr, wc, fr, fq, lds, wid, lane); S.done(cur); }
#undef PG8_SA
#undef PG8_SB
#undef PG8_STAGE
#undef PG8_LDA
#undef PG8_LDB
#undef PG8_MMA
#undef PG8_WAIT_V
#undef PG8_WAIT_L
#undef PG8_BAR
#undef PG8_SCHED
}
}

typedef unsigned short bf16;
typedef float f32x4 __attribute__((ext_vector_type(4)));
typedef short bf16x8 __attribute__((ext_vector_type(8)));
typedef short s16x4 __attribute__((ext_vector_type(4)));
typedef unsigned u32x4 __attribute__((ext_vector_type(4)));
typedef unsigned u32x2 __attribute__((ext_vector_type(2)));
typedef float f32x2 __attribute__((ext_vector_type(2)));
typedef __bf16 bf16x2_t __attribute__((ext_vector_type(2)));
#define LAS __attribute__((address_space(3)))

constexpr int T = 8192, NS = 512, M = 8704, D = 2048, NP = 6400, DEPTH = 2;
constexpr int C_QA = 0, C_KA = 1024, C_VA = 1152, C_GA = 1280, C_QB = 2304, C_KB = 3328, C_VB = 4352, C_GB = 5376;
constexpr int NPOS = 8196;
constexpr int LDS_BYTES = 147456;
constexpr int NTHREADS = 512;
using pg8::O_KP; using pg8::O_VP; using pg8::O_RP; using pg8::O_KS; using pg8::O_VS; using pg8::O_RS;

constexpr size_t MiB = 1u << 20;
constexpr size_t WS_CTL = 0, CTL_BYTES = 1 * MiB;
constexpr size_t WS_WIN = 2 * MiB;
constexpr size_t WS_WOUT = WS_WIN + 50 * MiB;
constexpr size_t WS_XA = WS_WOUT + 16 * MiB;
constexpr size_t WS_P = WS_XA + 34 * MiB;
constexpr size_t WS_Y = WS_P + 107 * MiB;
constexpr size_t WS_XR = WS_Y + 34 * MiB;
constexpr size_t WS_U = WS_XR + 68 * MiB;
constexpr size_t WS_RT = WS_U + 32 * MiB;
constexpr size_t WS_TAB = WS_RT + 16 * MiB;
constexpr size_t WS_END = WS_TAB + 8 * MiB;

struct Ctx {
    const float *x_prompt, *x_sample, *cache_k, *cache_v, *state, *norm_w, *w_in, *sinks, *ret_norm_w, *w_out, *final_w;
    float* out; unsigned char* ws;
    int ph_lo, ph_hi;
};

__device__ __forceinline__ unsigned cvtpk(float lo, float hi) { f32x2 v = {lo, hi}; bf16x2_t b = __builtin_convertvector(v, bf16x2_t); return __builtin_bit_cast(unsigned, b); }
__device__ __forceinline__ float bf_lo(unsigned u) { return __uint_as_float(u << 16); }
__device__ __forceinline__ float bf_hi(unsigned u) { return __uint_as_float(u & 0xffff0000u); }
__device__ __forceinline__ float silu_f(float x) { return x / (1.0f + __expf(-x)); }
__device__ __forceinline__ s16x4 vtr(const char* p) { typedef short v4i16_t __attribute__((ext_vector_type(4)));
    return __builtin_bit_cast(s16x4, __builtin_amdgcn_ds_read_tr16_b64_v4i16((LAS v4i16_t*)p)); }
__device__ __forceinline__ bf16x8 cat8(s16x4 lo, s16x4 hi) { return (bf16x8){lo[0], lo[1], lo[2], lo[3], hi[0], hi[1], hi[2], hi[3]}; }
__device__ __forceinline__ float ln_gamma(int h) {
    const double x = __builtin_ldexp(1.0, -5 - h);
    double s = 0.0, p = x;
#pragma unroll
    for (int k = 1; k <= 9; ++k) { s += p / (double)k; p *= x; }
    return (float)(-s);
}
#define LDS_WAIT() asm volatile("s_waitcnt lgkmcnt(0)" ::: "memory")
#define LAUNDER_V(x) asm volatile("" : "+v"(x))
#define LAUNDER_S(x) asm volatile("" : "+s"(x))

__device__ __forceinline__ int perm_src_col(int np, float& sc) {
    sc = 1.0f;
    if (np < 1152) { const int hb = np & ~63, g = np & 63; if (np < 1024) sc = 0.125f; return hb + 4 * (g >> 3) + (g & 3) + 32 * ((g >> 2) & 1); }
    if (np >= C_QB && np < C_VB) { const int hb = np & ~127, g = np & 127; if (np >= C_KB) sc = 0.08838834764831845f; return hb + 4 * (g >> 3) + (g & 3) + 64 * ((g >> 2) & 1); }
    return np;
}

template <bool WIN>
__device__ __forceinline__ void transpose_item(const float* W, int N, const float* nw, bf16* WT, float* scr, int kb, int nb, int lane) {
    const int k0 = 64 * kb, n0 = 64 * nb, l16 = lane & 15, r4 = lane >> 4;
    float sc = 1.0f; int srcc = n0 + 4 * l16;
    if (WIN) srcc = perm_src_col(n0 + 4 * l16, sc);
#pragma unroll 4
    for (int i = 0; i < 16; ++i) {
        const int kk = 4 * i + r4;
        const f32x4 v = *(const f32x4*)(W + (size_t)(k0 + kk) * N + srcc);
        float s2 = sc; if (WIN) s2 *= nw[k0 + kk];
        float* d = scr + kk * 65 + 4 * l16;
        d[0] = v[0] * s2; d[1] = v[1] * s2; d[2] = v[2] * s2; d[3] = v[3] * s2;
    }
    LDS_WAIT();
    const int c = lane & 7;
#pragma unroll
    for (int j = 0; j < 8; ++j) {
        const int n = (lane >> 3) + 8 * j; const float* s = scr + (8 * c) * 65 + n;
        u32x4 o; o.x = cvtpk(s[0], s[65]); o.y = cvtpk(s[130], s[195]); o.z = cvtpk(s[260], s[325]); o.w = cvtpk(s[390], s[455]);
        *(u32x4*)(WT + (size_t)(n0 + n) * 2048 + k0 + 8 * c) = o;
    }
    LDS_WAIT();
}

__device__ __forceinline__ void p0_prologue(const Ctx& C, char* lds, int tid, int wave, int lane, int G) {
    float* scr = (float*)(lds + wave * 16640);
    const int gw = blockIdx.x * 8 + wave, NGW = G * 8;
    bf16* WIN = (bf16*)(C.ws + WS_WIN); bf16* WOUT = (bf16*)(C.ws + WS_WOUT);
    constexpr int I_IN = 32 * 100, I_OUT = 32 * 32, NITEMS = 2 * (I_IN + I_OUT);
    for (int it = gw; it < NITEMS; it += NGW) {
        int r = it;
        if (r < 2 * I_IN) { const int l = r / I_IN; r -= l * I_IN; const int nb = r % 100, kb = r / 100;
            transpose_item<true>(C.w_in + (size_t)l * D * NP, NP, C.norm_w + l * D, WIN + (size_t)l * NP * D, scr, kb, nb, lane); }
        else { r -= 2 * I_IN; const int l = r / I_OUT; r -= l * I_OUT; const int nb = r & 31, kb = r >> 5;
            transpose_item<false>(C.w_out + (size_t)l * D * D, D, nullptr, WOUT + (size_t)l * D * D, scr, kb, nb, lane); }
    }
    bf16* XA = (bf16*)(C.ws + WS_XA); float* rss = (float*)(C.ws + WS_CTL);
    for (int m = gw; m < M; m += NGW) {
        const float* xr = m < T ? C.x_prompt + (size_t)m * D : C.x_sample + (size_t)(m - T) * D;
        float ss = 0.f;
#pragma unroll
        for (int j = 0; j < 8; ++j) {
            const f32x4 v = *((const f32x4*)xr + lane + 64 * j);
            ss += (v[0] * v[0] + v[1] * v[1]) + (v[2] * v[2] + v[3] * v[3]);
            u32x2 o; o.x = cvtpk(v[0], v[1]); o.y = cvtpk(v[2], v[3]);
            *((u32x2*)(XA + (size_t)m * D) + lane + 64 * j) = o;
        }
#pragma unroll
        for (int o = 1; o < 64; o <<= 1) ss += __shfl_xor(ss, o);
        if (lane == 0) rss[m] = ss;
    }
    float* cosA = (float*)(C.ws + WS_TAB); float* sinA = cosA + NPOS * 32; float* cosB = sinA + NPOS * 32; float* sinB = cosB + NPOS * 64;
    for (int i = blockIdx.x * NTHREADS + tid; i < NPOS * 96; i += G * NTHREADS) {
        int pos, f, half; float *pc, *ps;
        if (i < NPOS * 32) { pos = i >> 5; f = i & 31; half = 32; pc = cosA + i; ps = sinA + i; }
        else { const int k = i - NPOS * 32; pos = k >> 6; f = k & 63; half = 64; pc = cosB + k; ps = sinB + k; }
        const double rr = half == 32 ? 0.7498942093324559 : 0.8659643233600653;
        double inv = 1.0; for (int k = 0; k < f; ++k) inv *= rr;
        const float ang = (float)pos * (float)inv;
        const double a = (double)ang;
        const double qd = __builtin_rint(a * 0.6366197723675814);
        double r = __builtin_fma(-qd, 1.5707963267948966, a); r = __builtin_fma(-qd, 6.123233995736766e-17, r);
        const double r2 = r * r;
        double sp = -1.0 / 39916800.0; sp = sp * r2 + 1.0 / 362880.0; sp = sp * r2 - 1.0 / 5040.0; sp = sp * r2 + 1.0 / 120.0; sp = sp * r2 - 1.0 / 6.0; sp = sp * r2 + 1.0; sp *= r;
        double cp = 1.0 / 479001600.0; cp = cp * r2 - 1.0 / 3628800.0; cp = cp * r2 + 1.0 / 40320.0; cp = cp * r2 - 1.0 / 720.0; cp = cp * r2 + 1.0 / 24.0; cp = cp * r2 - 0.5; cp = cp * r2 + 1.0;
        const int qi = ((int)qd) & 3;
        const double sv = (qi == 0) ? sp : (qi == 1) ? cp : (qi == 2) ? -sp : -cp;
        const double cv = (qi == 0) ? cp : (qi == 1) ? -sp : (qi == 2) ? -cp : sp;
        *pc = (float)cv; *ps = (float)sv;
    }
}

__device__ __forceinline__ void attn_prompt_unit(const Ctx& C, char* lds, int layer, int blk, int kvh, int hq, int tid, int w, int lane) {
    const bf16* P = (const bf16*)(C.ws + WS_P); bf16* Y = (bf16*)(C.ws + WS_Y);
    char* Ks = lds; char* Vs = lds + 36864;
#pragma unroll
    for (int it = 0; it < 4; ++it) {
        const int r = (tid >> 3) + 64 * it, ch = tid & 7, krow = blk * 128 - 128 + r;
        u32x4 kv = (u32x4){0u, 0u, 0u, 0u}, vv = kv;
        if (krow >= 0) { kv = *(const u32x4*)(P + (size_t)krow * NP + C_KA + kvh * 64 + ch * 8); vv = *(const u32x4*)(P + (size_t)krow * NP + C_VA + kvh * 64 + ch * 8); }
        *(u32x4*)(Ks + r * 144 + ch * 16) = kv; *(u32x4*)(Vs + r * 144 + ch * 16) = vv;
    }
    __syncthreads();
    const int q = lane & 15, g = lane >> 4;
    const int jt0 = w < 6 ? w : 6;
    const int iq = 16 * w + q, row = blk * 128 + iq;
    for (int hh = 0; hh < 4; ++hh) {
        const int h = kvh * 8 + hq * 4 + hh;
        bf16x8 qf[2];
#pragma unroll
        for (int ks = 0; ks < 2; ++ks) qf[ks] = *(const bf16x8*)(P + (size_t)row * NP + C_QA + h * 64 + 32 * ks + 8 * g);
        f32x4 s[10];
        float mx = -INFINITY;
        int lo = (blk > 0 || iq + 1 >= 128) ? iq + 1 : 128; LAUNDER_V(lo);
        const unsigned span = (unsigned)(iq + 128 - lo);
#pragma unroll
        for (int tt = 0; tt < 10; ++tt) {
            const int jt = jt0 + tt;
            f32x4 a = (f32x4){0.f, 0.f, 0.f, 0.f};
#pragma unroll
            for (int ks = 0; ks < 2; ++ks) { const bf16x8 kf = *(const bf16x8*)(Ks + (16 * jt + q) * 144 + (32 * ks + 8 * g) * 2); a = __builtin_amdgcn_mfma_f32_16x16x32_bf16(kf, qf[ks], a, 0, 0, 0); }
#pragma unroll
            for (int j = 0; j < 4; ++j) {
                const int jj = 16 * jt + 4 * g + j;
                a[j] = ((unsigned)(jj - lo) <= span) ? a[j] : -INFINITY; mx = fmaxf(mx, a[j]);
            }
            s[tt] = a;
        }
        mx = fmaxf(mx, __shfl_xor(mx, 16)); mx = fmaxf(mx, __shfl_xor(mx, 32));
        const float sink = C.sinks[layer * 16 + h];
        const float mm = fmaxf(mx, sink);
        float sum = 0.f;
#pragma unroll
        for (int tt = 0; tt < 10; ++tt)
#pragma unroll
            for (int j = 0; j < 4; ++j) { const float e = __expf(s[tt][j] - mm); s[tt][j] = e; sum += e; }
        sum += __shfl_xor(sum, 16); sum += __shfl_xor(sum, 32);
        const float inv = 1.0f / (sum + __expf(sink - mm));
        f32x4 o[4];
#pragma unroll
        for (int dt = 0; dt < 4; ++dt) o[dt] = (f32x4){0.f, 0.f, 0.f, 0.f};
#pragma unroll
        for (int pr = 0; pr < 5; ++pr) {
            const int jt = jt0 + 2 * pr;
            u32x4 pw; pw.x = cvtpk(s[2 * pr][0], s[2 * pr][1]); pw.y = cvtpk(s[2 * pr][2], s[2 * pr][3]); pw.z = cvtpk(s[2 * pr + 1][0], s[2 * pr + 1][1]); pw.w = cvtpk(s[2 * pr + 1][2], s[2 * pr + 1][3]);
            const bf16x8 pf = __builtin_bit_cast(bf16x8, pw);
#pragma unroll
            for (int dt = 0; dt < 4; ++dt) {
                const char* a0 = Vs + (16 * jt + 4 * g + (q >> 2)) * 144 + (16 * dt + 4 * (q & 3)) * 2;
                const s16x4 lo = vtr(a0), hi = vtr(a0 + 16 * 144);
                o[dt] = __builtin_amdgcn_mfma_f32_16x16x32_bf16(cat8(lo, hi), pf, o[dt], 0, 0, 0);
            }
        }
#pragma unroll
        for (int dt = 0; dt < 4; ++dt) {
            const int dcol = h * 64 + 16 * dt + 4 * g;
            const u32x2 gt = *(const u32x2*)(P + (size_t)row * NP + C_GA + dcol);
            u32x2 yo; yo.x = cvtpk(o[dt][0] * inv * silu_f(bf_lo(gt.x)), o[dt][1] * inv * silu_f(bf_hi(gt.x)));
            yo.y = cvtpk(o[dt][2] * inv * silu_f(bf_lo(gt.y)), o[dt][3] * inv * silu_f(bf_hi(gt.y)));
            *(u32x2*)(Y + (size_t)row * D + dcol) = yo;
        }
    }
    __syncthreads();
}

template <bool SCALE>
__device__ __forceinline__ void stage128(char* dst, const bf16* src, size_t src_pitch, int tid, float lng) {
#pragma unroll
    for (int it = 0; it < 4; ++it) {
        const int r = (tid >> 4) + 32 * it, ch = tid & 15;
        u32x4 v = *(const u32x4*)(src + (size_t)r * src_pitch + ch * 8);
        if (SCALE) { const float sc = __expf((float)(127 - r) * lng);
            v.x = cvtpk(bf_lo(v.x) * sc, bf_hi(v.x) * sc); v.y = cvtpk(bf_lo(v.y) * sc, bf_hi(v.y) * sc); v.z = cvtpk(bf_lo(v.z) * sc, bf_hi(v.z) * sc); v.w = cvtpk(bf_lo(v.w) * sc, bf_hi(v.w) * sc); }
        *(u32x4*)(dst + r * 272 + ch * 16) = v;
    }
}

__device__ __forceinline__ void ret_u_unit(const Ctx& C, char* lds, int c, int h, int tid, int w, int lane) {
    const bf16* P = (const bf16*)(C.ws + WS_P); float* U = (float*)(C.ws + WS_U);
    char* Ks = lds; char* Vs = lds + 34816;
    const float lng = ln_gamma(h);
    stage128<false>(Ks, P + (size_t)(c * 128) * NP + C_KB + h * 128, NP, tid, lng);
    stage128<true>(Vs, P + (size_t)(c * 128) * NP + C_VB + h * 128, NP, tid, lng);
    __syncthreads();
    const int q = lane & 15, g = lane >> 4;
    f32x4 acc[8];
#pragma unroll
    for (int dt = 0; dt < 8; ++dt) acc[dt] = (f32x4){0.f, 0.f, 0.f, 0.f};
#pragma unroll
    for (int ks = 0; ks < 4; ++ks) {
        const int rbase = (32 * ks + 8 * g + (q >> 2)) * 272 + 4 * (q & 3) * 2;
        const bf16x8 vf = cat8(vtr(Vs + rbase + 32 * w), vtr(Vs + rbase + 32 * w + 4 * 272));
#pragma unroll
        for (int dt = 0; dt < 8; ++dt) {
            const bf16x8 kf = cat8(vtr(Ks + rbase + 32 * dt), vtr(Ks + rbase + 32 * dt + 4 * 272));
            acc[dt] = __builtin_amdgcn_mfma_f32_16x16x32_bf16(vf, kf, acc[dt], 0, 0, 0);
        }
    }
    float* Ub = U + (size_t)(c * 8 + h) * 16384;
#pragma unroll
    for (int dt = 0; dt < 8; ++dt)
#pragma unroll
        for (int j = 0; j < 4; ++j) Ub[(16 * w + 4 * g + j) * 128 + 16 * dt + q] = acc[dt][j];
    __syncthreads();
}

__device__ __forceinline__ void ret_scan(const Ctx& C, int layer, int tid, int G) {
    const float* U = (const float*)(C.ws + WS_U); bf16* Rt = (bf16*)(C.ws + WS_RT);
    for (int i = blockIdx.x * NTHREADS + tid; i < 8 * 16384; i += G * NTHREADS) {
        const int h = i >> 14, e = (i >> 7) & 127, d = i & 127;
        const float gc = __expf(128.0f * ln_gamma(h));
        float r = 0.f;
#pragma unroll 1
        for (int c0 = 0; c0 < 64; c0 += 8) {
            float u[8];
#pragma unroll
            for (int k = 0; k < 8; ++k) u[k] = U[(size_t)((c0 + k) * 8) * 16384 + i];
#pragma unroll
            for (int k = 0; k < 8; ++k) { Rt[(size_t)((c0 + k) * 8) * 16384 + i] = (bf16)(cvtpk(r, 0.f) & 0xffffu); r = gc * r + u[k]; }
        }
        const int dorig = 4 * (d >> 3) + (d & 3) + 64 * ((d >> 2) & 1);
        C.out[O_RP + ((size_t)(layer * 8 + h) * 128 + dorig) * 128 + e] = r;
    }
}

__device__ __forceinline__ void ret_prompt_unit(const Ctx& C, char* lds, int layer, int c, int h, int tid, int w, int lane) {
    const bf16* P = (const bf16*)(C.ws + WS_P); bf16* Y = (bf16*)(C.ws + WS_Y); const bf16* Rt = (const bf16*)(C.ws + WS_RT);
    char* Ks = lds; char* Vs = lds + 34816; char* Rs = lds + 69632;
    const float lng = ln_gamma(h);
    stage128<false>(Ks, P + (size_t)(c * 128) * NP + C_KB + h * 128, NP, tid, lng);
    stage128<false>(Vs, P + (size_t)(c * 128) * NP + C_VB + h * 128, NP, tid, lng);
    stage128<false>(Rs, Rt + (size_t)(c * 8 + h) * 16384, 128, tid, lng);
    __syncthreads();
    const int q = lane & 15, g = lane >> 4;
    const int n = 16 * w + q, row = c * 128 + n;
    bf16x8 qf[4];
#pragma unroll
    for (int ks = 0; ks < 4; ++ks) qf[ks] = *(const bf16x8*)(P + (size_t)row * NP + C_QB + h * 128 + 32 * ks + 8 * g);
    unsigned pk[8][2];
#pragma unroll
    for (int mt = 0; mt < 8; ++mt) {
        pk[mt][0] = 0u; pk[mt][1] = 0u;
        if (mt <= w) {
            f32x4 a = (f32x4){0.f, 0.f, 0.f, 0.f};
#pragma unroll
            for (int ks = 0; ks < 4; ++ks) { const bf16x8 kf = *(const bf16x8*)(Ks + (16 * mt + q) * 272 + (32 * ks + 8 * g) * 2); a = __builtin_amdgcn_mfma_f32_16x16x32_bf16(kf, qf[ks], a, 0, 0, 0); }
            float v[4];
#pragma unroll
            for (int j = 0; j < 4; ++j) { const int dl = n - (16 * mt + 4 * g + j); v[j] = dl >= 0 ? a[j] * __expf((float)dl * lng) : 0.f; }
            pk[mt][0] = cvtpk(v[0], v[1]); pk[mt][1] = cvtpk(v[2], v[3]);
        }
    }
    f32x4 oi[8], ox[8];
#pragma unroll
    for (int et = 0; et < 8; ++et) { oi[et] = (f32x4){0.f, 0.f, 0.f, 0.f}; ox[et] = oi[et]; }
#pragma unroll
    for (int pr = 0; pr < 4; ++pr) {
        if (2 * pr <= w) {
            u32x4 pw; pw.x = pk[2 * pr][0]; pw.y = pk[2 * pr][1]; pw.z = pk[2 * pr + 1][0]; pw.w = pk[2 * pr + 1][1];
            const bf16x8 pf = __builtin_bit_cast(bf16x8, pw);
#pragma unroll
            for (int et = 0; et < 8; ++et) {
                const char* a0 = Vs + (32 * pr + 4 * g + (q >> 2)) * 272 + (16 * et + 4 * (q & 3)) * 2;
                oi[et] = __builtin_amdgcn_mfma_f32_16x16x32_bf16(cat8(vtr(a0), vtr(a0 + 16 * 272)), pf, oi[et], 0, 0, 0);
            }
        }
    }
#pragma unroll
    for (int et = 0; et < 8; ++et)
#pragma unroll
        for (int ks = 0; ks < 4; ++ks) { const bf16x8 rf = *(const bf16x8*)(Rs + (16 * et + q) * 272 + (32 * ks + 8 * g) * 2); ox[et] = __builtin_amdgcn_mfma_f32_16x16x32_bf16(rf, qf[ks], ox[et], 0, 0, 0); }
    const float qdec = __expf((float)(n + 1) * lng);
    float sum = 0.f;
#pragma unroll
    for (int et = 0; et < 8; ++et) { oi[et] = oi[et] + ox[et] * qdec; sum += (oi[et][0] + oi[et][1]) + (oi[et][2] + oi[et][3]); }
    sum += __shfl_xor(sum, 16); sum += __shfl_xor(sum, 32);
    const float mu = sum * (1.0f / 128.0f);
    float var = 0.f;
#pragma unroll
    for (int et = 0; et < 8; ++et) { oi[et] = oi[et] - mu; var += (oi[et][0] * oi[et][0] + oi[et][1] * oi[et][1]) + (oi[et][2] * oi[et][2] + oi[et][3] * oi[et][3]); }
    var += __shfl_xor(var, 16); var += __shfl_xor(var, 32);
    const float rs = rsqrtf(var * (1.0f / 128.0f) + 1e-6f);
    const float* gw = C.ret_norm_w + layer * 1024 + h * 128;
#pragma unroll
    for (int et = 0; et < 8; ++et) {
        const int e0 = 16 * et + 4 * g;
        const u32x2 gt = *(const u32x2*)(P + (size_t)row * NP + C_GB + h * 128 + e0);
        const f32x4 wv = *(const f32x4*)(gw + e0);
        u32x2 yo; yo.x = cvtpk(oi[et][0] * rs * wv[0] * silu_f(bf_lo(gt.x)), oi[et][1] * rs * wv[1] * silu_f(bf_hi(gt.x)));
        yo.y = cvtpk(oi[et][2] * rs * wv[2] * silu_f(bf_lo(gt.y)), oi[et][3] * rs * wv[3] * silu_f(bf_hi(gt.y)));
        *(u32x2*)(Y + (size_t)row * D + 1024 + h * 128 + e0) = yo;
    }
    __syncthreads();
}

__device__ __forceinline__ void attn_sample_unit(const Ctx& C, char* lds, int layer, int b, int kvh, int tid) {
    const bf16* P = (const bf16*)(C.ws + WS_P); bf16* Y = (bf16*)(C.ws + WS_Y);
    float* Qs = (float*)lds;
    float* Kl = Qs + 32 * 65;
    float* Vl = Kl + 132 * 65;
    float* Pm = Vl + 132 * 68;
    const float* ck = C.cache_k + ((size_t)(layer * 128 + b) * 128) * 128 + kvh * 64;
    const float* cv = C.cache_v + ((size_t)(layer * 128 + b) * 128) * 128 + kvh * 64;
    float* ok = C.out + O_KS + ((size_t)(layer * 128 + b) * 128) * 128 + kvh * 64;
    float* ov = C.out + O_VS + ((size_t)(layer * 128 + b) * 128) * 128 + kvh * 64;
    for (int i = tid; i < 128 * 16; i += NTHREADS) {
        const int r = i >> 4, c4 = i & 15;
        const f32x4 k = *(const f32x4*)(ck + (size_t)r * 128 + 4 * c4), v = *(const f32x4*)(cv + (size_t)r * 128 + 4 * c4);
        float* kd = Kl + r * 65 + 4 * c4; kd[0] = k[0]; kd[1] = k[1]; kd[2] = k[2]; kd[3] = k[3];
        *(f32x4*)(Vl + r * 68 + 4 * c4) = v;
        if (r >= 4) { *(f32x4*)(ok + (size_t)(r - 4) * 128 + 4 * c4) = k; *(f32x4*)(ov + (size_t)(r - 4) * 128 + 4 * c4) = v; }
    }
    if (tid < 256) { const int t = tid >> 6, g = tid & 63; const size_t ro = (size_t)(T + 4 * b + t) * NP;
        const int dk = 4 * (g >> 3) + (g & 3) + 32 * ((g >> 2) & 1);
        Kl[(128 + t) * 65 + dk] = __uint_as_float((unsigned)P[ro + C_KA + kvh * 64 + g] << 16);
        Vl[(128 + t) * 68 + g] = __uint_as_float((unsigned)P[ro + C_VA + kvh * 64 + g] << 16); }
    for (int i = tid; i < 32 * 64; i += NTHREADS) {
        const int r = i >> 6, g = i & 63, hg = r >> 2, t = r & 3;
        const int dk = 4 * (g >> 3) + (g & 3) + 32 * ((g >> 2) & 1);
        Qs[r * 65 + dk] = __uint_as_float((unsigned)P[(size_t)(T + 4 * b + t) * NP + C_QA + (kvh * 8 + hg) * 64 + g] << 16);
    }
    __syncthreads();
    {
        const int r = tid >> 4, kg = tid & 15, t = r & 3, h = kvh * 8 + (r >> 2);
        float mx = -INFINITY;
#pragma unroll 1
        for (int it = 0; it < 9; ++it) {
            const int kk = kg + 16 * it;
            float a = -INFINITY;
            if (kk < 132) {
                const bool valid = kk < 128 ? (kk > t) : (kk - 128 <= t);
                if (valid) { a = 0.f;
#pragma unroll 16
                    for (int d = 0; d < 64; ++d) a += Qs[r * 65 + d] * Kl[kk * 65 + d]; }
                Pm[r * 133 + kk] = a;
            }
            mx = fmaxf(mx, a);
        }
#pragma unroll
        for (int o = 1; o < 16; o <<= 1) mx = fmaxf(mx, __shfl_xor(mx, o));
        const float sink = C.sinks[layer * 16 + h];
        const float mm = fmaxf(mx, sink);
        float sum = 0.f;
#pragma unroll 1
        for (int it = 0; it < 9; ++it) { const int kk = kg + 16 * it; if (kk < 132) { const float e = __expf(Pm[r * 133 + kk] - mm); Pm[r * 133 + kk] = e; sum += e; } }
#pragma unroll
        for (int o = 1; o < 16; o <<= 1) sum += __shfl_xor(sum, o);
        const float inv = 1.0f / (sum + __expf(sink - mm));
#pragma unroll 1
        for (int it = 0; it < 9; ++it) { const int kk = kg + 16 * it; if (kk < 132) Pm[r * 133 + kk] *= inv; }
    }
    __syncthreads();
    {
        const int r = tid >> 4, dq = tid & 15, t = r & 3, h = kvh * 8 + (r >> 2);
        f32x4 o = (f32x4){0.f, 0.f, 0.f, 0.f};
        for (int kk = 0; kk < 132; ++kk) { const float p = Pm[r * 133 + kk]; const f32x4 v = *(const f32x4*)(Vl + kk * 68 + 4 * dq); o += v * p; }
        const size_t row = (size_t)(T + 4 * b + t);
        const u32x2 gt = *(const u32x2*)(P + row * NP + C_GA + h * 64 + 4 * dq);
        u32x2 yo; yo.x = cvtpk(o[0] * silu_f(bf_lo(gt.x)), o[1] * silu_f(bf_hi(gt.x))); yo.y = cvtpk(o[2] * silu_f(bf_lo(gt.y)), o[3] * silu_f(bf_hi(gt.y)));
        *(u32x2*)(Y + row * D + h * 64 + 4 * dq) = yo;
    }
    __syncthreads();
}

__device__ __forceinline__ void ret_sample_unit(const Ctx& C, char* lds, int layer, int b, int h, int tid, int w, int lane) {
    const bf16* P = (const bf16*)(C.ws + WS_P); bf16* Y = (bf16*)(C.ws + WS_Y);
    float* qs = (float*)lds;
    float* ksm = qs + 512;
    float* vs = ksm + 512;
    float* kraw = vs + 512;
    float* Am = kraw + 512;
    float* ps = Am + 16;
    float* os = ps + 16;
    float* red = os + 512;
    const float lng = ln_gamma(h);
    const size_t ro = (size_t)(T + 4 * b) * NP;
    {
        const int t = tid >> 7, g = tid & 127;
        const int dk = 4 * (g >> 3) + (g & 3) + 64 * ((g >> 2) & 1);
        const float qv = __uint_as_float((unsigned)P[ro + (size_t)t * NP + C_QB + h * 128 + g] << 16);
        const float kv = __uint_as_float((unsigned)P[ro + (size_t)t * NP + C_KB + h * 128 + g] << 16);
        qs[t * 128 + dk] = qv; kraw[t * 128 + dk] = kv; ksm[t * 128 + dk] = kv * __expf((float)(3 - t) * lng);
        vs[t * 128 + g] = __uint_as_float((unsigned)P[ro + (size_t)t * NP + C_VB + h * 128 + g] << 16);
    }
    __syncthreads();
    {
#pragma unroll
        for (int k = 0; k < 2; ++k) { const int p = 2 * w + k, t = p >> 2, m = p & 3;
            float a = qs[t * 128 + lane] * kraw[m * 128 + lane] + qs[t * 128 + 64 + lane] * kraw[m * 128 + 64 + lane];
#pragma unroll
            for (int o = 1; o < 64; o <<= 1) a += __shfl_xor(a, o);
            if (lane == 0) Am[p] = (m <= t) ? a * __expf((float)(t - m) * lng) : 0.f; }
    }
    const float* r0 = C.state + ((size_t)(layer * 128 + b) * 8 + h) * 16384;
    float* rout = C.out + O_RS + ((size_t)(layer * 128 + b) * 8 + h) * 16384;
    const float g4 = __expf(4.0f * lng);
    const int e4 = tid & 31, dg = tid >> 5;
    f32x4 acc[4];
#pragma unroll
    for (int t = 0; t < 4; ++t) acc[t] = (f32x4){0.f, 0.f, 0.f, 0.f};
    const f32x4 v0 = *(const f32x4*)(vs + 4 * e4), v1 = *(const f32x4*)(vs + 128 + 4 * e4), v2 = *(const f32x4*)(vs + 256 + 4 * e4), v3 = *(const f32x4*)(vs + 384 + 4 * e4);
#pragma unroll
    for (int i = 0; i < 8; ++i) {
        const int d = dg + 16 * i;
        const f32x4 r = *(const f32x4*)(r0 + d * 128 + 4 * e4);
        const f32x4 rn = r * g4 + v0 * ksm[d] + v1 * ksm[128 + d] + v2 * ksm[256 + d] + v3 * ksm[384 + d];
        *(f32x4*)(rout + d * 128 + 4 * e4) = rn;
#pragma unroll
        for (int t = 0; t < 4; ++t) acc[t] += r * qs[t * 128 + d];
    }
#pragma unroll
    for (int t = 0; t < 4; ++t) *(f32x4*)(red + (dg * 4 + t) * 128 + 4 * e4) = acc[t];
    __syncthreads();
    const int t = tid >> 7, e = tid & 127;
    float o = 0.f;
#pragma unroll
    for (int k = 0; k < 16; ++k) o += red[(k * 4 + t) * 128 + e];
    o *= __expf((float)(t + 1) * lng);
#pragma unroll
    for (int m = 0; m < 4; ++m) o += Am[t * 4 + m] * vs[m * 128 + e];
    float s1 = o, s2 = o * o;
#pragma unroll
    for (int k = 1; k < 64; k <<= 1) { s1 += __shfl_xor(s1, k); s2 += __shfl_xor(s2, k); }
    if (lane == 0) { ps[w * 2] = s1; ps[w * 2 + 1] = s2; }
    __syncthreads();
    const float S1 = ps[(2 * t) * 2] + ps[(2 * t + 1) * 2], S2 = ps[(2 * t) * 2 + 1] + ps[(2 * t + 1) * 2 + 1];
    const float mu = S1 * (1.0f / 128.0f), var = fmaxf(S2 * (1.0f / 128.0f) - mu * mu, 0.f);
    const size_t row = (size_t)(T + 4 * b + t);
    const float gv = __uint_as_float((unsigned)P[row * NP + C_GB + h * 128 + e] << 16);
    const float y = (o - mu) * rsqrtf(var + 1e-6f) * C.ret_norm_w[layer * 1024 + h * 128 + e] * silu_f(gv);
    Y[row * D + 1024 + h * 128 + e] = (bf16)(cvtpk(y, 0.f) & 0xffffu);
    __syncthreads();
}

#ifndef SKIPM
#define SKIPM 0
#endif
__global__ void __launch_bounds__(NTHREADS, 2) hymba_fwd(Ctx C) {
    extern __shared__ __attribute__((aligned(16))) unsigned char lds_raw[];
    cg::grid_group grid = cg::this_grid();
    int ph = 0;
#define PHASE_BEGIN (C.ph_lo <= ph && ph < C.ph_hi)
#define PHASE_END do { if (C.ph_lo <= ph && ph + 1 < C.ph_hi) grid.sync(); ++ph; } while (0)
#define PHASE_LOCALS int tid = threadIdx.x; LAUNDER_V(tid); const int lane = tid & 63, wave = __builtin_amdgcn_readfirstlane(tid >> 6); \
    int G = gridDim.x, bid = blockIdx.x; LAUNDER_S(G); LAUNDER_S(bid); char* lds = (char*)lds_raw; Ctx Cc = C; LAUNDER_S(Cc.ws); (void)lane; (void)wave; (void)lds

    if (PHASE_BEGIN) { PHASE_LOCALS; if (!(SKIPM & 32)) p0_prologue(Cc, lds, tid, wave, lane, G); }
    PHASE_END;

    for (int layer = 0; layer < DEPTH; ++layer) {
        if (PHASE_BEGIN) {
            unsigned char* ws = C.ws; const int G = gridDim.x, bid = blockIdx.x;
            float* rss = (float*)(ws + WS_CTL); float* cosA = (float*)(ws + WS_TAB); float* sinA = cosA + NPOS * 32; float* cosB = sinA + NPOS * 32; float* sinB = cosB + NPOS * 64;
            pg8::Gemm g{(const bf16*)(ws + WS_XA), (const bf16*)(ws + WS_WIN) + (size_t)layer * NP * D, M, NP, D}; pg8::StaticOrder S; S.init(M, NP, G, bid);
            pg8::EpiProj E{(bf16*)(ws + WS_P), rss + layer * M, cosA, sinA, cosB, sinB, C.out, layer};
            pg8::gemm_phase<pg8::EpiProj, pg8::StaticOrder, true, true>((LAS unsigned char*)lds_raw, g, S, E);
        }
        PHASE_END;
        if (PHASE_BEGIN) {
            PHASE_LOCALS; int ly = layer; LAUNDER_S(ly);
            for (int u = bid; u < 2048; u += G) {
                if (u < 512) { if (!(SKIPM & 1)) ret_u_unit(Cc, lds, u >> 3, u & 7, tid, wave, lane); }
                else if (u < 768) { const int a = u - 512; if (!(SKIPM & 2)) attn_prompt_unit(Cc, lds, ly, a >> 2, (a >> 1) & 1, a & 1, tid, wave, lane); }
                else if (u < 1024) { const int a = u - 768; if (!(SKIPM & 4)) attn_sample_unit(Cc, lds, ly, a >> 1, a & 1, tid); }
                else { const int a = u - 1024; if (!(SKIPM & 8)) ret_sample_unit(Cc, lds, ly, a >> 3, a & 7, tid, wave, lane); }
            }
        }
        PHASE_END;
        if (PHASE_BEGIN) { PHASE_LOCALS; int ly = layer; LAUNDER_S(ly); ret_scan(Cc, ly, tid, G); }
        PHASE_END;
        if (PHASE_BEGIN) { PHASE_LOCALS; int ly = layer; LAUNDER_S(ly); for (int u = bid; u < 512; u += G) if (!(SKIPM & 16)) ret_prompt_unit(Cc, lds, ly, u >> 3, u & 7, tid, wave, lane); }
        PHASE_END;
        if (PHASE_BEGIN) {
            unsigned char* ws = C.ws; const int G = gridDim.x, bid = blockIdx.x;
            float* rss = (float*)(ws + WS_CTL); float* XR = (float*)(ws + WS_XR);
            pg8::Gemm g{(const bf16*)(ws + WS_Y), (const bf16*)(ws + WS_WOUT) + (size_t)layer * D * D, M, D, D}; pg8::StaticOrder S; S.init(M, D, G, bid);
            pg8::EpiRes E{layer == 0 ? C.x_prompt : XR, layer == 0 ? C.x_sample : XR + (size_t)T * D, layer == 0 ? XR : C.out, layer == 0 ? (bf16*)(ws + WS_XA) : nullptr, rss + (layer + 1) * M};
            pg8::gemm_phase<pg8::EpiRes, pg8::StaticOrder, true, true>((LAS unsigned char*)lds_raw, g, S, E);
        }
        PHASE_END;
    }
    if (PHASE_BEGIN) {
        PHASE_LOCALS;
        const float* rf = (const float*)(Cc.ws + WS_CTL) + 2 * M;
        for (int m = bid * 8 + wave; m < M; m += G * 8) {
            const float rv = rsqrtf(rf[m] * (1.0f / 2048.0f) + 1e-6f);
            f32x4* xr = (f32x4*)(Cc.out + (size_t)m * D);
#pragma unroll
            for (int j = 0; j < 8; ++j) { const f32x4 wv = *((const f32x4*)Cc.final_w + lane + 64 * j); xr[lane + 64 * j] = xr[lane + 64 * j] * rv * wv; }
        }
    }
}

constexpr int N_PHASES = 1 + DEPTH * 5 + 1;
#ifndef MK_MULTI
#define MK_MULTI 0
#endif
extern "C" void kernel_launch(void* const* d_in, const int* in_sizes, int n_in, void* d_out, int out_size, void* d_ws, size_t ws_size, hipStream_t stream) {
    static int grid = 0;
    if (grid == 0) {
        if (n_in != 11 || ws_size < WS_END) { fprintf(stderr, "kernel_launch: unexpected inputs (n_in %d, ws %zu)\n", n_in, ws_size); grid = -1; return; }
        int dev = 0, cus = 0, per_cu = 0;
        hipGetDevice(&dev); hipDeviceGetAttribute(&cus, hipDeviceAttributeMultiprocessorCount, dev);
        if (hipFuncSetAttribute((const void*)hymba_fwd, hipFuncAttributeMaxDynamicSharedMemorySize, LDS_BYTES) != hipSuccess) { fprintf(stderr, "kernel_launch: hipFuncSetAttribute failed\n"); grid = -1; return; }
        if (hipOccupancyMaxActiveBlocksPerMultiprocessor(&per_cu, (const void*)hymba_fwd, NTHREADS, LDS_BYTES) != hipSuccess || per_cu < 1) { fprintf(stderr, "kernel_launch: occupancy query says %d\n", per_cu); (void)hipGetLastError(); per_cu = 1; }
        grid = cus;
    }
    if (grid < 0) return;
    hipMemsetAsync((char*)d_ws + WS_CTL, 0, CTL_BYTES, stream);
    Ctx c{};
    c.x_prompt = (const float*)d_in[0]; c.x_sample = (const float*)d_in[1]; c.cache_k = (const float*)d_in[2]; c.cache_v = (const float*)d_in[3]; c.state = (const float*)d_in[4];
    c.norm_w = (const float*)d_in[5]; c.w_in = (const float*)d_in[6]; c.sinks = (const float*)d_in[7]; c.ret_norm_w = (const float*)d_in[8]; c.w_out = (const float*)d_in[9]; c.final_w = (const float*)d_in[10];
    c.out = (float*)d_out; c.ws = (unsigned char*)d_ws;
#if MK_MULTI
    for (int p = 0; p < N_PHASES; ++p) { c.ph_lo = p; c.ph_hi = p + 1; void* args[] = {&c};
        hipError_t e = hipLaunchCooperativeKernel((const void*)hymba_fwd, dim3(grid), dim3(NTHREADS), args, LDS_BYTES, stream);
        if (e != hipSuccess) { fprintf(stderr, "launch %d failed: %s\n", p, hipGetErrorString(e)); break; } }
#else
    c.ph_lo = 0; c.ph_hi = N_PHASES; void* args[] = {&c};
    hipError_t e = hipLaunchCooperativeKernel((const void*)hymba_fwd, dim3(grid), dim3(NTHREADS), args, LDS_BYTES, stream);
    if (e != hipSuccess) fprintf(stderr, "cooperative launch failed: %s (grid %d)\n", hipGetErrorString(e), grid);
#endif
}
```

```cpp
#include <hip/hip_runtime.h>
#include <hip/hip_cooperative_groups.h>
#include <cstdio>
#include <cstdint>
namespace cg = cooperative_groups;
namespace pg8 {
#define PG8_LAS __attribute__((address_space(3)))
typedef unsigned short bf16_t;
typedef short bf16x8 __attribute__((ext_vector_type(8)));
typedef float f32x4 __attribute__((ext_vector_type(4)));
typedef unsigned u32x4 __attribute__((ext_vector_type(4)));
constexpr int BM = 256, BK = 64, HALF = 128, HTB = HALF * BK * 2  , STAGE_BYTES = 8 * HTB, NXCD = 8, WGM = 8;

__host__ __device__ __forceinline__ int lds_byte(int r, int c) { const int st = (r >> 4) * 2 + (c >> 5), rr = r & 15, cc = c & 31, ob = rr * 64 + cc * 2; return st * 1024 + (ob ^ (((ob >> 9) & 1) << 5)); }
__host__ __device__ __forceinline__ void stage_rc(int b, int& R, int& C) { const int st = b / 1024, sb = b % 1024, swz = sb ^ (((sb >> 9) & 1) << 5); R = (st >> 1) * 16 + swz / 64; C = (st & 1) * 32 + (swz % 64) / 2; }
__host__ __device__ __forceinline__ int perm32(int rho) { const int n = rho >> 4, i = rho & 15; return 8 * (i >> 2) + 4 * n + (i & 3); }

struct Unit { int pm, pn; };
struct Gemm { const bf16_t* A; const bf16_t* Bt; int M, N, K; };

struct StaticOrder {
    int nM, nN, nwg, G, c;
    __host__ __device__ void init(int M, int N, int G_, int c_) { nM = M / BM; nN = N / BM; nwg = nM * nN; G = G_; c = c_; }
    __host__ __device__ bool next(int i, Unit& u) const {
        const long L = (long)i * G + c; if (L >= nwg) return false;
        int wgid = (int)L; { const int q = nwg / NXCD, r = nwg % NXCD, xcd = wgid % NXCD, off = wgid / NXCD; wgid = (xcd < r ? xcd * (q + 1) : r * (q + 1) + (xcd - r) * q) + off; }
        const int nig = WGM * nN, gid = wgid / nig, fm = gid * WGM, gsz = (nM - fm) < WGM ? (nM - fm) : WGM;
        u.pm = fm + ((wgid % nig) % gsz); u.pn = (wgid % nig) / gsz; return true;
    }
    __device__ __forceinline__ void a_ready(const Unit&) const {}
    __device__ __forceinline__ void done(const Unit&) const {}
};

__device__ __forceinline__ unsigned cvt_pk_bf16(float lo, float hi) { unsigned r; asm volatile("v_cvt_pk_bf16_f32 %0, %1, %2" : "=v"(r) : "v"(lo), "v"(hi)); return r; }
constexpr int T_ = 8192, NPROJ = 6400, DMODEL = 2048;
constexpr size_t O_KP = (size_t)8704 * 2048, O_VP = O_KP + 32768, O_RP = O_VP + 32768, O_KS = O_RP + 262144, O_VS = O_KS + 4194304, O_RS = O_VS + 4194304;

struct EpiProj {
    static constexpr bool PERM = true, AFTER_DRAIN = false;
    bf16_t* P; const float* rss; const float* cosA; const float* sinA; const float* cosB; const float* sinB; float* out; int layer;
    __device__ __forceinline__ void operator()(const f32x4 (&acc)[2][2][4][2], const Unit& u, int wr, int wc, int fr, int fq) const {
        float rv[2][4];
#pragma unroll
        for (int ai = 0; ai < 2; ++ai)
#pragma unroll
            for (int m = 0; m < 4; ++m) rv[ai][m] = rsqrtf(rss[u.pm * BM + ai * HALF + wr * 64 + m * 16 + fr] * (1.0f / 2048.0f) + 1e-6f);
#pragma unroll
        for (int bj = 0; bj < 2; ++bj) {
            const int cb = u.pn * BM + bj * HALF;
            const int c0 = cb + wc * 32 + 8 * fq;
            const int mode = (cb < 1152) ? 1 : ((cb >= 2304 && cb < 4352) ? 2 : 0);
            const int kvmode = (cb == 1024) ? 1 : ((cb == 1152) ? 2 : 0);
#pragma unroll
            for (int ai = 0; ai < 2; ++ai)
#pragma unroll
                for (int m = 0; m < 4; ++m) {
                    const int row = u.pm * BM + ai * HALF + wr * 64 + m * 16 + fr;
                    f32x4 v0 = acc[ai][bj][m][0] * rv[ai][m], v1 = acc[ai][bj][m][1] * rv[ai][m];
                    if (mode) {
                        const int pos = row < T_ ? row : T_ + ((row - T_) & 3);
                        f32x4 c, s;
                        if (mode == 1) { const int i = (c0 & 63) >> 3; c = *(const f32x4*)(cosA + pos * 32 + 4 * i); s = *(const f32x4*)(sinA + pos * 32 + 4 * i); }
                        else { const int i = (c0 & 127) >> 3; c = *(const f32x4*)(cosB + pos * 64 + 4 * i); s = *(const f32x4*)(sinB + pos * 64 + 4 * i); }
                        const f32x4 y0 = v0 * c - v1 * s, y1 = v1 * c + v0 * s; v0 = y0; v1 = y1;
                    }
                    u32x4 w; w.x = cvt_pk_bf16(v0[0], v0[1]); w.y = cvt_pk_bf16(v0[2], v0[3]); w.z = cvt_pk_bf16(v1[0], v1[1]); w.w = cvt_pk_bf16(v1[2], v1[3]);
                    *(u32x4*)(P + (size_t)row * NPROJ + c0) = w;
                    if (kvmode && row >= T_ - 128) {
                        const int kvh = (c0 - cb) >> 6, g0 = c0 & 63;
                        float* dst;
                        if (row < T_) dst = out + (kvmode == 1 ? O_KP : O_VP) + ((size_t)(layer * 128 + (row - (T_ - 128))) * 2 + kvh) * 64;
                        else { const int b = (row - T_) >> 2, t = (row - T_) & 3; dst = out + (kvmode == 1 ? O_KS : O_VS) + ((((size_t)layer * 128 + b) * 128 + 124 + t) * 2 + kvh) * 64; }
                        if (kvmode == 1) { const int i = g0 >> 3; *(f32x4*)(dst + 4 * i) = v0; *(f32x4*)(dst + 4 * i + 32) = v1; }
                        else { *(f32x4*)(dst + g0) = v0; *(f32x4*)(dst + g0 + 4) = v1; }
                    }
                }
        }
    }
};

struct EpiRes {
    static constexpr bool PERM = true, AFTER_DRAIN = false;
    const float* base_p; const float* base_s; float* outx; bf16_t* xa; float* rss;
    __device__ __forceinline__ void operator()(const f32x4 (&acc)[2][2][4][2], const Unit& u, int wr, int wc, int fr, int fq) const {
#pragma unroll
        for (int ai = 0; ai < 2; ++ai)
#pragma unroll
            for (int m = 0; m < 4; ++m) {
                const int row = u.pm * BM + ai * HALF + wr * 64 + m * 16 + fr;
                const float* bp = row < T_ ? base_p + (size_t)row * DMODEL : base_s + (size_t)(row - T_) * DMODEL;
                float ss = 0.f;
#pragma unroll
                for (int bj = 0; bj < 2; ++bj) {
                    const int c0 = u.pn * BM + bj * HALF + wc * 32 + 8 * fq;
                    const f32x4 b0 = *(const f32x4*)(bp + c0), b1 = *(const f32x4*)(bp + c0 + 4);
                    const f32x4 v0 = acc[ai][bj][m][0] + b0, v1 = acc[ai][bj][m][1] + b1;
                    *(f32x4*)(outx + (size_t)row * DMODEL + c0) = v0; *(f32x4*)(outx + (size_t)row * DMODEL + c0 + 4) = v1;
                    if (xa) { u32x4 w; w.x = cvt_pk_bf16(v0[0], v0[1]); w.y = cvt_pk_bf16(v0[2], v0[3]); w.z = cvt_pk_bf16(v1[0], v1[1]); w.w = cvt_pk_bf16(v1[2], v1[3]);
                        *(u32x4*)(xa + (size_t)row * DMODEL + c0) = w; }
                    ss += (v0[0] * v0[0] + v0[1] * v0[1]) + (v0[2] * v0[2] + v0[3] * v0[3]) + (v1[0] * v1[0] + v1[1] * v1[1]) + (v1[2] * v1[2] + v1[3] * v1[3]);
                }
                ss += __shfl_xor(ss, 16); ss += __shfl_xor(ss, 32);
                if (fq == 0) atomicAdd(rss + row, ss);
            }
    }
};

template <class Epi, class Sched, bool ALIGN_EPI = false, bool SP2 = false>
__device__ __forceinline__ void gemm_phase(PG8_LAS unsigned char* lds, const Gemm g, const Sched& S, const Epi& E) {
    const int tid = threadIdx.x, wid = __builtin_amdgcn_readfirstlane(tid >> 6), lane = tid & 63, wr = wid >> 2, wc = wid & 3, fr = lane & 15, fq = lane >> 4;
    const int K = g.K, nt = K / BK;
    unsigned voffA[2], voffB[2];
#pragma unroll
    for (int i = 0; i < 2; ++i) { int R, C; stage_rc(tid * 16 + i * 8192, R, C); const int Rb = Epi::PERM ? ((R & ~31) + perm32(R & 31)) : R;
        voffA[i] = (unsigned)(R * K + C) * 2u; voffB[i] = (unsigned)(Rb * K + C) * 2u; }
    const size_t kstep = (size_t)(BK * 2);
    const size_t hstep = (size_t)HALF * K * 2;
    const size_t tstep = 2 * hstep;
    const unsigned ldsw = (unsigned)wid * 1024u;
    const int aoff = lds_byte(wr * 64 + fr, fq * 8), boff = lds_byte(wc * 32 + fr, fq * 8);
#define PG8_SA(b, h) (((b) * 2 + (h)) * HTB)
#define PG8_SB(b, h) ((4 + (b) * 2 + (h)) * HTB)
#define PG8_STAGE(bufoff, gbase, voff) do { _Pragma("unroll") for (int _i = 0; _i < 2; ++_i) \
        __builtin_amdgcn_global_load_lds((const unsigned*)((const char*)(gbase) + (voff)[_i]), (PG8_LAS unsigned*)(lds + (bufoff) + ldsw + _i * 8192), 16, 0, 0); } while (0)
#define PG8_LDA(dst, b, h) do { _Pragma("unroll") for (int m = 0; m < 4; ++m) _Pragma("unroll") for (int k = 0; k < 2; ++k) dst[m][k] = *(const PG8_LAS bf16x8*)(lds + PG8_SA(b, h) + aoff + m * 2048 + k * 1024); } while (0)
#define PG8_LDB(dst, b, h) do { _Pragma("unroll") for (int n = 0; n < 2; ++n) _Pragma("unroll") for (int k = 0; k < 2; ++k) dst[n][k] = *(const PG8_LAS bf16x8*)(lds + PG8_SB(b, h) + boff + n * 2048 + k * 1024); } while (0)
#define PG8_MMA(ai, bj, At, Bt) do { __builtin_amdgcn_s_setprio(1); _Pragma("unroll") for (int m = 0; m < 4; ++m) _Pragma("unroll") for (int n = 0; n < 2; ++n) _Pragma("unroll") for (int k = 0; k < 2; ++k) \
        acc[ai][bj][m][n] = __builtin_amdgcn_mfma_f32_16x16x32_bf16(Bt[n][k], At[m][k], acc[ai][bj][m][n], 0, 0, 0); __builtin_amdgcn_s_setprio(0); } while (0)
#define PG8_WAIT_V(n) asm volatile("s_waitcnt vmcnt(" #n ")" ::: "memory")
#define PG8_WAIT_L(n) asm volatile("s_waitcnt lgkmcnt(" #n ")" ::: "memory")
#define PG8_BAR __builtin_amdgcn_s_barrier()
#define PG8_SCHED __builtin_amdgcn_sched_barrier(0)
    Unit cur, nxt; int ui = 0;
    if (!S.next(0, cur)) return;
    f32x4 acc[2][2][4][2];
#pragma unroll
    for (int a = 0; a < 2; ++a)
#pragma unroll
        for (int b = 0; b < 2; ++b)
#pragma unroll
            for (int m = 0; m < 4; ++m)
#pragma unroll
                for (int n = 0; n < 2; ++n) acc[a][b][m][n] = (f32x4){0.f, 0.f, 0.f, 0.f};
    bf16x8 At[4][2], B0[2][2], B1[2][2];
    const char* cA = (const char*)g.A + (size_t)cur.pm * tstep; const char* cB = (const char*)g.Bt + (size_t)cur.pn * tstep;
    S.a_ready(cur);
    if constexpr (SP2) {
        PG8_STAGE(PG8_SB(0, 0), cB, voffB); PG8_STAGE(PG8_SB(0, 1), cB + hstep, voffB); PG8_STAGE(PG8_SA(0, 0), cA, voffA); PG8_STAGE(PG8_SA(0, 1), cA + hstep, voffA);
        if (wr == 1) PG8_BAR;
        PG8_WAIT_V(2); PG8_BAR;
        PG8_STAGE(PG8_SB(1, 0), cB + kstep, voffB); PG8_STAGE(PG8_SA(1, 0), cA + kstep, voffA); PG8_STAGE(PG8_SB(1, 1), cB + hstep + kstep, voffB);
        PG8_WAIT_V(6); PG8_BAR;
    } else {
        PG8_STAGE(PG8_SB(0, 0), cB, voffB); PG8_STAGE(PG8_SA(0, 0), cA, voffA); PG8_STAGE(PG8_SB(0, 1), cB + hstep, voffB); PG8_STAGE(PG8_SA(0, 1), cA + hstep, voffA);
        if (wr == 1) PG8_BAR;
        PG8_WAIT_V(4); PG8_BAR;
        PG8_STAGE(PG8_SB(1, 0), cB + kstep, voffB); PG8_STAGE(PG8_SA(1, 0), cA + kstep, voffA); PG8_STAGE(PG8_SB(1, 1), cB + hstep + kstep, voffB);
        PG8_WAIT_V(6); PG8_BAR;
    }
    for (;;) {
        const bool has_next = S.next(ui + 1, nxt);
        const char* nA = has_next ? (const char*)g.A + (size_t)nxt.pm * tstep : cA; const char* nB = has_next ? (const char*)g.Bt + (size_t)nxt.pn * tstep : cB;
        for (int t = 0; t < nt; t += 2) {
            const bool last = (t == nt - 2);
            const char* a1 = cA + (size_t)(t + 1) * kstep;
            const char* a2 = last ? nA : cA + (size_t)(t + 2) * kstep; const char* b2 = last ? nB : cB + (size_t)(t + 2) * kstep;
            const char* a3 = a2 + kstep; const char* b3 = b2 + kstep;
            if (last && has_next) S.a_ready(nxt);
            if constexpr (SP2) {
            PG8_LDB(B0, 0, 0); PG8_LDB(B1, 0, 1); PG8_SCHED; PG8_LDA(At, 0, 0); PG8_STAGE(PG8_SA(1, 1), a1 + hstep, voffA);
            PG8_WAIT_V(8); PG8_WAIT_L(0); PG8_BAR; PG8_MMA(0, 0, At, B0); PG8_MMA(0, 1, At, B1); PG8_BAR; PG8_SCHED;
            PG8_LDA(At, 0, 1); PG8_STAGE(PG8_SB(0, 0), b2, voffB); PG8_STAGE(PG8_SB(0, 1), b2 + hstep, voffB); PG8_STAGE(PG8_SA(0, 0), a2, voffA);
            PG8_WAIT_V(8); PG8_WAIT_L(0); PG8_BAR; PG8_MMA(1, 0, At, B0); PG8_MMA(1, 1, At, B1); PG8_BAR; PG8_SCHED;
            PG8_LDB(B0, 1, 0); PG8_LDB(B1, 1, 1); PG8_SCHED; PG8_LDA(At, 1, 0); PG8_STAGE(PG8_SA(0, 1), a2 + hstep, voffA);
            PG8_WAIT_V(8); PG8_WAIT_L(0); PG8_BAR; PG8_MMA(0, 0, At, B0); PG8_MMA(0, 1, At, B1); PG8_BAR; PG8_SCHED;
            PG8_LDA(At, 1, 1); PG8_STAGE(PG8_SB(1, 0), b3, voffB); PG8_STAGE(PG8_SB(1, 1), b3 + hstep, voffB); PG8_STAGE(PG8_SA(1, 0), a3, voffA);
            PG8_WAIT_V(8); PG8_WAIT_L(0); PG8_BAR; PG8_MMA(1, 0, At, B0); PG8_MMA(1, 1, At, B1); PG8_BAR; PG8_SCHED;
            } else {
            PG8_LDB(B0, 0, 0); PG8_SCHED; PG8_LDA(At, 0, 0); PG8_STAGE(PG8_SA(1, 1), a1 + hstep, voffA);
            PG8_WAIT_L(8); PG8_BAR; PG8_WAIT_L(0); PG8_MMA(0, 0, At, B0); PG8_BAR; PG8_SCHED;
            PG8_LDB(B1, 0, 1); PG8_STAGE(PG8_SB(0, 0), b2, voffB);
            PG8_BAR; PG8_WAIT_L(0); PG8_MMA(0, 1, At, B1); PG8_BAR;
            PG8_LDA(At, 0, 1); PG8_STAGE(PG8_SA(0, 0), a2, voffA);
            PG8_BAR; PG8_WAIT_L(0); PG8_MMA(1, 0, At, B0); PG8_BAR; PG8_SCHED;
            PG8_STAGE(PG8_SB(0, 1), b2 + hstep, voffB);
            PG8_WAIT_V(6); PG8_BAR; PG8_MMA(1, 1, At, B1); PG8_BAR;
            PG8_LDB(B0, 1, 0); PG8_SCHED; PG8_LDA(At, 1, 0); PG8_STAGE(PG8_SA(0, 1), a2 + hstep, voffA);
            PG8_WAIT_L(8); PG8_BAR; PG8_WAIT_L(0); PG8_MMA(0, 0, At, B0); PG8_BAR; PG8_SCHED;
            PG8_LDB(B1, 1, 1); PG8_STAGE(PG8_SB(1, 0), b3, voffB);
            PG8_BAR; PG8_WAIT_L(0); PG8_MMA(0, 1, At, B1); PG8_BAR;
            PG8_LDA(At, 1, 1); PG8_STAGE(PG8_SA(1, 0), a3, voffA);
            PG8_BAR; PG8_WAIT_L(0); PG8_MMA(1, 0, At, B0); PG8_BAR; PG8_SCHED;
            PG8_STAGE(PG8_SB(1, 1), b3 + hstep, voffB);
            PG8_WAIT_V(6); PG8_BAR; PG8_MMA(1, 1, At, B1); PG8_BAR;
            }
        }
        if constexpr (ALIGN_EPI) { if (wr == 0) PG8_BAR; }
        if constexpr (!Epi::AFTER_DRAIN) { E(acc, cur, wr, wc, fr, fq); S.done(cur); }
        if (!has_next) break;
#pragma unroll
        for (int a = 0; a < 2; ++a)
#pragma unroll
            for (int b = 0; b < 2; ++b)
#pragma unroll
                for (int m = 0; m < 4; ++m)
#pragma unroll
                    for (int n = 0; n < 2; ++n) acc[a][b][m][n] = (f32x4){0.f, 0.f, 0.f, 0.f};
        cur = nxt; cA = nA; cB = nB; ++ui;
        if constexpr (ALIGN_EPI) { if (wr == 1) PG8_BAR; }
    }
    PG8_WAIT_V(0);
    if constexpr (!ALIGN_EPI) { if (wr == 0) PG8_BAR; }
    PG8_BAR;
    if constexpr (Epi::AFTER_DRAIN) { E.fused(acc, cur, wr, wc, fr, fq, lds, wid, lane); S.done(cur); }
#undef PG8_SA
#undef PG8_SB
#undef PG8_STAGE
#undef PG8_LDA
#undef PG8_LDB
#undef PG8_MMA
#undef PG8_WAIT_V
#undef PG8_WAIT_L
#undef PG8_BAR
#undef PG8_SCHED
}
}

typedef unsigned short bf16;
typedef float f32x4 __attribute__((ext_vector_type(4)));
typedef short bf16x8 __attribute__((ext_vector_type(8)));
typedef short s16x4 __attribute__((ext_vector_type(4)));
typedef unsigned u32x4 __attribute__((ext_vector_type(4)));
typedef unsigned u32x2 __attribute__((ext_vector_type(2)));
typedef float f32x2 __attribute__((ext_vector_type(2)));
typedef __bf16 bf16x2_t __attribute__((ext_vector_type(2)));
#define LAS __attribute__((address_space(3)))

constexpr int T = 8192, NS = 512, M = 8704, D = 2048, NP = 6400, DEPTH = 2;
constexpr int C_QA = 0, C_KA = 1024, C_VA = 1152, C_GA = 1280, C_QB = 2304, C_KB = 3328, C_VB = 4352, C_GB = 5376;
constexpr int NPOS = 8196;
constexpr int LDS_BYTES = 147456;
constexpr int NTHREADS = 512;
using pg8::O_KP; using pg8::O_VP; using pg8::O_RP; using pg8::O_KS; using pg8::O_VS; using pg8::O_RS;

constexpr size_t MiB = 1u << 20;
constexpr size_t WS_CTL = 0, CTL_BYTES = 1 * MiB;
constexpr size_t WS_WIN = 2 * MiB;
constexpr size_t WS_WOUT = WS_WIN + 50 * MiB;
constexpr size_t WS_XA = WS_WOUT + 16 * MiB;
constexpr size_t WS_P = WS_XA + 34 * MiB;
constexpr size_t WS_Y = WS_P + 107 * MiB;
constexpr size_t WS_XR = WS_Y + 34 * MiB;
constexpr size_t WS_U = WS_XR + 68 * MiB;
constexpr size_t WS_RT = WS_U + 32 * MiB;
constexpr size_t WS_TAB = WS_RT + 16 * MiB;
constexpr size_t WS_END = WS_TAB + 8 * MiB;

struct Ctx {
    const float *x_prompt, *x_sample, *cache_k, *cache_v, *state, *norm_w, *w_in, *sinks, *ret_norm_w, *w_out, *final_w;
    float* out; unsigned char* ws;
    int ph_lo, ph_hi;
};

__device__ __forceinline__ unsigned cvtpk(float lo, float hi) { f32x2 v = {lo, hi}; bf16x2_t b = __builtin_convertvector(v, bf16x2_t); return __builtin_bit_cast(unsigned, b); }
__device__ __forceinline__ float bf_lo(unsigned u) { return __uint_as_float(u << 16); }
__device__ __forceinline__ float bf_hi(unsigned u) { return __uint_as_float(u & 0xffff0000u); }
__device__ __forceinline__ float silu_f(float x) { return x / (1.0f + __expf(-x)); }
__device__ __forceinline__ s16x4 vtr(const char* p) { typedef short v4i16_t __attribute__((ext_vector_type(4)));
    return __builtin_bit_cast(s16x4, __builtin_amdgcn_ds_read_tr16_b64_v4i16((LAS v4i16_t*)p)); }
__device__ __forceinline__ bf16x8 cat8(s16x4 lo, s16x4 hi) { return (bf16x8){lo[0], lo[1], lo[2], lo[3], hi[0], hi[1], hi[2], hi[3]}; }
__device__ __forceinline__ float ln_gamma(int h) {
    const double x = __builtin_ldexp(1.0, -5 - h);
    double s = 0.0, p = x;
#pragma unroll
    for (int k = 1; k <= 9; ++k) { s += p / (double)k; p *= x; }
    return (float)(-s);
}
#define LDS_WAIT() asm volatile("s_waitcnt lgkmcnt(0)" ::: "memory")
#define LAUNDER_V(x) asm volatile("" : "+v"(x))
#define LAUNDER_S(x) asm volatile("" : "+s"(x))

__device__ __forceinline__ int perm_src_col(int np, float& sc) {
    sc = 1.0f;
    if (np < 1152) { const int hb = np & ~63, g = np & 63; if (np < 1024) sc = 0.125f; return hb + 4 * (g >> 3) + (g & 3) + 32 * ((g >> 2) & 1); }
    if (np >= C_QB && np < C_VB) { const int hb = np & ~127, g = np & 127; if (np >= C_KB) sc = 0.08838834764831845f; return hb + 4 * (g >> 3) + (g & 3) + 64 * ((g >> 2) & 1); }
    return np;
}

template <bool WIN>
__device__ __forceinline__ void transpose_item(const float* W, int N, const float* nw, bf16* WT, float* scr, int kb, int nb, int lane) {
    const int k0 = 64 * kb, n0 = 64 * nb, l16 = lane & 15, r4 = lane >> 4;
    float sc = 1.0f; int srcc = n0 + 4 * l16;
    if (WIN) srcc = perm_src_col(n0 + 4 * l16, sc);
#pragma unroll 4
    for (int i = 0; i < 16; ++i) {
        const int kk = 4 * i + r4;
        const f32x4 v = *(const f32x4*)(W + (size_t)(k0 + kk) * N + srcc);
        float s2 = sc; if (WIN) s2 *= nw[k0 + kk];
        float* d = scr + kk * 65 + 4 * l16;
        d[0] = v[0] * s2; d[1] = v[1] * s2; d[2] = v[2] * s2; d[3] = v[3] * s2;
    }
    LDS_WAIT();
    const int c = lane & 7;
#pragma unroll
    for (int j = 0; j < 8; ++j) {
        const int n = (lane >> 3) + 8 * j; const float* s = scr + (8 * c) * 65 + n;
        u32x4 o; o.x = cvtpk(s[0], s[65]); o.y = cvtpk(s[130], s[195]); o.z = cvtpk(s[260], s[325]); o.w = cvtpk(s[390], s[455]);
        *(u32x4*)(WT + (size_t)(n0 + n) * 2048 + k0 + 8 * c) = o;
    }
    LDS_WAIT();
}

__device__ __forceinline__ void p0_prologue(const Ctx& C, char* lds, int tid, int wave, int lane, int G) {
    float* scr = (float*)(lds + wave * 16640);
    const int gw = blockIdx.x * 8 + wave, NGW = G * 8;
    bf16* WIN = (bf16*)(C.ws + WS_WIN); bf16* WOUT = (bf16*)(C.ws + WS_WOUT);
    constexpr int I_IN = 32 * 100, I_OUT = 32 * 32, NITEMS = 2 * (I_IN + I_OUT);
    for (int it = gw; it < NITEMS; it += NGW) {
        int r = it;
        if (r < 2 * I_IN) { const int l = r / I_IN; r -= l * I_IN; const int nb = r % 100, kb = r / 100;
            transpose_item<true>(C.w_in + (size_t)l * D * NP, NP, C.norm_w + l * D, WIN + (size_t)l * NP * D, scr, kb, nb, lane); }
        else { r -= 2 * I_IN; const int l = r / I_OUT; r -= l * I_OUT; const int nb = r & 31, kb = r >> 5;
            transpose_item<false>(C.w_out + (size_t)l * D * D, D, nullptr, WOUT + (size_t)l * D * D, scr, kb, nb, lane); }
    }
    bf16* XA = (bf16*)(C.ws + WS_XA); float* rss = (float*)(C.ws + WS_CTL);
    for (int m = gw; m < M; m += NGW) {
        const float* xr = m < T ? C.x_prompt + (size_t)m * D : C.x_sample + (size_t)(m - T) * D;
        float ss = 0.f;
#pragma unroll
        for (int j = 0; j < 8; ++j) {
            const f32x4 v = *((const f32x4*)xr + lane + 64 * j);
            ss += (v[0] * v[0] + v[1] * v[1]) + (v[2] * v[2] + v[3] * v[3]);
            u32x2 o; o.x = cvtpk(v[0], v[1]); o.y = cvtpk(v[2], v[3]);
            *((u32x2*)(XA + (size_t)m * D) + lane + 64 * j) = o;
        }
#pragma unroll
        for (int o = 1; o < 64; o <<= 1) ss += __shfl_xor(ss, o);
        if (lane == 0) rss[m] = ss;
    }
    float* cosA = (float*)(C.ws + WS_TAB); float* sinA = cosA + NPOS * 32; float* cosB = sinA + NPOS * 32; float* sinB = cosB + NPOS * 64;
    for (int i = blockIdx.x * NTHREADS + tid; i < NPOS * 96; i += G * NTHREADS) {
        int pos, f, half; float *pc, *ps;
        if (i < NPOS * 32) { pos = i >> 5; f = i & 31; half = 32; pc = cosA + i; ps = sinA + i; }
        else { const int k = i - NPOS * 32; pos = k >> 6; f = k & 63; half = 64; pc = cosB + k; ps = sinB + k; }
        const double rr = half == 32 ? 0.7498942093324559 : 0.8659643233600653;
        double inv = 1.0; for (int k = 0; k < f; ++k) inv *= rr;
        const float ang = (float)pos * (float)inv;
        const double a = (double)ang;
        const double qd = __builtin_rint(a * 0.6366197723675814);
        double r = __builtin_fma(-qd, 1.5707963267948966, a); r = __builtin_fma(-qd, 6.123233995736766e-17, r);
        const double r2 = r * r;
        double sp = -1.0 / 39916800.0; sp = sp * r2 + 1.0 / 362880.0; sp = sp * r2 - 1.0 / 5040.0; sp = sp * r2 + 1.0 / 120.0; sp = sp * r2 - 1.0 / 6.0; sp = sp * r2 + 1.0; sp *= r;
        double cp = 1.0 / 479001600.0; cp = cp * r2 - 1.0 / 3628800.0; cp = cp * r2 + 1.0 / 40320.0; cp = cp * r2 - 1.0 / 720.0; cp = cp * r2 + 1.0 / 24.0; cp = cp * r2 - 0.5; cp = cp * r2 + 1.0;
        const int qi = ((int)qd) & 3;
        const double sv = (qi == 0) ? sp : (qi == 1) ? cp : (qi == 2) ? -sp : -cp;
        const double cv = (qi == 0) ? cp : (qi == 1) ? -sp : (qi == 2) ? -cp : sp;
        *pc = (float)cv; *ps = (float)sv;
    }
}

__device__ __forceinline__ void attn_prompt_unit(const Ctx& C, char* lds, int layer, int blk, int kvh, int hq, int tid, int w, int lane) {
    const bf16* P = (const bf16*)(C.ws + WS_P); bf16* Y = (bf16*)(C.ws + WS_Y);
    char* Ks = lds; char* Vs = lds + 36864;
#pragma unroll
    for (int it = 0; it < 4; ++it) {
        const int r = (tid >> 3) + 64 * it, ch = tid & 7, krow = blk * 128 - 128 + r;
        u32x4 kv = (u32x4){0u, 0u, 0u, 0u}, vv = kv;
        if (krow >= 0) { kv = *(const u32x4*)(P + (size_t)krow * NP + C_KA + kvh * 64 + ch * 8); vv = *(const u32x4*)(P + (size_t)krow * NP + C_VA + kvh * 64 + ch * 8); }
        *(u32x4*)(Ks + r * 144 + ch * 16) = kv; *(u32x4*)(Vs + r * 144 + ch * 16) = vv;
    }
    __syncthreads();
    const int q = lane & 15, g = lane >> 4;
    const int jt0 = w < 6 ? w : 6;
    const int iq = 16 * w + q, row = blk * 128 + iq;
    for (int hh = 0; hh < 4; ++hh) {
        const int h = kvh * 8 + hq * 4 + hh;
        bf16x8 qf[2];
#pragma unroll
        for (int ks = 0; ks < 2; ++ks) qf[ks] = *(const bf16x8*)(P + (size_t)row * NP + C_QA + h * 64 + 32 * ks + 8 * g);
        f32x4 s[10];
        float mx = -INFINITY;
        int lo = (blk > 0 || iq + 1 >= 128) ? iq + 1 : 128; LAUNDER_V(lo);
        const unsigned span = (unsigned)(iq + 128 - lo);
#pragma unroll
        for (int tt = 0; tt < 10; ++tt) {
            const int jt = jt0 + tt;
            f32x4 a = (f32x4){0.f, 0.f, 0.f, 0.f};
#pragma unroll
            for (int ks = 0; ks < 2; ++ks) { const bf16x8 kf = *(const bf16x8*)(Ks + (16 * jt + q) * 144 + (32 * ks + 8 * g) * 2); a = __builtin_amdgcn_mfma_f32_16x16x32_bf16(kf, qf[ks], a, 0, 0, 0); }
#pragma unroll
            for (int j = 0; j < 4; ++j) {
                const int jj = 16 * jt + 4 * g + j;
                a[j] = ((unsigned)(jj - lo) <= span) ? a[j] : -INFINITY; mx = fmaxf(mx, a[j]);
            }
            s[tt] = a;
        }
        mx = fmaxf(mx, __shfl_xor(mx, 16)); mx = fmaxf(mx, __shfl_xor(mx, 32));
        const float sink = C.sinks[layer * 16 + h];
        const float mm = fmaxf(mx, sink);
        float sum = 0.f;
#pragma unroll
        for (int tt = 0; tt < 10; ++tt)
#pragma unroll
            for (int j = 0; j < 4; ++j) { const float e = __expf(s[tt][j] - mm); s[tt][j] = e; sum += e; }
        sum += __shfl_xor(sum, 16); sum += __shfl_xor(sum, 32);
        const float inv = 1.0f / (sum + __expf(sink - mm));
        f32x4 o[4];
#pragma unroll
        for (int dt = 0; dt < 4; ++dt) o[dt] = (f32x4){0.f, 0.f, 0.f, 0.f};
#pragma unroll
        for (int pr = 0; pr < 5; ++pr) {
            const int jt = jt0 + 2 * pr;
            u32x4 pw; pw.x = cvtpk(s[2 * pr][0], s[2 * pr][1]); pw.y = cvtpk(s[2 * pr][2], s[2 * pr][3]); pw.z = cvtpk(s[2 * pr + 1][0], s[2 * pr + 1][1]); pw.w = cvtpk(s[2 * pr + 1][2], s[2 * pr + 1][3]);
            const bf16x8 pf = __builtin_bit_cast(bf16x8, pw);
#pragma unroll
            for (int dt = 0; dt < 4; ++dt) {
                const char* a0 = Vs + (16 * jt + 4 * g + (q >> 2)) * 144 + (16 * dt + 4 * (q & 3)) * 2;
                const s16x4 lo = vtr(a0), hi = vtr(a0 + 16 * 144);
                o[dt] = __builtin_amdgcn_mfma_f32_16x16x32_bf16(cat8(lo, hi), pf, o[dt], 0, 0, 0);
            }
        }
#pragma unroll
        for (int dt = 0; dt < 4; ++dt) {
            const int dcol = h * 64 + 16 * dt + 4 * g;
            const u32x2 gt = *(const u32x2*)(P + (size_t)row * NP + C_GA + dcol);
            u32x2 yo; yo.x = cvtpk(o[dt][0] * inv * silu_f(bf_lo(gt.x)), o[dt][1] * inv * silu_f(bf_hi(gt.x)));
            yo.y = cvtpk(o[dt][2] * inv * silu_f(bf_lo(gt.y)), o[dt][3] * inv * silu_f(bf_hi(gt.y)));
            *(u32x2*)(Y + (size_t)row * D + dcol) = yo;
        }
    }
    __syncthreads();
}

template <bool SCALE>
__device__ __forceinline__ void stage128(char* dst, const bf16* src, size_t src_pitch, int tid, float lng) {
#pragma unroll
    for (int it = 0; it < 4; ++it) {
        const int r = (tid >> 4) + 32 * it, ch = tid & 15;
        u32x4 v = *(const u32x4*)(src + (size_t)r * src_pitch + ch * 8);
        if (SCALE) { const float sc = __expf((float)(127 - r) * lng);
            v.x = cvtpk(bf_lo(v.x) * sc, bf_hi(v.x) * sc); v.y = cvtpk(bf_lo(v.y) * sc, bf_hi(v.y) * sc); v.z = cvtpk(bf_lo(v.z) * sc, bf_hi(v.z) * sc); v.w = cvtpk(bf_lo(v.w) * sc, bf_hi(v.w) * sc); }
        *(u32x4*)(dst + r * 272 + ch * 16) = v;
    }
}

__device__ __forceinline__ void ret_u_unit(const Ctx& C, char* lds, int c, int h, int tid, int w, int lane) {
    const bf16* P = (const bf16*)(C.ws + WS_P); float* U = (float*)(C.ws + WS_U);
    char* Ks = lds; char* Vs = lds + 34816;
    const float lng = ln_gamma(h);
    stage128<false>(Ks, P + (size_t)(c * 128) * NP + C_KB + h * 128, NP, tid, lng);
    stage128<true>(Vs, P + (size_t)(c * 128) * NP + C_VB + h * 128, NP, tid, lng);
    __syncthreads();
    const int q = lane & 15, g = lane >> 4;
    f32x4 acc[8];
#pragma unroll
    for (int dt = 0; dt < 8; ++dt) acc[dt] = (f32x4){0.f, 0.f, 0.f, 0.f};
#pragma unroll
    for (int ks = 0; ks < 4; ++ks) {
        const int rbase = (32 * ks + 8 * g + (q >> 2)) * 272 + 4 * (q & 3) * 2;
        const bf16x8 vf = cat8(vtr(Vs + rbase + 32 * w), vtr(Vs + rbase + 32 * w + 4 * 272));
#pragma unroll
        for (int dt = 0; dt < 8; ++dt) {
            const bf16x8 kf = cat8(vtr(Ks + rbase + 32 * dt), vtr(Ks + rbase + 32 * dt + 4 * 272));
            acc[dt] = __builtin_amdgcn_mfma_f32_16x16x32_bf16(vf, kf, acc[dt], 0, 0, 0);
        }
    }
    float* Ub = U + (size_t)(c * 8 + h) * 16384;
#pragma unroll
    for (int dt = 0; dt < 8; ++dt)
#pragma unroll
        for (int j = 0; j < 4; ++j) Ub[(16 * w + 4 * g + j) * 128 + 16 * dt + q] = acc[dt][j];
    __syncthreads();
}

__device__ __forceinline__ void ret_scan(const Ctx& C, int layer, int tid, int G) {
    const float* U = (const float*)(C.ws + WS_U); bf16* Rt = (bf16*)(C.ws + WS_RT);
    for (int i = blockIdx.x * NTHREADS + tid; i < 8 * 16384; i += G * NTHREADS) {
        const int h = i >> 14, e = (i >> 7) & 127, d = i & 127;
        const float gc = __expf(128.0f * ln_gamma(h));
        float r = 0.f;
#pragma unroll 1
        for (int c0 = 0; c0 < 64; c0 += 8) {
            float u[8];
#pragma unroll
            for (int k = 0; k < 8; ++k) u[k] = U[(size_t)((c0 + k) * 8) * 16384 + i];
#pragma unroll
            for (int k = 0; k < 8; ++k) { Rt[(size_t)((c0 + k) * 8) * 16384 + i] = (bf16)(cvtpk(r, 0.f) & 0xffffu); r = gc * r + u[k]; }
        }
        const int dorig = 4 * (d >> 3) + (d & 3) + 64 * ((d >> 2) & 1);
        C.out[O_RP + ((size_t)(layer * 8 + h) * 128 + dorig) * 128 + e] = r;
    }
}

__device__ __forceinline__ void ret_prompt_unit(const Ctx& C, char* lds, int layer, int c, int h, int tid, int w, int lane) {
    const bf16* P = (const bf16*)(C.ws + WS_P); bf16* Y = (bf16*)(C.ws + WS_Y); const bf16* Rt = (const bf16*)(C.ws + WS_RT);
    char* Ks = lds; char* Vs = lds + 34816; char* Rs = lds + 69632;
    const float lng = ln_gamma(h);
    stage128<false>(Ks, P + (size_t)(c * 128) * NP + C_KB + h * 128, NP, tid, lng);
    stage128<false>(Vs, P + (size_t)(c * 128) * NP + C_VB + h * 128, NP, tid, lng);
    stage128<false>(Rs, Rt + (size_t)(c * 8 + h) * 16384, 128, tid, lng);
    __syncthreads();
    const int q = lane & 15, g = lane >> 4;
    const int n = 16 * w + q, row = c * 128 + n;
    bf16x8 qf[4];
#pragma unroll
    for (int ks = 0; ks < 4; ++ks) qf[ks] = *(const bf16x8*)(P + (size_t)row * NP + C_QB + h * 128 + 32 * ks + 8 * g);
    unsigned pk[8][2];
#pragma unroll
    for (int mt = 0; mt < 8; ++mt) {
        pk[mt][0] = 0u; pk[mt][1] = 0u;
        if (mt <= w) {
            f32x4 a = (f32x4){0.f, 0.f, 0.f, 0.f};
#pragma unroll
            for (int ks = 0; ks < 4; ++ks) { const bf16x8 kf = *(const bf16x8*)(Ks + (16 * mt + q) * 272 + (32 * ks + 8 * g) * 2); a = __builtin_amdgcn_mfma_f32_16x16x32_bf16(kf, qf[ks], a, 0, 0, 0); }
            float v[4];
#pragma unroll
            for (int j = 0; j < 4; ++j) { const int dl = n - (16 * mt + 4 * g + j); v[j] = dl >= 0 ? a[j] * __expf((float)dl * lng) : 0.f; }
            pk[mt][0] = cvtpk(v[0], v[1]); pk[mt][1] = cvtpk(v[2], v[3]);
        }
    }
    f32x4 oi[8], ox[8];
#pragma unroll
    for (int et = 0; et < 8; ++et) { oi[et] = (f32x4){0.f, 0.f, 0.f, 0.f}; ox[et] = oi[et]; }
#pragma unroll
    for (int pr = 0; pr < 4; ++pr) {
        if (2 * pr <= w) {
            u32x4 pw; pw.x = pk[2 * pr][0]; pw.y = pk[2 * pr][1]; pw.z = pk[2 * pr + 1][0]; pw.w = pk[2 * pr + 1][1];
            const bf16x8 pf = __builtin_bit_cast(bf16x8, pw);
#pragma unroll
            for (int et = 0; et < 8; ++et) {
                const char* a0 = Vs + (32 * pr + 4 * g + (q >> 2)) * 272 + (16 * et + 4 * (q & 3)) * 2;
                oi[et] = __builtin_amdgcn_mfma_f32_16x16x32_bf16(cat8(vtr(a0), vtr(a0 + 16 * 272)), pf, oi[et], 0, 0, 0);
            }
        }
    }
#pragma unroll
    for (int et = 0; et < 8; ++et)
#pragma unroll
        for (int ks = 0; ks < 4; ++ks) { const bf16x8 rf = *(const bf16x8*)(Rs + (16 * et + q) * 272 + (32 * ks + 8 * g) * 2); ox[et] = __builtin_amdgcn_mfma_f32_16x16x32_bf16(rf, qf[ks], ox[et], 0, 0, 0); }
    const float qdec = __expf((float)(n + 1) * lng);
    float sum = 0.f;
#pragma unroll
    for (int et = 0; et < 8; ++et) { oi[et] = oi[et] + ox[et] * qdec; sum += (oi[et][0] + oi[et][1]) + (oi[et][2] + oi[et][3]); }
    sum += __shfl_xor(sum, 16); sum += __shfl_xor(sum, 32);
    const float mu = sum * (1.0f / 128.0f);
    float var = 0.f;
#pragma unroll
    for (int et = 0; et < 8; ++et) { oi[et] = oi[et] - mu; var += (oi[et][0] * oi[et][0] + oi[et][1] * oi[et][1]) + (oi[et][2] * oi[et][2] + oi[et][3] * oi[et][3]); }
    var += __shfl_xor(var, 16); var += __shfl_xor(var, 32);
    const float rs = rsqrtf(var * (1.0f / 128.0f) + 1e-6f);
    const float* gw = C.ret_norm_w + layer * 1024 + h * 128;
#pragma unroll
    for (int et = 0; et < 8; ++et) {
        const int e0 = 16 * et + 4 * g;
        const u32x2 gt = *(const u32x2*)(P + (size_t)row * NP + C_GB + h * 128 + e0);
        const f32x4 wv = *(const f32x4*)(gw + e0);
        u32x2 yo; yo.x = cvtpk(oi[et][0] * rs * wv[0] * silu_f(bf_lo(gt.x)), oi[et][1] * rs * wv[1] * silu_f(bf_hi(gt.x)));
        yo.y = cvtpk(oi[et][2] * rs * wv[2] * silu_f(bf_lo(gt.y)), oi[et][3] * rs * wv[3] * silu_f(bf_hi(gt.y)));
        *(u32x2*)(Y + (size_t)row * D + 1024 + h * 128 + e0) = yo;
    }
    __syncthreads();
}

__device__ __forceinline__ void attn_sample_unit(const Ctx& C, char* lds, int layer, int b, int kvh, int tid) {
    const bf16* P = (const bf16*)(C.ws + WS_P); bf16* Y = (bf16*)(C.ws + WS_Y);
    float* Qs = (float*)lds;
    float* Kl = Qs + 32 * 65;
    float* Vl = Kl + 132 * 65;
    float* Pm = Vl + 132 * 68;
    const float* ck = C.cache_k + ((size_t)(layer * 128 + b) * 128) * 128 + kvh * 64;
    const float* cv = C.cache_v + ((size_t)(layer * 128 + b) * 128) * 128 + kvh * 64;
    float* ok = C.out + O_KS + ((size_t)(layer * 128 + b) * 128) * 128 + kvh * 64;
    float* ov = C.out + O_VS + ((size_t)(layer * 128 + b) * 128) * 128 + kvh * 64;
    for (int i = tid; i < 128 * 16; i += NTHREADS) {
        const int r = i >> 4, c4 = i & 15;
        const f32x4 k = *(const f32x4*)(ck + (size_t)r * 128 + 4 * c4), v = *(const f32x4*)(cv + (size_t)r * 128 + 4 * c4);
        float* kd = Kl + r * 65 + 4 * c4; kd[0] = k[0]; kd[1] = k[1]; kd[2] = k[2]; kd[3] = k[3];
        *(f32x4*)(Vl + r * 68 + 4 * c4) = v;
        if (r >= 4) { *(f32x4*)(ok + (size_t)(r - 4) * 128 + 4 * c4) = k; *(f32x4*)(ov + (size_t)(r - 4) * 128 + 4 * c4) = v; }
    }
    if (tid < 256) { const int t = tid >> 6, g = tid & 63; const size_t ro = (size_t)(T + 4 * b + t) * NP;
        const int dk = 4 * (g >> 3) + (g & 3) + 32 * ((g >> 2) & 1);
        Kl[(128 + t) * 65 + dk] = __uint_as_float((unsigned)P[ro + C_KA + kvh * 64 + g] << 16);
        Vl[(128 + t) * 68 + g] = __uint_as_float((unsigned)P[ro + C_VA + kvh * 64 + g] << 16); }
    for (int i = tid; i < 32 * 64; i += NTHREADS) {
        const int r = i >> 6, g = i & 63, hg = r >> 2, t = r & 3;
        const int dk = 4 * (g >> 3) + (g & 3) + 32 * ((g >> 2) & 1);
        Qs[r * 65 + dk] = __uint_as_float((unsigned)P[(size_t)(T + 4 * b + t) * NP + C_QA + (kvh * 8 + hg) * 64 + g] << 16);
    }
    __syncthreads();
    {
        const int r = tid >> 4, kg = tid & 15, t = r & 3, h = kvh * 8 + (r >> 2);
        float mx = -INFINITY;
#pragma unroll 1
        for (int it = 0; it < 9; ++it) {
            const int kk = kg + 16 * it;
            float a = -INFINITY;
            if (kk < 132) {
                const bool valid = kk < 128 ? (kk > t) : (kk - 128 <= t);
                if (valid) { a = 0.f;
#pragma unroll 16
                    for (int d = 0; d < 64; ++d) a += Qs[r * 65 + d] * Kl[kk * 65 + d]; }
                Pm[r * 133 + kk] = a;
            }
            mx = fmaxf(mx, a);
        }
#pragma unroll
        for (int o = 1; o < 16; o <<= 1) mx = fmaxf(mx, __shfl_xor(mx, o));
        const float sink = C.sinks[layer * 16 + h];
        const float mm = fmaxf(mx, sink);
        float sum = 0.f;
#pragma unroll 1
        for (int it = 0; it < 9; ++it) { const int kk = kg + 16 * it; if (kk < 132) { const float e = __expf(Pm[r * 133 + kk] - mm); Pm[r * 133 + kk] = e; sum += e; } }
#pragma unroll
        for (int o = 1; o < 16; o <<= 1) sum += __shfl_xor(sum, o);
        const float inv = 1.0f / (sum + __expf(sink - mm));
#pragma unroll 1
        for (int it = 0; it < 9; ++it) { const int kk = kg + 16 * it; if (kk < 132) Pm[r * 133 + kk] *= inv; }
    }
    __syncthreads();
    {
        const int r = tid >> 4, dq = tid & 15, t = r & 3, h = kvh * 8 + (r >> 2);
        f32x4 o = (f32x4){0.f, 0.f, 0.f, 0.f};
        for (int kk = 0; kk < 132; ++kk) { const float p = Pm[r * 133 + kk]; const f32x4 v = *(const f32x4*)(Vl + kk * 68 + 4 * dq); o += v * p; }
        const size_t row = (size_t)(T + 4 * b + t);
        const u32x2 gt = *(const u32x2*)(P + row * NP + C_GA + h * 64 + 4 * dq);
        u32x2 yo; yo.x = cvtpk(o[0] * silu_f(bf_lo(gt.x)), o[1] * silu_f(bf_hi(gt.x))); yo.y = cvtpk(o[2] * silu_f(bf_lo(gt.y)), o[3] * silu_f(bf_hi(gt.y)));
        *(u32x2*)(Y + row * D + h * 64 + 4 * dq) = yo;
    }
    __syncthreads();
}

__device__ __forceinline__ void ret_sample_unit(const Ctx& C, char* lds, int layer, int b, int h, int tid, int w, int lane) {
    const bf16* P = (const bf16*)(C.ws + WS_P); bf16* Y = (bf16*)(C.ws + WS_Y);
    float* qs = (float*)lds;
    float* ksm = qs + 512;
    float* vs = ksm + 512;
    float* kraw = vs + 512;
    float* Am = kraw + 512;
    float* ps = Am + 16;
    float* os = ps + 16;
    float* red = os + 512;
    const float lng = ln_gamma(h);
    const size_t ro = (size_t)(T + 4 * b) * NP;
    {
        const int t = tid >> 7, g = tid & 127;
        const int dk = 4 * (g >> 3) + (g & 3) + 64 * ((g >> 2) & 1);
        const float qv = __uint_as_float((unsigned)P[ro + (size_t)t * NP + C_QB + h * 128 + g] << 16);
        const float kv = __uint_as_float((unsigned)P[ro + (size_t)t * NP + C_KB + h * 128 + g] << 16);
        qs[t * 128 + dk] = qv; kraw[t * 128 + dk] = kv; ksm[t * 128 + dk] = kv * __expf((float)(3 - t) * lng);
        vs[t * 128 + g] = __uint_as_float((unsigned)P[ro + (size_t)t * NP + C_VB + h * 128 + g] << 16);
    }
    __syncthreads();
    {
#pragma unroll
        for (int k = 0; k < 2; ++k) { const int p = 2 * w + k, t = p >> 2, m = p & 3;
            float a = qs[t * 128 + lane] * kraw[m * 128 + lane] + qs[t * 128 + 64 + lane] * kraw[m * 128 + 64 + lane];
#pragma unroll
            for (int o = 1; o < 64; o <<= 1) a += __shfl_xor(a, o);
            if (lane == 0) Am[p] = (m <= t) ? a * __expf((float)(t - m) * lng) : 0.f; }
    }
    const float* r0 = C.state + ((size_t)(layer * 128 + b) * 8 + h) * 16384;
    float* rout = C.out + O_RS + ((size_t)(layer * 128 + b) * 8 + h) * 16384;
    const float g4 = __expf(4.0f * lng);
    const int e4 = tid & 31, dg = tid >> 5;
    f32x4 acc[4];
#pragma unroll
    for (int t = 0; t < 4; ++t) acc[t] = (f32x4){0.f, 0.f, 0.f, 0.f};
    const f32x4 v0 = *(const f32x4*)(vs + 4 * e4), v1 = *(const f32x4*)(vs + 128 + 4 * e4), v2 = *(const f32x4*)(vs + 256 + 4 * e4), v3 = *(const f32x4*)(vs + 384 + 4 * e4);
#pragma unroll
    for (int i = 0; i < 8; ++i) {
        const int d = dg + 16 * i;
        const f32x4 r = *(const f32x4*)(r0 + d * 128 + 4 * e4);
        const f32x4 rn = r * g4 + v0 * ksm[d] + v1 * ksm[128 + d] + v2 * ksm[256 + d] + v3 * ksm[384 + d];
        *(f32x4*)(rout + d * 128 + 4 * e4) = rn;
#pragma unroll
        for (int t = 0; t < 4; ++t) acc[t] += r * qs[t * 128 + d];
    }
#pragma unroll
    for (int t = 0; t < 4; ++t) *(f32x4*)(red + (dg * 4 + t) * 128 + 4 * e4) = acc[t];
    __syncthreads();
    const int t = tid >> 7, e = tid & 127;
    float o = 0.f;
#pragma unroll
    for (int k = 0; k < 16; ++k) o += red[(k * 4 + t) * 128 + e];
    o *= __expf((float)(t + 1) * lng);
#pragma unroll
    for (int m = 0; m < 4; ++m) o += Am[t * 4 + m] * vs[m * 128 + e];
    float s1 = o, s2 = o * o;
#pragma unroll
    for (int k = 1; k < 64; k <<= 1) { s1 += __shfl_xor(s1, k); s2 += __shfl_xor(s2, k); }
    if (lane == 0) { ps[w * 2] = s1; ps[w * 2 + 1] = s2; }
    __syncthreads();
    const float S1 = ps[(2 * t) * 2] + ps[(2 * t + 1) * 2], S2 = ps[(2 * t) * 2 + 1] + ps[(2 * t + 1) * 2 + 1];
    const float mu = S1 * (1.0f / 128.0f), var = fmaxf(S2 * (1.0f / 128.0f) - mu * mu, 0.f);
    const size_t row = (size_t)(T + 4 * b + t);
    const float gv = __uint_as_float((unsigned)P[row * NP + C_GB + h * 128 + e] << 16);
    const float y = (o - mu) * rsqrtf(var + 1e-6f) * C.ret_norm_w[layer * 1024 + h * 128 + e] * silu_f(gv);
    Y[row * D + 1024 + h * 128 + e] = (bf16)(cvtpk(y, 0.f) & 0xffffu);
    __syncthreads();
}

#ifndef SKIPM
#define SKIPM 0
#endif
#ifndef REP_P0
#define REP_P0 1
#endif
#ifndef REP_G1
#define REP_G1 1
#endif
#ifndef REP_MX1
#define REP_MX1 1
#endif
#ifndef REP_RP
#define REP_RP 1
#endif
#ifndef REP_G2
#define REP_G2 1
#endif

#define GAS __attribute__((address_space(1)))
typedef GAS unsigned gu32;
#define XB_TMO      128
#define XB_XCNT(j)  (256  + 64 * (j))
#define XB_XSUB(j)  (1280 + 64 * (j))
#define XB_XGEN(j)  (2304 + 64 * (j))
#define XB_TOP      3328
#define XB_TOPGEN   3392
#define XCD_BAR_WORDS 3456
#define XB_SPIN_CAP (1u << 18)

__device__ __forceinline__ unsigned xb_ld(unsigned* p)              { return __hip_atomic_load(p, __ATOMIC_RELAXED, __HIP_MEMORY_SCOPE_AGENT); }
__device__ __forceinline__ unsigned xb_add(unsigned* p, unsigned v) { return __hip_atomic_fetch_add(p, v, __ATOMIC_RELAXED, __HIP_MEMORY_SCOPE_AGENT); }
__device__ __forceinline__ unsigned xb_xcc_id() { return (unsigned)__builtin_amdgcn_s_getreg((3 << 11) | 20) & 0xFu; }
#define XB_SPIN(cond, bar) do { unsigned _sp = 0; while (cond) { __builtin_amdgcn_s_sleep(1); \
    if ((++_sp & 255u) == 0u) { if (xb_ld(&(bar)[XB_TMO])) break; if (_sp > XB_SPIN_CAP) { atomicAdd(&(bar)[XB_TMO], 1u); break; } } } } while (0)

struct XcdBarrier {
    unsigned* bar; unsigned x;
    volatile LAS unsigned* st;
};

__device__ __forceinline__ XcdBarrier xcd_barrier_post(unsigned* bar, volatile LAS unsigned* st) {
    XcdBarrier b; b.bar = bar; b.x = xb_xcc_id(); b.st = st;
    if (threadIdx.x == 0) (void)xb_add(&bar[XB_XCNT(b.x)], 1u);
    return b;
}
__device__ __forceinline__ void xcd_barrier_complete(unsigned* bar, unsigned x, unsigned& nloc, unsigned& nx) {
    const unsigned G = gridDim.x * gridDim.y * gridDim.z;
    unsigned sum, cnt, mine, sp = 0u;
    for (;;) {
        sum = 0u; cnt = 0u; mine = 0u;
#pragma unroll
        for (unsigned j = 0; j < 16; ++j) { const unsigned c = xb_ld(&bar[XB_XCNT(j)]); sum += c; cnt += (c > 0u) ? 1u : 0u; mine = (j == x) ? c : mine; }
        if (sum == G) break;
        __builtin_amdgcn_s_sleep(1);
        if ((++sp & 255u) == 0u) { if (xb_ld(&bar[XB_TMO])) break; if (sp > XB_SPIN_CAP) { atomicAdd(&bar[XB_TMO], 1u); break; } }
    }
    nloc = mine > 0u ? mine : 1u; nx = cnt > 0u ? cnt : 1u;
}

__device__ __forceinline__ void xcd_barrier(const XcdBarrier& b) {
    asm volatile("s_waitcnt vmcnt(0)" ::: "memory");
    __syncthreads();
    if (threadIdx.x == 0) {
        unsigned* bar = b.bar;
        __builtin_amdgcn_s_waitcnt(0);
        unsigned nloc = b.st[0], nx = b.st[1];
        if (nloc == 0u) { xcd_barrier_complete(bar, b.x, nloc, nx); b.st[0] = nloc; b.st[1] = nx; }
        const unsigned old = xb_add(&bar[XB_XSUB(b.x)], 1u);
        const unsigned gen = old / nloc;
        if (old + 1u == (gen + 1u) * nloc) {
            __builtin_amdgcn_fence(__ATOMIC_RELEASE, "agent");
            asm volatile("s_waitcnt vmcnt(0)" ::: "memory");
            const unsigned og = xb_add(&bar[XB_TOP], 1u);
            const unsigned tg = og / nx;
            if (og + 1u == (tg + 1u) * nx) xb_add(&bar[XB_TOPGEN], 1u);
            else XB_SPIN(xb_ld(&bar[XB_TOPGEN]) == tg, bar);
            __builtin_amdgcn_fence(__ATOMIC_ACQUIRE, "agent");
            xb_add(&bar[XB_XGEN(b.x)], 1u);
            asm volatile("s_waitcnt vmcnt(0)" ::: "memory");
        } else {
            XB_SPIN(xb_ld(&bar[XB_XGEN(b.x)]) == gen, bar);
            __builtin_amdgcn_fence(__ATOMIC_ACQUIRE, "agent");
            asm volatile("s_waitcnt vmcnt(0)" ::: "memory");
        }
    }
    __syncthreads();
}

constexpr size_t WS_BAR = WS_CTL + 768 * 1024;
constexpr int LDS_BARST = LDS_BYTES - 64;
__global__ void __launch_bounds__(NTHREADS, 2) hymba_fwd(Ctx C) {
    extern __shared__ __attribute__((aligned(16))) unsigned char lds_raw[];
    cg::grid_group grid = cg::this_grid();
    if (threadIdx.x < 2) ((volatile LAS unsigned*)((LAS unsigned char*)lds_raw + LDS_BARST))[threadIdx.x] = 0u;
    __syncthreads();
    (void)xcd_barrier_post((unsigned*)(C.ws + WS_BAR), (volatile LAS unsigned*)((LAS unsigned char*)lds_raw + LDS_BARST));
    int ph = 0;
#define PHASE_BEGIN (C.ph_lo <= ph && ph < C.ph_hi)
#define PHASE_END do { if (C.ph_lo <= ph && ph + 1 < C.ph_hi) { if (ph == 0) grid.sync(); else { XcdBarrier xb_; xb_.bar = (unsigned*)(C.ws + WS_BAR); xb_.x = xb_xcc_id(); xb_.st = (volatile LAS unsigned*)((LAS unsigned char*)lds_raw + LDS_BARST); xcd_barrier(xb_); } } ++ph; } while (0)
#define PHASE_LOCALS int tid = threadIdx.x; LAUNDER_V(tid); const int lane = tid & 63, wave = __builtin_amdgcn_readfirstlane(tid >> 6); \
    int G = gridDim.x, bid = blockIdx.x; LAUNDER_S(G); LAUNDER_S(bid); char* lds = (char*)lds_raw; Ctx Cc = C; LAUNDER_S(Cc.ws); (void)lane; (void)wave; (void)lds

    if (PHASE_BEGIN) { PHASE_LOCALS; for (int rep = 0; rep < REP_P0; ++rep) { p0_prologue(Cc, lds, tid, wave, lane, G); __syncthreads(); } }
    PHASE_END;

    for (int layer = 0; layer < DEPTH; ++layer) {
        if (PHASE_BEGIN) {
            unsigned char* ws = C.ws; const int G = gridDim.x, bid = blockIdx.x;
            float* rss = (float*)(ws + WS_CTL); float* cosA = (float*)(ws + WS_TAB); float* sinA = cosA + NPOS * 32; float* cosB = sinA + NPOS * 32; float* sinB = cosB + NPOS * 64;
            pg8::Gemm g{(const bf16*)(ws + WS_XA), (const bf16*)(ws + WS_WIN) + (size_t)layer * NP * D, M, NP, D}; pg8::StaticOrder S; S.init(M, NP, G, bid);
            pg8::EpiProj E{(bf16*)(ws + WS_P), rss + layer * M, cosA, sinA, cosB, sinB, C.out, layer};
            for (int rep = 0; rep < REP_G1; ++rep) pg8::gemm_phase<pg8::EpiProj, pg8::StaticOrder, true, true>((LAS unsigned char*)lds_raw, g, S, E);
        }
        PHASE_END;
        if (PHASE_BEGIN) {
            PHASE_LOCALS; int ly = layer; LAUNDER_S(ly);
            for (int rep = 0; rep < REP_MX1; ++rep) for (int u = bid; u < 2048; u += G) {
                if (u < 512) { if (!(SKIPM & 1)) ret_u_unit(Cc, lds, u >> 3, u & 7, tid, wave, lane); }
                else if (u < 768) { const int a = u - 512; if (!(SKIPM & 2)) attn_prompt_unit(Cc, lds, ly, a >> 2, (a >> 1) & 1, a & 1, tid, wave, lane); }
                else if (u < 1024) { const int a = u - 768; if (!(SKIPM & 4)) attn_sample_unit(Cc, lds, ly, a >> 1, a & 1, tid); }
                else { const int a = u - 1024; if (!(SKIPM & 8)) ret_sample_unit(Cc, lds, ly, a >> 3, a & 7, tid, wave, lane); }
            }
        }
        PHASE_END;
        if (PHASE_BEGIN) { PHASE_LOCALS; int ly = layer; LAUNDER_S(ly); ret_scan(Cc, ly, tid, G); }
        PHASE_END;
        if (PHASE_BEGIN) { PHASE_LOCALS; int ly = layer; LAUNDER_S(ly); for (int rep = 0; rep < REP_RP; ++rep) for (int u = bid; u < 512; u += G) if (!(SKIPM & 16)) ret_prompt_unit(Cc, lds, ly, u >> 3, u & 7, tid, wave, lane); }
        PHASE_END;
        if (PHASE_BEGIN) {
            unsigned char* ws = C.ws; const int G = gridDim.x, bid = blockIdx.x;
            float* rss = (float*)(ws + WS_CTL); float* XR = (float*)(ws + WS_XR);
            pg8::Gemm g{(const bf16*)(ws + WS_Y), (const bf16*)(ws + WS_WOUT) + (size_t)layer * D * D, M, D, D}; pg8::StaticOrder S; S.init(M, D, G, bid);
            pg8::EpiRes E{layer == 0 ? C.x_prompt : XR, layer == 0 ? C.x_sample : XR + (size_t)T * D, layer == 0 ? XR : C.out, layer == 0 ? (bf16*)(ws + WS_XA) : nullptr, rss + (layer + 1) * M};
            pg8::gemm_phase<pg8::EpiRes, pg8::StaticOrder, true, true>((LAS unsigned char*)lds_raw, g, S, E);
            for (int rep = 1; rep < REP_G2; ++rep) { pg8::EpiRes E2 = E; E2.rss = rss + 131072; pg8::gemm_phase<pg8::EpiRes, pg8::StaticOrder, true, true>((LAS unsigned char*)lds_raw, g, S, E2); }
        }
        PHASE_END;
    }
#ifdef REP_SYNC
    for (int rep = 0; rep < REP_SYNC; ++rep) grid.sync();
#endif
    if (PHASE_BEGIN) {
        PHASE_LOCALS;
        const float* rf = (const float*)(Cc.ws + WS_CTL) + 2 * M;
        for (int m = bid * 8 + wave; m < M; m += G * 8) {
            const float rv = rsqrtf(rf[m] * (1.0f / 2048.0f) + 1e-6f);
            f32x4* xr = (f32x4*)(Cc.out + (size_t)m * D);
#pragma unroll
            for (int j = 0; j < 8; ++j) { const f32x4 wv = *((const f32x4*)Cc.final_w + lane + 64 * j); xr[lane + 64 * j] = xr[lane + 64 * j] * rv * wv; }
        }
    }
}

constexpr int N_PHASES = 1 + DEPTH * 5 + 1;
#ifndef MK_MULTI
#define MK_MULTI 0
#endif
extern "C" void kernel_launch(void* const* d_in, const int* in_sizes, int n_in, void* d_out, int out_size, void* d_ws, size_t ws_size, hipStream_t stream) {
    static int grid = 0;
    if (grid == 0) {
        if (n_in != 11 || ws_size < WS_END) { fprintf(stderr, "kernel_launch: unexpected inputs (n_in %d, ws %zu)\n", n_in, ws_size); grid = -1; return; }
        int dev = 0, cus = 0, per_cu = 0;
        hipGetDevice(&dev); hipDeviceGetAttribute(&cus, hipDeviceAttributeMultiprocessorCount, dev);
        if (hipFuncSetAttribute((const void*)hymba_fwd, hipFuncAttributeMaxDynamicSharedMemorySize, LDS_BYTES) != hipSuccess) { fprintf(stderr, "kernel_launch: hipFuncSetAttribute failed\n"); grid = -1; return; }
        if (hipOccupancyMaxActiveBlocksPerMultiprocessor(&per_cu, (const void*)hymba_fwd, NTHREADS, LDS_BYTES) != hipSuccess || per_cu < 1) { fprintf(stderr, "kernel_launch: occupancy query says %d\n", per_cu); (void)hipGetLastError(); per_cu = 1; }
        grid = cus;
    }
    if (grid < 0) return;
    hipMemsetAsync((char*)d_ws + WS_CTL, 0, CTL_BYTES, stream);
    Ctx c{};
    c.x_prompt = (const float*)d_in[0]; c.x_sample = (const float*)d_in[1]; c.cache_k = (const float*)d_in[2]; c.cache_v = (const float*)d_in[3]; c.state = (const float*)d_in[4];
    c.norm_w = (const float*)d_in[5]; c.w_in = (const float*)d_in[6]; c.sinks = (const float*)d_in[7]; c.ret_norm_w = (const float*)d_in[8]; c.w_out = (const float*)d_in[9]; c.final_w = (const float*)d_in[10];
    c.out = (float*)d_out; c.ws = (unsigned char*)d_ws;
#if MK_MULTI
    for (int p = 0; p < N_PHASES; ++p) { c.ph_lo = p; c.ph_hi = p + 1; void* args[] = {&c};
        hipError_t e = hipLaunchCooperativeKernel((const void*)hymba_fwd, dim3(grid), dim3(NTHREADS), args, LDS_BYTES, stream);
        if (e != hipSuccess) { fprintf(stderr, "launch %d failed: %s\n", p, hipGetErrorString(e)); break; } }
#else
    c.ph_lo = 0; c.ph_hi = N_PHASES; void* args[] = {&c};
    hipError_t e = hipLaunchCooperativeKernel((const void*)hymba_fwd, dim3(grid), dim3(NTHREADS), args, LDS_BYTES, stream);
    if (e != hipSuccess) fprintf(stderr, "cooperative launch failed: %s (grid %d)\n", hipGetErrorString(e), grid);
#endif
}
```

```cpp
#include <hip/hip_runtime.h>
#include <hip/hip_cooperative_groups.h>
#include <cstdio>
#include <cstdint>
namespace cg = cooperative_groups;
namespace pg8 {
#define PG8_LAS __attribute__((address_space(3)))
typedef unsigned short bf16_t;
typedef short bf16x8 __attribute__((ext_vector_type(8)));
typedef float f32x4 __attribute__((ext_vector_type(4)));
typedef unsigned u32x4 __attribute__((ext_vector_type(4)));
constexpr int BM = 256, BK = 64, HALF = 128, HTB = HALF * BK * 2  , STAGE_BYTES = 8 * HTB, NXCD = 8, WGM = 8;

__host__ __device__ __forceinline__ int lds_byte(int r, int c) { const int st = (r >> 4) * 2 + (c >> 5), rr = r & 15, cc = c & 31, ob = rr * 64 + cc * 2; return st * 1024 + (ob ^ (((ob >> 9) & 1) << 5)); }
__host__ __device__ __forceinline__ void stage_rc(int b, int& R, int& C) { const int st = b / 1024, sb = b % 1024, swz = sb ^ (((sb >> 9) & 1) << 5); R = (st >> 1) * 16 + swz / 64; C = (st & 1) * 32 + (swz % 64) / 2; }
__host__ __device__ __forceinline__ int perm32(int rho) { const int n = rho >> 4, i = rho & 15; return 8 * (i >> 2) + 4 * n + (i & 3); }

struct Unit { int pm, pn; };
struct Gemm { const bf16_t* A; const bf16_t* Bt; int M, N, K; };

struct StaticOrder {
    int nM, nN, nwg, G, c;
    __host__ __device__ void init(int M, int N, int G_, int c_) { nM = M / BM; nN = N / BM; nwg = nM * nN; G = G_; c = c_; }
    __host__ __device__ bool next(int i, Unit& u) const {
        const long L = (long)i * G + c; if (L >= nwg) return false;
        int wgid = (int)L; { const int q = nwg / NXCD, r = nwg % NXCD, xcd = wgid % NXCD, off = wgid / NXCD; wgid = (xcd < r ? xcd * (q + 1) : r * (q + 1) + (xcd - r) * q) + off; }
        const int nig = WGM * nN, gid = wgid / nig, fm = gid * WGM, gsz = (nM - fm) < WGM ? (nM - fm) : WGM;
        u.pm = fm + ((wgid % nig) % gsz); u.pn = (wgid % nig) / gsz; return true;
    }
    __device__ __forceinline__ void a_ready(const Unit&) const {}
    __device__ __forceinline__ void done(const Unit&) const {}
};

__device__ __forceinline__ unsigned cvt_pk_bf16(float lo, float hi) { unsigned r; asm volatile("v_cvt_pk_bf16_f32 %0, %1, %2" : "=v"(r) : "v"(lo), "v"(hi)); return r; }
constexpr int T_ = 8192, NPROJ = 6400, DMODEL = 2048;
constexpr size_t O_KP = (size_t)8704 * 2048, O_VP = O_KP + 32768, O_RP = O_VP + 32768, O_KS = O_RP + 262144, O_VS = O_KS + 4194304, O_RS = O_VS + 4194304;

struct EpiProj {
    static constexpr bool PERM = true, AFTER_DRAIN = false;
    bf16_t* P; const float* rss; const float* cosA; const float* sinA; const float* cosB; const float* sinB; float* out; int layer;
    __device__ __forceinline__ void operator()(const f32x4 (&acc)[2][2][4][2], const Unit& u, int wr, int wc, int fr, int fq) const {
        float rv[2][4];
#pragma unroll
        for (int ai = 0; ai < 2; ++ai)
#pragma unroll
            for (int m = 0; m < 4; ++m) rv[ai][m] = rsqrtf(rss[u.pm * BM + ai * HALF + wr * 64 + m * 16 + fr] * (1.0f / 2048.0f) + 1e-6f);
#pragma unroll
        for (int bj = 0; bj < 2; ++bj) {
            const int cb = u.pn * BM + bj * HALF;
            const int c0 = cb + wc * 32 + 8 * fq;
            const int mode = (cb < 1152) ? 1 : ((cb >= 2304 && cb < 4352) ? 2 : 0);
            const int kvmode = (cb == 1024) ? 1 : ((cb == 1152) ? 2 : 0);
#pragma unroll
            for (int ai = 0; ai < 2; ++ai)
#pragma unroll
                for (int m = 0; m < 4; ++m) {
                    const int row = u.pm * BM + ai * HALF + wr * 64 + m * 16 + fr;
                    f32x4 v0 = acc[ai][bj][m][0] * rv[ai][m], v1 = acc[ai][bj][m][1] * rv[ai][m];
                    if (mode) {
                        const int pos = row < T_ ? row : T_ + ((row - T_) & 3);
                        f32x4 c, s;
                        if (mode == 1) { const int i = (c0 & 63) >> 3; c = *(const f32x4*)(cosA + pos * 32 + 4 * i); s = *(const f32x4*)(sinA + pos * 32 + 4 * i); }
                        else { const int i = (c0 & 127) >> 3; c = *(const f32x4*)(cosB + pos * 64 + 4 * i); s = *(const f32x4*)(sinB + pos * 64 + 4 * i); }
                        const f32x4 y0 = v0 * c - v1 * s, y1 = v1 * c + v0 * s; v0 = y0; v1 = y1;
                    }
                    u32x4 w; w.x = cvt_pk_bf16(v0[0], v0[1]); w.y = cvt_pk_bf16(v0[2], v0[3]); w.z = cvt_pk_bf16(v1[0], v1[1]); w.w = cvt_pk_bf16(v1[2], v1[3]);
                    *(u32x4*)(P + (size_t)row * NPROJ + c0) = w;
                    if (kvmode && row >= T_ - 128) {
                        const int kvh = (c0 - cb) >> 6, g0 = c0 & 63;
                        float* dst;
                        if (row < T_) dst = out + (kvmode == 1 ? O_KP : O_VP) + ((size_t)(layer * 128 + (row - (T_ - 128))) * 2 + kvh) * 64;
                        else { const int b = (row - T_) >> 2, t = (row - T_) & 3; dst = out + (kvmode == 1 ? O_KS : O_VS) + ((((size_t)layer * 128 + b) * 128 + 124 + t) * 2 + kvh) * 64; }
                        if (kvmode == 1) { const int i = g0 >> 3; *(f32x4*)(dst + 4 * i) = v0; *(f32x4*)(dst + 4 * i + 32) = v1; }
                        else { *(f32x4*)(dst + g0) = v0; *(f32x4*)(dst + g0 + 4) = v1; }
                    }
                }
        }
    }
};

struct EpiRes {
    static constexpr bool PERM = true, AFTER_DRAIN = false;
    const float* base_p; const float* base_s; float* outx; bf16_t* xa; float* rss;
    __device__ __forceinline__ void operator()(const f32x4 (&acc)[2][2][4][2], const Unit& u, int wr, int wc, int fr, int fq) const {
#pragma unroll
        for (int ai = 0; ai < 2; ++ai)
#pragma unroll
            for (int m = 0; m < 4; ++m) {
                const int row = u.pm * BM + ai * HALF + wr * 64 + m * 16 + fr;
                const float* bp = row < T_ ? base_p + (size_t)row * DMODEL : base_s + (size_t)(row - T_) * DMODEL;
                float ss = 0.f;
#pragma unroll
                for (int bj = 0; bj < 2; ++bj) {
                    const int c0 = u.pn * BM + bj * HALF + wc * 32 + 8 * fq;
                    const f32x4 b0 = *(const f32x4*)(bp + c0), b1 = *(const f32x4*)(bp + c0 + 4);
                    const f32x4 v0 = acc[ai][bj][m][0] + b0, v1 = acc[ai][bj][m][1] + b1;
                    *(f32x4*)(outx + (size_t)row * DMODEL + c0) = v0; *(f32x4*)(outx + (size_t)row * DMODEL + c0 + 4) = v1;
                    if (xa) { u32x4 w; w.x = cvt_pk_bf16(v0[0], v0[1]); w.y = cvt_pk_bf16(v0[2], v0[3]); w.z = cvt_pk_bf16(v1[0], v1[1]); w.w = cvt_pk_bf16(v1[2], v1[3]);
                        *(u32x4*)(xa + (size_t)row * DMODEL + c0) = w; }
                    ss += (v0[0] * v0[0] + v0[1] * v0[1]) + (v0[2] * v0[2] + v0[3] * v0[3]) + (v1[0] * v1[0] + v1[1] * v1[1]) + (v1[2] * v1[2] + v1[3] * v1[3]);
                }
                ss += __shfl_xor(ss, 16); ss += __shfl_xor(ss, 32);
                if (fq == 0) atomicAdd(rss + row, ss);
            }
    }
};

template <class Epi, class Sched, bool ALIGN_EPI = false, bool SP2 = false>
__device__ __forceinline__ void gemm_phase(PG8_LAS unsigned char* lds, const Gemm g, const Sched& S, const Epi& E) {
    int tid_ = threadIdx.x; asm volatile("" : "+v"(tid_));
    const int tid = tid_, wid = __builtin_amdgcn_readfirstlane(tid >> 6), lane = tid & 63, wr = wid >> 2, wc = wid & 3, fr = lane & 15, fq = lane >> 4;
    const int K = g.K, nt = K / BK;
    unsigned voffA[2], voffB[2];
#pragma unroll
    for (int i = 0; i < 2; ++i) { int R, C; stage_rc(tid * 16 + i * 8192, R, C); const int Rb = Epi::PERM ? ((R & ~31) + perm32(R & 31)) : R;
        voffA[i] = (unsigned)(R * K + C) * 2u; voffB[i] = (unsigned)(Rb * K + C) * 2u; }
    const size_t kstep = (size_t)(BK * 2);
    const size_t hstep = (size_t)HALF * K * 2;
    const size_t tstep = 2 * hstep;
    const unsigned ldsw = (unsigned)wid * 1024u;
    const int aoff = lds_byte(wr * 64 + fr, fq * 8), boff = lds_byte(wc * 32 + fr, fq * 8);
#define PG8_SA(b, h) (((b) * 2 + (h)) * HTB)
#define PG8_SB(b, h) ((4 + (b) * 2 + (h)) * HTB)
#define PG8_STAGE(bufoff, gbase, voff) do { _Pragma("unroll") for (int _i = 0; _i < 2; ++_i) \
        __builtin_amdgcn_global_load_lds((const unsigned*)((const char*)(gbase) + (voff)[_i]), (PG8_LAS unsigned*)(lds + (bufoff) + ldsw + _i * 8192), 16, 0, 0); } while (0)
#define PG8_LDA(dst, b, h) do { _Pragma("unroll") for (int m = 0; m < 4; ++m) _Pragma("unroll") for (int k = 0; k < 2; ++k) dst[m][k] = *(const PG8_LAS bf16x8*)(lds + PG8_SA(b, h) + aoff + m * 2048 + k * 1024); } while (0)
#define PG8_LDB(dst, b, h) do { _Pragma("unroll") for (int n = 0; n < 2; ++n) _Pragma("unroll") for (int k = 0; k < 2; ++k) dst[n][k] = *(const PG8_LAS bf16x8*)(lds + PG8_SB(b, h) + boff + n * 2048 + k * 1024); } while (0)
#define PG8_MMA(ai, bj, At, Bt) do { __builtin_amdgcn_s_setprio(1); _Pragma("unroll") for (int m = 0; m < 4; ++m) _Pragma("unroll") for (int n = 0; n < 2; ++n) _Pragma("unroll") for (int k = 0; k < 2; ++k) \
        acc[ai][bj][m][n] = __builtin_amdgcn_mfma_f32_16x16x32_bf16(Bt[n][k], At[m][k], acc[ai][bj][m][n], 0, 0, 0); __builtin_amdgcn_s_setprio(0); } while (0)
#define PG8_WAIT_V(n) asm volatile("s_waitcnt vmcnt(" #n ")" ::: "memory")
#define PG8_WAIT_L(n) asm volatile("s_waitcnt lgkmcnt(" #n ")" ::: "memory")
#define PG8_BAR __builtin_amdgcn_s_barrier()
#define PG8_SCHED __builtin_amdgcn_sched_barrier(0)
    Unit cur, nxt; int ui = 0;
    if (!S.next(0, cur)) return;
    f32x4 acc[2][2][4][2];
#pragma unroll
    for (int a = 0; a < 2; ++a)
#pragma unroll
        for (int b = 0; b < 2; ++b)
#pragma unroll
            for (int m = 0; m < 4; ++m)
#pragma unroll
                for (int n = 0; n < 2; ++n) acc[a][b][m][n] = (f32x4){0.f, 0.f, 0.f, 0.f};
    bf16x8 At[4][2], B0[2][2], B1[2][2];
    const char* cA = (const char*)g.A + (size_t)cur.pm * tstep; const char* cB = (const char*)g.Bt + (size_t)cur.pn * tstep;
    S.a_ready(cur);
    if constexpr (SP2) {
        PG8_STAGE(PG8_SB(0, 0), cB, voffB); PG8_STAGE(PG8_SB(0, 1), cB + hstep, voffB); PG8_STAGE(PG8_SA(0, 0), cA, voffA); PG8_STAGE(PG8_SA(0, 1), cA + hstep, voffA);
        if (wr == 1) PG8_BAR;
        PG8_WAIT_V(2); PG8_BAR;
        PG8_STAGE(PG8_SB(1, 0), cB + kstep, voffB); PG8_STAGE(PG8_SA(1, 0), cA + kstep, voffA); PG8_STAGE(PG8_SB(1, 1), cB + hstep + kstep, voffB);
        PG8_WAIT_V(6); PG8_BAR;
    } else {
        PG8_STAGE(PG8_SB(0, 0), cB, voffB); PG8_STAGE(PG8_SA(0, 0), cA, voffA); PG8_STAGE(PG8_SB(0, 1), cB + hstep, voffB); PG8_STAGE(PG8_SA(0, 1), cA + hstep, voffA);
        if (wr == 1) PG8_BAR;
        PG8_WAIT_V(4); PG8_BAR;
        PG8_STAGE(PG8_SB(1, 0), cB + kstep, voffB); PG8_STAGE(PG8_SA(1, 0), cA + kstep, voffA); PG8_STAGE(PG8_SB(1, 1), cB + hstep + kstep, voffB);
        PG8_WAIT_V(6); PG8_BAR;
    }
    for (;;) {
        const bool has_next = S.next(ui + 1, nxt);
        const char* nA = has_next ? (const char*)g.A + (size_t)nxt.pm * tstep : cA; const char* nB = has_next ? (const char*)g.Bt + (size_t)nxt.pn * tstep : cB;
        for (int t = 0; t < nt; t += 2) {
            const bool last = (t == nt - 2);
            const char* a1 = cA + (size_t)(t + 1) * kstep;
            const char* a2 = last ? nA : cA + (size_t)(t + 2) * kstep; const char* b2 = last ? nB : cB + (size_t)(t + 2) * kstep;
            const char* a3 = a2 + kstep; const char* b3 = b2 + kstep;
            if (last && has_next) S.a_ready(nxt);
            if constexpr (SP2) {
            PG8_LDB(B0, 0, 0); PG8_LDB(B1, 0, 1); PG8_SCHED; PG8_LDA(At, 0, 0); PG8_STAGE(PG8_SA(1, 1), a1 + hstep, voffA);
            PG8_WAIT_V(8); PG8_WAIT_L(0); PG8_BAR; PG8_MMA(0, 0, At, B0); PG8_MMA(0, 1, At, B1); PG8_BAR; PG8_SCHED;
            PG8_LDA(At, 0, 1); PG8_STAGE(PG8_SB(0, 0), b2, voffB); PG8_STAGE(PG8_SB(0, 1), b2 + hstep, voffB); PG8_STAGE(PG8_SA(0, 0), a2, voffA);
            PG8_WAIT_V(8); PG8_WAIT_L(0); PG8_BAR; PG8_MMA(1, 0, At, B0); PG8_MMA(1, 1, At, B1); PG8_BAR; PG8_SCHED;
            PG8_LDB(B0, 1, 0); PG8_LDB(B1, 1, 1); PG8_SCHED; PG8_LDA(At, 1, 0); PG8_STAGE(PG8_SA(0, 1), a2 + hstep, voffA);
            PG8_WAIT_V(8); PG8_WAIT_L(0); PG8_BAR; PG8_MMA(0, 0, At, B0); PG8_MMA(0, 1, At, B1); PG8_BAR; PG8_SCHED;
            PG8_LDA(At, 1, 1); PG8_STAGE(PG8_SB(1, 0), b3, voffB); PG8_STAGE(PG8_SB(1, 1), b3 + hstep, voffB); PG8_STAGE(PG8_SA(1, 0), a3, voffA);
            PG8_WAIT_V(8); PG8_WAIT_L(0); PG8_BAR; PG8_MMA(1, 0, At, B0); PG8_MMA(1, 1, At, B1); PG8_BAR; PG8_SCHED;
            } else {
            PG8_LDB(B0, 0, 0); PG8_SCHED; PG8_LDA(At, 0, 0); PG8_STAGE(PG8_SA(1, 1), a1 + hstep, voffA);
            PG8_WAIT_L(8); PG8_BAR; PG8_WAIT_L(0); PG8_MMA(0, 0, At, B0); PG8_BAR; PG8_SCHED;
            PG8_LDB(B1, 0, 1); PG8_STAGE(PG8_SB(0, 0), b2, voffB);
            PG8_BAR; PG8_WAIT_L(0); PG8_MMA(0, 1, At, B1); PG8_BAR;
            PG8_LDA(At, 0, 1); PG8_STAGE(PG8_SA(0, 0), a2, voffA);
            PG8_BAR; PG8_WAIT_L(0); PG8_MMA(1, 0, At, B0); PG8_BAR; PG8_SCHED;
            PG8_STAGE(PG8_SB(0, 1), b2 + hstep, voffB);
            PG8_WAIT_V(6); PG8_BAR; PG8_MMA(1, 1, At, B1); PG8_BAR;
            PG8_LDB(B0, 1, 0); PG8_SCHED; PG8_LDA(At, 1, 0); PG8_STAGE(PG8_SA(0, 1), a2 + hstep, voffA);
            PG8_WAIT_L(8); PG8_BAR; PG8_WAIT_L(0); PG8_MMA(0, 0, At, B0); PG8_BAR; PG8_SCHED;
            PG8_LDB(B1, 1, 1); PG8_STAGE(PG8_SB(1, 0), b3, voffB);
            PG8_BAR; PG8_WAIT_L(0); PG8_MMA(0, 1, At, B1); PG8_BAR;
            PG8_LDA(At, 1, 1); PG8_STAGE(PG8_SA(1, 0), a3, voffA);
            PG8_BAR; PG8_WAIT_L(0); PG8_MMA(1, 0, At, B0); PG8_BAR; PG8_SCHED;
            PG8_STAGE(PG8_SB(1, 1), b3 + hstep, voffB);
            PG8_WAIT_V(6); PG8_BAR; PG8_MMA(1, 1, At, B1); PG8_BAR;
            }
        }
        if constexpr (ALIGN_EPI) { if (wr == 0) PG8_BAR; }
        if constexpr (!Epi::AFTER_DRAIN) { E(acc, cur, wr, wc, fr, fq); S.done(cur); }
        if (!has_next) break;
#pragma unroll
        for (int a = 0; a < 2; ++a)
#pragma unroll
            for (int b = 0; b < 2; ++b)
#pragma unroll
                for (int m = 0; m < 4; ++m)
#pragma unroll
                    for (int n = 0; n < 2; ++n) acc[a][b][m][n] = (f32x4){0.f, 0.f, 0.f, 0.f};
        cur = nxt; cA = nA; cB = nB; ++ui;
        if constexpr (ALIGN_EPI) { if (wr == 1) PG8_BAR; }
    }
    PG8_WAIT_V(0);
    if constexpr (!ALIGN_EPI) { if (wr == 0) PG8_BAR; }
    PG8_BAR;
    if constexpr (Epi::AFTER_DRAIN) { E.fused(acc, cur, wr, wc, fr, fq, lds, wid, lane); S.done(cur); }
#undef PG8_SA
#undef PG8_SB
#undef PG8_STAGE
#undef PG8_LDA
#undef PG8_LDB
#undef PG8_MMA
#undef PG8_WAIT_V
#undef PG8_WAIT_L
#undef PG8_BAR
#undef PG8_SCHED
}
}

typedef unsigned short bf16;
typedef float f32x4 __attribute__((ext_vector_type(4)));
typedef short bf16x8 __attribute__((ext_vector_type(8)));
typedef short s16x4 __attribute__((ext_vector_type(4)));
typedef unsigned u32x4 __attribute__((ext_vector_type(4)));
typedef unsigned u32x2 __attribute__((ext_vector_type(2)));
typedef float f32x2 __attribute__((ext_vector_type(2)));
typedef __bf16 bf16x2_t __attribute__((ext_vector_type(2)));
#define LAS __attribute__((address_space(3)))

constexpr int T = 8192, NS = 512, M = 8704, D = 2048, NP = 6400, DEPTH = 2;
constexpr int C_QA = 0, C_KA = 1024, C_VA = 1152, C_GA = 1280, C_QB = 2304, C_KB = 3328, C_VB = 4352, C_GB = 5376;
constexpr int NPOS = 8196;
constexpr int LDS_BYTES = 147456;
constexpr int NTHREADS = 512;
using pg8::O_KP; using pg8::O_VP; using pg8::O_RP; using pg8::O_KS; using pg8::O_VS; using pg8::O_RS;

constexpr size_t MiB = 1u << 20;
constexpr size_t WS_CTL = 0, CTL_BYTES = 1 * MiB;
constexpr size_t WS_WIN = 2 * MiB;
constexpr size_t WS_WOUT = WS_WIN + 50 * MiB;
constexpr size_t WS_XA = WS_WOUT + 16 * MiB;
constexpr size_t WS_P = WS_XA + 34 * MiB;
constexpr size_t WS_Y = WS_P + 107 * MiB;
constexpr size_t WS_XR = WS_Y + 34 * MiB;
constexpr size_t WS_U = WS_XR + 68 * MiB;
constexpr size_t WS_RT = WS_U + 32 * MiB;
constexpr size_t WS_TAB = WS_RT + 16 * MiB;
constexpr size_t WS_END = WS_TAB + 8 * MiB;

struct Ctx {
    const float *x_prompt, *x_sample, *cache_k, *cache_v, *state, *norm_w, *w_in, *sinks, *ret_norm_w, *w_out, *final_w;
    float* out; unsigned char* ws;
    int ph_lo, ph_hi;
};

__device__ __forceinline__ unsigned cvtpk(float lo, float hi) { f32x2 v = {lo, hi}; bf16x2_t b = __builtin_convertvector(v, bf16x2_t); return __builtin_bit_cast(unsigned, b); }
__device__ __forceinline__ float bf_lo(unsigned u) { return __uint_as_float(u << 16); }
__device__ __forceinline__ float bf_hi(unsigned u) { return __uint_as_float(u & 0xffff0000u); }
__device__ __forceinline__ float silu_f(float x) { return x / (1.0f + __expf(-x)); }
__device__ __forceinline__ s16x4 vtr(const char* p) { typedef short v4i16_t __attribute__((ext_vector_type(4)));
    return __builtin_bit_cast(s16x4, __builtin_amdgcn_ds_read_tr16_b64_v4i16((LAS v4i16_t*)p)); }
__device__ __forceinline__ bf16x8 cat8(s16x4 lo, s16x4 hi) { return (bf16x8){lo[0], lo[1], lo[2], lo[3], hi[0], hi[1], hi[2], hi[3]}; }
__device__ __forceinline__ float ln_gamma(int h) {
    const double x = __builtin_ldexp(1.0, -5 - h);
    double s = 0.0, p = x;
#pragma unroll
    for (int k = 1; k <= 9; ++k) { s += p / (double)k; p *= x; }
    return (float)(-s);
}
#define LDS_WAIT() asm volatile("s_waitcnt lgkmcnt(0)" ::: "memory")
#define LAUNDER_V(x) asm volatile("" : "+v"(x))
#define LAUNDER_S(x) asm volatile("" : "+s"(x))

__device__ __forceinline__ int perm_src_col(int np, float& sc) {
    sc = 1.0f;
    if (np < 1152) { const int hb = np & ~63, g = np & 63; if (np < 1024) sc = 0.125f; return hb + 4 * (g >> 3) + (g & 3) + 32 * ((g >> 2) & 1); }
    if (np >= C_QB && np < C_VB) { const int hb = np & ~127, g = np & 127; if (np >= C_KB) sc = 0.08838834764831845f; return hb + 4 * (g >> 3) + (g & 3) + 64 * ((g >> 2) & 1); }
    return np;
}

template <bool WIN>
__device__ __forceinline__ void transpose_item(const float* W, int N, const float* nw, bf16* WT, float* scr, int kb, int nb, int lane) {
    const int k0 = 64 * kb, n0 = 64 * nb, l16 = lane & 15, r4 = lane >> 4;
    float sc = 1.0f; int srcc = n0 + 4 * l16;
    if (WIN) srcc = perm_src_col(n0 + 4 * l16, sc);
#pragma unroll 4
    for (int i = 0; i < 16; ++i) {
        const int kk = 4 * i + r4;
        const f32x4 v = *(const f32x4*)(W + (size_t)(k0 + kk) * N + srcc);
        float s2 = sc; if (WIN) s2 *= nw[k0 + kk];
        float* d = scr + kk * 65 + 4 * l16;
        d[0] = v[0] * s2; d[1] = v[1] * s2; d[2] = v[2] * s2; d[3] = v[3] * s2;
    }
    LDS_WAIT();
    const int c = lane & 7;
#pragma unroll
    for (int j = 0; j < 8; ++j) {
        const int n = (lane >> 3) + 8 * j; const float* s = scr + (8 * c) * 65 + n;
        u32x4 o; o.x = cvtpk(s[0], s[65]); o.y = cvtpk(s[130], s[195]); o.z = cvtpk(s[260], s[325]); o.w = cvtpk(s[390], s[455]);
        *(u32x4*)(WT + (size_t)(n0 + n) * 2048 + k0 + 8 * c) = o;
    }
    LDS_WAIT();
}

__device__ __forceinline__ void p0_prologue(const Ctx& C, char* lds, int tid, int wave, int lane, int G) {
    float* scr = (float*)(lds + wave * 16640);
    const int gw = blockIdx.x * 8 + wave, NGW = G * 8;
    bf16* WIN = (bf16*)(C.ws + WS_WIN); bf16* WOUT = (bf16*)(C.ws + WS_WOUT);
    constexpr int I_IN = 32 * 100, I_OUT = 32 * 32, NITEMS = 2 * (I_IN + I_OUT);
    for (int it = gw; it < NITEMS; it += NGW) {
        int r = it;
        if (r < 2 * I_IN) { const int l = r / I_IN; r -= l * I_IN; const int nb = r % 100, kb = r / 100;
            transpose_item<true>(C.w_in + (size_t)l * D * NP, NP, C.norm_w + l * D, WIN + (size_t)l * NP * D, scr, kb, nb, lane); }
        else { r -= 2 * I_IN; const int l = r / I_OUT; r -= l * I_OUT; const int nb = r & 31, kb = r >> 5;
            transpose_item<false>(C.w_out + (size_t)l * D * D, D, nullptr, WOUT + (size_t)l * D * D, scr, kb, nb, lane); }
    }
    bf16* XA = (bf16*)(C.ws + WS_XA); float* rss = (float*)(C.ws + WS_CTL);
    for (int m = gw; m < M; m += NGW) {
        const float* xr = m < T ? C.x_prompt + (size_t)m * D : C.x_sample + (size_t)(m - T) * D;
        float ss = 0.f;
#pragma unroll
        for (int j = 0; j < 8; ++j) {
            const f32x4 v = *((const f32x4*)xr + lane + 64 * j);
            ss += (v[0] * v[0] + v[1] * v[1]) + (v[2] * v[2] + v[3] * v[3]);
            u32x2 o; o.x = cvtpk(v[0], v[1]); o.y = cvtpk(v[2], v[3]);
            *((u32x2*)(XA + (size_t)m * D) + lane + 64 * j) = o;
        }
#pragma unroll
        for (int o = 1; o < 64; o <<= 1) ss += __shfl_xor(ss, o);
        if (lane == 0) rss[m] = ss;
    }
    float* cosA = (float*)(C.ws + WS_TAB); float* sinA = cosA + NPOS * 32; float* cosB = sinA + NPOS * 32; float* sinB = cosB + NPOS * 64;
    for (int i = blockIdx.x * NTHREADS + tid; i < NPOS * 96; i += G * NTHREADS) {
        int pos, f, half; float *pc, *ps;
        if (i < NPOS * 32) { pos = i >> 5; f = i & 31; half = 32; pc = cosA + i; ps = sinA + i; }
        else { const int k = i - NPOS * 32; pos = k >> 6; f = k & 63; half = 64; pc = cosB + k; ps = sinB + k; }
        const double rr = half == 32 ? 0.7498942093324559 : 0.8659643233600653;
        double inv = 1.0; for (int k = 0; k < f; ++k) inv *= rr;
        const float ang = (float)pos * (float)inv;
        const double a = (double)ang;
        const double qd = __builtin_rint(a * 0.6366197723675814);
        double r = __builtin_fma(-qd, 1.5707963267948966, a); r = __builtin_fma(-qd, 6.123233995736766e-17, r);
        const double r2 = r * r;
        double sp = -1.0 / 39916800.0; sp = sp * r2 + 1.0 / 362880.0; sp = sp * r2 - 1.0 / 5040.0; sp = sp * r2 + 1.0 / 120.0; sp = sp * r2 - 1.0 / 6.0; sp = sp * r2 + 1.0; sp *= r;
        double cp = 1.0 / 479001600.0; cp = cp * r2 - 1.0 / 3628800.0; cp = cp * r2 + 1.0 / 40320.0; cp = cp * r2 - 1.0 / 720.0; cp = cp * r2 + 1.0 / 24.0; cp = cp * r2 - 0.5; cp = cp * r2 + 1.0;
        const int qi = ((int)qd) & 3;
        const double sv = (qi == 0) ? sp : (qi == 1) ? cp : (qi == 2) ? -sp : -cp;
        const double cv = (qi == 0) ? cp : (qi == 1) ? -sp : (qi == 2) ? -cp : sp;
        *pc = (float)cv; *ps = (float)sv;
    }
}

__device__ __forceinline__ void attn_prompt_unit(const Ctx& C, char* lds, int layer, int blk, int kvh, int hq, int tid, int w, int lane) {
    const bf16* P = (const bf16*)(C.ws + WS_P); bf16* Y = (bf16*)(C.ws + WS_Y);
    char* Ks = lds; char* Vs = lds + 36864;
#pragma unroll
    for (int it = 0; it < 4; ++it) {
        const int r = (tid >> 3) + 64 * it, ch = tid & 7, krow = blk * 128 - 128 + r;
        u32x4 kv = (u32x4){0u, 0u, 0u, 0u}, vv = kv;
        if (krow >= 0) { kv = *(const u32x4*)(P + (size_t)krow * NP + C_KA + kvh * 64 + ch * 8); vv = *(const u32x4*)(P + (size_t)krow * NP + C_VA + kvh * 64 + ch * 8); }
        *(u32x4*)(Ks + r * 144 + ch * 16) = kv; *(u32x4*)(Vs + r * 144 + ch * 16) = vv;
    }
    __syncthreads();
    const int q = lane & 15, g = lane >> 4;
    const int jt0 = w < 6 ? w : 6;
    const int iq = 16 * w + q, row = blk * 128 + iq;
    for (int hh = 0; hh < 4; ++hh) {
        const int h = kvh * 8 + hq * 4 + hh;
        bf16x8 qf[2];
#pragma unroll
        for (int ks = 0; ks < 2; ++ks) qf[ks] = *(const bf16x8*)(P + (size_t)row * NP + C_QA + h * 64 + 32 * ks + 8 * g);
        f32x4 s[10];
        float mx = -INFINITY;
        int lo = (blk > 0 || iq + 1 >= 128) ? iq + 1 : 128; LAUNDER_V(lo);
        const unsigned span = (unsigned)(iq + 128 - lo);
#pragma unroll
        for (int tt = 0; tt < 10; ++tt) {
            const int jt = jt0 + tt;
            f32x4 a = (f32x4){0.f, 0.f, 0.f, 0.f};
#pragma unroll
            for (int ks = 0; ks < 2; ++ks) { const bf16x8 kf = *(const bf16x8*)(Ks + (16 * jt + q) * 144 + (32 * ks + 8 * g) * 2); a = __builtin_amdgcn_mfma_f32_16x16x32_bf16(kf, qf[ks], a, 0, 0, 0); }
#pragma unroll
            for (int j = 0; j < 4; ++j) {
                const int jj = 16 * jt + 4 * g + j;
                a[j] = ((unsigned)(jj - lo) <= span) ? a[j] : -INFINITY; mx = fmaxf(mx, a[j]);
            }
            s[tt] = a;
        }
        mx = fmaxf(mx, __shfl_xor(mx, 16)); mx = fmaxf(mx, __shfl_xor(mx, 32));
        const float sink = C.sinks[layer * 16 + h];
        const float mm = fmaxf(mx, sink);
        float sum = 0.f;
#pragma unroll
        for (int tt = 0; tt < 10; ++tt)
#pragma unroll
            for (int j = 0; j < 4; ++j) { const float e = __expf(s[tt][j] - mm); s[tt][j] = e; sum += e; }
        sum += __shfl_xor(sum, 16); sum += __shfl_xor(sum, 32);
        const float inv = 1.0f / (sum + __expf(sink - mm));
        f32x4 o[4];
#pragma unroll
        for (int dt = 0; dt < 4; ++dt) o[dt] = (f32x4){0.f, 0.f, 0.f, 0.f};
#pragma unroll
        for (int pr = 0; pr < 5; ++pr) {
            const int jt = jt0 + 2 * pr;
            u32x4 pw; pw.x = cvtpk(s[2 * pr][0], s[2 * pr][1]); pw.y = cvtpk(s[2 * pr][2], s[2 * pr][3]); pw.z = cvtpk(s[2 * pr + 1][0], s[2 * pr + 1][1]); pw.w = cvtpk(s[2 * pr + 1][2], s[2 * pr + 1][3]);
            const bf16x8 pf = __builtin_bit_cast(bf16x8, pw);
#pragma unroll
            for (int dt = 0; dt < 4; ++dt) {
                const char* a0 = Vs + (16 * jt + 4 * g + (q >> 2)) * 144 + (16 * dt + 4 * (q & 3)) * 2;
                const s16x4 lo = vtr(a0), hi = vtr(a0 + 16 * 144);
                o[dt] = __builtin_amdgcn_mfma_f32_16x16x32_bf16(cat8(lo, hi), pf, o[dt], 0, 0, 0);
            }
        }
#pragma unroll
        for (int dt = 0; dt < 4; ++dt) {
            const int dcol = h * 64 + 16 * dt + 4 * g;
            const u32x2 gt = *(const u32x2*)(P + (size_t)row * NP + C_GA + dcol);
            u32x2 yo; yo.x = cvtpk(o[dt][0] * inv * silu_f(bf_lo(gt.x)), o[dt][1] * inv * silu_f(bf_hi(gt.x)));
            yo.y = cvtpk(o[dt][2] * inv * silu_f(bf_lo(gt.y)), o[dt][3] * inv * silu_f(bf_hi(gt.y)));
            *(u32x2*)(Y + (size_t)row * D + dcol) = yo;
        }
    }
    __syncthreads();
}

template <bool SCALE>
__device__ __forceinline__ void stage128(char* dst, const bf16* src, size_t src_pitch, int tid, float lng) {
#pragma unroll
    for (int it = 0; it < 4; ++it) {
        const int r = (tid >> 4) + 32 * it, ch = tid & 15;
        u32x4 v = *(const u32x4*)(src + (size_t)r * src_pitch + ch * 8);
        if (SCALE) { const float sc = __expf((float)(127 - r) * lng);
            v.x = cvtpk(bf_lo(v.x) * sc, bf_hi(v.x) * sc); v.y = cvtpk(bf_lo(v.y) * sc, bf_hi(v.y) * sc); v.z = cvtpk(bf_lo(v.z) * sc, bf_hi(v.z) * sc); v.w = cvtpk(bf_lo(v.w) * sc, bf_hi(v.w) * sc); }
        *(u32x4*)(dst + r * 272 + ch * 16) = v;
    }
}

__device__ __forceinline__ void ret_u_unit(const Ctx& C, char* lds, int c, int h, int tid, int w, int lane) {
    const bf16* P = (const bf16*)(C.ws + WS_P); float* U = (float*)(C.ws + WS_U);
    char* Ks = lds; char* Vs = lds + 34816;
    const float lng = ln_gamma(h);
    stage128<false>(Ks, P + (size_t)(c * 128) * NP + C_KB + h * 128, NP, tid, lng);
    stage128<true>(Vs, P + (size_t)(c * 128) * NP + C_VB + h * 128, NP, tid, lng);
    __syncthreads();
    const int q = lane & 15, g = lane >> 4;
    f32x4 acc[8];
#pragma unroll
    for (int dt = 0; dt < 8; ++dt) acc[dt] = (f32x4){0.f, 0.f, 0.f, 0.f};
#pragma unroll
    for (int ks = 0; ks < 4; ++ks) {
        const int rbase = (32 * ks + 8 * g + (q >> 2)) * 272 + 4 * (q & 3) * 2;
        const bf16x8 vf = cat8(vtr(Vs + rbase + 32 * w), vtr(Vs + rbase + 32 * w + 4 * 272));
#pragma unroll
        for (int dt = 0; dt < 8; ++dt) {
            const bf16x8 kf = cat8(vtr(Ks + rbase + 32 * dt), vtr(Ks + rbase + 32 * dt + 4 * 272));
            acc[dt] = __builtin_amdgcn_mfma_f32_16x16x32_bf16(vf, kf, acc[dt], 0, 0, 0);
        }
    }
    float* Ub = U + (size_t)(c * 8 + h) * 16384;
#pragma unroll
    for (int dt = 0; dt < 8; ++dt)
#pragma unroll
        for (int j = 0; j < 4; ++j) Ub[(16 * w + 4 * g + j) * 128 + 16 * dt + q] = acc[dt][j];
    __syncthreads();
}

__device__ __forceinline__ void ret_scan(const Ctx& C, int layer, int tid, int G) {
    const float* U = (const float*)(C.ws + WS_U); bf16* Rt = (bf16*)(C.ws + WS_RT);
    for (int i = blockIdx.x * NTHREADS + tid; i < 8 * 16384; i += G * NTHREADS) {
        const int h = i >> 14, e = (i >> 7) & 127, d = i & 127;
        const float gc = __expf(128.0f * ln_gamma(h));
        float r = 0.f;
#pragma unroll 1
        for (int c0 = 0; c0 < 64; c0 += 8) {
            float u[8];
#pragma unroll
            for (int k = 0; k < 8; ++k) u[k] = U[(size_t)((c0 + k) * 8) * 16384 + i];
#pragma unroll
            for (int k = 0; k < 8; ++k) { Rt[(size_t)((c0 + k) * 8) * 16384 + i] = (bf16)(cvtpk(r, 0.f) & 0xffffu); r = gc * r + u[k]; }
        }
        const int dorig = 4 * (d >> 3) + (d & 3) + 64 * ((d >> 2) & 1);
        C.out[O_RP + ((size_t)(layer * 8 + h) * 128 + dorig) * 128 + e] = r;
    }
}

__device__ __forceinline__ void ret_prompt_unit(const Ctx& C, char* lds, int layer, int c, int h, int tid, int w, int lane) {
    const bf16* P = (const bf16*)(C.ws + WS_P); bf16* Y = (bf16*)(C.ws + WS_Y); const bf16* Rt = (const bf16*)(C.ws + WS_RT);
    char* Ks = lds; char* Vs = lds + 34816; char* Rs = lds + 69632;
    const float lng = ln_gamma(h);
    stage128<false>(Ks, P + (size_t)(c * 128) * NP + C_KB + h * 128, NP, tid, lng);
    stage128<false>(Vs, P + (size_t)(c * 128) * NP + C_VB + h * 128, NP, tid, lng);
    stage128<false>(Rs, Rt + (size_t)(c * 8 + h) * 16384, 128, tid, lng);
    __syncthreads();
    const int q = lane & 15, g = lane >> 4;
    const int n = 16 * w + q, row = c * 128 + n;
    bf16x8 qf[4];
#pragma unroll
    for (int ks = 0; ks < 4; ++ks) qf[ks] = *(const bf16x8*)(P + (size_t)row * NP + C_QB + h * 128 + 32 * ks + 8 * g);
    unsigned pk[8][2];
#pragma unroll
    for (int mt = 0; mt < 8; ++mt) {
        pk[mt][0] = 0u; pk[mt][1] = 0u;
        if (mt <= w) {
            f32x4 a = (f32x4){0.f, 0.f, 0.f, 0.f};
#pragma unroll
            for (int ks = 0; ks < 4; ++ks) { const bf16x8 kf = *(const bf16x8*)(Ks + (16 * mt + q) * 272 + (32 * ks + 8 * g) * 2); a = __builtin_amdgcn_mfma_f32_16x16x32_bf16(kf, qf[ks], a, 0, 0, 0); }
            float v[4];
#pragma unroll
            for (int j = 0; j < 4; ++j) { const int dl = n - (16 * mt + 4 * g + j); v[j] = dl >= 0 ? a[j] * __expf((float)dl * lng) : 0.f; }
            pk[mt][0] = cvtpk(v[0], v[1]); pk[mt][1] = cvtpk(v[2], v[3]);
        }
    }
    f32x4 oi[8], ox[8];
#pragma unroll
    for (int et = 0; et < 8; ++et) { oi[et] = (f32x4){0.f, 0.f, 0.f, 0.f}; ox[et] = oi[et]; }
#pragma unroll
    for (int pr = 0; pr < 4; ++pr) {
        if (2 * pr <= w) {
            u32x4 pw; pw.x = pk[2 * pr][0]; pw.y = pk[2 * pr][1]; pw.z = pk[2 * pr + 1][0]; pw.w = pk[2 * pr + 1][1];
            const bf16x8 pf = __builtin_bit_cast(bf16x8, pw);
#pragma unroll
            for (int et = 0; et < 8; ++et) {
                const char* a0 = Vs + (32 * pr + 4 * g + (q >> 2)) * 272 + (16 * et + 4 * (q & 3)) * 2;
                oi[et] = __builtin_amdgcn_mfma_f32_16x16x32_bf16(cat8(vtr(a0), vtr(a0 + 16 * 272)), pf, oi[et], 0, 0, 0);
            }
        }
    }
#pragma unroll
    for (int et = 0; et < 8; ++et)
#pragma unroll
        for (int ks = 0; ks < 4; ++ks) { const bf16x8 rf = *(const bf16x8*)(Rs + (16 * et + q) * 272 + (32 * ks + 8 * g) * 2); ox[et] = __builtin_amdgcn_mfma_f32_16x16x32_bf16(rf, qf[ks], ox[et], 0, 0, 0); }
    const float qdec = __expf((float)(n + 1) * lng);
    float sum = 0.f;
#pragma unroll
    for (int et = 0; et < 8; ++et) { oi[et] = oi[et] + ox[et] * qdec; sum += (oi[et][0] + oi[et][1]) + (oi[et][2] + oi[et][3]); }
    sum += __shfl_xor(sum, 16); sum += __shfl_xor(sum, 32);
    const float mu = sum * (1.0f / 128.0f);
    float var = 0.f;
#pragma unroll
    for (int et = 0; et < 8; ++et) { oi[et] = oi[et] - mu; var += (oi[et][0] * oi[et][0] + oi[et][1] * oi[et][1]) + (oi[et][2] * oi[et][2] + oi[et][3] * oi[et][3]); }
    var += __shfl_xor(var, 16); var += __shfl_xor(var, 32);
    const float rs = rsqrtf(var * (1.0f / 128.0f) + 1e-6f);
    const float* gw = C.ret_norm_w + layer * 1024 + h * 128;
#pragma unroll
    for (int et = 0; et < 8; ++et) {
        const int e0 = 16 * et + 4 * g;
        const u32x2 gt = *(const u32x2*)(P + (size_t)row * NP + C_GB + h * 128 + e0);
        const f32x4 wv = *(const f32x4*)(gw + e0);
        u32x2 yo; yo.x = cvtpk(oi[et][0] * rs * wv[0] * silu_f(bf_lo(gt.x)), oi[et][1] * rs * wv[1] * silu_f(bf_hi(gt.x)));
        yo.y = cvtpk(oi[et][2] * rs * wv[2] * silu_f(bf_lo(gt.y)), oi[et][3] * rs * wv[3] * silu_f(bf_hi(gt.y)));
        *(u32x2*)(Y + (size_t)row * D + 1024 + h * 128 + e0) = yo;
    }
    __syncthreads();
}

__device__ __forceinline__ void attn_sample_unit(const Ctx& C, char* lds, int layer, int b, int kvh, int tid) {
    const bf16* P = (const bf16*)(C.ws + WS_P); bf16* Y = (bf16*)(C.ws + WS_Y);
    float* Qs = (float*)lds;
    float* Kl = Qs + 32 * 65;
    float* Vl = Kl + 132 * 65;
    float* Pm = Vl + 132 * 68;
    const float* ck = C.cache_k + ((size_t)(layer * 128 + b) * 128) * 128 + kvh * 64;
    const float* cv = C.cache_v + ((size_t)(layer * 128 + b) * 128) * 128 + kvh * 64;
    float* ok = C.out + O_KS + ((size_t)(layer * 128 + b) * 128) * 128 + kvh * 64;
    float* ov = C.out + O_VS + ((size_t)(layer * 128 + b) * 128) * 128 + kvh * 64;
    for (int i = tid; i < 128 * 16; i += NTHREADS) {
        const int r = i >> 4, c4 = i & 15;
        const f32x4 k = *(const f32x4*)(ck + (size_t)r * 128 + 4 * c4), v = *(const f32x4*)(cv + (size_t)r * 128 + 4 * c4);
        float* kd = Kl + r * 65 + 4 * c4; kd[0] = k[0]; kd[1] = k[1]; kd[2] = k[2]; kd[3] = k[3];
        *(f32x4*)(Vl + r * 68 + 4 * c4) = v;
        if (r >= 4) { *(f32x4*)(ok + (size_t)(r - 4) * 128 + 4 * c4) = k; *(f32x4*)(ov + (size_t)(r - 4) * 128 + 4 * c4) = v; }
    }
    if (tid < 256) { const int t = tid >> 6, g = tid & 63; const size_t ro = (size_t)(T + 4 * b + t) * NP;
        const int dk = 4 * (g >> 3) + (g & 3) + 32 * ((g >> 2) & 1);
        Kl[(128 + t) * 65 + dk] = __uint_as_float((unsigned)P[ro + C_KA + kvh * 64 + g] << 16);
        Vl[(128 + t) * 68 + g] = __uint_as_float((unsigned)P[ro + C_VA + kvh * 64 + g] << 16); }
    for (int i = tid; i < 32 * 64; i += NTHREADS) {
        const int r = i >> 6, g = i & 63, hg = r >> 2, t = r & 3;
        const int dk = 4 * (g >> 3) + (g & 3) + 32 * ((g >> 2) & 1);
        Qs[r * 65 + dk] = __uint_as_float((unsigned)P[(size_t)(T + 4 * b + t) * NP + C_QA + (kvh * 8 + hg) * 64 + g] << 16);
    }
    __syncthreads();
    {
        const int r = tid >> 4, kg = tid & 15, t = r & 3, h = kvh * 8 + (r >> 2);
        float mx = -INFINITY;
#pragma unroll 1
        for (int it = 0; it < 9; ++it) {
            const int kk = kg + 16 * it;
            float a = -INFINITY;
            if (kk < 132) {
                const bool valid = kk < 128 ? (kk > t) : (kk - 128 <= t);
                if (valid) { a = 0.f;
#pragma unroll 16
                    for (int d = 0; d < 64; ++d) a += Qs[r * 65 + d] * Kl[kk * 65 + d]; }
                Pm[r * 133 + kk] = a;
            }
            mx = fmaxf(mx, a);
        }
#pragma unroll
        for (int o = 1; o < 16; o <<= 1) mx = fmaxf(mx, __shfl_xor(mx, o));
        const float sink = C.sinks[layer * 16 + h];
        const float mm = fmaxf(mx, sink);
        float sum = 0.f;
#pragma unroll 1
        for (int it = 0; it < 9; ++it) { const int kk = kg + 16 * it; if (kk < 132) { const float e = __expf(Pm[r * 133 + kk] - mm); Pm[r * 133 + kk] = e; sum += e; } }
#pragma unroll
        for (int o = 1; o < 16; o <<= 1) sum += __shfl_xor(sum, o);
        const float inv = 1.0f / (sum + __expf(sink - mm));
#pragma unroll 1
        for (int it = 0; it < 9; ++it) { const int kk = kg + 16 * it; if (kk < 132) Pm[r * 133 + kk] *= inv; }
    }
    __syncthreads();
    {
        const int r = tid >> 4, dq = tid & 15, t = r & 3, h = kvh * 8 + (r >> 2);
        f32x4 o = (f32x4){0.f, 0.f, 0.f, 0.f};
        for (int kk = 0; kk < 132; ++kk) { const float p = Pm[r * 133 + kk]; const f32x4 v = *(const f32x4*)(Vl + kk * 68 + 4 * dq); o += v * p; }
        const size_t row = (size_t)(T + 4 * b + t);
        const u32x2 gt = *(const u32x2*)(P + row * NP + C_GA + h * 64 + 4 * dq);
        u32x2 yo; yo.x = cvtpk(o[0] * silu_f(bf_lo(gt.x)), o[1] * silu_f(bf_hi(gt.x))); yo.y = cvtpk(o[2] * silu_f(bf_lo(gt.y)), o[3] * silu_f(bf_hi(gt.y)));
        *(u32x2*)(Y + row * D + h * 64 + 4 * dq) = yo;
    }
    __syncthreads();
}

__device__ __forceinline__ void ret_sample_group(const Ctx& C, char* lds, int layer, int ug, int tid, int w, int lane) {
    const bf16* P = (const bf16*)(C.ws + WS_P); bf16* Y = (bf16*)(C.ws + WS_Y);
    const int idx = 4 * ug + (w >> 1), b = idx >> 3, h = idx & 7, eh = w & 1;
    float* qs = (float*)(lds + w * 4096);
    float* ksm = qs + 512;
    float* pst = (float*)(lds + 32768);
    const float lng = ln_gamma(h);
    const size_t ro = (size_t)(T + 4 * b) * NP;
    float qv[4][2], kv[4][2];
    {
        const int g0 = 2 * lane, g1 = g0 + 1;
        const int d0 = 4 * (g0 >> 3) + (g0 & 3) + 64 * ((g0 >> 2) & 1), d1 = 4 * (g1 >> 3) + (g1 & 3) + 64 * ((g1 >> 2) & 1);
#pragma unroll
        for (int t = 0; t < 4; ++t) {
            const unsigned qq = *(const unsigned*)(P + ro + (size_t)t * NP + C_QB + h * 128 + g0), kk = *(const unsigned*)(P + ro + (size_t)t * NP + C_KB + h * 128 + g0);
            qv[t][0] = bf_lo(qq); qv[t][1] = bf_hi(qq); kv[t][0] = bf_lo(kk); kv[t][1] = bf_hi(kk);
            const float kd = __expf((float)(3 - t) * lng);
            qs[t * 128 + d0] = qv[t][0]; qs[t * 128 + d1] = qv[t][1]; ksm[t * 128 + d0] = kv[t][0] * kd; ksm[t * 128 + d1] = kv[t][1] * kd;
        }
    }
    const int e4 = lane & 15, dq = lane >> 4, e = eh * 64 + 4 * e4;
    f32x4 vm[4];
#pragma unroll
    for (int m = 0; m < 4; ++m) { const u32x2 vv = *(const u32x2*)(P + ro + (size_t)m * NP + C_VB + h * 128 + e); vm[m] = (f32x4){bf_lo(vv.x), bf_hi(vv.x), bf_lo(vv.y), bf_hi(vv.y)}; }
    float A[4][4];
#pragma unroll
    for (int t = 0; t < 4; ++t)
#pragma unroll
        for (int m = 0; m < 4; ++m) {
            A[t][m] = 0.f;
            if (m <= t) { float a = qv[t][0] * kv[m][0] + qv[t][1] * kv[m][1];
#pragma unroll
                for (int o = 1; o < 64; o <<= 1) a += __shfl_xor(a, o);
                A[t][m] = a * __expf((float)(t - m) * lng); }
        }
    LDS_WAIT();
    const float* r0 = C.state + ((size_t)(layer * 128 + b) * 8 + h) * 16384 + e;
    float* rout = C.out + O_RS + ((size_t)(layer * 128 + b) * 8 + h) * 16384 + e;
    const float g4 = __expf(4.0f * lng);
    f32x4 acc[4];
#pragma unroll
    for (int t = 0; t < 4; ++t) acc[t] = (f32x4){0.f, 0.f, 0.f, 0.f};
#pragma unroll 1
    for (int i0 = 0; i0 < 32; i0 += 8) {
        f32x4 r[8];
#pragma unroll
        for (int k = 0; k < 8; ++k) r[k] = __builtin_nontemporal_load((const f32x4*)(r0 + (4 * (i0 + k) + dq) * 128));
#pragma unroll
        for (int k = 0; k < 8; ++k) {
            const int d = 4 * (i0 + k) + dq;
            const f32x4 rn = r[k] * g4 + vm[0] * ksm[d] + vm[1] * ksm[128 + d] + vm[2] * ksm[256 + d] + vm[3] * ksm[384 + d];
            __builtin_nontemporal_store(rn, (f32x4*)(rout + d * 128));
#pragma unroll
            for (int t = 0; t < 4; ++t) acc[t] += r[k] * qs[t * 128 + d];
        }
    }
    float o[4][4]; float s1[4], s2[4];
#pragma unroll
    for (int t = 0; t < 4; ++t) {
        const float qd = __expf((float)(t + 1) * lng);
        s1[t] = 0.f; s2[t] = 0.f;
#pragma unroll
        for (int j = 0; j < 4; ++j) {
            float a = acc[t][j]; a += __shfl_xor(a, 16); a += __shfl_xor(a, 32);
            a *= qd;
#pragma unroll
            for (int m = 0; m < 4; ++m) a += A[t][m] * vm[m][j];
            o[t][j] = a; s1[t] += a; s2[t] += a * a;
        }
#pragma unroll
        for (int k = 1; k < 16; k <<= 1) { s1[t] += __shfl_xor(s1[t], k); s2[t] += __shfl_xor(s2[t], k); }
        if (lane == 0) { pst[(w * 4 + t) * 2] = s1[t]; pst[(w * 4 + t) * 2 + 1] = s2[t]; }
    }
    __syncthreads();
    if (lane < 16) {
        const float* gw = C.ret_norm_w + layer * 1024 + h * 128 + e;
        const f32x4 wv = *(const f32x4*)gw;
#pragma unroll
        for (int t = 0; t < 4; ++t) {
            const float S1 = pst[(w * 4 + t) * 2] + pst[((w ^ 1) * 4 + t) * 2], S2 = pst[(w * 4 + t) * 2 + 1] + pst[((w ^ 1) * 4 + t) * 2 + 1];
            const float mu = S1 * (1.0f / 128.0f), var = fmaxf(S2 * (1.0f / 128.0f) - mu * mu, 0.f), rs = rsqrtf(var + 1e-6f);
            const size_t row = (size_t)(T + 4 * b + t);
            const u32x2 gt = *(const u32x2*)(P + row * NP + C_GB + h * 128 + e);
            u32x2 yo; yo.x = cvtpk((o[t][0] - mu) * rs * wv[0] * silu_f(bf_lo(gt.x)), (o[t][1] - mu) * rs * wv[1] * silu_f(bf_hi(gt.x)));
            yo.y = cvtpk((o[t][2] - mu) * rs * wv[2] * silu_f(bf_lo(gt.y)), (o[t][3] - mu) * rs * wv[3] * silu_f(bf_hi(gt.y)));
            *(u32x2*)(Y + row * D + 1024 + h * 128 + e) = yo;
        }
    }
    __syncthreads();
}

#ifndef SKIPM
#define SKIPM 0
#endif
#ifndef REPU
#define REPU 0
#endif
#ifndef REP_P0
#define REP_P0 1
#endif
#ifndef REP_G1
#define REP_G1 1
#endif
#ifndef REP_MX1
#define REP_MX1 1
#endif
#ifndef REP_RP
#define REP_RP 1
#endif
#ifndef REP_G2
#define REP_G2 1
#endif

#define GAS __attribute__((address_space(1)))
typedef GAS unsigned gu32;
#define XB_TMO      128
#define XB_XCNT(j)  (256  + 64 * (j))
#define XB_XSUB(j)  (1280 + 64 * (j))
#define XB_XGEN(j)  (2304 + 64 * (j))
#define XB_TOP      3328
#define XB_TOPGEN   3392
#define XCD_BAR_WORDS 3456
#define XB_SPIN_CAP (1u << 18)

__device__ __forceinline__ unsigned xb_ld(unsigned* p)              { return __hip_atomic_load(p, __ATOMIC_RELAXED, __HIP_MEMORY_SCOPE_AGENT); }
__device__ __forceinline__ unsigned xb_add(unsigned* p, unsigned v) { return __hip_atomic_fetch_add(p, v, __ATOMIC_RELAXED, __HIP_MEMORY_SCOPE_AGENT); }
__device__ __forceinline__ unsigned xb_xcc_id() { return (unsigned)__builtin_amdgcn_s_getreg((3 << 11) | 20) & 0xFu; }
#define XB_SPIN(cond, bar) do { unsigned _sp = 0; while (cond) { __builtin_amdgcn_s_sleep(1); \
    if ((++_sp & 255u) == 0u) { if (xb_ld(&(bar)[XB_TMO])) break; if (_sp > XB_SPIN_CAP) { atomicAdd(&(bar)[XB_TMO], 1u); break; } } } } while (0)

struct XcdBarrier {
    unsigned* bar; unsigned x;
    volatile LAS unsigned* st;
};

__device__ __forceinline__ XcdBarrier xcd_barrier_post(unsigned* bar, volatile LAS unsigned* st) {
    XcdBarrier b; b.bar = bar; b.x = xb_xcc_id(); b.st = st;
    if (threadIdx.x == 0) (void)xb_add(&bar[XB_XCNT(b.x)], 1u);
    return b;
}
__device__ __forceinline__ void xcd_barrier_complete(unsigned* bar, unsigned x, unsigned& nloc, unsigned& nx) {
    const unsigned G = gridDim.x * gridDim.y * gridDim.z;
    unsigned sum, cnt, mine, sp = 0u;
    for (;;) {
        sum = 0u; cnt = 0u; mine = 0u;
#pragma unroll
        for (unsigned j = 0; j < 16; ++j) { const unsigned c = xb_ld(&bar[XB_XCNT(j)]); sum += c; cnt += (c > 0u) ? 1u : 0u; mine = (j == x) ? c : mine; }
        if (sum == G) break;
        __builtin_amdgcn_s_sleep(1);
        if ((++sp & 255u) == 0u) { if (xb_ld(&bar[XB_TMO])) break; if (sp > XB_SPIN_CAP) { atomicAdd(&bar[XB_TMO], 1u); break; } }
    }
    nloc = mine > 0u ? mine : 1u; nx = cnt > 0u ? cnt : 1u;
}

__device__ __forceinline__ void xcd_barrier(const XcdBarrier& b) {
    asm volatile("s_waitcnt vmcnt(0)" ::: "memory");
    __syncthreads();
    if (threadIdx.x == 0) {
        unsigned* bar = b.bar;
        __builtin_amdgcn_s_waitcnt(0);
        unsigned nloc = b.st[0], nx = b.st[1];
        if (nloc == 0u) { xcd_barrier_complete(bar, b.x, nloc, nx); b.st[0] = nloc; b.st[1] = nx; }
        const unsigned old = xb_add(&bar[XB_XSUB(b.x)], 1u);
        const unsigned gen = old / nloc;
        if (old + 1u == (gen + 1u) * nloc) {
            __builtin_amdgcn_fence(__ATOMIC_RELEASE, "agent");
            asm volatile("s_waitcnt vmcnt(0)" ::: "memory");
            const unsigned og = xb_add(&bar[XB_TOP], 1u);
            const unsigned tg = og / nx;
            if (og + 1u == (tg + 1u) * nx) xb_add(&bar[XB_TOPGEN], 1u);
            else XB_SPIN(xb_ld(&bar[XB_TOPGEN]) == tg, bar);
            __builtin_amdgcn_fence(__ATOMIC_ACQUIRE, "agent");
            xb_add(&bar[XB_XGEN(b.x)], 1u);
            asm volatile("s_waitcnt vmcnt(0)" ::: "memory");
        } else {
            XB_SPIN(xb_ld(&bar[XB_XGEN(b.x)]) == gen, bar);
            __builtin_amdgcn_fence(__ATOMIC_ACQUIRE, "agent");
            asm volatile("s_waitcnt vmcnt(0)" ::: "memory");
        }
    }
    __syncthreads();
}

constexpr size_t WS_BAR = WS_CTL + 768 * 1024;
constexpr int LDS_BARST = LDS_BYTES - 64;
__global__ void __launch_bounds__(NTHREADS, 2) hymba_fwd(Ctx C) {
    extern __shared__ __attribute__((aligned(16))) unsigned char lds_raw[];
    cg::grid_group grid = cg::this_grid();
    if (threadIdx.x < 2) ((volatile LAS unsigned*)((LAS unsigned char*)lds_raw + LDS_BARST))[threadIdx.x] = 0u;
    __syncthreads();
    (void)xcd_barrier_post((unsigned*)(C.ws + WS_BAR), (volatile LAS unsigned*)((LAS unsigned char*)lds_raw + LDS_BARST));
    int ph = 0;
#define PHASE_BEGIN (C.ph_lo <= ph && ph < C.ph_hi)
#define PHASE_END do { if (C.ph_lo <= ph && ph + 1 < C.ph_hi) { if (C.ph_lo < 0) grid.sync(); else { XcdBarrier xb_; xb_.bar = (unsigned*)(C.ws + WS_BAR); xb_.x = xb_xcc_id(); xb_.st = (volatile LAS unsigned*)((LAS unsigned char*)lds_raw + LDS_BARST); xcd_barrier(xb_); } } ++ph; } while (0)
#define PHASE_LOCALS int tid = threadIdx.x; LAUNDER_V(tid); const int lane = tid & 63, wave = __builtin_amdgcn_readfirstlane(tid >> 6); \
    int G = gridDim.x, bid = blockIdx.x; LAUNDER_S(G); LAUNDER_S(bid); char* lds = (char*)lds_raw; Ctx Cc = C; LAUNDER_S(Cc.ws); (void)lane; (void)wave; (void)lds

    if (PHASE_BEGIN) { PHASE_LOCALS; for (int rep = 0; rep < REP_P0; ++rep) { p0_prologue(Cc, lds, tid, wave, lane, G); __syncthreads(); } }
    PHASE_END;

    for (int layer = 0; layer < DEPTH; ++layer) {
        if (PHASE_BEGIN) {
            unsigned char* ws = C.ws; const int G = gridDim.x, bid = blockIdx.x;
            float* rss = (float*)(ws + WS_CTL); float* cosA = (float*)(ws + WS_TAB); float* sinA = cosA + NPOS * 32; float* cosB = sinA + NPOS * 32; float* sinB = cosB + NPOS * 64;
            pg8::Gemm g{(const bf16*)(ws + WS_XA), (const bf16*)(ws + WS_WIN) + (size_t)layer * NP * D, M, NP, D}; pg8::StaticOrder S; S.init(M, NP, G, bid);
            pg8::EpiProj E{(bf16*)(ws + WS_P), rss + layer * M, cosA, sinA, cosB, sinB, C.out, layer};
            for (int rep = 0; rep < REP_G1; ++rep) pg8::gemm_phase<pg8::EpiProj, pg8::StaticOrder, true, true>((LAS unsigned char*)lds_raw, g, S, E);
        }
        PHASE_END;
        if (PHASE_BEGIN) {
            PHASE_LOCALS; int ly = layer; LAUNDER_S(ly);
            for (int rep = 0; rep < REP_MX1; ++rep) for (int u = bid; u < 1280; u += G) {
                if (u < 512) { for (int r2 = 0; r2 < 1 + (REPU & 1); ++r2) ret_u_unit(Cc, lds, u >> 3, u & 7, tid, wave, lane); }
                else if (u < 768) { const int a = u - 512; for (int r2 = 0; r2 < 1 + ((REPU >> 1) & 1); ++r2) attn_prompt_unit(Cc, lds, ly, a >> 2, (a >> 1) & 1, a & 1, tid, wave, lane); }
                else if (u < 1024) { const int a = u - 768; for (int r2 = 0; r2 < 1 + ((REPU >> 2) & 1); ++r2) attn_sample_unit(Cc, lds, ly, a >> 1, a & 1, tid); }
                else { const int a = u - 1024; ret_sample_group(Cc, lds, ly, a, tid, wave, lane); }
            }
        }
        PHASE_END;
        if (PHASE_BEGIN) { PHASE_LOCALS; int ly = layer; LAUNDER_S(ly); for (int r2 = 0; r2 < 1 + ((REPU >> 4) & 1); ++r2) ret_scan(Cc, ly, tid, G); }
        PHASE_END;
        if (PHASE_BEGIN) { PHASE_LOCALS; int ly = layer; LAUNDER_S(ly); for (int rep = 0; rep < REP_RP; ++rep) for (int u = bid; u < 512; u += G) if (!(SKIPM & 16)) ret_prompt_unit(Cc, lds, ly, u >> 3, u & 7, tid, wave, lane); }
        PHASE_END;
        if (PHASE_BEGIN) {
            unsigned char* ws = C.ws; const int G = gridDim.x, bid = blockIdx.x;
            float* rss = (float*)(ws + WS_CTL); float* XR = (float*)(ws + WS_XR);
            pg8::Gemm g{(const bf16*)(ws + WS_Y), (const bf16*)(ws + WS_WOUT) + (size_t)layer * D * D, M, D, D}; pg8::StaticOrder S; S.init(M, D, G, bid);
            pg8::EpiRes E{layer == 0 ? C.x_prompt : XR, layer == 0 ? C.x_sample : XR + (size_t)T * D, layer == 0 ? XR : C.out, layer == 0 ? (bf16*)(ws + WS_XA) : nullptr, rss + (layer + 1) * M};
            pg8::gemm_phase<pg8::EpiRes, pg8::StaticOrder, true, true>((LAS unsigned char*)lds_raw, g, S, E);
            for (int rep = 1; rep < REP_G2; ++rep) { pg8::EpiRes E2 = E; E2.rss = rss + 131072; pg8::gemm_phase<pg8::EpiRes, pg8::StaticOrder, true, true>((LAS unsigned char*)lds_raw, g, S, E2); }
        }
        PHASE_END;
    }
#ifdef REP_SYNC
    for (int rep = 0; rep < REP_SYNC; ++rep) { XcdBarrier xb_; xb_.bar = (unsigned*)(C.ws + WS_BAR); xb_.x = xb_xcc_id(); xb_.st = (volatile LAS unsigned*)((LAS unsigned char*)lds_raw + LDS_BARST); xcd_barrier(xb_); }
#endif
    if (PHASE_BEGIN) {
        PHASE_LOCALS;
        const float* rf = (const float*)(Cc.ws + WS_CTL) + 2 * M;
        for (int m = bid * 8 + wave; m < M; m += G * 8) {
            const float rv = rsqrtf(rf[m] * (1.0f / 2048.0f) + 1e-6f);
            f32x4* xr = (f32x4*)(Cc.out + (size_t)m * D);
#pragma unroll
            for (int j = 0; j < 8; ++j) { const f32x4 wv = *((const f32x4*)Cc.final_w + lane + 64 * j); xr[lane + 64 * j] = xr[lane + 64 * j] * rv * wv; }
        }
    }
}

constexpr int N_PHASES = 1 + DEPTH * 5 + 1;
#ifndef MK_MULTI
#define MK_MULTI 0
#endif
extern "C" void kernel_launch(void* const* d_in, const int* in_sizes, int n_in, void* d_out, int out_size, void* d_ws, size_t ws_size, hipStream_t stream) {
    static int grid = 0;
    if (grid == 0) {
        if (n_in != 11 || ws_size < WS_END) { fprintf(stderr, "kernel_launch: unexpected inputs (n_in %d, ws %zu)\n", n_in, ws_size); grid = -1; return; }
        int dev = 0, cus = 0, per_cu = 0;
        hipGetDevice(&dev); hipDeviceGetAttribute(&cus, hipDeviceAttributeMultiprocessorCount, dev);
        if (hipFuncSetAttribute((const void*)hymba_fwd, hipFuncAttributeMaxDynamicSharedMemorySize, LDS_BYTES) != hipSuccess) { fprintf(stderr, "kernel_launch: hipFuncSetAttribute failed\n"); grid = -1; return; }
        if (hipOccupancyMaxActiveBlocksPerMultiprocessor(&per_cu, (const void*)hymba_fwd, NTHREADS, LDS_BYTES) != hipSuccess || per_cu < 1) { fprintf(stderr, "kernel_launch: occupancy query says %d\n", per_cu); (void)hipGetLastError(); per_cu = 1; }
        grid = cus;
    }
    if (grid < 0) return;
    hipMemsetAsync((char*)d_ws + WS_CTL, 0, CTL_BYTES, stream);
    Ctx c{};
    c.x_prompt = (const float*)d_in[0]; c.x_sample = (const float*)d_in[1]; c.cache_k = (const float*)d_in[2]; c.cache_v = (const float*)d_in[3]; c.state = (const float*)d_in[4];
    c.norm_w = (const float*)d_in[5]; c.w_in = (const float*)d_in[6]; c.sinks = (const float*)d_in[7]; c.ret_norm_w = (const float*)d_in[8]; c.w_out = (const float*)d_in[9]; c.final_w = (const float*)d_in[10];
    c.out = (float*)d_out; c.ws = (unsigned char*)d_ws;
#if MK_MULTI
    for (int p = 0; p < N_PHASES; ++p) { c.ph_lo = p; c.ph_hi = p + 1; void* args[] = {&c};
        hipError_t e = hipLaunchCooperativeKernel((const void*)hymba_fwd, dim3(grid), dim3(NTHREADS), args, LDS_BYTES, stream);
        if (e != hipSuccess) { fprintf(stderr, "launch %d failed: %s\n", p, hipGetErrorString(e)); break; } }
#else
    c.ph_lo = 0; c.ph_hi = N_PHASES; void* args[] = {&c};
    hipError_t e = hipLaunchCooperativeKernel((const void*)hymba_fwd, dim3(grid), dim3(NTHREADS), args, LDS_BYTES, stream);
    if (e != hipSuccess) fprintf(stderr, "cooperative launch failed: %s (grid %d)\n", hipGetErrorString(e), grid);
#endif
}
```

```cpp
#include <hip/hip_runtime.h>
#include <hip/hip_cooperative_groups.h>
#include <cstdio>
#include <cstdint>
namespace cg = cooperative_groups;
namespace pg8 {
#define PG8_LAS __attribute__((address_space(3)))
typedef unsigned short bf16_t;
typedef short bf16x8 __attribute__((ext_vector_type(8)));
typedef float f32x4 __attribute__((ext_vector_type(4)));
typedef unsigned u32x4 __attribute__((ext_vector_type(4)));
constexpr int BM = 256, BK = 64, HALF = 128, HTB = HALF * BK * 2  , STAGE_BYTES = 8 * HTB, NXCD = 8, WGM = 8;

__host__ __device__ __forceinline__ int lds_byte(int r, int c) { const int st = (r >> 4) * 2 + (c >> 5), rr = r & 15, cc = c & 31, ob = rr * 64 + cc * 2; return st * 1024 + (ob ^ (((ob >> 9) & 1) << 5)); }
__host__ __device__ __forceinline__ void stage_rc(int b, int& R, int& C) { const int st = b / 1024, sb = b % 1024, swz = sb ^ (((sb >> 9) & 1) << 5); R = (st >> 1) * 16 + swz / 64; C = (st & 1) * 32 + (swz % 64) / 2; }
__host__ __device__ __forceinline__ int perm32(int rho) { const int n = rho >> 4, i = rho & 15; return 8 * (i >> 2) + 4 * n + (i & 3); }

struct Unit { int pm, pn; };
struct Gemm { const bf16_t* A; const bf16_t* Bt; int M, N, K; };

struct StaticOrder {
    int nM, nN, nwg, G, c;
    __host__ __device__ void init(int M, int N, int G_, int c_) { nM = M / BM; nN = N / BM; nwg = nM * nN; G = G_; c = c_; }
    __host__ __device__ bool next(int i, Unit& u) const {
        const long L = (long)i * G + c; if (L >= nwg) return false;
        int wgid = (int)L; { const int q = nwg / NXCD, r = nwg % NXCD, xcd = wgid % NXCD, off = wgid / NXCD; wgid = (xcd < r ? xcd * (q + 1) : r * (q + 1) + (xcd - r) * q) + off; }
        const int nig = WGM * nN, gid = wgid / nig, fm = gid * WGM, gsz = (nM - fm) < WGM ? (nM - fm) : WGM;
        u.pm = fm + ((wgid % nig) % gsz); u.pn = (wgid % nig) / gsz; return true;
    }
    __device__ __forceinline__ void a_ready(const Unit&) const {}
    __device__ __forceinline__ void done(const Unit&) const {}
};

__device__ __forceinline__ unsigned cvt_pk_bf16(float lo, float hi) { unsigned r; asm volatile("v_cvt_pk_bf16_f32 %0, %1, %2" : "=v"(r) : "v"(lo), "v"(hi)); return r; }
constexpr int T_ = 8192, NPROJ = 6400, DMODEL = 2048;
constexpr size_t O_KP = (size_t)8704 * 2048, O_VP = O_KP + 32768, O_RP = O_VP + 32768, O_KS = O_RP + 262144, O_VS = O_KS + 4194304, O_RS = O_VS + 4194304;

struct EpiProj {
    static constexpr bool PERM = true, AFTER_DRAIN = false;
    bf16_t* P; const float* rss; const float* cosA; const float* sinA; const float* cosB; const float* sinB; float* out; int layer;
    __device__ __forceinline__ void operator()(const f32x4 (&acc)[2][2][4][2], const Unit& u, int wr, int wc, int fr, int fq) const {
        float rv[2][4];
#pragma unroll
        for (int ai = 0; ai < 2; ++ai)
#pragma unroll
            for (int m = 0; m < 4; ++m) rv[ai][m] = rsqrtf(rss[u.pm * BM + ai * HALF + wr * 64 + m * 16 + fr] * (1.0f / 2048.0f) + 1e-6f);
#pragma unroll
        for (int bj = 0; bj < 2; ++bj) {
            const int cb = u.pn * BM + bj * HALF;
            const int c0 = cb + wc * 32 + 8 * fq;
            const int mode = (cb < 1152) ? 1 : ((cb >= 2304 && cb < 4352) ? 2 : 0);
            const int kvmode = (cb == 1024) ? 1 : ((cb == 1152) ? 2 : 0);
#pragma unroll
            for (int ai = 0; ai < 2; ++ai)
#pragma unroll
                for (int m = 0; m < 4; ++m) {
                    const int row = u.pm * BM + ai * HALF + wr * 64 + m * 16 + fr;
                    f32x4 v0 = acc[ai][bj][m][0] * rv[ai][m], v1 = acc[ai][bj][m][1] * rv[ai][m];
                    if (mode) {
                        const int pos = row < T_ ? row : T_ + ((row - T_) & 3);
                        f32x4 c, s;
                        if (mode == 1) { const int i = (c0 & 63) >> 3; c = *(const f32x4*)(cosA + pos * 32 + 4 * i); s = *(const f32x4*)(sinA + pos * 32 + 4 * i); }
                        else { const int i = (c0 & 127) >> 3; c = *(const f32x4*)(cosB + pos * 64 + 4 * i); s = *(const f32x4*)(sinB + pos * 64 + 4 * i); }
                        const f32x4 y0 = v0 * c - v1 * s, y1 = v1 * c + v0 * s; v0 = y0; v1 = y1;
                    }
                    u32x4 w; w.x = cvt_pk_bf16(v0[0], v0[1]); w.y = cvt_pk_bf16(v0[2], v0[3]); w.z = cvt_pk_bf16(v1[0], v1[1]); w.w = cvt_pk_bf16(v1[2], v1[3]);
                    *(u32x4*)(P + (size_t)row * NPROJ + c0) = w;
                    if (kvmode && row >= T_ - 128) {
                        const int kvh = (c0 - cb) >> 6, g0 = c0 & 63;
                        float* dst;
                        if (row < T_) dst = out + (kvmode == 1 ? O_KP : O_VP) + ((size_t)(layer * 128 + (row - (T_ - 128))) * 2 + kvh) * 64;
                        else { const int b = (row - T_) >> 2, t = (row - T_) & 3; dst = out + (kvmode == 1 ? O_KS : O_VS) + ((((size_t)layer * 128 + b) * 128 + 124 + t) * 2 + kvh) * 64; }
                        if (kvmode == 1) { const int i = g0 >> 3; *(f32x4*)(dst + 4 * i) = v0; *(f32x4*)(dst + 4 * i + 32) = v1; }
                        else { *(f32x4*)(dst + g0) = v0; *(f32x4*)(dst + g0 + 4) = v1; }
                    }
                }
        }
    }
};

struct EpiRes {
    static constexpr bool PERM = true, AFTER_DRAIN = false;
    const float* base_p; const float* base_s; float* outx; bf16_t* xa; float* rss;
    __device__ __forceinline__ void operator()(const f32x4 (&acc)[2][2][4][2], const Unit& u, int wr, int wc, int fr, int fq) const {
#pragma unroll
        for (int ai = 0; ai < 2; ++ai)
#pragma unroll
            for (int m = 0; m < 4; ++m) {
                const int row = u.pm * BM + ai * HALF + wr * 64 + m * 16 + fr;
                const float* bp = row < T_ ? base_p + (size_t)row * DMODEL : base_s + (size_t)(row - T_) * DMODEL;
                float ss = 0.f;
#pragma unroll
                for (int bj = 0; bj < 2; ++bj) {
                    const int c0 = u.pn * BM + bj * HALF + wc * 32 + 8 * fq;
                    const f32x4 b0 = *(const f32x4*)(bp + c0), b1 = *(const f32x4*)(bp + c0 + 4);
                    const f32x4 v0 = acc[ai][bj][m][0] + b0, v1 = acc[ai][bj][m][1] + b1;
                    *(f32x4*)(outx + (size_t)row * DMODEL + c0) = v0; *(f32x4*)(outx + (size_t)row * DMODEL + c0 + 4) = v1;
                    if (xa) { u32x4 w; w.x = cvt_pk_bf16(v0[0], v0[1]); w.y = cvt_pk_bf16(v0[2], v0[3]); w.z = cvt_pk_bf16(v1[0], v1[1]); w.w = cvt_pk_bf16(v1[2], v1[3]);
                        *(u32x4*)(xa + (size_t)row * DMODEL + c0) = w; }
                    ss += (v0[0] * v0[0] + v0[1] * v0[1]) + (v0[2] * v0[2] + v0[3] * v0[3]) + (v1[0] * v1[0] + v1[1] * v1[1]) + (v1[2] * v1[2] + v1[3] * v1[3]);
                }
                ss += __shfl_xor(ss, 16); ss += __shfl_xor(ss, 32);
                if (fq == 0) atomicAdd(rss + row, ss);
            }
    }
};

template <class Epi, class Sched, bool ALIGN_EPI = false, bool SP2 = false>
__device__ __forceinline__ void gemm_phase(PG8_LAS unsigned char* lds, const Gemm g, const Sched& S, const Epi& E) {
    int tid_ = threadIdx.x; asm volatile("" : "+v"(tid_));
    const int tid = tid_, wid = __builtin_amdgcn_readfirstlane(tid >> 6), lane = tid & 63, wr = wid >> 2, wc = wid & 3, fr = lane & 15, fq = lane >> 4;
    const int K = g.K, nt = K / BK;
    unsigned voffA[2], voffB[2];
#pragma unroll
    for (int i = 0; i < 2; ++i) { int R, C; stage_rc(tid * 16 + i * 8192, R, C); const int Rb = Epi::PERM ? ((R & ~31) + perm32(R & 31)) : R;
        voffA[i] = (unsigned)(R * K + C) * 2u; voffB[i] = (unsigned)(Rb * K + C) * 2u; }
    const size_t kstep = (size_t)(BK * 2);
    const size_t hstep = (size_t)HALF * K * 2;
    const size_t tstep = 2 * hstep;
    const unsigned ldsw = (unsigned)wid * 1024u;
    const int aoff = lds_byte(wr * 64 + fr, fq * 8), boff = lds_byte(wc * 32 + fr, fq * 8);
#define PG8_SA(b, h) (((b) * 2 + (h)) * HTB)
#define PG8_SB(b, h) ((4 + (b) * 2 + (h)) * HTB)
#define PG8_STAGE(bufoff, gbase, voff) do { _Pragma("unroll") for (int _i = 0; _i < 2; ++_i) \
        __builtin_amdgcn_global_load_lds((const unsigned*)((const char*)(gbase) + (voff)[_i]), (PG8_LAS unsigned*)(lds + (bufoff) + ldsw + _i * 8192), 16, 0, 0); } while (0)
#define PG8_LDA(dst, b, h) do { _Pragma("unroll") for (int m = 0; m < 4; ++m) _Pragma("unroll") for (int k = 0; k < 2; ++k) dst[m][k] = *(const PG8_LAS bf16x8*)(lds + PG8_SA(b, h) + aoff + m * 2048 + k * 1024); } while (0)
#define PG8_LDB(dst, b, h) do { _Pragma("unroll") for (int n = 0; n < 2; ++n) _Pragma("unroll") for (int k = 0; k < 2; ++k) dst[n][k] = *(const PG8_LAS bf16x8*)(lds + PG8_SB(b, h) + boff + n * 2048 + k * 1024); } while (0)
#define PG8_MMA(ai, bj, At, Bt) do { __builtin_amdgcn_s_setprio(1); _Pragma("unroll") for (int m = 0; m < 4; ++m) _Pragma("unroll") for (int n = 0; n < 2; ++n) _Pragma("unroll") for (int k = 0; k < 2; ++k) \
        acc[ai][bj][m][n] = __builtin_amdgcn_mfma_f32_16x16x32_bf16(Bt[n][k], At[m][k], acc[ai][bj][m][n], 0, 0, 0); __builtin_amdgcn_s_setprio(0); } while (0)
#define PG8_WAIT_V(n) asm volatile("s_waitcnt vmcnt(" #n ")" ::: "memory")
#define PG8_WAIT_L(n) asm volatile("s_waitcnt lgkmcnt(" #n ")" ::: "memory")
#define PG8_BAR __builtin_amdgcn_s_barrier()
#define PG8_SCHED __builtin_amdgcn_sched_barrier(0)
    Unit cur, nxt; int ui = 0;
    if (!S.next(0, cur)) return;
    f32x4 acc[2][2][4][2];
#pragma unroll
    for (int a = 0; a < 2; ++a)
#pragma unroll
        for (int b = 0; b < 2; ++b)
#pragma unroll
            for (int m = 0; m < 4; ++m)
#pragma unroll
                for (int n = 0; n < 2; ++n) acc[a][b][m][n] = (f32x4){0.f, 0.f, 0.f, 0.f};
    bf16x8 At[4][2], B0[2][2], B1[2][2];
    const char* cA = (const char*)g.A + (size_t)cur.pm * tstep; const char* cB = (const char*)g.Bt + (size_t)cur.pn * tstep;
    S.a_ready(cur);
    if constexpr (SP2) {
        PG8_STAGE(PG8_SB(0, 0), cB, voffB); PG8_STAGE(PG8_SB(0, 1), cB + hstep, voffB); PG8_STAGE(PG8_SA(0, 0), cA, voffA); PG8_STAGE(PG8_SA(0, 1), cA + hstep, voffA);
        if (wr == 1) PG8_BAR;
        PG8_WAIT_V(2); PG8_BAR;
        PG8_STAGE(PG8_SB(1, 0), cB + kstep, voffB); PG8_STAGE(PG8_SA(1, 0), cA + kstep, voffA); PG8_STAGE(PG8_SB(1, 1), cB + hstep + kstep, voffB);
        PG8_WAIT_V(6); PG8_BAR;
    } else {
        PG8_STAGE(PG8_SB(0, 0), cB, voffB); PG8_STAGE(PG8_SA(0, 0), cA, voffA); PG8_STAGE(PG8_SB(0, 1), cB + hstep, voffB); PG8_STAGE(PG8_SA(0, 1), cA + hstep, voffA);
        if (wr == 1) PG8_BAR;
        PG8_WAIT_V(4); PG8_BAR;
        PG8_STAGE(PG8_SB(1, 0), cB + kstep, voffB); PG8_STAGE(PG8_SA(1, 0), cA + kstep, voffA); PG8_STAGE(PG8_SB(1, 1), cB + hstep + kstep, voffB);
        PG8_WAIT_V(6); PG8_BAR;
    }
    for (;;) {
        const bool has_next = S.next(ui + 1, nxt);
        const char* nA = has_next ? (const char*)g.A + (size_t)nxt.pm * tstep : cA; const char* nB = has_next ? (const char*)g.Bt + (size_t)nxt.pn * tstep : cB;
        for (int t = 0; t < nt; t += 2) {
            const bool last = (t == nt - 2);
            const char* a1 = cA + (size_t)(t + 1) * kstep;
            const char* a2 = last ? nA : cA + (size_t)(t + 2) * kstep; const char* b2 = last ? nB : cB + (size_t)(t + 2) * kstep;
            const char* a3 = a2 + kstep; const char* b3 = b2 + kstep;
            if (last && has_next) S.a_ready(nxt);
            if constexpr (SP2) {
            PG8_LDB(B0, 0, 0); PG8_LDB(B1, 0, 1); PG8_SCHED; PG8_LDA(At, 0, 0); PG8_STAGE(PG8_SA(1, 1), a1 + hstep, voffA);
            PG8_WAIT_V(8); PG8_WAIT_L(0); PG8_BAR; PG8_MMA(0, 0, At, B0); PG8_MMA(0, 1, At, B1); PG8_BAR; PG8_SCHED;
            PG8_LDA(At, 0, 1); PG8_STAGE(PG8_SB(0, 0), b2, voffB); PG8_STAGE(PG8_SB(0, 1), b2 + hstep, voffB); PG8_STAGE(PG8_SA(0, 0), a2, voffA);
            PG8_WAIT_V(8); PG8_WAIT_L(0); PG8_BAR; PG8_MMA(1, 0, At, B0); PG8_MMA(1, 1, At, B1); PG8_BAR; PG8_SCHED;
            PG8_LDB(B0, 1, 0); PG8_LDB(B1, 1, 1); PG8_SCHED; PG8_LDA(At, 1, 0); PG8_STAGE(PG8_SA(0, 1), a2 + hstep, voffA);
            PG8_WAIT_V(8); PG8_WAIT_L(0); PG8_BAR; PG8_MMA(0, 0, At, B0); PG8_MMA(0, 1, At, B1); PG8_BAR; PG8_SCHED;
            PG8_LDA(At, 1, 1); PG8_STAGE(PG8_SB(1, 0), b3, voffB); PG8_STAGE(PG8_SB(1, 1), b3 + hstep, voffB); PG8_STAGE(PG8_SA(1, 0), a3, voffA);
            PG8_WAIT_V(8); PG8_WAIT_L(0); PG8_BAR; PG8_MMA(1, 0, At, B0); PG8_MMA(1, 1, At, B1); PG8_BAR; PG8_SCHED;
            } else {
            PG8_LDB(B0, 0, 0); PG8_SCHED; PG8_LDA(At, 0, 0); PG8_STAGE(PG8_SA(1, 1), a1 + hstep, voffA);
            PG8_WAIT_L(8); PG8_BAR; PG8_WAIT_L(0); PG8_MMA(0, 0, At, B0); PG8_BAR; PG8_SCHED;
            PG8_LDB(B1, 0, 1); PG8_STAGE(PG8_SB(0, 0), b2, voffB);
            PG8_BAR; PG8_WAIT_L(0); PG8_MMA(0, 1, At, B1); PG8_BAR;
            PG8_LDA(At, 0, 1); PG8_STAGE(PG8_SA(0, 0), a2, voffA);
            PG8_BAR; PG8_WAIT_L(0); PG8_MMA(1, 0, At, B0); PG8_BAR; PG8_SCHED;
            PG8_STAGE(PG8_SB(0, 1), b2 + hstep, voffB);
            PG8_WAIT_V(6); PG8_BAR; PG8_MMA(1, 1, At, B1); PG8_BAR;
            PG8_LDB(B0, 1, 0); PG8_SCHED; PG8_LDA(At, 1, 0); PG8_STAGE(PG8_SA(0, 1), a2 + hstep, voffA);
            PG8_WAIT_L(8); PG8_BAR; PG8_WAIT_L(0); PG8_MMA(0, 0, At, B0); PG8_BAR; PG8_SCHED;
            PG8_LDB(B1, 1, 1); PG8_STAGE(PG8_SB(1, 0), b3, voffB);
            PG8_BAR; PG8_WAIT_L(0); PG8_MMA(0, 1, At, B1); PG8_BAR;
            PG8_LDA(At, 1, 1); PG8_STAGE(PG8_SA(1, 0), a3, voffA);
            PG8_BAR; PG8_WAIT_L(0); PG8_MMA(1, 0, At, B0); PG8_BAR; PG8_SCHED;
            PG8_STAGE(PG8_SB(1, 1), b3 + hstep, voffB);
            PG8_WAIT_V(6); PG8_BAR; PG8_MMA(1, 1, At, B1); PG8_BAR;
            }
        }
        if constexpr (ALIGN_EPI) { if (wr == 0) PG8_BAR; }
        if constexpr (!Epi::AFTER_DRAIN) { E(acc, cur, wr, wc, fr, fq); S.done(cur); }
        if (!has_next) break;
#pragma unroll
        for (int a = 0; a < 2; ++a)
#pragma unroll
            for (int b = 0; b < 2; ++b)
#pragma unroll
                for (int m = 0; m < 4; ++m)
#pragma unroll
                    for (int n = 0; n < 2; ++n) acc[a][b][m][n] = (f32x4){0.f, 0.f, 0.f, 0.f};
        cur = nxt; cA = nA; cB = nB; ++ui;
        if constexpr (ALIGN_EPI) { if (wr == 1) PG8_BAR; }
    }
    PG8_WAIT_V(0);
    if constexpr (!ALIGN_EPI) { if (wr == 0) PG8_BAR; }
    PG8_BAR;
    if constexpr (Epi::AFTER_DRAIN) { E.fused(acc, cur, wr, wc, fr, fq, lds, wid, lane); S.done(cur); }
#undef PG8_SA
#undef PG8_SB
#undef PG8_STAGE
#undef PG8_LDA
#undef PG8_LDB
#undef PG8_MMA
#undef PG8_WAIT_V
#undef PG8_WAIT_L
#undef PG8_BAR
#undef PG8_SCHED
}
}

typedef unsigned short bf16;
typedef float f32x4 __attribute__((ext_vector_type(4)));
typedef short bf16x8 __attribute__((ext_vector_type(8)));
typedef short s16x4 __attribute__((ext_vector_type(4)));
typedef unsigned u32x4 __attribute__((ext_vector_type(4)));
typedef unsigned u32x2 __attribute__((ext_vector_type(2)));
typedef float f32x2 __attribute__((ext_vector_type(2)));
typedef __bf16 bf16x2_t __attribute__((ext_vector_type(2)));
#define LAS __attribute__((address_space(3)))

constexpr int T = 8192, NS = 512, M = 8704, D = 2048, NP = 6400, DEPTH = 2;
constexpr int C_QA = 0, C_KA = 1024, C_VA = 1152, C_GA = 1280, C_QB = 2304, C_KB = 3328, C_VB = 4352, C_GB = 5376;
constexpr int NPOS = 8196;
constexpr int LDS_BYTES = 147456;
constexpr int NTHREADS = 512;
using pg8::O_KP; using pg8::O_VP; using pg8::O_RP; using pg8::O_KS; using pg8::O_VS; using pg8::O_RS;

constexpr size_t MiB = 1u << 20;
constexpr size_t WS_CTL = 0, CTL_BYTES = 1 * MiB;
constexpr size_t WS_WIN = 2 * MiB;
constexpr size_t WS_WOUT = WS_WIN + 50 * MiB;
constexpr size_t WS_XA = WS_WOUT + 16 * MiB;
constexpr size_t WS_P = WS_XA + 34 * MiB;
constexpr size_t WS_Y = WS_P + 107 * MiB;
constexpr size_t WS_XR = WS_Y + 34 * MiB;
constexpr size_t WS_U = WS_XR + 68 * MiB;
constexpr size_t WS_RT = WS_U + 32 * MiB;
constexpr size_t WS_TAB = WS_RT + 16 * MiB;
constexpr size_t WS_END = WS_TAB + 8 * MiB;

struct Ctx {
    const float *x_prompt, *x_sample, *cache_k, *cache_v, *state, *norm_w, *w_in, *sinks, *ret_norm_w, *w_out, *final_w;
    float* out; unsigned char* ws;
    int ph_lo, ph_hi;
};

__device__ __forceinline__ unsigned cvtpk(float lo, float hi) { f32x2 v = {lo, hi}; bf16x2_t b = __builtin_convertvector(v, bf16x2_t); return __builtin_bit_cast(unsigned, b); }
__device__ __forceinline__ float bf_lo(unsigned u) { return __uint_as_float(u << 16); }
__device__ __forceinline__ float bf_hi(unsigned u) { return __uint_as_float(u & 0xffff0000u); }
__device__ __forceinline__ float silu_f(float x) { return x / (1.0f + __expf(-x)); }
__device__ __forceinline__ s16x4 vtr(const char* p) { typedef short v4i16_t __attribute__((ext_vector_type(4)));
    return __builtin_bit_cast(s16x4, __builtin_amdgcn_ds_read_tr16_b64_v4i16((LAS v4i16_t*)p)); }
__device__ __forceinline__ bf16x8 cat8(s16x4 lo, s16x4 hi) { return (bf16x8){lo[0], lo[1], lo[2], lo[3], hi[0], hi[1], hi[2], hi[3]}; }
__device__ __forceinline__ float ln_gamma(int h) {
    const double x = __builtin_ldexp(1.0, -5 - h);
    double s = 0.0, p = x;
#pragma unroll
    for (int k = 1; k <= 9; ++k) { s += p / (double)k; p *= x; }
    return (float)(-s);
}
#define LDS_WAIT() asm volatile("s_waitcnt lgkmcnt(0)" ::: "memory")
#define LAUNDER_V(x) asm volatile("" : "+v"(x))
#define LAUNDER_S(x) asm volatile("" : "+s"(x))

__device__ __forceinline__ int perm_src_col(int np, float& sc) {
    sc = 1.0f;
    if (np < 1152) { const int hb = np & ~63, g = np & 63; if (np < 1024) sc = 0.125f; return hb + 4 * (g >> 3) + (g & 3) + 32 * ((g >> 2) & 1); }
    if (np >= C_QB && np < C_VB) { const int hb = np & ~127, g = np & 127; if (np >= C_KB) sc = 0.08838834764831845f; return hb + 4 * (g >> 3) + (g & 3) + 64 * ((g >> 2) & 1); }
    return np;
}

template <bool WIN>
__device__ __forceinline__ void transpose_item(const float* W, int N, const float* nw, bf16* WT, float* scr, int kb, int nb, int lane) {
    const int k0 = 64 * kb, n0 = 64 * nb, l16 = lane & 15, r4 = lane >> 4;
    float sc = 1.0f; int srcc = n0 + 4 * l16;
    if (WIN) srcc = perm_src_col(n0 + 4 * l16, sc);
#pragma unroll 4
    for (int i = 0; i < 16; ++i) {
        const int kk = 4 * i + r4;
        const f32x4 v = *(const f32x4*)(W + (size_t)(k0 + kk) * N + srcc);
        float s2 = sc; if (WIN) s2 *= nw[k0 + kk];
        float* d = scr + kk * 65 + 4 * l16;
        d[0] = v[0] * s2; d[1] = v[1] * s2; d[2] = v[2] * s2; d[3] = v[3] * s2;
    }
    LDS_WAIT();
    const int c = lane & 7;
#pragma unroll
    for (int j = 0; j < 8; ++j) {
        const int n = (lane >> 3) + 8 * j; const float* s = scr + (8 * c) * 65 + n;
        u32x4 o; o.x = cvtpk(s[0], s[65]); o.y = cvtpk(s[130], s[195]); o.z = cvtpk(s[260], s[325]); o.w = cvtpk(s[390], s[455]);
        *(u32x4*)(WT + (size_t)(n0 + n) * 2048 + k0 + 8 * c) = o;
    }
    LDS_WAIT();
}

__device__ __forceinline__ void p0_prologue(const Ctx& C, char* lds, int tid, int wave, int lane, int G) {
    float* scr = (float*)(lds + wave * 16640);
    const int gw = blockIdx.x * 8 + wave, NGW = G * 8;
    bf16* WIN = (bf16*)(C.ws + WS_WIN); bf16* WOUT = (bf16*)(C.ws + WS_WOUT);
    constexpr int I_IN = 32 * 100, I_OUT = 32 * 32, NITEMS = 2 * (I_IN + I_OUT);
    for (int it = gw; it < NITEMS; it += NGW) {
        int r = it;
        if (r < 2 * I_IN) { const int l = r / I_IN; r -= l * I_IN; const int nb = r % 100, kb = r / 100;
            transpose_item<true>(C.w_in + (size_t)l * D * NP, NP, C.norm_w + l * D, WIN + (size_t)l * NP * D, scr, kb, nb, lane); }
        else { r -= 2 * I_IN; const int l = r / I_OUT; r -= l * I_OUT; const int nb = r & 31, kb = r >> 5;
            transpose_item<false>(C.w_out + (size_t)l * D * D, D, nullptr, WOUT + (size_t)l * D * D, scr, kb, nb, lane); }
    }
    bf16* XA = (bf16*)(C.ws + WS_XA); float* rss = (float*)(C.ws + WS_CTL);
    for (int m = gw; m < M; m += NGW) {
        const float* xr = m < T ? C.x_prompt + (size_t)m * D : C.x_sample + (size_t)(m - T) * D;
        float ss = 0.f;
#pragma unroll
        for (int j = 0; j < 8; ++j) {
            const f32x4 v = *((const f32x4*)xr + lane + 64 * j);
            ss += (v[0] * v[0] + v[1] * v[1]) + (v[2] * v[2] + v[3] * v[3]);
            u32x2 o; o.x = cvtpk(v[0], v[1]); o.y = cvtpk(v[2], v[3]);
            *((u32x2*)(XA + (size_t)m * D) + lane + 64 * j) = o;
        }
#pragma unroll
        for (int o = 1; o < 64; o <<= 1) ss += __shfl_xor(ss, o);
        if (lane == 0) rss[m] = ss;
    }
    float* cosA = (float*)(C.ws + WS_TAB); float* sinA = cosA + NPOS * 32; float* cosB = sinA + NPOS * 32; float* sinB = cosB + NPOS * 64;
    for (int i = blockIdx.x * NTHREADS + tid; i < NPOS * 96; i += G * NTHREADS) {
        int pos, f, half; float *pc, *ps;
        if (i < NPOS * 32) { pos = i >> 5; f = i & 31; half = 32; pc = cosA + i; ps = sinA + i; }
        else { const int k = i - NPOS * 32; pos = k >> 6; f = k & 63; half = 64; pc = cosB + k; ps = sinB + k; }
        const double rr = half == 32 ? 0.7498942093324559 : 0.8659643233600653;
        double inv = 1.0; for (int k = 0; k < f; ++k) inv *= rr;
        const float ang = (float)pos * (float)inv;
        const double a = (double)ang;
        const double qd = __builtin_rint(a * 0.6366197723675814);
        double r = __builtin_fma(-qd, 1.5707963267948966, a); r = __builtin_fma(-qd, 6.123233995736766e-17, r);
        const double r2 = r * r;
        double sp = -1.0 / 39916800.0; sp = sp * r2 + 1.0 / 362880.0; sp = sp * r2 - 1.0 / 5040.0; sp = sp * r2 + 1.0 / 120.0; sp = sp * r2 - 1.0 / 6.0; sp = sp * r2 + 1.0; sp *= r;
        double cp = 1.0 / 479001600.0; cp = cp * r2 - 1.0 / 3628800.0; cp = cp * r2 + 1.0 / 40320.0; cp = cp * r2 - 1.0 / 720.0; cp = cp * r2 + 1.0 / 24.0; cp = cp * r2 - 0.5; cp = cp * r2 + 1.0;
        const int qi = ((int)qd) & 3;
        const double sv = (qi == 0) ? sp : (qi == 1) ? cp : (qi == 2) ? -sp : -cp;
        const double cv = (qi == 0) ? cp : (qi == 1) ? -sp : (qi == 2) ? -cp : sp;
        *pc = (float)cv; *ps = (float)sv;
    }
}

__device__ __forceinline__ void attn_prompt_unit(const Ctx& C, char* lds, int layer, int blk, int kvh, int hq, int tid, int w, int lane) {
    const bf16* P = (const bf16*)(C.ws + WS_P); bf16* Y = (bf16*)(C.ws + WS_Y);
    char* Ks = lds; char* Vs = lds + 36864;
    const int q = lane & 15, g = lane >> 4;
    const int jt0 = w < 6 ? w : 6;
    const int iq = 16 * w + q, row = blk * 128 + iq;
    bf16x8 qfa[4][2]; u32x2 gta[4][4];
#pragma unroll
    for (int hh = 0; hh < 4; ++hh) {
        const int h = kvh * 8 + hq * 4 + hh;
#pragma unroll
        for (int ks = 0; ks < 2; ++ks) qfa[hh][ks] = *(const bf16x8*)(P + (size_t)row * NP + C_QA + h * 64 + 32 * ks + 8 * g);
#pragma unroll
        for (int dt = 0; dt < 4; ++dt) gta[hh][dt] = *(const u32x2*)(P + (size_t)row * NP + C_GA + h * 64 + 16 * dt + 4 * g);
    }
#pragma unroll
    for (int it = 0; it < 4; ++it) {
        const int r = (tid >> 3) + 64 * it, ch = tid & 7, krow = blk * 128 - 128 + r;
        u32x4 kv = (u32x4){0u, 0u, 0u, 0u}, vv = kv;
        if (krow >= 0) { kv = *(const u32x4*)(P + (size_t)krow * NP + C_KA + kvh * 64 + ch * 8); vv = *(const u32x4*)(P + (size_t)krow * NP + C_VA + kvh * 64 + ch * 8); }
        *(u32x4*)(Ks + r * 144 + ch * 16) = kv; *(u32x4*)(Vs + r * 144 + ch * 16) = vv;
    }
    __syncthreads();
#pragma unroll
    for (int hh = 0; hh < 4; ++hh) {
        const int h = kvh * 8 + hq * 4 + hh;
        bf16x8 qf[2]; qf[0] = qfa[hh][0]; qf[1] = qfa[hh][1];
        f32x4 s[10];
        float mx = -INFINITY;
        int lo = (blk > 0 || iq + 1 >= 128) ? iq + 1 : 128; LAUNDER_V(lo);
        const unsigned span = (unsigned)(iq + 128 - lo);
#pragma unroll
        for (int tt = 0; tt < 10; ++tt) {
            const int jt = jt0 + tt;
            f32x4 a = (f32x4){0.f, 0.f, 0.f, 0.f};
#pragma unroll
            for (int ks = 0; ks < 2; ++ks) { const bf16x8 kf = *(const bf16x8*)(Ks + (16 * jt + q) * 144 + (32 * ks + 8 * g) * 2); a = __builtin_amdgcn_mfma_f32_16x16x32_bf16(kf, qf[ks], a, 0, 0, 0); }
#pragma unroll
            for (int j = 0; j < 4; ++j) {
                const int jj = 16 * jt + 4 * g + j;
                a[j] = ((unsigned)(jj - lo) <= span) ? a[j] : -INFINITY; mx = fmaxf(mx, a[j]);
            }
            s[tt] = a;
        }
        mx = fmaxf(mx, __shfl_xor(mx, 16)); mx = fmaxf(mx, __shfl_xor(mx, 32));
        const float sink = C.sinks[layer * 16 + h];
        const float mm = fmaxf(mx, sink);
        float sum = 0.f;
#pragma unroll
        for (int tt = 0; tt < 10; ++tt)
#pragma unroll
            for (int j = 0; j < 4; ++j) { const float e = __expf(s[tt][j] - mm); s[tt][j] = e; sum += e; }
        sum += __shfl_xor(sum, 16); sum += __shfl_xor(sum, 32);
        const float inv = 1.0f / (sum + __expf(sink - mm));
        f32x4 o[4];
#pragma unroll
        for (int dt = 0; dt < 4; ++dt) o[dt] = (f32x4){0.f, 0.f, 0.f, 0.f};
#pragma unroll
        for (int pr = 0; pr < 5; ++pr) {
            const int jt = jt0 + 2 * pr;
            u32x4 pw; pw.x = cvtpk(s[2 * pr][0], s[2 * pr][1]); pw.y = cvtpk(s[2 * pr][2], s[2 * pr][3]); pw.z = cvtpk(s[2 * pr + 1][0], s[2 * pr + 1][1]); pw.w = cvtpk(s[2 * pr + 1][2], s[2 * pr + 1][3]);
            const bf16x8 pf = __builtin_bit_cast(bf16x8, pw);
#pragma unroll
            for (int dt = 0; dt < 4; ++dt) {
                const char* a0 = Vs + (16 * jt + 4 * g + (q >> 2)) * 144 + (16 * dt + 4 * (q & 3)) * 2;
                const s16x4 lo = vtr(a0), hi = vtr(a0 + 16 * 144);
                o[dt] = __builtin_amdgcn_mfma_f32_16x16x32_bf16(cat8(lo, hi), pf, o[dt], 0, 0, 0);
            }
        }
#pragma unroll
        for (int dt = 0; dt < 4; ++dt) {
            const int dcol = h * 64 + 16 * dt + 4 * g;
            const u32x2 gt = gta[hh][dt];
            u32x2 yo; yo.x = cvtpk(o[dt][0] * inv * silu_f(bf_lo(gt.x)), o[dt][1] * inv * silu_f(bf_hi(gt.x)));
            yo.y = cvtpk(o[dt][2] * inv * silu_f(bf_lo(gt.y)), o[dt][3] * inv * silu_f(bf_hi(gt.y)));
            *(u32x2*)(Y + (size_t)row * D + dcol) = yo;
        }
    }
    __syncthreads();
}

template <bool SCALE>
__device__ __forceinline__ void stage128(char* dst, const bf16* src, size_t src_pitch, int tid, float lng) {
#pragma unroll
    for (int it = 0; it < 4; ++it) {
        const int r = (tid >> 4) + 32 * it, ch = tid & 15;
        u32x4 v = *(const u32x4*)(src + (size_t)r * src_pitch + ch * 8);
        if (SCALE) { const float sc = __expf((float)(127 - r) * lng);
            v.x = cvtpk(bf_lo(v.x) * sc, bf_hi(v.x) * sc); v.y = cvtpk(bf_lo(v.y) * sc, bf_hi(v.y) * sc); v.z = cvtpk(bf_lo(v.z) * sc, bf_hi(v.z) * sc); v.w = cvtpk(bf_lo(v.w) * sc, bf_hi(v.w) * sc); }
        *(u32x4*)(dst + r * 272 + ch * 16) = v;
    }
}

__device__ __forceinline__ void ret_u_unit(const Ctx& C, char* lds, int c, int h, int tid, int w, int lane) {
    const bf16* P = (const bf16*)(C.ws + WS_P); float* U = (float*)(C.ws + WS_U);
    char* Ks = lds; char* Vs = lds + 34816;
    const float lng = ln_gamma(h);
    stage128<false>(Ks, P + (size_t)(c * 128) * NP + C_KB + h * 128, NP, tid, lng);
    stage128<true>(Vs, P + (size_t)(c * 128) * NP + C_VB + h * 128, NP, tid, lng);
    __syncthreads();
    const int q = lane & 15, g = lane >> 4;
    f32x4 acc[8];
#pragma unroll
    for (int dt = 0; dt < 8; ++dt) acc[dt] = (f32x4){0.f, 0.f, 0.f, 0.f};
#pragma unroll
    for (int ks = 0; ks < 4; ++ks) {
        const int rbase = (32 * ks + 8 * g + (q >> 2)) * 272 + 4 * (q & 3) * 2;
        const bf16x8 vf = cat8(vtr(Vs + rbase + 32 * w), vtr(Vs + rbase + 32 * w + 4 * 272));
#pragma unroll
        for (int dt = 0; dt < 8; ++dt) {
            const bf16x8 kf = cat8(vtr(Ks + rbase + 32 * dt), vtr(Ks + rbase + 32 * dt + 4 * 272));
            acc[dt] = __builtin_amdgcn_mfma_f32_16x16x32_bf16(vf, kf, acc[dt], 0, 0, 0);
        }
    }
    float* Ub = U + (size_t)(c * 8 + h) * 16384;
#pragma unroll
    for (int dt = 0; dt < 8; ++dt)
#pragma unroll
        for (int j = 0; j < 4; ++j) Ub[(16 * w + 4 * g + j) * 128 + 16 * dt + q] = acc[dt][j];
    __syncthreads();
}

__device__ __forceinline__ void ret_scan(const Ctx& C, int layer, int tid, int G) {
    const float* U = (const float*)(C.ws + WS_U); bf16* Rt = (bf16*)(C.ws + WS_RT);
    for (int i = blockIdx.x * NTHREADS + tid; i < 8 * 16384; i += G * NTHREADS) {
        const int h = i >> 14, e = (i >> 7) & 127, d = i & 127;
        const float gc = __expf(128.0f * ln_gamma(h));
        float r = 0.f;
#pragma unroll 1
        for (int c0 = 0; c0 < 64; c0 += 8) {
            float u[8];
#pragma unroll
            for (int k = 0; k < 8; ++k) u[k] = U[(size_t)((c0 + k) * 8) * 16384 + i];
#pragma unroll
            for (int k = 0; k < 8; ++k) { Rt[(size_t)((c0 + k) * 8) * 16384 + i] = (bf16)(cvtpk(r, 0.f) & 0xffffu); r = gc * r + u[k]; }
        }
        const int dorig = 4 * (d >> 3) + (d & 3) + 64 * ((d >> 2) & 1);
        C.out[O_RP + ((size_t)(layer * 8 + h) * 128 + dorig) * 128 + e] = r;
    }
}

__device__ __forceinline__ void ret_prompt_unit(const Ctx& C, char* lds, int layer, int c, int h, int tid, int w, int lane) {
    const bf16* P = (const bf16*)(C.ws + WS_P); bf16* Y = (bf16*)(C.ws + WS_Y); const bf16* Rt = (const bf16*)(C.ws + WS_RT);
    char* Ks = lds; char* Vs = lds + 34816; char* Rs = lds + 69632;
    const float lng = ln_gamma(h);
    stage128<false>(Ks, P + (size_t)(c * 128) * NP + C_KB + h * 128, NP, tid, lng);
    stage128<false>(Vs, P + (size_t)(c * 128) * NP + C_VB + h * 128, NP, tid, lng);
    stage128<false>(Rs, Rt + (size_t)(c * 8 + h) * 16384, 128, tid, lng);
    __syncthreads();
    const int q = lane & 15, g = lane >> 4;
    const int n = 16 * w + q, row = c * 128 + n;
    bf16x8 qf[4];
#pragma unroll
    for (int ks = 0; ks < 4; ++ks) qf[ks] = *(const bf16x8*)(P + (size_t)row * NP + C_QB + h * 128 + 32 * ks + 8 * g);
    unsigned pk[8][2];
#pragma unroll
    for (int mt = 0; mt < 8; ++mt) {
        pk[mt][0] = 0u; pk[mt][1] = 0u;
        if (mt <= w) {
            f32x4 a = (f32x4){0.f, 0.f, 0.f, 0.f};
#pragma unroll
            for (int ks = 0; ks < 4; ++ks) { const bf16x8 kf = *(const bf16x8*)(Ks + (16 * mt + q) * 272 + (32 * ks + 8 * g) * 2); a = __builtin_amdgcn_mfma_f32_16x16x32_bf16(kf, qf[ks], a, 0, 0, 0); }
            float v[4];
#pragma unroll
            for (int j = 0; j < 4; ++j) { const int dl = n - (16 * mt + 4 * g + j); v[j] = dl >= 0 ? a[j] * __expf((float)dl * lng) : 0.f; }
            pk[mt][0] = cvtpk(v[0], v[1]); pk[mt][1] = cvtpk(v[2], v[3]);
        }
    }
    f32x4 oi[8], ox[8];
#pragma unroll
    for (int et = 0; et < 8; ++et) { oi[et] = (f32x4){0.f, 0.f, 0.f, 0.f}; ox[et] = oi[et]; }
#pragma unroll
    for (int pr = 0; pr < 4; ++pr) {
        if (2 * pr <= w) {
            u32x4 pw; pw.x = pk[2 * pr][0]; pw.y = pk[2 * pr][1]; pw.z = pk[2 * pr + 1][0]; pw.w = pk[2 * pr + 1][1];
            const bf16x8 pf = __builtin_bit_cast(bf16x8, pw);
#pragma unroll
            for (int et = 0; et < 8; ++et) {
                const char* a0 = Vs + (32 * pr + 4 * g + (q >> 2)) * 272 + (16 * et + 4 * (q & 3)) * 2;
                oi[et] = __builtin_amdgcn_mfma_f32_16x16x32_bf16(cat8(vtr(a0), vtr(a0 + 16 * 272)), pf, oi[et], 0, 0, 0);
            }
        }
    }
#pragma unroll
    for (int et = 0; et < 8; ++et)
#pragma unroll
        for (int ks = 0; ks < 4; ++ks) { const bf16x8 rf = *(const bf16x8*)(Rs + (16 * et + q) * 272 + (32 * ks + 8 * g) * 2); ox[et] = __builtin_amdgcn_mfma_f32_16x16x32_bf16(rf, qf[ks], ox[et], 0, 0, 0); }
    const float qdec = __expf((float)(n + 1) * lng);
    float sum = 0.f;
#pragma unroll
    for (int et = 0; et < 8; ++et) { oi[et] = oi[et] + ox[et] * qdec; sum += (oi[et][0] + oi[et][1]) + (oi[et][2] + oi[et][3]); }
    sum += __shfl_xor(sum, 16); sum += __shfl_xor(sum, 32);
    const float mu = sum * (1.0f / 128.0f);
    float var = 0.f;
#pragma unroll
    for (int et = 0; et < 8; ++et) { oi[et] = oi[et] - mu; var += (oi[et][0] * oi[et][0] + oi[et][1] * oi[et][1]) + (oi[et][2] * oi[et][2] + oi[et][3] * oi[et][3]); }
    var += __shfl_xor(var, 16); var += __shfl_xor(var, 32);
    const float rs = rsqrtf(var * (1.0f / 128.0f) + 1e-6f);
    const float* gw = C.ret_norm_w + layer * 1024 + h * 128;
#pragma unroll
    for (int et = 0; et < 8; ++et) {
        const int e0 = 16 * et + 4 * g;
        const u32x2 gt = *(const u32x2*)(P + (size_t)row * NP + C_GB + h * 128 + e0);
        const f32x4 wv = *(const f32x4*)(gw + e0);
        u32x2 yo; yo.x = cvtpk(oi[et][0] * rs * wv[0] * silu_f(bf_lo(gt.x)), oi[et][1] * rs * wv[1] * silu_f(bf_hi(gt.x)));
        yo.y = cvtpk(oi[et][2] * rs * wv[2] * silu_f(bf_lo(gt.y)), oi[et][3] * rs * wv[3] * silu_f(bf_hi(gt.y)));
        *(u32x2*)(Y + (size_t)row * D + 1024 + h * 128 + e0) = yo;
    }
    __syncthreads();
}

__device__ __forceinline__ void attn_sample_unit(const Ctx& C, char* lds, int layer, int b, int kvh, int tid) {
    const bf16* P = (const bf16*)(C.ws + WS_P); bf16* Y = (bf16*)(C.ws + WS_Y);
    float* Qs = (float*)lds;
    float* Kl = Qs + 32 * 65;
    float* Vl = Kl + 132 * 68;
    float* Pm = Vl + 132 * 68;
    const float* ck = C.cache_k + ((size_t)(layer * 128 + b) * 128) * 128 + kvh * 64;
    const float* cv = C.cache_v + ((size_t)(layer * 128 + b) * 128) * 128 + kvh * 64;
    float* ok = C.out + O_KS + ((size_t)(layer * 128 + b) * 128) * 128 + kvh * 64;
    float* ov = C.out + O_VS + ((size_t)(layer * 128 + b) * 128) * 128 + kvh * 64;
    for (int i = tid; i < 128 * 16; i += NTHREADS) {
        const int r = i >> 4, c4 = i & 15;
        const f32x4 k = *(const f32x4*)(ck + (size_t)r * 128 + 4 * c4), v = *(const f32x4*)(cv + (size_t)r * 128 + 4 * c4);
        *(f32x4*)(Kl + r * 68 + 4 * c4) = k;
        *(f32x4*)(Vl + r * 68 + 4 * c4) = v;
        if (r >= 4) { *(f32x4*)(ok + (size_t)(r - 4) * 128 + 4 * c4) = k; *(f32x4*)(ov + (size_t)(r - 4) * 128 + 4 * c4) = v; }
    }
    if (tid < 256) { const int t = tid >> 6, g = tid & 63; const size_t ro = (size_t)(T + 4 * b + t) * NP;
        const int dk = 4 * (g >> 3) + (g & 3) + 32 * ((g >> 2) & 1);
        Kl[(128 + t) * 68 + dk] = __uint_as_float((unsigned)P[ro + C_KA + kvh * 64 + g] << 16);
        Vl[(128 + t) * 68 + g] = __uint_as_float((unsigned)P[ro + C_VA + kvh * 64 + g] << 16); }
    for (int i = tid; i < 32 * 64; i += NTHREADS) {
        const int r = i >> 6, g = i & 63, hg = r >> 2, t = r & 3;
        const int dk = 4 * (g >> 3) + (g & 3) + 32 * ((g >> 2) & 1);
        Qs[r * 65 + dk] = __uint_as_float((unsigned)P[(size_t)(T + 4 * b + t) * NP + C_QA + (kvh * 8 + hg) * 64 + g] << 16);
    }
    __syncthreads();
    {
        const int r = tid >> 4, kg = tid & 15, t = r & 3, h = kvh * 8 + (r >> 2);
        float mx = -INFINITY;
        f32x4 qr[16];
#pragma unroll
        for (int i = 0; i < 16; ++i) qr[i] = (f32x4){Qs[r * 65 + 4 * i], Qs[r * 65 + 4 * i + 1], Qs[r * 65 + 4 * i + 2], Qs[r * 65 + 4 * i + 3]};
#pragma unroll 1
        for (int it = 0; it < 9; ++it) {
            const int kk = kg + 16 * it;
            float a = -INFINITY;
            if (kk < 132) {
                const bool valid = kk < 128 ? (kk > t) : (kk - 128 <= t);
                if (valid) { f32x4 a4 = (f32x4){0.f, 0.f, 0.f, 0.f};
#pragma unroll
                    for (int i = 0; i < 16; ++i) a4 += qr[i] * *(const f32x4*)(Kl + kk * 68 + 4 * i);
                    a = (a4[0] + a4[1]) + (a4[2] + a4[3]); }
                Pm[r * 133 + kk] = a;
            }
            mx = fmaxf(mx, a);
        }
#pragma unroll
        for (int o = 1; o < 16; o <<= 1) mx = fmaxf(mx, __shfl_xor(mx, o));
        const float sink = C.sinks[layer * 16 + h];
        const float mm = fmaxf(mx, sink);
        float sum = 0.f;
#pragma unroll 1
        for (int it = 0; it < 9; ++it) { const int kk = kg + 16 * it; if (kk < 132) { const float e = __expf(Pm[r * 133 + kk] - mm); Pm[r * 133 + kk] = e; sum += e; } }
#pragma unroll
        for (int o = 1; o < 16; o <<= 1) sum += __shfl_xor(sum, o);
        const float inv = 1.0f / (sum + __expf(sink - mm));
#pragma unroll 1
        for (int it = 0; it < 9; ++it) { const int kk = kg + 16 * it; if (kk < 132) Pm[r * 133 + kk] *= inv; }
    }
    __syncthreads();
    {
        const int r = tid >> 4, dq = tid & 15, t = r & 3, h = kvh * 8 + (r >> 2);
        f32x4 o = (f32x4){0.f, 0.f, 0.f, 0.f};
        for (int kk = 0; kk < 132; ++kk) { const float p = Pm[r * 133 + kk]; const f32x4 v = *(const f32x4*)(Vl + kk * 68 + 4 * dq); o += v * p; }
        const size_t row = (size_t)(T + 4 * b + t);
        const u32x2 gt = *(const u32x2*)(P + row * NP + C_GA + h * 64 + 4 * dq);
        u32x2 yo; yo.x = cvtpk(o[0] * silu_f(bf_lo(gt.x)), o[1] * silu_f(bf_hi(gt.x))); yo.y = cvtpk(o[2] * silu_f(bf_lo(gt.y)), o[3] * silu_f(bf_hi(gt.y)));
        *(u32x2*)(Y + row * D + h * 64 + 4 * dq) = yo;
    }
    __syncthreads();
}

__device__ __forceinline__ void ret_sample_group(const Ctx& C, char* lds, int layer, int ug, int tid, int w, int lane) {
    const bf16* P = (const bf16*)(C.ws + WS_P); bf16* Y = (bf16*)(C.ws + WS_Y);
    const int idx = 4 * ug + (w >> 1), b = idx >> 3, h = idx & 7, eh = w & 1;
    float* qs = (float*)(lds + w * 4096);
    float* ksm = qs + 512;
    float* pst = (float*)(lds + 32768);
    const float lng = ln_gamma(h);
    const size_t ro = (size_t)(T + 4 * b) * NP;
    float qv[4][2], kv[4][2];
    {
        const int g0 = 2 * lane, g1 = g0 + 1;
        const int d0 = 4 * (g0 >> 3) + (g0 & 3) + 64 * ((g0 >> 2) & 1), d1 = 4 * (g1 >> 3) + (g1 & 3) + 64 * ((g1 >> 2) & 1);
#pragma unroll
        for (int t = 0; t < 4; ++t) {
            const unsigned qq = *(const unsigned*)(P + ro + (size_t)t * NP + C_QB + h * 128 + g0), kk = *(const unsigned*)(P + ro + (size_t)t * NP + C_KB + h * 128 + g0);
            qv[t][0] = bf_lo(qq); qv[t][1] = bf_hi(qq); kv[t][0] = bf_lo(kk); kv[t][1] = bf_hi(kk);
            const float kd = __expf((float)(3 - t) * lng);
            qs[t * 128 + d0] = qv[t][0]; qs[t * 128 + d1] = qv[t][1]; ksm[t * 128 + d0] = kv[t][0] * kd; ksm[t * 128 + d1] = kv[t][1] * kd;
        }
    }
    const int e4 = lane & 15, dq = lane >> 4, e = eh * 64 + 4 * e4;
    f32x4 vm[4];
#pragma unroll
    for (int m = 0; m < 4; ++m) { const u32x2 vv = *(const u32x2*)(P + ro + (size_t)m * NP + C_VB + h * 128 + e); vm[m] = (f32x4){bf_lo(vv.x), bf_hi(vv.x), bf_lo(vv.y), bf_hi(vv.y)}; }
    float A[4][4];
#pragma unroll
    for (int t = 0; t < 4; ++t)
#pragma unroll
        for (int m = 0; m < 4; ++m) {
            A[t][m] = 0.f;
            if (m <= t) { float a = qv[t][0] * kv[m][0] + qv[t][1] * kv[m][1];
#pragma unroll
                for (int o = 1; o < 64; o <<= 1) a += __shfl_xor(a, o);
                A[t][m] = a * __expf((float)(t - m) * lng); }
        }
    LDS_WAIT();
    const float* r0 = C.state + ((size_t)(layer * 128 + b) * 8 + h) * 16384 + e;
    float* rout = C.out + O_RS + ((size_t)(layer * 128 + b) * 8 + h) * 16384 + e;
    const float g4 = __expf(4.0f * lng);
    f32x4 acc[4];
#pragma unroll
    for (int t = 0; t < 4; ++t) acc[t] = (f32x4){0.f, 0.f, 0.f, 0.f};
#pragma unroll 1
    for (int i0 = 0; i0 < 32; i0 += 8) {
        f32x4 r[8];
#pragma unroll
        for (int k = 0; k < 8; ++k) r[k] = __builtin_nontemporal_load((const f32x4*)(r0 + (4 * (i0 + k) + dq) * 128));
#pragma unroll
        for (int k = 0; k < 8; ++k) {
            const int d = 4 * (i0 + k) + dq;
            const f32x4 rn = r[k] * g4 + vm[0] * ksm[d] + vm[1] * ksm[128 + d] + vm[2] * ksm[256 + d] + vm[3] * ksm[384 + d];
            __builtin_nontemporal_store(rn, (f32x4*)(rout + d * 128));
#pragma unroll
            for (int t = 0; t < 4; ++t) acc[t] += r[k] * qs[t * 128 + d];
        }
    }
    float o[4][4]; float s1[4], s2[4];
#pragma unroll
    for (int t = 0; t < 4; ++t) {
        const float qd = __expf((float)(t + 1) * lng);
        s1[t] = 0.f; s2[t] = 0.f;
#pragma unroll
        for (int j = 0; j < 4; ++j) {
            float a = acc[t][j]; a += __shfl_xor(a, 16); a += __shfl_xor(a, 32);
            a *= qd;
#pragma unroll
            for (int m = 0; m < 4; ++m) a += A[t][m] * vm[m][j];
            o[t][j] = a; s1[t] += a; s2[t] += a * a;
        }
#pragma unroll
        for (int k = 1; k < 16; k <<= 1) { s1[t] += __shfl_xor(s1[t], k); s2[t] += __shfl_xor(s2[t], k); }
        if (lane == 0) { pst[(w * 4 + t) * 2] = s1[t]; pst[(w * 4 + t) * 2 + 1] = s2[t]; }
    }
    __syncthreads();
    if (lane < 16) {
        const float* gw = C.ret_norm_w + layer * 1024 + h * 128 + e;
        const f32x4 wv = *(const f32x4*)gw;
#pragma unroll
        for (int t = 0; t < 4; ++t) {
            const float S1 = pst[(w * 4 + t) * 2] + pst[((w ^ 1) * 4 + t) * 2], S2 = pst[(w * 4 + t) * 2 + 1] + pst[((w ^ 1) * 4 + t) * 2 + 1];
            const float mu = S1 * (1.0f / 128.0f), var = fmaxf(S2 * (1.0f / 128.0f) - mu * mu, 0.f), rs = rsqrtf(var + 1e-6f);
            const size_t row = (size_t)(T + 4 * b + t);
            const u32x2 gt = *(const u32x2*)(P + row * NP + C_GB + h * 128 + e);
            u32x2 yo; yo.x = cvtpk((o[t][0] - mu) * rs * wv[0] * silu_f(bf_lo(gt.x)), (o[t][1] - mu) * rs * wv[1] * silu_f(bf_hi(gt.x)));
            yo.y = cvtpk((o[t][2] - mu) * rs * wv[2] * silu_f(bf_lo(gt.y)), (o[t][3] - mu) * rs * wv[3] * silu_f(bf_hi(gt.y)));
            *(u32x2*)(Y + row * D + 1024 + h * 128 + e) = yo;
        }
    }
    __syncthreads();
}

__device__ __forceinline__ void outproj_sample_unit(const Ctx& C, char* lds, int layer, int u, int tid, int w, int lane) {
    const bf16* Yb = (const bf16*)(C.ws + WS_Y) + (size_t)T * D; const bf16* Wt = (const bf16*)(C.ws + WS_WOUT) + (size_t)layer * D * D;
    const int m0 = (u >> 5) * 64, n0 = (u & 31) * 64, q = lane & 15, g = lane >> 4, k0 = 256 * w;
    f32x4 acc[4][4];
#pragma unroll
    for (int nt = 0; nt < 4; ++nt)
#pragma unroll
        for (int mt = 0; mt < 4; ++mt) acc[nt][mt] = (f32x4){0.f, 0.f, 0.f, 0.f};
    const bf16* ap = Wt + (size_t)(n0 + q) * D + k0 + 8 * g;
    const bf16* bp = Yb + (size_t)(m0 + q) * D + k0 + 8 * g;
    bf16x8 af[2][2][4], bfr[2][2][4];
#define OSU_LOAD(buf, kb) do { _Pragma("unroll") for (int ks = 0; ks < 2; ++ks) _Pragma("unroll") for (int t4 = 0; t4 < 4; ++t4) { \
        af[buf][ks][t4] = *(const bf16x8*)(ap + (size_t)(16 * t4) * D + 64 * (kb) + 32 * ks); bfr[buf][ks][t4] = *(const bf16x8*)(bp + (size_t)(16 * t4) * D + 64 * (kb) + 32 * ks); } } while (0)
    OSU_LOAD(0, 0);
#pragma unroll
    for (int kb = 0; kb < 4; ++kb) {
        if (kb + 1 < 4) { if ((kb & 1) == 0) OSU_LOAD(1, kb + 1); else OSU_LOAD(0, kb + 1); }
#pragma unroll
        for (int ks = 0; ks < 2; ++ks)
#pragma unroll
            for (int nt = 0; nt < 4; ++nt)
#pragma unroll
                for (int mt = 0; mt < 4; ++mt) acc[nt][mt] = __builtin_amdgcn_mfma_f32_16x16x32_bf16(af[kb & 1][ks][nt], bfr[kb & 1][ks][mt], acc[nt][mt], 0, 0, 0);
    }
#undef OSU_LOAD
    float* part = (float*)lds + w * (64 * 68);
#pragma unroll
    for (int nt = 0; nt < 4; ++nt)
#pragma unroll
        for (int mt = 0; mt < 4; ++mt) *(f32x4*)(part + (16 * mt + q) * 68 + 16 * nt + 4 * g) = acc[nt][mt];
    __syncthreads();
    {
        const int m = tid >> 3, n8 = (tid & 7) * 8;
        f32x4 v0 = (f32x4){0.f, 0.f, 0.f, 0.f}, v1 = v0;
#pragma unroll
        for (int ww = 0; ww < 8; ++ww) { const float* pp = (const float*)lds + ww * (64 * 68) + m * 68 + n8; v0 += *(const f32x4*)pp; v1 += *(const f32x4*)(pp + 4); }
        const int rs_ = m0 + m;
        float* XR = (float*)(C.ws + WS_XR);
        const float* bpz = (layer == 0 ? C.x_sample : XR + (size_t)T * D) + (size_t)rs_ * D + n0 + n8;
        float* op = (layer == 0 ? XR : C.out) + (size_t)(T + rs_) * D + n0 + n8;
        v0 += *(const f32x4*)bpz; v1 += *(const f32x4*)(bpz + 4);
        *(f32x4*)op = v0; *(f32x4*)(op + 4) = v1;
        if (layer == 0) { u32x4 wv; wv.x = cvtpk(v0[0], v0[1]); wv.y = cvtpk(v0[2], v0[3]); wv.z = cvtpk(v1[0], v1[1]); wv.w = cvtpk(v1[2], v1[3]);
            *(u32x4*)((bf16*)(C.ws + WS_XA) + (size_t)(T + rs_) * D + n0 + n8) = wv; }
        float ss = (v0[0] * v0[0] + v0[1] * v0[1]) + (v0[2] * v0[2] + v0[3] * v0[3]) + (v1[0] * v1[0] + v1[1] * v1[1]) + (v1[2] * v1[2] + v1[3] * v1[3]);
        ss += __shfl_xor(ss, 1); ss += __shfl_xor(ss, 2); ss += __shfl_xor(ss, 4);
        if ((tid & 7) == 0) atomicAdd((float*)(C.ws + WS_CTL) + (layer + 1) * M + T + rs_, ss);
    }
    __syncthreads();
}

#ifndef SKIPM
#define SKIPM 0
#endif
#ifndef REPU
#define REPU 0
#endif
#ifndef REP_P0
#define REP_P0 1
#endif
#ifndef REP_G1
#define REP_G1 1
#endif
#ifndef REP_MX1
#define REP_MX1 1
#endif
#ifndef REP_RP
#define REP_RP 1
#endif
#ifndef REP_G2
#define REP_G2 1
#endif

#define GAS __attribute__((address_space(1)))
typedef GAS unsigned gu32;
#define XB_TMO      128
#define XB_XCNT(j)  (256  + 64 * (j))
#define XB_XSUB(j)  (1280 + 64 * (j))
#define XB_XGEN(j)  (2304 + 64 * (j))
#define XB_TOP      3328
#define XB_TOPGEN   3392
#define XCD_BAR_WORDS 3456
#define XB_SPIN_CAP (1u << 18)

__device__ __forceinline__ unsigned xb_ld(unsigned* p)              { return __hip_atomic_load(p, __ATOMIC_RELAXED, __HIP_MEMORY_SCOPE_AGENT); }
__device__ __forceinline__ unsigned xb_add(unsigned* p, unsigned v) { return __hip_atomic_fetch_add(p, v, __ATOMIC_RELAXED, __HIP_MEMORY_SCOPE_AGENT); }
__device__ __forceinline__ unsigned xb_xcc_id() { return (unsigned)__builtin_amdgcn_s_getreg((3 << 11) | 20) & 0xFu; }
#define XB_SPIN(cond, bar) do { unsigned _sp = 0; while (cond) { __builtin_amdgcn_s_sleep(1); \
    if ((++_sp & 255u) == 0u) { if (xb_ld(&(bar)[XB_TMO])) break; if (_sp > XB_SPIN_CAP) { atomicAdd(&(bar)[XB_TMO], 1u); break; } } } } while (0)

struct XcdBarrier {
    unsigned* bar; unsigned x;
    volatile LAS unsigned* st;
};

__device__ __forceinline__ XcdBarrier xcd_barrier_post(unsigned* bar, volatile LAS unsigned* st) {
    XcdBarrier b; b.bar = bar; b.x = xb_xcc_id(); b.st = st;
    if (threadIdx.x == 0) (void)xb_add(&bar[XB_XCNT(b.x)], 1u);
    return b;
}
__device__ __forceinline__ void xcd_barrier_complete(unsigned* bar, unsigned x, unsigned& nloc, unsigned& nx) {
    const unsigned G = gridDim.x * gridDim.y * gridDim.z;
    unsigned sum, cnt, mine, sp = 0u;
    for (;;) {
        sum = 0u; cnt = 0u; mine = 0u;
#pragma unroll
        for (unsigned j = 0; j < 16; ++j) { const unsigned c = xb_ld(&bar[XB_XCNT(j)]); sum += c; cnt += (c > 0u) ? 1u : 0u; mine = (j == x) ? c : mine; }
        if (sum == G) break;
        __builtin_amdgcn_s_sleep(1);
        if ((++sp & 255u) == 0u) { if (xb_ld(&bar[XB_TMO])) break; if (sp > XB_SPIN_CAP) { atomicAdd(&bar[XB_TMO], 1u); break; } }
    }
    nloc = mine > 0u ? mine : 1u; nx = cnt > 0u ? cnt : 1u;
}

__device__ __forceinline__ void xcd_barrier(const XcdBarrier& b) {
    asm volatile("s_waitcnt vmcnt(0)" ::: "memory");
    __syncthreads();
    if (threadIdx.x == 0) {
        unsigned* bar = b.bar;
        __builtin_amdgcn_s_waitcnt(0);
        unsigned nloc = b.st[0], nx = b.st[1];
        if (nloc == 0u) { xcd_barrier_complete(bar, b.x, nloc, nx); b.st[0] = nloc; b.st[1] = nx; }
        const unsigned old = xb_add(&bar[XB_XSUB(b.x)], 1u);
        const unsigned gen = old / nloc;
        if (old + 1u == (gen + 1u) * nloc) {
            __builtin_amdgcn_fence(__ATOMIC_RELEASE, "agent");
            asm volatile("s_waitcnt vmcnt(0)" ::: "memory");
            const unsigned og = xb_add(&bar[XB_TOP], 1u);
            const unsigned tg = og / nx;
            if (og + 1u == (tg + 1u) * nx) xb_add(&bar[XB_TOPGEN], 1u);
            else XB_SPIN(xb_ld(&bar[XB_TOPGEN]) == tg, bar);
            __builtin_amdgcn_fence(__ATOMIC_ACQUIRE, "agent");
            xb_add(&bar[XB_XGEN(b.x)], 1u);
            asm volatile("s_waitcnt vmcnt(0)" ::: "memory");
        } else {
            XB_SPIN(xb_ld(&bar[XB_XGEN(b.x)]) == gen, bar);
            __builtin_amdgcn_fence(__ATOMIC_ACQUIRE, "agent");
            asm volatile("s_waitcnt vmcnt(0)" ::: "memory");
        }
    }
    __syncthreads();
}

constexpr size_t WS_BAR = WS_CTL + 768 * 1024;
constexpr int LDS_BARST = LDS_BYTES - 64;
__global__ void __launch_bounds__(NTHREADS, 2) hymba_fwd(Ctx C) {
    extern __shared__ __attribute__((aligned(16))) unsigned char lds_raw[];
    cg::grid_group grid = cg::this_grid();
    if (threadIdx.x < 2) ((volatile LAS unsigned*)((LAS unsigned char*)lds_raw + LDS_BARST))[threadIdx.x] = 0u;
    __syncthreads();
    (void)xcd_barrier_post((unsigned*)(C.ws + WS_BAR), (volatile LAS unsigned*)((LAS unsigned char*)lds_raw + LDS_BARST));
    int ph = 0;
#define PHASE_BEGIN (C.ph_lo <= ph && ph < C.ph_hi)
#define PHASE_END do { if (C.ph_lo <= ph && ph + 1 < C.ph_hi) { if (C.ph_lo < 0) grid.sync(); else { XcdBarrier xb_; xb_.bar = (unsigned*)(C.ws + WS_BAR); xb_.x = xb_xcc_id(); xb_.st = (volatile LAS unsigned*)((LAS unsigned char*)lds_raw + LDS_BARST); xcd_barrier(xb_); } } ++ph; } while (0)
#define PHASE_LOCALS int tid = threadIdx.x; LAUNDER_V(tid); const int lane = tid & 63, wave = __builtin_amdgcn_readfirstlane(tid >> 6); \
    int G = gridDim.x, bid = blockIdx.x; LAUNDER_S(G); LAUNDER_S(bid); char* lds = (char*)lds_raw; Ctx Cc = C; LAUNDER_S(Cc.ws); (void)lane; (void)wave; (void)lds

    if (PHASE_BEGIN) { PHASE_LOCALS; for (int rep = 0; rep < REP_P0; ++rep) { p0_prologue(Cc, lds, tid, wave, lane, G); __syncthreads(); } }
    PHASE_END;

    for (int layer = 0; layer < DEPTH; ++layer) {
        if (PHASE_BEGIN) {
            unsigned char* ws = C.ws; const int G = gridDim.x, bid = blockIdx.x;
            float* rss = (float*)(ws + WS_CTL); float* cosA = (float*)(ws + WS_TAB); float* sinA = cosA + NPOS * 32; float* cosB = sinA + NPOS * 32; float* sinB = cosB + NPOS * 64;
            pg8::Gemm g{(const bf16*)(ws + WS_XA), (const bf16*)(ws + WS_WIN) + (size_t)layer * NP * D, M, NP, D}; pg8::StaticOrder S; S.init(M, NP, G, bid);
            pg8::EpiProj E{(bf16*)(ws + WS_P), rss + layer * M, cosA, sinA, cosB, sinB, C.out, layer};
            for (int rep = 0; rep < REP_G1; ++rep) pg8::gemm_phase<pg8::EpiProj, pg8::StaticOrder, true, true>((LAS unsigned char*)lds_raw, g, S, E);
        }
        PHASE_END;
        if (PHASE_BEGIN) {
            PHASE_LOCALS; int ly = layer; LAUNDER_S(ly);
            for (int rep = 0; rep < REP_MX1; ++rep) for (int u = bid; u < 1280; u += G) {
                if (u < 512) { for (int r2 = 0; r2 < 1 + (REPU & 1); ++r2) ret_u_unit(Cc, lds, u >> 3, u & 7, tid, wave, lane); }
                else if (u < 768) { const int a = u - 512; for (int r2 = 0; r2 < 1 + ((REPU >> 1) & 1); ++r2) attn_prompt_unit(Cc, lds, ly, a >> 2, (a >> 1) & 1, a & 1, tid, wave, lane); }
                else if (u < 1024) { const int a = u - 768; for (int r2 = 0; r2 < 1 + ((REPU >> 2) & 1); ++r2) attn_sample_unit(Cc, lds, ly, a >> 1, a & 1, tid); }
                else { const int a = u - 1024; ret_sample_group(Cc, lds, ly, a, tid, wave, lane); }
            }
        }
        PHASE_END;
        if (PHASE_BEGIN) { PHASE_LOCALS; int ly = layer; LAUNDER_S(ly); for (int r2 = 0; r2 < 1 + ((REPU >> 4) & 1); ++r2) ret_scan(Cc, ly, tid, G); for (int u = bid; u < 256; u += G) outproj_sample_unit(Cc, lds, ly, u, tid, wave, lane); }
        PHASE_END;
        if (PHASE_BEGIN) { PHASE_LOCALS; int ly = layer; LAUNDER_S(ly); for (int rep = 0; rep < REP_RP; ++rep) for (int u = bid; u < 512; u += G) if (!(SKIPM & 16)) ret_prompt_unit(Cc, lds, ly, u >> 3, u & 7, tid, wave, lane); }
        PHASE_END;
        if (PHASE_BEGIN) {
            unsigned char* ws = C.ws; const int G = gridDim.x, bid = blockIdx.x;
            float* rss = (float*)(ws + WS_CTL); float* XR = (float*)(ws + WS_XR);
            pg8::Gemm g{(const bf16*)(ws + WS_Y), (const bf16*)(ws + WS_WOUT) + (size_t)layer * D * D, T, D, D}; pg8::StaticOrder S; S.init(T, D, G, bid);
            pg8::EpiRes E{layer == 0 ? C.x_prompt : XR, layer == 0 ? C.x_sample : XR + (size_t)T * D, layer == 0 ? XR : C.out, layer == 0 ? (bf16*)(ws + WS_XA) : nullptr, rss + (layer + 1) * M};
            pg8::gemm_phase<pg8::EpiRes, pg8::StaticOrder, true, true>((LAS unsigned char*)lds_raw, g, S, E);
            for (int rep = 1; rep < REP_G2; ++rep) { pg8::EpiRes E2 = E; E2.rss = rss + 131072; pg8::gemm_phase<pg8::EpiRes, pg8::StaticOrder, true, true>((LAS unsigned char*)lds_raw, g, S, E2); }
        }
        PHASE_END;
    }
#ifdef REP_SYNC
    for (int rep = 0; rep < REP_SYNC; ++rep) { XcdBarrier xb_; xb_.bar = (unsigned*)(C.ws + WS_BAR); xb_.x = xb_xcc_id(); xb_.st = (volatile LAS unsigned*)((LAS unsigned char*)lds_raw + LDS_BARST); xcd_barrier(xb_); }
#endif
    if (PHASE_BEGIN) {
        PHASE_LOCALS;
        const float* rf = (const float*)(Cc.ws + WS_CTL) + 2 * M;
        for (int m = bid * 8 + wave; m < M; m += G * 8) {
            const float rv = rsqrtf(rf[m] * (1.0f / 2048.0f) + 1e-6f);
            f32x4* xr = (f32x4*)(Cc.out + (size_t)m * D);
#pragma unroll
            for (int j = 0; j < 8; ++j) { const f32x4 wv = *((const f32x4*)Cc.final_w + lane + 64 * j); xr[lane + 64 * j] = xr[lane + 64 * j] * rv * wv; }
        }
    }
}

constexpr int N_PHASES = 1 + DEPTH * 5 + 1;
#ifndef MK_MULTI
#define MK_MULTI 0
#endif
extern "C" void kernel_launch(void* const* d_in, const int* in_sizes, int n_in, void* d_out, int out_size, void* d_ws, size_t ws_size, hipStream_t stream) {
    static int grid = 0;
    if (grid == 0) {
        if (n_in != 11 || ws_size < WS_END) { fprintf(stderr, "kernel_launch: unexpected inputs (n_in %d, ws %zu)\n", n_in, ws_size); grid = -1; return; }
        int dev = 0, cus = 0, per_cu = 0;
        hipGetDevice(&dev); hipDeviceGetAttribute(&cus, hipDeviceAttributeMultiprocessorCount, dev);
        if (hipFuncSetAttribute((const void*)hymba_fwd, hipFuncAttributeMaxDynamicSharedMemorySize, LDS_BYTES) != hipSuccess) { fprintf(stderr, "kernel_launch: hipFuncSetAttribute failed\n"); grid = -1; return; }
        if (hipOccupancyMaxActiveBlocksPerMultiprocessor(&per_cu, (const void*)hymba_fwd, NTHREADS, LDS_BYTES) != hipSuccess || per_cu < 1) { fprintf(stderr, "kernel_launch: occupancy query says %d\n", per_cu); (void)hipGetLastError(); per_cu = 1; }
        grid = cus;
    }
    if (grid < 0) return;
    hipMemsetAsync((char*)d_ws + WS_CTL, 0, CTL_BYTES, stream);
    Ctx c{};
    c.x_prompt = (const float*)d_in[0]; c.x_sample = (const float*)d_in[1]; c.cache_k = (const float*)d_in[2]; c.cache_v = (const float*)d_in[3]; c.state = (const float*)d_in[4];
    c.norm_w = (const float*)d_in[5]; c.w_in = (const float*)d_in[6]; c.sinks = (const float*)d_in[7]; c.ret_norm_w = (const float*)d_in[8]; c.w_out = (const float*)d_in[9]; c.final_w = (const float*)d_in[10];
    c.out = (float*)d_out; c.ws = (unsigned char*)d_ws;
#if MK_MULTI
    for (int p = 0; p < N_PHASES; ++p) { c.ph_lo = p; c.ph_hi = p + 1; void* args[] = {&c};
        hipError_t e = hipLaunchCooperativeKernel((const void*)hymba_fwd, dim3(grid), dim3(NTHREADS), args, LDS_BYTES, stream);
        if (e != hipSuccess) { fprintf(stderr, "launch %d failed: %s\n", p, hipGetErrorString(e)); break; } }
#else
    c.ph_lo = 0; c.ph_hi = N_PHASES; void* args[] = {&c};
    hipError_t e = hipLaunchCooperativeKernel((const void*)hymba_fwd, dim3(grid), dim3(NTHREADS), args, LDS_BYTES, stream);
    if (e != hipSuccess) fprintf(stderr, "cooperative launch failed: %s (grid %d)\n", hipGetErrorString(e), grid);
#endif
}
```

```cpp
#include <hip/hip_runtime.h>
#include <hip/hip_cooperative_groups.h>
#include <cstdio>
#include <cstdint>
namespace cg = cooperative_groups;
namespace pg8 {
#define PG8_LAS __attribute__((address_space(3)))
typedef unsigned short bf16_t;
typedef short bf16x8 __attribute__((ext_vector_type(8)));
typedef float f32x4 __attribute__((ext_vector_type(4)));
typedef unsigned u32x4 __attribute__((ext_vector_type(4)));
constexpr int BM = 256, BK = 64, HALF = 128, HTB = HALF * BK * 2  , STAGE_BYTES = 8 * HTB, NXCD = 8, WGM = 8;

__host__ __device__ __forceinline__ int lds_byte(int r, int c) { const int st = (r >> 4) * 2 + (c >> 5), rr = r & 15, cc = c & 31, ob = rr * 64 + cc * 2; return st * 1024 + (ob ^ (((ob >> 9) & 1) << 5)); }
__host__ __device__ __forceinline__ void stage_rc(int b, int& R, int& C) { const int st = b / 1024, sb = b % 1024, swz = sb ^ (((sb >> 9) & 1) << 5); R = (st >> 1) * 16 + swz / 64; C = (st & 1) * 32 + (swz % 64) / 2; }
__host__ __device__ __forceinline__ int perm32(int rho) { const int n = rho >> 4, i = rho & 15; return 8 * (i >> 2) + 4 * n + (i & 3); }

struct Unit { int pm, pn; };
struct Gemm { const bf16_t* A; const bf16_t* Bt; int M, N, K; };

struct StaticOrder {
    int nM, nN, nwg, G, c;
    __host__ __device__ void init(int M, int N, int G_, int c_) { nM = M / BM; nN = N / BM; nwg = nM * nN; G = G_; c = c_; }
    __host__ __device__ bool next(int i, Unit& u) const {
        const long L = (long)i * G + c; if (L >= nwg) return false;
        int wgid = (int)L; { const int q = nwg / NXCD, r = nwg % NXCD, xcd = wgid % NXCD, off = wgid / NXCD; wgid = (xcd < r ? xcd * (q + 1) : r * (q + 1) + (xcd - r) * q) + off; }
        const int nig = WGM * nN, gid = wgid / nig, fm = gid * WGM, gsz = (nM - fm) < WGM ? (nM - fm) : WGM;
        u.pm = fm + ((wgid % nig) % gsz); u.pn = (wgid % nig) / gsz; return true;
    }
    __device__ __forceinline__ void a_ready(const Unit&) const {}
    __device__ __forceinline__ void done(const Unit&) const {}
};

__device__ __forceinline__ unsigned cvt_pk_bf16(float lo, float hi) { unsigned r; asm volatile("v_cvt_pk_bf16_f32 %0, %1, %2" : "=v"(r) : "v"(lo), "v"(hi)); return r; }
constexpr int T_ = 8192, NPROJ = 6400, DMODEL = 2048;
constexpr size_t O_KP = (size_t)8704 * 2048, O_VP = O_KP + 32768, O_RP = O_VP + 32768, O_KS = O_RP + 262144, O_VS = O_KS + 4194304, O_RS = O_VS + 4194304;

struct EpiProj {
    static constexpr bool PERM = true, AFTER_DRAIN = false;
    bf16_t* P; const float* rss; const float* cosA; const float* sinA; const float* cosB; const float* sinB; float* out; int layer;
    __device__ __forceinline__ void operator()(const f32x4 (&acc)[2][2][4][2], const Unit& u, int wr, int wc, int fr, int fq) const {
        float rv[2][4];
#pragma unroll
        for (int ai = 0; ai < 2; ++ai)
#pragma unroll
            for (int m = 0; m < 4; ++m) rv[ai][m] = rsqrtf(rss[u.pm * BM + ai * HALF + wr * 64 + m * 16 + fr] * (1.0f / 2048.0f) + 1e-6f);
#pragma unroll
        for (int bj = 0; bj < 2; ++bj) {
            const int cb = u.pn * BM + bj * HALF;
            const int c0 = cb + wc * 32 + 8 * fq;
            const int mode = (cb < 1152) ? 1 : ((cb >= 2304 && cb < 4352) ? 2 : 0);
            const int kvmode = (cb == 1024) ? 1 : ((cb == 1152) ? 2 : 0);
#pragma unroll
            for (int ai = 0; ai < 2; ++ai)
#pragma unroll
                for (int m = 0; m < 4; ++m) {
                    const int row = u.pm * BM + ai * HALF + wr * 64 + m * 16 + fr;
                    f32x4 v0 = acc[ai][bj][m][0] * rv[ai][m], v1 = acc[ai][bj][m][1] * rv[ai][m];
                    if (mode) {
                        const int pos = row < T_ ? row : T_ + ((row - T_) & 3);
                        f32x4 c, s;
                        if (mode == 1) { const int i = (c0 & 63) >> 3; c = *(const f32x4*)(cosA + pos * 32 + 4 * i); s = *(const f32x4*)(sinA + pos * 32 + 4 * i); }
                        else { const int i = (c0 & 127) >> 3; c = *(const f32x4*)(cosB + pos * 64 + 4 * i); s = *(const f32x4*)(sinB + pos * 64 + 4 * i); }
                        const f32x4 y0 = v0 * c - v1 * s, y1 = v1 * c + v0 * s; v0 = y0; v1 = y1;
                    }
                    u32x4 w; w.x = cvt_pk_bf16(v0[0], v0[1]); w.y = cvt_pk_bf16(v0[2], v0[3]); w.z = cvt_pk_bf16(v1[0], v1[1]); w.w = cvt_pk_bf16(v1[2], v1[3]);
                    *(u32x4*)(P + (size_t)row * NPROJ + c0) = w;
                    if (kvmode && row >= T_ - 128) {
                        const int kvh = (c0 - cb) >> 6, g0 = c0 & 63;
                        float* dst;
                        if (row < T_) dst = out + (kvmode == 1 ? O_KP : O_VP) + ((size_t)(layer * 128 + (row - (T_ - 128))) * 2 + kvh) * 64;
                        else { const int b = (row - T_) >> 2, t = (row - T_) & 3; dst = out + (kvmode == 1 ? O_KS : O_VS) + ((((size_t)layer * 128 + b) * 128 + 124 + t) * 2 + kvh) * 64; }
                        if (kvmode == 1) { const int i = g0 >> 3; *(f32x4*)(dst + 4 * i) = v0; *(f32x4*)(dst + 4 * i + 32) = v1; }
                        else { *(f32x4*)(dst + g0) = v0; *(f32x4*)(dst + g0 + 4) = v1; }
                    }
                }
        }
    }
};

struct EpiRes {
    static constexpr bool PERM = true, AFTER_DRAIN = false;
    const float* base_p; const float* base_s; float* outx; bf16_t* xa; float* rss;
    __device__ __forceinline__ void operator()(const f32x4 (&acc)[2][2][4][2], const Unit& u, int wr, int wc, int fr, int fq) const {
#pragma unroll
        for (int ai = 0; ai < 2; ++ai)
#pragma unroll
            for (int m = 0; m < 4; ++m) {
                const int row = u.pm * BM + ai * HALF + wr * 64 + m * 16 + fr;
                const float* bp = row < T_ ? base_p + (size_t)row * DMODEL : base_s + (size_t)(row - T_) * DMODEL;
                float ss = 0.f;
#pragma unroll
                for (int bj = 0; bj < 2; ++bj) {
                    const int c0 = u.pn * BM + bj * HALF + wc * 32 + 8 * fq;
                    const f32x4 b0 = *(const f32x4*)(bp + c0), b1 = *(const f32x4*)(bp + c0 + 4);
                    const f32x4 v0 = acc[ai][bj][m][0] + b0, v1 = acc[ai][bj][m][1] + b1;
                    *(f32x4*)(outx + (size_t)row * DMODEL + c0) = v0; *(f32x4*)(outx + (size_t)row * DMODEL + c0 + 4) = v1;
                    if (xa) { u32x4 w; w.x = cvt_pk_bf16(v0[0], v0[1]); w.y = cvt_pk_bf16(v0[2], v0[3]); w.z = cvt_pk_bf16(v1[0], v1[1]); w.w = cvt_pk_bf16(v1[2], v1[3]);
                        *(u32x4*)(xa + (size_t)row * DMODEL + c0) = w; }
                    ss += (v0[0] * v0[0] + v0[1] * v0[1]) + (v0[2] * v0[2] + v0[3] * v0[3]) + (v1[0] * v1[0] + v1[1] * v1[1]) + (v1[2] * v1[2] + v1[3] * v1[3]);
                }
                ss += __shfl_xor(ss, 16); ss += __shfl_xor(ss, 32);
                if (fq == 0) atomicAdd(rss + row, ss);
            }
    }
};

template <class Epi, class Sched, bool ALIGN_EPI = false, bool SP2 = false>
__device__ __forceinline__ void gemm_phase(PG8_LAS unsigned char* lds, const Gemm g, const Sched& S, const Epi& E) {
    int tid_ = threadIdx.x; asm volatile("" : "+v"(tid_));
    const int tid = tid_, wid = __builtin_amdgcn_readfirstlane(tid >> 6), lane = tid & 63, wr = wid >> 2, wc = wid & 3, fr = lane & 15, fq = lane >> 4;
    const int K = g.K, nt = K / BK;
    unsigned voffA[2], voffB[2];
#pragma unroll
    for (int i = 0; i < 2; ++i) { int R, C; stage_rc(tid * 16 + i * 8192, R, C); const int Rb = Epi::PERM ? ((R & ~31) + perm32(R & 31)) : R;
        voffA[i] = (unsigned)(R * K + C) * 2u; voffB[i] = (unsigned)(Rb * K + C) * 2u; }
    const size_t kstep = (size_t)(BK * 2);
    const size_t hstep = (size_t)HALF * K * 2;
    const size_t tstep = 2 * hstep;
    const unsigned ldsw = (unsigned)wid * 1024u;
    const int aoff = lds_byte(wr * 64 + fr, fq * 8), boff = lds_byte(wc * 32 + fr, fq * 8);
#define PG8_SA(b, h) (((b) * 2 + (h)) * HTB)
#define PG8_SB(b, h) ((4 + (b) * 2 + (h)) * HTB)
#define PG8_STAGE(bufoff, gbase, voff) do { _Pragma("unroll") for (int _i = 0; _i < 2; ++_i) \
        __builtin_amdgcn_global_load_lds((const unsigned*)((const char*)(gbase) + (voff)[_i]), (PG8_LAS unsigned*)(lds + (bufoff) + ldsw + _i * 8192), 16, 0, 0); } while (0)
#define PG8_LDA(dst, b, h) do { _Pragma("unroll") for (int m = 0; m < 4; ++m) _Pragma("unroll") for (int k = 0; k < 2; ++k) dst[m][k] = *(const PG8_LAS bf16x8*)(lds + PG8_SA(b, h) + aoff + m * 2048 + k * 1024); } while (0)
#define PG8_LDB(dst, b, h) do { _Pragma("unroll") for (int n = 0; n < 2; ++n) _Pragma("unroll") for (int k = 0; k < 2; ++k) dst[n][k] = *(const PG8_LAS bf16x8*)(lds + PG8_SB(b, h) + boff + n * 2048 + k * 1024); } while (0)
#define PG8_MMA(ai, bj, At, Bt) do { __builtin_amdgcn_s_setprio(1); _Pragma("unroll") for (int m = 0; m < 4; ++m) _Pragma("unroll") for (int n = 0; n < 2; ++n) _Pragma("unroll") for (int k = 0; k < 2; ++k) \
        acc[ai][bj][m][n] = __builtin_amdgcn_mfma_f32_16x16x32_bf16(Bt[n][k], At[m][k], acc[ai][bj][m][n], 0, 0, 0); __builtin_amdgcn_s_setprio(0); } while (0)
#define PG8_WAIT_V(n) asm volatile("s_waitcnt vmcnt(" #n ")" ::: "memory")
#define PG8_WAIT_L(n) asm volatile("s_waitcnt lgkmcnt(" #n ")" ::: "memory")
#define PG8_BAR __builtin_amdgcn_s_barrier()
#define PG8_SCHED __builtin_amdgcn_sched_barrier(0)
    Unit cur, nxt; int ui = 0;
    if (!S.next(0, cur)) return;
    f32x4 acc[2][2][4][2];
#pragma unroll
    for (int a = 0; a < 2; ++a)
#pragma unroll
        for (int b = 0; b < 2; ++b)
#pragma unroll
            for (int m = 0; m < 4; ++m)
#pragma unroll
                for (int n = 0; n < 2; ++n) acc[a][b][m][n] = (f32x4){0.f, 0.f, 0.f, 0.f};
    bf16x8 At[4][2], B0[2][2], B1[2][2];
    const char* cA = (const char*)g.A + (size_t)cur.pm * tstep; const char* cB = (const char*)g.Bt + (size_t)cur.pn * tstep;
    S.a_ready(cur);
    if constexpr (SP2) {
        PG8_STAGE(PG8_SB(0, 0), cB, voffB); PG8_STAGE(PG8_SB(0, 1), cB + hstep, voffB); PG8_STAGE(PG8_SA(0, 0), cA, voffA); PG8_STAGE(PG8_SA(0, 1), cA + hstep, voffA);
        if (wr == 1) PG8_BAR;
        PG8_WAIT_V(2); PG8_BAR;
        PG8_STAGE(PG8_SB(1, 0), cB + kstep, voffB); PG8_STAGE(PG8_SA(1, 0), cA + kstep, voffA); PG8_STAGE(PG8_SB(1, 1), cB + hstep + kstep, voffB);
        PG8_WAIT_V(6); PG8_BAR;
    } else {
        PG8_STAGE(PG8_SB(0, 0), cB, voffB); PG8_STAGE(PG8_SA(0, 0), cA, voffA); PG8_STAGE(PG8_SB(0, 1), cB + hstep, voffB); PG8_STAGE(PG8_SA(0, 1), cA + hstep, voffA);
        if (wr == 1) PG8_BAR;
        PG8_WAIT_V(4); PG8_BAR;
        PG8_STAGE(PG8_SB(1, 0), cB + kstep, voffB); PG8_STAGE(PG8_SA(1, 0), cA + kstep, voffA); PG8_STAGE(PG8_SB(1, 1), cB + hstep + kstep, voffB);
        PG8_WAIT_V(6); PG8_BAR;
    }
    for (;;) {
        const bool has_next = S.next(ui + 1, nxt);
        const char* nA = has_next ? (const char*)g.A + (size_t)nxt.pm * tstep : cA; const char* nB = has_next ? (const char*)g.Bt + (size_t)nxt.pn * tstep : cB;
        for (int t = 0; t < nt; t += 2) {
            const bool last = (t == nt - 2);
            const char* a1 = cA + (size_t)(t + 1) * kstep;
            const char* a2 = last ? nA : cA + (size_t)(t + 2) * kstep; const char* b2 = last ? nB : cB + (size_t)(t + 2) * kstep;
            const char* a3 = a2 + kstep; const char* b3 = b2 + kstep;
            if (last && has_next) S.a_ready(nxt);
            if constexpr (SP2) {
            PG8_LDB(B0, 0, 0); PG8_LDB(B1, 0, 1); PG8_SCHED; PG8_LDA(At, 0, 0); PG8_STAGE(PG8_SA(1, 1), a1 + hstep, voffA);
            PG8_WAIT_V(8); PG8_WAIT_L(0); PG8_BAR; PG8_MMA(0, 0, At, B0); PG8_MMA(0, 1, At, B1); PG8_BAR; PG8_SCHED;
            PG8_LDA(At, 0, 1); PG8_STAGE(PG8_SB(0, 0), b2, voffB); PG8_STAGE(PG8_SB(0, 1), b2 + hstep, voffB); PG8_STAGE(PG8_SA(0, 0), a2, voffA);
            PG8_WAIT_V(8); PG8_WAIT_L(0); PG8_BAR; PG8_MMA(1, 0, At, B0); PG8_MMA(1, 1, At, B1); PG8_BAR; PG8_SCHED;
            PG8_LDB(B0, 1, 0); PG8_LDB(B1, 1, 1); PG8_SCHED; PG8_LDA(At, 1, 0); PG8_STAGE(PG8_SA(0, 1), a2 + hstep, voffA);
            PG8_WAIT_V(8); PG8_WAIT_L(0); PG8_BAR; PG8_MMA(0, 0, At, B0); PG8_MMA(0, 1, At, B1); PG8_BAR; PG8_SCHED;
            PG8_LDA(At, 1, 1); PG8_STAGE(PG8_SB(1, 0), b3, voffB); PG8_STAGE(PG8_SB(1, 1), b3 + hstep, voffB); PG8_STAGE(PG8_SA(1, 0), a3, voffA);
            PG8_WAIT_V(8); PG8_WAIT_L(0); PG8_BAR; PG8_MMA(1, 0, At, B0); PG8_MMA(1, 1, At, B1); PG8_BAR; PG8_SCHED;
            } else {
            PG8_LDB(B0, 0, 0); PG8_SCHED; PG8_LDA(At, 0, 0); PG8_STAGE(PG8_SA(1, 1), a1 + hstep, voffA);
            PG8_WAIT_L(8); PG8_BAR; PG8_WAIT_L(0); PG8_MMA(0, 0, At, B0); PG8_BAR; PG8_SCHED;
            PG8_LDB(B1, 0, 1); PG8_STAGE(PG8_SB(0, 0), b2, voffB);
            PG8_BAR; PG8_WAIT_L(0); PG8_MMA(0, 1, At, B1); PG8_BAR;
            PG8_LDA(At, 0, 1); PG8_STAGE(PG8_SA(0, 0), a2, voffA);
            PG8_BAR; PG8_WAIT_L(0); PG8_MMA(1, 0, At, B0); PG8_BAR; PG8_SCHED;
            PG8_STAGE(PG8_SB(0, 1), b2 + hstep, voffB);
            PG8_WAIT_V(6); PG8_BAR; PG8_MMA(1, 1, At, B1); PG8_BAR;
            PG8_LDB(B0, 1, 0); PG8_SCHED; PG8_LDA(At, 1, 0); PG8_STAGE(PG8_SA(0, 1), a2 + hstep, voffA);
            PG8_WAIT_L(8); PG8_BAR; PG8_WAIT_L(0); PG8_MMA(0, 0, At, B0); PG8_BAR; PG8_SCHED;
            PG8_LDB(B1, 1, 1); PG8_STAGE(PG8_SB(1, 0), b3, voffB);
            PG8_BAR; PG8_WAIT_L(0); PG8_MMA(0, 1, At, B1); PG8_BAR;
            PG8_LDA(At, 1, 1); PG8_STAGE(PG8_SA(1, 0), a3, voffA);
            PG8_BAR; PG8_WAIT_L(0); PG8_MMA(1, 0, At, B0); PG8_BAR; PG8_SCHED;
            PG8_STAGE(PG8_SB(1, 1), b3 + hstep, voffB);
            PG8_WAIT_V(6); PG8_BAR; PG8_MMA(1, 1, At, B1); PG8_BAR;
            }
        }
        if constexpr (ALIGN_EPI) { if (wr == 0) PG8_BAR; }
        if constexpr (!Epi::AFTER_DRAIN) { E(acc, cur, wr, wc, fr, fq); S.done(cur); }
        if (!has_next) break;
#pragma unroll
        for (int a = 0; a < 2; ++a)
#pragma unroll
            for (int b = 0; b < 2; ++b)
#pragma unroll
                for (int m = 0; m < 4; ++m)
#pragma unroll
                    for (int n = 0; n < 2; ++n) acc[a][b][m][n] = (f32x4){0.f, 0.f, 0.f, 0.f};
        cur = nxt; cA = nA; cB = nB; ++ui;
        if constexpr (ALIGN_EPI) { if (wr == 1) PG8_BAR; }
    }
    PG8_WAIT_V(0);
    if constexpr (!ALIGN_EPI) { if (wr == 0) PG8_BAR; }
    PG8_BAR;
    if constexpr (Epi::AFTER_DRAIN) { E.fused(acc, cur, wr, wc, fr, fq, lds, wid, lane); S.done(cur); }
#undef PG8_SA
#undef PG8_SB
#undef PG8_STAGE
#undef PG8_LDA
#undef PG8_LDB
#undef PG8_MMA
#undef PG8_WAIT_V
#undef PG8_WAIT_L
#undef PG8_BAR
#undef PG8_SCHED
}
}

typedef unsigned short bf16;
typedef float f32x4 __attribute__((ext_vector_type(4)));
typedef short bf16x8 __attribute__((ext_vector_type(8)));
typedef short s16x4 __attribute__((ext_vector_type(4)));
typedef unsigned u32x4 __attribute__((ext_vector_type(4)));
typedef unsigned u32x2 __attribute__((ext_vector_type(2)));
typedef float f32x2 __attribute__((ext_vector_type(2)));
typedef __bf16 bf16x2_t __attribute__((ext_vector_type(2)));
#define LAS __attribute__((address_space(3)))

constexpr int T = 8192, NS = 512, M = 8704, D = 2048, NP = 6400, DEPTH = 2;
constexpr int C_QA = 0, C_KA = 1024, C_VA = 1152, C_GA = 1280, C_QB = 2304, C_KB = 3328, C_VB = 4352, C_GB = 5376;
constexpr int NPOS = 8196;
constexpr int LDS_BYTES = 147456;
constexpr int NTHREADS = 512;
using pg8::O_KP; using pg8::O_VP; using pg8::O_RP; using pg8::O_KS; using pg8::O_VS; using pg8::O_RS;

constexpr size_t MiB = 1u << 20;
constexpr size_t WS_CTL = 0, CTL_BYTES = 1 * MiB;
constexpr size_t WS_WIN = 2 * MiB;
constexpr size_t WS_WOUT = WS_WIN + 50 * MiB;
constexpr size_t WS_XA = WS_WOUT + 16 * MiB;
constexpr size_t WS_P = WS_XA + 34 * MiB;
constexpr size_t WS_Y = WS_P + 107 * MiB;
constexpr size_t WS_XR = WS_Y + 34 * MiB;
constexpr size_t WS_U = WS_XR + 68 * MiB;
constexpr size_t WS_RT = WS_U + 32 * MiB;
constexpr size_t WS_TAB = WS_RT + 16 * MiB;
constexpr size_t WS_END = WS_TAB + 8 * MiB;

struct Ctx {
    const float *x_prompt, *x_sample, *cache_k, *cache_v, *state, *norm_w, *w_in, *sinks, *ret_norm_w, *w_out, *final_w;
    float* out; unsigned char* ws;
    int ph_lo, ph_hi;
};

__device__ __forceinline__ unsigned cvtpk(float lo, float hi) { f32x2 v = {lo, hi}; bf16x2_t b = __builtin_convertvector(v, bf16x2_t); return __builtin_bit_cast(unsigned, b); }
__device__ __forceinline__ float bf_lo(unsigned u) { return __uint_as_float(u << 16); }
__device__ __forceinline__ float bf_hi(unsigned u) { return __uint_as_float(u & 0xffff0000u); }
__device__ __forceinline__ float silu_f(float x) { return x / (1.0f + __expf(-x)); }
__device__ __forceinline__ s16x4 vtr(const char* p) { typedef short v4i16_t __attribute__((ext_vector_type(4)));
    return __builtin_bit_cast(s16x4, __builtin_amdgcn_ds_read_tr16_b64_v4i16((LAS v4i16_t*)p)); }
__device__ __forceinline__ bf16x8 cat8(s16x4 lo, s16x4 hi) { return (bf16x8){lo[0], lo[1], lo[2], lo[3], hi[0], hi[1], hi[2], hi[3]}; }
__device__ __forceinline__ float ln_gamma(int h) {
    const double x = __builtin_ldexp(1.0, -5 - h);
    double s = 0.0, p = x;
#pragma unroll
    for (int k = 1; k <= 9; ++k) { s += p / (double)k; p *= x; }
    return (float)(-s);
}
#define LDS_WAIT() asm volatile("s_waitcnt lgkmcnt(0)" ::: "memory")
#define LAUNDER_V(x) asm volatile("" : "+v"(x))
#define LAUNDER_S(x) asm volatile("" : "+s"(x))

__device__ __forceinline__ int perm_src_col(int np, float& sc) {
    sc = 1.0f;
    if (np < 1152) { const int hb = np & ~63, g = np & 63; if (np < 1024) sc = 0.125f; return hb + 4 * (g >> 3) + (g & 3) + 32 * ((g >> 2) & 1); }
    if (np >= C_QB && np < C_VB) { const int hb = np & ~127, g = np & 127; if (np >= C_KB) sc = 0.08838834764831845f; return hb + 4 * (g >> 3) + (g & 3) + 64 * ((g >> 2) & 1); }
    return np;
}

template <bool WIN>
__device__ __forceinline__ void transpose_item(const float* W, int N, const float* nw, bf16* WT, float* scr, int kb, int nb, int lane) {
    const int k0 = 64 * kb, n0 = 64 * nb, l16 = lane & 15, r4 = lane >> 4;
    float sc = 1.0f; int srcc = n0 + 4 * l16;
    if (WIN) srcc = perm_src_col(n0 + 4 * l16, sc);
    f32x4 v[16]; float nwv[16];
#pragma unroll
    for (int i = 0; i < 16; ++i) { const int kk = 4 * i + r4; v[i] = __builtin_nontemporal_load((const f32x4*)(W + (size_t)(k0 + kk) * N + srcc)); nwv[i] = WIN ? nw[k0 + kk] : 1.0f; }
#pragma unroll
    for (int i = 0; i < 16; ++i) {
        const int kk = 4 * i + r4; const float s2 = sc * nwv[i];
        float* d = scr + kk * 65 + 4 * l16;
        d[0] = v[i][0] * s2; d[1] = v[i][1] * s2; d[2] = v[i][2] * s2; d[3] = v[i][3] * s2;
    }
    LDS_WAIT();
    const int c = lane & 7;
#pragma unroll
    for (int j = 0; j < 8; ++j) {
        const int n = (lane >> 3) + 8 * j; const float* s = scr + (8 * c) * 65 + n;
        u32x4 o; o.x = cvtpk(s[0], s[65]); o.y = cvtpk(s[130], s[195]); o.z = cvtpk(s[260], s[325]); o.w = cvtpk(s[390], s[455]);
        *(u32x4*)(WT + (size_t)(n0 + n) * 2048 + k0 + 8 * c) = o;
    }
    LDS_WAIT();
}

__device__ __forceinline__ void convert_weights(const Ctx& C, float* scr, int l, int gw, int NGW, int lane) {
    bf16* WIN = (bf16*)(C.ws + WS_WIN); bf16* WOUT = (bf16*)(C.ws + WS_WOUT);
    constexpr int I_IN = 32 * 100, I_OUT = 32 * 32;
    for (int it = gw; it < I_IN + I_OUT; it += NGW) {
        int r = it;
        if (r < I_IN) { const int nb = r % 100, kb = r / 100;
            transpose_item<true>(C.w_in + (size_t)l * D * NP, NP, C.norm_w + l * D, WIN + (size_t)l * NP * D, scr, kb, nb, lane); }
        else { r -= I_IN; const int nb = r & 31, kb = r >> 5;
            transpose_item<false>(C.w_out + (size_t)l * D * D, D, nullptr, WOUT + (size_t)l * D * D, scr, kb, nb, lane); }
    }
}

__device__ __forceinline__ void p0_prologue(const Ctx& C, char* lds, int tid, int wave, int lane, int G) {
    float* scr = (float*)(lds + wave * 16640);
    const int gw = blockIdx.x * 8 + wave, NGW = G * 8;
    convert_weights(C, scr, 0, gw, NGW, lane);
    bf16* XA = (bf16*)(C.ws + WS_XA); float* rss = (float*)(C.ws + WS_CTL);
    for (int m = gw; m < M; m += 2 * NGW) {
        const int m2 = m + NGW; const bool has2 = m2 < M;
        const float* xr = m < T ? C.x_prompt + (size_t)m * D : C.x_sample + (size_t)(m - T) * D;
        const int m2c = has2 ? m2 : m;
        const float* xr2 = m2c < T ? C.x_prompt + (size_t)m2c * D : C.x_sample + (size_t)(m2c - T) * D;
        f32x4 va[8], vb[8];
#pragma unroll
        for (int j = 0; j < 8; ++j) { va[j] = __builtin_nontemporal_load((const f32x4*)xr + lane + 64 * j); vb[j] = __builtin_nontemporal_load((const f32x4*)xr2 + lane + 64 * j); }
        float ss = 0.f, ss2 = 0.f;
#pragma unroll
        for (int j = 0; j < 8; ++j) {
            ss += (va[j][0] * va[j][0] + va[j][1] * va[j][1]) + (va[j][2] * va[j][2] + va[j][3] * va[j][3]);
            ss2 += (vb[j][0] * vb[j][0] + vb[j][1] * vb[j][1]) + (vb[j][2] * vb[j][2] + vb[j][3] * vb[j][3]);
            u32x2 o; o.x = cvtpk(va[j][0], va[j][1]); o.y = cvtpk(va[j][2], va[j][3]);
            *((u32x2*)(XA + (size_t)m * D) + lane + 64 * j) = o;
            if (has2) { u32x2 o2; o2.x = cvtpk(vb[j][0], vb[j][1]); o2.y = cvtpk(vb[j][2], vb[j][3]); *((u32x2*)(XA + (size_t)m2 * D) + lane + 64 * j) = o2; }
        }
#pragma unroll
        for (int o = 1; o < 64; o <<= 1) { ss += __shfl_xor(ss, o); ss2 += __shfl_xor(ss2, o); }
        if (lane == 0) { rss[m] = ss; if (has2) rss[m2] = ss2; }
    }
    float* cosA = (float*)(C.ws + WS_TAB); float* sinA = cosA + NPOS * 32; float* cosB = sinA + NPOS * 32; float* sinB = cosB + NPOS * 64;
    for (int i = blockIdx.x * NTHREADS + tid; i < NPOS * 96; i += G * NTHREADS) {
        int pos, f, half; float *pc, *ps;
        if (i < NPOS * 32) { pos = i >> 5; f = i & 31; half = 32; pc = cosA + i; ps = sinA + i; }
        else { const int k = i - NPOS * 32; pos = k >> 6; f = k & 63; half = 64; pc = cosB + k; ps = sinB + k; }
        const double rr = half == 32 ? 0.7498942093324559 : 0.8659643233600653;
        double inv = 1.0; for (int k = 0; k < f; ++k) inv *= rr;
        const float ang = (float)pos * (float)inv;
        const double a = (double)ang;
        const double qd = __builtin_rint(a * 0.6366197723675814);
        double r = __builtin_fma(-qd, 1.5707963267948966, a); r = __builtin_fma(-qd, 6.123233995736766e-17, r);
        const double r2 = r * r;
        double sp = -1.0 / 39916800.0; sp = sp * r2 + 1.0 / 362880.0; sp = sp * r2 - 1.0 / 5040.0; sp = sp * r2 + 1.0 / 120.0; sp = sp * r2 - 1.0 / 6.0; sp = sp * r2 + 1.0; sp *= r;
        double cp = 1.0 / 479001600.0; cp = cp * r2 - 1.0 / 3628800.0; cp = cp * r2 + 1.0 / 40320.0; cp = cp * r2 - 1.0 / 720.0; cp = cp * r2 + 1.0 / 24.0; cp = cp * r2 - 0.5; cp = cp * r2 + 1.0;
        const int qi = ((int)qd) & 3;
        const double sv = (qi == 0) ? sp : (qi == 1) ? cp : (qi == 2) ? -sp : -cp;
        const double cv = (qi == 0) ? cp : (qi == 1) ? -sp : (qi == 2) ? -cp : sp;
        *pc = (float)cv; *ps = (float)sv;
    }
}

__device__ __forceinline__ void attn_prompt_unit(const Ctx& C, char* lds, int layer, int blk, int kvh, int hq, int tid, int w, int lane) {
    const bf16* P = (const bf16*)(C.ws + WS_P); bf16* Y = (bf16*)(C.ws + WS_Y);
    char* Ks = lds; char* Vs = lds + 36864;
    const int q = lane & 15, g = lane >> 4;
    const int jt0 = w < 6 ? w : 6;
    const int iq = 16 * w + q, row = blk * 128 + iq;
    bf16x8 qfa[4][2]; u32x2 gta[4][4];
#pragma unroll
    for (int hh = 0; hh < 4; ++hh) {
        const int h = kvh * 8 + hq * 4 + hh;
#pragma unroll
        for (int ks = 0; ks < 2; ++ks) qfa[hh][ks] = *(const bf16x8*)(P + (size_t)row * NP + C_QA + h * 64 + 32 * ks + 8 * g);
#pragma unroll
        for (int dt = 0; dt < 4; ++dt) gta[hh][dt] = *(const u32x2*)(P + (size_t)row * NP + C_GA + h * 64 + 16 * dt + 4 * g);
    }
#pragma unroll
    for (int it = 0; it < 4; ++it) {
        const int r = (tid >> 3) + 64 * it, ch = tid & 7, krow = blk * 128 - 128 + r;
        u32x4 kv = (u32x4){0u, 0u, 0u, 0u}, vv = kv;
        if (krow >= 0) { kv = *(const u32x4*)(P + (size_t)krow * NP + C_KA + kvh * 64 + ch * 8); vv = *(const u32x4*)(P + (size_t)krow * NP + C_VA + kvh * 64 + ch * 8); }
        *(u32x4*)(Ks + r * 144 + ch * 16) = kv; *(u32x4*)(Vs + r * 144 + ch * 16) = vv;
    }
    __syncthreads();
#pragma unroll
    for (int hh = 0; hh < 4; ++hh) {
        const int h = kvh * 8 + hq * 4 + hh;
        bf16x8 qf[2]; qf[0] = qfa[hh][0]; qf[1] = qfa[hh][1];
        f32x4 s[10];
        float mx = -INFINITY;
        int lo = (blk > 0 || iq + 1 >= 128) ? iq + 1 : 128; LAUNDER_V(lo);
        const unsigned span = (unsigned)(iq + 128 - lo);
#pragma unroll
        for (int tt = 0; tt < 10; ++tt) {
            const int jt = jt0 + tt;
            f32x4 a = (f32x4){0.f, 0.f, 0.f, 0.f};
#pragma unroll
            for (int ks = 0; ks < 2; ++ks) { const bf16x8 kf = *(const bf16x8*)(Ks + (16 * jt + q) * 144 + (32 * ks + 8 * g) * 2); a = __builtin_amdgcn_mfma_f32_16x16x32_bf16(kf, qf[ks], a, 0, 0, 0); }
#pragma unroll
            for (int j = 0; j < 4; ++j) {
                const int jj = 16 * jt + 4 * g + j;
                a[j] = ((unsigned)(jj - lo) <= span) ? a[j] : -INFINITY; mx = fmaxf(mx, a[j]);
            }
            s[tt] = a;
        }
        mx = fmaxf(mx, __shfl_xor(mx, 16)); mx = fmaxf(mx, __shfl_xor(mx, 32));
        const float sink = C.sinks[layer * 16 + h];
        const float mm = fmaxf(mx, sink);
        float sum = 0.f;
#pragma unroll
        for (int tt = 0; tt < 10; ++tt)
#pragma unroll
            for (int j = 0; j < 4; ++j) { const float e = __expf(s[tt][j] - mm); s[tt][j] = e; sum += e; }
        sum += __shfl_xor(sum, 16); sum += __shfl_xor(sum, 32);
        const float inv = 1.0f / (sum + __expf(sink - mm));
        f32x4 o[4];
#pragma unroll
        for (int dt = 0; dt < 4; ++dt) o[dt] = (f32x4){0.f, 0.f, 0.f, 0.f};
#pragma unroll
        for (int pr = 0; pr < 5; ++pr) {
            const int jt = jt0 + 2 * pr;
            u32x4 pw; pw.x = cvtpk(s[2 * pr][0], s[2 * pr][1]); pw.y = cvtpk(s[2 * pr][2], s[2 * pr][3]); pw.z = cvtpk(s[2 * pr + 1][0], s[2 * pr + 1][1]); pw.w = cvtpk(s[2 * pr + 1][2], s[2 * pr + 1][3]);
            const bf16x8 pf = __builtin_bit_cast(bf16x8, pw);
#pragma unroll
            for (int dt = 0; dt < 4; ++dt) {
                const char* a0 = Vs + (16 * jt + 4 * g + (q >> 2)) * 144 + (16 * dt + 4 * (q & 3)) * 2;
                const s16x4 lo = vtr(a0), hi = vtr(a0 + 16 * 144);
                o[dt] = __builtin_amdgcn_mfma_f32_16x16x32_bf16(cat8(lo, hi), pf, o[dt], 0, 0, 0);
            }
        }
#pragma unroll
        for (int dt = 0; dt < 4; ++dt) {
            const int dcol = h * 64 + 16 * dt + 4 * g;
            const u32x2 gt = gta[hh][dt];
            u32x2 yo; yo.x = cvtpk(o[dt][0] * inv * silu_f(bf_lo(gt.x)), o[dt][1] * inv * silu_f(bf_hi(gt.x)));
            yo.y = cvtpk(o[dt][2] * inv * silu_f(bf_lo(gt.y)), o[dt][3] * inv * silu_f(bf_hi(gt.y)));
            *(u32x2*)(Y + (size_t)row * D + dcol) = yo;
        }
    }
    __syncthreads();
}

template <bool SCALE>
__device__ __forceinline__ void stage128(char* dst, const bf16* src, size_t src_pitch, int tid, float lng) {
#pragma unroll
    for (int it = 0; it < 4; ++it) {
        const int r = (tid >> 4) + 32 * it, ch = tid & 15;
        u32x4 v = *(const u32x4*)(src + (size_t)r * src_pitch + ch * 8);
        if (SCALE) { const float sc = __expf((float)(127 - r) * lng);
            v.x = cvtpk(bf_lo(v.x) * sc, bf_hi(v.x) * sc); v.y = cvtpk(bf_lo(v.y) * sc, bf_hi(v.y) * sc); v.z = cvtpk(bf_lo(v.z) * sc, bf_hi(v.z) * sc); v.w = cvtpk(bf_lo(v.w) * sc, bf_hi(v.w) * sc); }
        *(u32x4*)(dst + r * 272 + ch * 16) = v;
    }
}

__device__ __forceinline__ void ret_u_unit(const Ctx& C, char* lds, int c, int h, int tid, int w, int lane) {
    const bf16* P = (const bf16*)(C.ws + WS_P); float* U = (float*)(C.ws + WS_U);
    char* Ks = lds; char* Vs = lds + 34816;
    const float lng = ln_gamma(h);
    stage128<false>(Ks, P + (size_t)(c * 128) * NP + C_KB + h * 128, NP, tid, lng);
    stage128<true>(Vs, P + (size_t)(c * 128) * NP + C_VB + h * 128, NP, tid, lng);
    __syncthreads();
    const int q = lane & 15, g = lane >> 4;
    f32x4 acc[8];
#pragma unroll
    for (int dt = 0; dt < 8; ++dt) acc[dt] = (f32x4){0.f, 0.f, 0.f, 0.f};
#pragma unroll
    for (int ks = 0; ks < 4; ++ks) {
        const int rbase = (32 * ks + 8 * g + (q >> 2)) * 272 + 4 * (q & 3) * 2;
        const bf16x8 vf = cat8(vtr(Vs + rbase + 32 * w), vtr(Vs + rbase + 32 * w + 4 * 272));
#pragma unroll
        for (int dt = 0; dt < 8; ++dt) {
            const bf16x8 kf = cat8(vtr(Ks + rbase + 32 * dt), vtr(Ks + rbase + 32 * dt + 4 * 272));
            acc[dt] = __builtin_amdgcn_mfma_f32_16x16x32_bf16(vf, kf, acc[dt], 0, 0, 0);
        }
    }
    float* Ub = U + (size_t)(c * 8 + h) * 16384;
#pragma unroll
    for (int dt = 0; dt < 8; ++dt)
#pragma unroll
        for (int j = 0; j < 4; ++j) Ub[(16 * w + 4 * g + j) * 128 + 16 * dt + q] = acc[dt][j];
    __syncthreads();
}

__device__ __forceinline__ void ret_scan(const Ctx& C, int layer, int tid, int G) {
    const float* U = (const float*)(C.ws + WS_U); bf16* Rt = (bf16*)(C.ws + WS_RT);
    for (int i = blockIdx.x * NTHREADS + tid; i < 8 * 16384; i += G * NTHREADS) {
        const int h = i >> 14, e = (i >> 7) & 127, d = i & 127;
        const float gc = __expf(128.0f * ln_gamma(h));
        float r = 0.f;
#pragma unroll 1
        for (int c0 = 0; c0 < 64; c0 += 32) {
            float u[32];
#pragma unroll
            for (int k = 0; k < 32; ++k) u[k] = __builtin_nontemporal_load(U + (size_t)((c0 + k) * 8) * 16384 + i);
#pragma unroll
            for (int k = 0; k < 32; ++k) { Rt[(size_t)((c0 + k) * 8) * 16384 + i] = (bf16)(cvtpk(r, 0.f) & 0xffffu); r = gc * r + u[k]; }
        }
        const int dorig = 4 * (d >> 3) + (d & 3) + 64 * ((d >> 2) & 1);
        C.out[O_RP + ((size_t)(layer * 8 + h) * 128 + dorig) * 128 + e] = r;
    }
}

__device__ __forceinline__ void ret_prompt_unit(const Ctx& C, char* lds, int layer, int c, int h, int tid, int w, int lane) {
    const bf16* P = (const bf16*)(C.ws + WS_P); bf16* Y = (bf16*)(C.ws + WS_Y); const bf16* Rt = (const bf16*)(C.ws + WS_RT);
    char* Ks = lds; char* Vs = lds + 34816; char* Rs = lds + 69632;
    const float lng = ln_gamma(h);
    const int q = lane & 15, g = lane >> 4;
    const int n = 16 * w + q, row = c * 128 + n;
    bf16x8 qf[4]; u32x2 gta[8];
#pragma unroll
    for (int ks = 0; ks < 4; ++ks) qf[ks] = *(const bf16x8*)(P + (size_t)row * NP + C_QB + h * 128 + 32 * ks + 8 * g);
#pragma unroll
    for (int et = 0; et < 8; ++et) gta[et] = *(const u32x2*)(P + (size_t)row * NP + C_GB + h * 128 + 16 * et + 4 * g);
    stage128<false>(Ks, P + (size_t)(c * 128) * NP + C_KB + h * 128, NP, tid, lng);
    stage128<false>(Vs, P + (size_t)(c * 128) * NP + C_VB + h * 128, NP, tid, lng);
    stage128<false>(Rs, Rt + (size_t)(c * 8 + h) * 16384, 128, tid, lng);
    __syncthreads();
    unsigned pk[8][2];
#pragma unroll
    for (int mt = 0; mt < 8; ++mt) {
        pk[mt][0] = 0u; pk[mt][1] = 0u;
        if (mt <= w) {
            f32x4 a = (f32x4){0.f, 0.f, 0.f, 0.f};
#pragma unroll
            for (int ks = 0; ks < 4; ++ks) { const bf16x8 kf = *(const bf16x8*)(Ks + (16 * mt + q) * 272 + (32 * ks + 8 * g) * 2); a = __builtin_amdgcn_mfma_f32_16x16x32_bf16(kf, qf[ks], a, 0, 0, 0); }
            float v[4];
#pragma unroll
            for (int j = 0; j < 4; ++j) { const int dl = n - (16 * mt + 4 * g + j); v[j] = dl >= 0 ? a[j] * __expf((float)dl * lng) : 0.f; }
            pk[mt][0] = cvtpk(v[0], v[1]); pk[mt][1] = cvtpk(v[2], v[3]);
        }
    }
    f32x4 oi[8], ox[8];
#pragma unroll
    for (int et = 0; et < 8; ++et) { oi[et] = (f32x4){0.f, 0.f, 0.f, 0.f}; ox[et] = oi[et]; }
#pragma unroll
    for (int pr = 0; pr < 4; ++pr) {
        if (2 * pr <= w) {
            u32x4 pw; pw.x = pk[2 * pr][0]; pw.y = pk[2 * pr][1]; pw.z = pk[2 * pr + 1][0]; pw.w = pk[2 * pr + 1][1];
            const bf16x8 pf = __builtin_bit_cast(bf16x8, pw);
#pragma unroll
            for (int et = 0; et < 8; ++et) {
                const char* a0 = Vs + (32 * pr + 4 * g + (q >> 2)) * 272 + (16 * et + 4 * (q & 3)) * 2;
                oi[et] = __builtin_amdgcn_mfma_f32_16x16x32_bf16(cat8(vtr(a0), vtr(a0 + 16 * 272)), pf, oi[et], 0, 0, 0);
            }
        }
    }
#pragma unroll
    for (int et = 0; et < 8; ++et)
#pragma unroll
        for (int ks = 0; ks < 4; ++ks) { const bf16x8 rf = *(const bf16x8*)(Rs + (16 * et + q) * 272 + (32 * ks + 8 * g) * 2); ox[et] = __builtin_amdgcn_mfma_f32_16x16x32_bf16(rf, qf[ks], ox[et], 0, 0, 0); }
    const float qdec = __expf((float)(n + 1) * lng);
    float sum = 0.f;
#pragma unroll
    for (int et = 0; et < 8; ++et) { oi[et] = oi[et] + ox[et] * qdec; sum += (oi[et][0] + oi[et][1]) + (oi[et][2] + oi[et][3]); }
    sum += __shfl_xor(sum, 16); sum += __shfl_xor(sum, 32);
    const float mu = sum * (1.0f / 128.0f);
    float var = 0.f;
#pragma unroll
    for (int et = 0; et < 8; ++et) { oi[et] = oi[et] - mu; var += (oi[et][0] * oi[et][0] + oi[et][1] * oi[et][1]) + (oi[et][2] * oi[et][2] + oi[et][3] * oi[et][3]); }
    var += __shfl_xor(var, 16); var += __shfl_xor(var, 32);
    const float rs = rsqrtf(var * (1.0f / 128.0f) + 1e-6f);
    const float* gw = C.ret_norm_w + layer * 1024 + h * 128;
#pragma unroll
    for (int et = 0; et < 8; ++et) {
        const int e0 = 16 * et + 4 * g;
        const u32x2 gt = gta[et];
        const f32x4 wv = *(const f32x4*)(gw + e0);
        u32x2 yo; yo.x = cvtpk(oi[et][0] * rs * wv[0] * silu_f(bf_lo(gt.x)), oi[et][1] * rs * wv[1] * silu_f(bf_hi(gt.x)));
        yo.y = cvtpk(oi[et][2] * rs * wv[2] * silu_f(bf_lo(gt.y)), oi[et][3] * rs * wv[3] * silu_f(bf_hi(gt.y)));
        *(u32x2*)(Y + (size_t)row * D + 1024 + h * 128 + e0) = yo;
    }
    __syncthreads();
}

__device__ __forceinline__ void attn_sample_unit(const Ctx& C, char* lds, int layer, int b, int kvh, int tid) {
    const bf16* P = (const bf16*)(C.ws + WS_P); bf16* Y = (bf16*)(C.ws + WS_Y);
    float* Qs = (float*)lds;
    float* Kl = Qs + 32 * 65;
    float* Vl = Kl + 132 * 68;
    float* Pm = Vl + 132 * 68;
    const float* ck = C.cache_k + ((size_t)(layer * 128 + b) * 128) * 128 + kvh * 64;
    const float* cv = C.cache_v + ((size_t)(layer * 128 + b) * 128) * 128 + kvh * 64;
    float* ok = C.out + O_KS + ((size_t)(layer * 128 + b) * 128) * 128 + kvh * 64;
    float* ov = C.out + O_VS + ((size_t)(layer * 128 + b) * 128) * 128 + kvh * 64;
    for (int i = tid; i < 128 * 16; i += NTHREADS) {
        const int r = i >> 4, c4 = i & 15;
        const f32x4 k = *(const f32x4*)(ck + (size_t)r * 128 + 4 * c4), v = *(const f32x4*)(cv + (size_t)r * 128 + 4 * c4);
        *(f32x4*)(Kl + r * 68 + 4 * c4) = k;
        *(f32x4*)(Vl + r * 68 + 4 * c4) = v;
        if (r >= 4) { *(f32x4*)(ok + (size_t)(r - 4) * 128 + 4 * c4) = k; *(f32x4*)(ov + (size_t)(r - 4) * 128 + 4 * c4) = v; }
    }
    if (tid < 256) { const int t = tid >> 6, g = tid & 63; const size_t ro = (size_t)(T + 4 * b + t) * NP;
        const int dk = 4 * (g >> 3) + (g & 3) + 32 * ((g >> 2) & 1);
        Kl[(128 + t) * 68 + dk] = __uint_as_float((unsigned)P[ro + C_KA + kvh * 64 + g] << 16);
        Vl[(128 + t) * 68 + g] = __uint_as_float((unsigned)P[ro + C_VA + kvh * 64 + g] << 16); }
    for (int i = tid; i < 32 * 64; i += NTHREADS) {
        const int r = i >> 6, g = i & 63, hg = r >> 2, t = r & 3;
        const int dk = 4 * (g >> 3) + (g & 3) + 32 * ((g >> 2) & 1);
        Qs[r * 65 + dk] = __uint_as_float((unsigned)P[(size_t)(T + 4 * b + t) * NP + C_QA + (kvh * 8 + hg) * 64 + g] << 16);
    }
    __syncthreads();
    {
        const int r = tid >> 4, kg = tid & 15, t = r & 3, h = kvh * 8 + (r >> 2);
        float mx = -INFINITY;
        f32x4 qr[16];
#pragma unroll
        for (int i = 0; i < 16; ++i) qr[i] = (f32x4){Qs[r * 65 + 4 * i], Qs[r * 65 + 4 * i + 1], Qs[r * 65 + 4 * i + 2], Qs[r * 65 + 4 * i + 3]};
#pragma unroll 1
        for (int it = 0; it < 9; ++it) {
            const int kk = kg + 16 * it;
            float a = -INFINITY;
            if (kk < 132) {
                const bool valid = kk < 128 ? (kk > t) : (kk - 128 <= t);
                if (valid) { f32x4 a4 = (f32x4){0.f, 0.f, 0.f, 0.f};
#pragma unroll
                    for (int i = 0; i < 16; ++i) a4 += qr[i] * *(const f32x4*)(Kl + kk * 68 + 4 * i);
                    a = (a4[0] + a4[1]) + (a4[2] + a4[3]); }
                Pm[r * 133 + kk] = a;
            }
            mx = fmaxf(mx, a);
        }
#pragma unroll
        for (int o = 1; o < 16; o <<= 1) mx = fmaxf(mx, __shfl_xor(mx, o));
        const float sink = C.sinks[layer * 16 + h];
        const float mm = fmaxf(mx, sink);
        float sum = 0.f;
#pragma unroll 1
        for (int it = 0; it < 9; ++it) { const int kk = kg + 16 * it; if (kk < 132) { const float e = __expf(Pm[r * 133 + kk] - mm); Pm[r * 133 + kk] = e; sum += e; } }
#pragma unroll
        for (int o = 1; o < 16; o <<= 1) sum += __shfl_xor(sum, o);
        const float inv = 1.0f / (sum + __expf(sink - mm));
#pragma unroll 1
        for (int it = 0; it < 9; ++it) { const int kk = kg + 16 * it; if (kk < 132) Pm[r * 133 + kk] *= inv; }
    }
    __syncthreads();
    {
        const int r = tid >> 4, dq = tid & 15, t = r & 3, h = kvh * 8 + (r >> 2);
        f32x4 o = (f32x4){0.f, 0.f, 0.f, 0.f};
        for (int kk = 0; kk < 132; ++kk) { const float p = Pm[r * 133 + kk]; const f32x4 v = *(const f32x4*)(Vl + kk * 68 + 4 * dq); o += v * p; }
        const size_t row = (size_t)(T + 4 * b + t);
        const u32x2 gt = *(const u32x2*)(P + row * NP + C_GA + h * 64 + 4 * dq);
        u32x2 yo; yo.x = cvtpk(o[0] * silu_f(bf_lo(gt.x)), o[1] * silu_f(bf_hi(gt.x))); yo.y = cvtpk(o[2] * silu_f(bf_lo(gt.y)), o[3] * silu_f(bf_hi(gt.y)));
        *(u32x2*)(Y + row * D + h * 64 + 4 * dq) = yo;
    }
    __syncthreads();
}

__device__ __forceinline__ void ret_sample_group(const Ctx& C, char* lds, int layer, int ug, int tid, int w, int lane) {
    const bf16* P = (const bf16*)(C.ws + WS_P); bf16* Y = (bf16*)(C.ws + WS_Y);
    const int idx = 4 * ug + (w >> 1), b = idx >> 3, h = idx & 7, eh = w & 1;
    float* qs = (float*)(lds + w * 4096);
    float* ksm = qs + 512;
    float* pst = (float*)(lds + 32768);
    const float lng = ln_gamma(h);
    const size_t ro = (size_t)(T + 4 * b) * NP;
    float qv[4][2], kv[4][2];
    {
        const int g0 = 2 * lane, g1 = g0 + 1;
        const int d0 = 4 * (g0 >> 3) + (g0 & 3) + 64 * ((g0 >> 2) & 1), d1 = 4 * (g1 >> 3) + (g1 & 3) + 64 * ((g1 >> 2) & 1);
#pragma unroll
        for (int t = 0; t < 4; ++t) {
            const unsigned qq = *(const unsigned*)(P + ro + (size_t)t * NP + C_QB + h * 128 + g0), kk = *(const unsigned*)(P + ro + (size_t)t * NP + C_KB + h * 128 + g0);
            qv[t][0] = bf_lo(qq); qv[t][1] = bf_hi(qq); kv[t][0] = bf_lo(kk); kv[t][1] = bf_hi(kk);
            const float kd = __expf((float)(3 - t) * lng);
            qs[t * 128 + d0] = qv[t][0]; qs[t * 128 + d1] = qv[t][1]; ksm[t * 128 + d0] = kv[t][0] * kd; ksm[t * 128 + d1] = kv[t][1] * kd;
        }
    }
    const int e4 = lane & 15, dq = lane >> 4, e = eh * 64 + 4 * e4;
    f32x4 vm[4];
#pragma unroll
    for (int m = 0; m < 4; ++m) { const u32x2 vv = *(const u32x2*)(P + ro + (size_t)m * NP + C_VB + h * 128 + e); vm[m] = (f32x4){bf_lo(vv.x), bf_hi(vv.x), bf_lo(vv.y), bf_hi(vv.y)}; }
    float A[4][4];
#pragma unroll
    for (int t = 0; t < 4; ++t)
#pragma unroll
        for (int m = 0; m < 4; ++m) {
            A[t][m] = 0.f;
            if (m <= t) { float a = qv[t][0] * kv[m][0] + qv[t][1] * kv[m][1];
#pragma unroll
                for (int o = 1; o < 64; o <<= 1) a += __shfl_xor(a, o);
                A[t][m] = a * __expf((float)(t - m) * lng); }
        }
    LDS_WAIT();
    const float* r0 = C.state + ((size_t)(layer * 128 + b) * 8 + h) * 16384 + e;
    float* rout = C.out + O_RS + ((size_t)(layer * 128 + b) * 8 + h) * 16384 + e;
    const float g4 = __expf(4.0f * lng);
    f32x4 acc[4];
#pragma unroll
    for (int t = 0; t < 4; ++t) acc[t] = (f32x4){0.f, 0.f, 0.f, 0.f};
#pragma unroll 1
    for (int i0 = 0; i0 < 32; i0 += 8) {
        f32x4 r[8];
#pragma unroll
        for (int k = 0; k < 8; ++k) r[k] = __builtin_nontemporal_load((const f32x4*)(r0 + (4 * (i0 + k) + dq) * 128));
#pragma unroll
        for (int k = 0; k < 8; ++k) {
            const int d = 4 * (i0 + k) + dq;
            const f32x4 rn = r[k] * g4 + vm[0] * ksm[d] + vm[1] * ksm[128 + d] + vm[2] * ksm[256 + d] + vm[3] * ksm[384 + d];
            __builtin_nontemporal_store(rn, (f32x4*)(rout + d * 128));
#pragma unroll
            for (int t = 0; t < 4; ++t) acc[t] += r[k] * qs[t * 128 + d];
        }
    }
    float o[4][4]; float s1[4], s2[4];
#pragma unroll
    for (int t = 0; t < 4; ++t) {
        const float qd = __expf((float)(t + 1) * lng);
        s1[t] = 0.f; s2[t] = 0.f;
#pragma unroll
        for (int j = 0; j < 4; ++j) {
            float a = acc[t][j]; a += __shfl_xor(a, 16); a += __shfl_xor(a, 32);
            a *= qd;
#pragma unroll
            for (int m = 0; m < 4; ++m) a += A[t][m] * vm[m][j];
            o[t][j] = a; s1[t] += a; s2[t] += a * a;
        }
#pragma unroll
        for (int k = 1; k < 16; k <<= 1) { s1[t] += __shfl_xor(s1[t], k); s2[t] += __shfl_xor(s2[t], k); }
        if (lane == 0) { pst[(w * 4 + t) * 2] = s1[t]; pst[(w * 4 + t) * 2 + 1] = s2[t]; }
    }
    __syncthreads();
    if (lane < 16) {
        const float* gw = C.ret_norm_w + layer * 1024 + h * 128 + e;
        const f32x4 wv = *(const f32x4*)gw;
#pragma unroll
        for (int t = 0; t < 4; ++t) {
            const float S1 = pst[(w * 4 + t) * 2] + pst[((w ^ 1) * 4 + t) * 2], S2 = pst[(w * 4 + t) * 2 + 1] + pst[((w ^ 1) * 4 + t) * 2 + 1];
            const float mu = S1 * (1.0f / 128.0f), var = fmaxf(S2 * (1.0f / 128.0f) - mu * mu, 0.f), rs = rsqrtf(var + 1e-6f);
            const size_t row = (size_t)(T + 4 * b + t);
            const u32x2 gt = *(const u32x2*)(P + row * NP + C_GB + h * 128 + e);
            u32x2 yo; yo.x = cvtpk((o[t][0] - mu) * rs * wv[0] * silu_f(bf_lo(gt.x)), (o[t][1] - mu) * rs * wv[1] * silu_f(bf_hi(gt.x)));
            yo.y = cvtpk((o[t][2] - mu) * rs * wv[2] * silu_f(bf_lo(gt.y)), (o[t][3] - mu) * rs * wv[3] * silu_f(bf_hi(gt.y)));
            *(u32x2*)(Y + row * D + 1024 + h * 128 + e) = yo;
        }
    }
    __syncthreads();
}

__device__ __forceinline__ void outproj_sample_unit(const Ctx& C, char* lds, int layer, int u, int tid, int w, int lane) {
    const bf16* Yb = (const bf16*)(C.ws + WS_Y) + (size_t)T * D; const bf16* Wt = (const bf16*)(C.ws + WS_WOUT) + (size_t)layer * D * D;
    const int m0 = (u >> 5) * 64, n0 = (u & 31) * 64, q = lane & 15, g = lane >> 4, k0 = 256 * w;
    f32x4 acc[4][4];
#pragma unroll
    for (int nt = 0; nt < 4; ++nt)
#pragma unroll
        for (int mt = 0; mt < 4; ++mt) acc[nt][mt] = (f32x4){0.f, 0.f, 0.f, 0.f};
    const int em = tid >> 3, en8 = (tid & 7) * 8;
    const float* bpz = (layer == 0 ? C.x_sample : (const float*)(C.ws + WS_XR) + (size_t)T * D) + (size_t)(m0 + em) * D + n0 + en8;
    const f32x4 rz0 = *(const f32x4*)bpz, rz1 = *(const f32x4*)(bpz + 4);
    const bf16* ap = Wt + (size_t)(n0 + q) * D + k0 + 8 * g;
    const bf16* bp = Yb + (size_t)(m0 + q) * D + k0 + 8 * g;
    bf16x8 af[2][2][4], bfr[2][2][4];
#define OSU_LOAD(buf, kb) do { _Pragma("unroll") for (int ks = 0; ks < 2; ++ks) _Pragma("unroll") for (int t4 = 0; t4 < 4; ++t4) { \
        af[buf][ks][t4] = *(const bf16x8*)(ap + (size_t)(16 * t4) * D + 64 * (kb) + 32 * ks); bfr[buf][ks][t4] = *(const bf16x8*)(bp + (size_t)(16 * t4) * D + 64 * (kb) + 32 * ks); } } while (0)
    OSU_LOAD(0, 0);
#pragma unroll
    for (int kb = 0; kb < 4; ++kb) {
        if (kb + 1 < 4) { if ((kb & 1) == 0) OSU_LOAD(1, kb + 1); else OSU_LOAD(0, kb + 1); }
#pragma unroll
        for (int ks = 0; ks < 2; ++ks)
#pragma unroll
            for (int nt = 0; nt < 4; ++nt)
#pragma unroll
                for (int mt = 0; mt < 4; ++mt) acc[nt][mt] = __builtin_amdgcn_mfma_f32_16x16x32_bf16(af[kb & 1][ks][nt], bfr[kb & 1][ks][mt], acc[nt][mt], 0, 0, 0);
    }
#undef OSU_LOAD
    float* part = (float*)lds + w * (64 * 68);
#pragma unroll
    for (int nt = 0; nt < 4; ++nt)
#pragma unroll
        for (int mt = 0; mt < 4; ++mt) *(f32x4*)(part + (16 * mt + q) * 68 + 16 * nt + 4 * g) = acc[nt][mt];
    __syncthreads();
    {
        const int m = tid >> 3, n8 = (tid & 7) * 8;
        f32x4 v0 = (f32x4){0.f, 0.f, 0.f, 0.f}, v1 = v0;
#pragma unroll
        for (int ww = 0; ww < 8; ++ww) { const float* pp = (const float*)lds + ww * (64 * 68) + m * 68 + n8; v0 += *(const f32x4*)pp; v1 += *(const f32x4*)(pp + 4); }
        const int rs_ = m0 + m;
        float* XR = (float*)(C.ws + WS_XR);
        float* op = (layer == 0 ? XR : C.out) + (size_t)(T + rs_) * D + n0 + n8;
        v0 += rz0; v1 += rz1;
        *(f32x4*)op = v0; *(f32x4*)(op + 4) = v1;
        if (layer == 0) { u32x4 wv; wv.x = cvtpk(v0[0], v0[1]); wv.y = cvtpk(v0[2], v0[3]); wv.z = cvtpk(v1[0], v1[1]); wv.w = cvtpk(v1[2], v1[3]);
            *(u32x4*)((bf16*)(C.ws + WS_XA) + (size_t)(T + rs_) * D + n0 + n8) = wv; }
        float ss = (v0[0] * v0[0] + v0[1] * v0[1]) + (v0[2] * v0[2] + v0[3] * v0[3]) + (v1[0] * v1[0] + v1[1] * v1[1]) + (v1[2] * v1[2] + v1[3] * v1[3]);
        ss += __shfl_xor(ss, 1); ss += __shfl_xor(ss, 2); ss += __shfl_xor(ss, 4);
        if ((tid & 7) == 0) atomicAdd((float*)(C.ws + WS_CTL) + (layer + 1) * M + T + rs_, ss);
    }
    __syncthreads();
}

#ifndef SKIPM
#define SKIPM 0
#endif
#ifndef REPU
#define REPU 0
#endif
#ifndef REP_P0
#define REP_P0 1
#endif
#ifndef REP_G1
#define REP_G1 1
#endif
#ifndef REP_MX1
#define REP_MX1 1
#endif
#ifndef REP_RP
#define REP_RP 1
#endif
#ifndef REP_G2
#define REP_G2 1
#endif

#define GAS __attribute__((address_space(1)))
typedef GAS unsigned gu32;
#define XB_TMO      128
#define XB_XCNT(j)  (256  + 64 * (j))
#define XB_XSUB(j)  (1280 + 64 * (j))
#define XB_XGEN(j)  (2304 + 64 * (j))
#define XB_TOP      3328
#define XB_TOPGEN   3392
#define XCD_BAR_WORDS 3456
#define XB_SPIN_CAP (1u << 18)

__device__ __forceinline__ unsigned xb_ld(unsigned* p)              { return __hip_atomic_load(p, __ATOMIC_RELAXED, __HIP_MEMORY_SCOPE_AGENT); }
__device__ __forceinline__ unsigned xb_add(unsigned* p, unsigned v) { return __hip_atomic_fetch_add(p, v, __ATOMIC_RELAXED, __HIP_MEMORY_SCOPE_AGENT); }
__device__ __forceinline__ unsigned xb_xcc_id() { return (unsigned)__builtin_amdgcn_s_getreg((3 << 11) | 20) & 0xFu; }
#define XB_SPIN(cond, bar) do { unsigned _sp = 0; while (cond) { __builtin_amdgcn_s_sleep(1); \
    if ((++_sp & 255u) == 0u) { if (xb_ld(&(bar)[XB_TMO])) break; if (_sp > XB_SPIN_CAP) { atomicAdd(&(bar)[XB_TMO], 1u); break; } } } } while (0)

struct XcdBarrier {
    unsigned* bar; unsigned x;
    volatile LAS unsigned* st;
};

__device__ __forceinline__ XcdBarrier xcd_barrier_post(unsigned* bar, volatile LAS unsigned* st) {
    XcdBarrier b; b.bar = bar; b.x = xb_xcc_id(); b.st = st;
    if (threadIdx.x == 0) (void)xb_add(&bar[XB_XCNT(b.x)], 1u);
    return b;
}
__device__ __forceinline__ void xcd_barrier_complete(unsigned* bar, unsigned x, unsigned& nloc, unsigned& nx) {
    const unsigned G = gridDim.x * gridDim.y * gridDim.z;
    unsigned sum, cnt, mine, sp = 0u;
    for (;;) {
        sum = 0u; cnt = 0u; mine = 0u;
#pragma unroll
        for (unsigned j = 0; j < 16; ++j) { const unsigned c = xb_ld(&bar[XB_XCNT(j)]); sum += c; cnt += (c > 0u) ? 1u : 0u; mine = (j == x) ? c : mine; }
        if (sum == G) break;
        __builtin_amdgcn_s_sleep(1);
        if ((++sp & 255u) == 0u) { if (xb_ld(&bar[XB_TMO])) break; if (sp > XB_SPIN_CAP) { atomicAdd(&bar[XB_TMO], 1u); break; } }
    }
    nloc = mine > 0u ? mine : 1u; nx = cnt > 0u ? cnt : 1u;
}

__device__ __forceinline__ void xcd_barrier(const XcdBarrier& b) {
    asm volatile("s_waitcnt vmcnt(0)" ::: "memory");
    __syncthreads();
    if (threadIdx.x == 0) {
        unsigned* bar = b.bar;
        __builtin_amdgcn_s_waitcnt(0);
        unsigned nloc = b.st[0], nx = b.st[1];
        if (nloc == 0u) { xcd_barrier_complete(bar, b.x, nloc, nx); b.st[0] = nloc; b.st[1] = nx; }
        const unsigned old = xb_add(&bar[XB_XSUB(b.x)], 1u);
        const unsigned gen = old / nloc;
        if (old + 1u == (gen + 1u) * nloc) {
            __builtin_amdgcn_fence(__ATOMIC_RELEASE, "agent");
            asm volatile("s_waitcnt vmcnt(0)" ::: "memory");
            const unsigned og = xb_add(&bar[XB_TOP], 1u);
            const unsigned tg = og / nx;
            if (og + 1u == (tg + 1u) * nx) xb_add(&bar[XB_TOPGEN], 1u);
            else XB_SPIN(xb_ld(&bar[XB_TOPGEN]) == tg, bar);
            __builtin_amdgcn_fence(__ATOMIC_ACQUIRE, "agent");
            xb_add(&bar[XB_XGEN(b.x)], 1u);
            asm volatile("s_waitcnt vmcnt(0)" ::: "memory");
        } else {
            XB_SPIN(xb_ld(&bar[XB_XGEN(b.x)]) == gen, bar);
            __builtin_amdgcn_fence(__ATOMIC_ACQUIRE, "agent");
            asm volatile("s_waitcnt vmcnt(0)" ::: "memory");
        }
    }
    __syncthreads();
}

constexpr size_t WS_BAR = WS_CTL + 768 * 1024;
constexpr int LDS_BARST = LDS_BYTES - 64;
__global__ void __launch_bounds__(NTHREADS, 2) hymba_fwd(Ctx C) {
    extern __shared__ __attribute__((aligned(16))) unsigned char lds_raw[];
    cg::grid_group grid = cg::this_grid();
    if (threadIdx.x < 2) ((volatile LAS unsigned*)((LAS unsigned char*)lds_raw + LDS_BARST))[threadIdx.x] = 0u;
    __syncthreads();
    (void)xcd_barrier_post((unsigned*)(C.ws + WS_BAR), (volatile LAS unsigned*)((LAS unsigned char*)lds_raw + LDS_BARST));
    int ph = 0;
#define PHASE_LOCALS2 int tid = threadIdx.x; LAUNDER_V(tid); const int lane = tid & 63, wave = __builtin_amdgcn_readfirstlane(tid >> 6); char* lds = (char*)lds_raw; Ctx Cc = C; LAUNDER_S(Cc.ws); (void)lane; (void)wave; (void)lds
#define PHASE_BEGIN (C.ph_lo <= ph && ph < C.ph_hi)
#define PHASE_END do { if (C.ph_lo <= ph && ph + 1 < C.ph_hi) { if (C.ph_lo < 0) grid.sync(); else { XcdBarrier xb_; xb_.bar = (unsigned*)(C.ws + WS_BAR); xb_.x = xb_xcc_id(); xb_.st = (volatile LAS unsigned*)((LAS unsigned char*)lds_raw + LDS_BARST); xcd_barrier(xb_); } } ++ph; } while (0)
#define PHASE_LOCALS int tid = threadIdx.x; LAUNDER_V(tid); const int lane = tid & 63, wave = __builtin_amdgcn_readfirstlane(tid >> 6); \
    int G = gridDim.x, bid = blockIdx.x; LAUNDER_S(G); LAUNDER_S(bid); char* lds = (char*)lds_raw; Ctx Cc = C; LAUNDER_S(Cc.ws); (void)lane; (void)wave; (void)lds

    if (PHASE_BEGIN) { PHASE_LOCALS; for (int rep = 0; rep < REP_P0; ++rep) { p0_prologue(Cc, lds, tid, wave, lane, G); __syncthreads(); } }
    PHASE_END;

    for (int layer = 0; layer < DEPTH; ++layer) {
        if (PHASE_BEGIN) {
            unsigned char* ws = C.ws; const int G = gridDim.x, bid = blockIdx.x;
            float* rss = (float*)(ws + WS_CTL); float* cosA = (float*)(ws + WS_TAB); float* sinA = cosA + NPOS * 32; float* cosB = sinA + NPOS * 32; float* sinB = cosB + NPOS * 64;
            pg8::Gemm g{(const bf16*)(ws + WS_XA), (const bf16*)(ws + WS_WIN) + (size_t)layer * NP * D, M, NP, D}; pg8::StaticOrder S; S.init(M, NP, G, bid);
            pg8::EpiProj E{(bf16*)(ws + WS_P), rss + layer * M, cosA, sinA, cosB, sinB, C.out, layer};
            for (int rep = 0; rep < REP_G1; ++rep) pg8::gemm_phase<pg8::EpiProj, pg8::StaticOrder, true, true>((LAS unsigned char*)lds_raw, g, S, E);
            if (layer == 0) {
                const int nfull = (M / 256) * (NP / 256) - 3 * G;
                if (G * 4 >= (M / 256) * (NP / 256) && nfull > 0 && nfull < G) {
                    if (bid >= nfull) { PHASE_LOCALS2; convert_weights(Cc, (float*)(lds + wave * 16640), 1, (bid - nfull) * 8 + wave, (G - nfull) * 8, lane); }
                } else { PHASE_LOCALS2; convert_weights(Cc, (float*)(lds + wave * 16640), 1, bid * 8 + wave, G * 8, lane); }
            }
        }
        PHASE_END;
        if (PHASE_BEGIN) {
            PHASE_LOCALS; int ly = layer; LAUNDER_S(ly);
            for (int rep = 0; rep < REP_MX1; ++rep) for (int u = bid; u < 1280; u += G) {
                if (u < 512) { for (int r2 = 0; r2 < 1 + (REPU & 1); ++r2) ret_u_unit(Cc, lds, u >> 3, u & 7, tid, wave, lane); }
                else if (u < 768) { const int a = u - 512; for (int r2 = 0; r2 < 1 + ((REPU >> 1) & 1); ++r2) attn_prompt_unit(Cc, lds, ly, a >> 2, (a >> 1) & 1, a & 1, tid, wave, lane); }
                else if (u < 1024) { const int a = u - 768; for (int r2 = 0; r2 < 1 + ((REPU >> 2) & 1); ++r2) attn_sample_unit(Cc, lds, ly, a >> 1, a & 1, tid); }
                else { const int a = u - 1024; ret_sample_group(Cc, lds, ly, a, tid, wave, lane); }
            }
        }
        PHASE_END;
        if (PHASE_BEGIN) { PHASE_LOCALS; int ly = layer; LAUNDER_S(ly); for (int r2 = 0; r2 < 1 + ((REPU >> 4) & 1); ++r2) ret_scan(Cc, ly, tid, G); for (int u = bid; u < 256; u += G) outproj_sample_unit(Cc, lds, ly, u, tid, wave, lane); }
        PHASE_END;
        if (PHASE_BEGIN) { PHASE_LOCALS; int ly = layer; LAUNDER_S(ly); for (int rep = 0; rep < REP_RP; ++rep) for (int u = bid; u < 512; u += G) if (!(SKIPM & 16)) ret_prompt_unit(Cc, lds, ly, u >> 3, u & 7, tid, wave, lane); }
        PHASE_END;
        if (PHASE_BEGIN) {
            unsigned char* ws = C.ws; const int G = gridDim.x, bid = blockIdx.x;
            float* rss = (float*)(ws + WS_CTL); float* XR = (float*)(ws + WS_XR);
            pg8::Gemm g{(const bf16*)(ws + WS_Y), (const bf16*)(ws + WS_WOUT) + (size_t)layer * D * D, T, D, D}; pg8::StaticOrder S; S.init(T, D, G, bid);
            pg8::EpiRes E{layer == 0 ? C.x_prompt : XR, layer == 0 ? C.x_sample : XR + (size_t)T * D, layer == 0 ? XR : C.out, layer == 0 ? (bf16*)(ws + WS_XA) : nullptr, rss + (layer + 1) * M};
            pg8::gemm_phase<pg8::EpiRes, pg8::StaticOrder, true, true>((LAS unsigned char*)lds_raw, g, S, E);
            for (int rep = 1; rep < REP_G2; ++rep) { pg8::EpiRes E2 = E; E2.rss = rss + 131072; pg8::gemm_phase<pg8::EpiRes, pg8::StaticOrder, true, true>((LAS unsigned char*)lds_raw, g, S, E2); }
        }
        PHASE_END;
    }
#ifdef REP_SYNC
    for (int rep = 0; rep < REP_SYNC; ++rep) { XcdBarrier xb_; xb_.bar = (unsigned*)(C.ws + WS_BAR); xb_.x = xb_xcc_id(); xb_.st = (volatile LAS unsigned*)((LAS unsigned char*)lds_raw + LDS_BARST); xcd_barrier(xb_); }
#endif
    if (PHASE_BEGIN) {
        PHASE_LOCALS;
        const float* rf = (const float*)(Cc.ws + WS_CTL) + 2 * M;
        for (int m = bid * 8 + wave; m < M; m += G * 8) {
            const float rv = rsqrtf(rf[m] * (1.0f / 2048.0f) + 1e-6f);
            f32x4* xr = (f32x4*)(Cc.out + (size_t)m * D);
#pragma unroll
            for (int j = 0; j < 8; ++j) { const f32x4 wv = *((const f32x4*)Cc.final_w + lane + 64 * j); xr[lane + 64 * j] = xr[lane + 64 * j] * rv * wv; }
        }
    }
}

constexpr int N_PHASES = 1 + DEPTH * 5 + 1;
#ifndef MK_MULTI
#define MK_MULTI 0
#endif
extern "C" void kernel_launch(void* const* d_in, const int* in_sizes, int n_in, void* d_out, int out_size, void* d_ws, size_t ws_size, hipStream_t stream) {
    static int grid = 0;
    if (grid == 0) {
        if (n_in != 11 || ws_size < WS_END) { fprintf(stderr, "kernel_launch: unexpected inputs (n_in %d, ws %zu)\n", n_in, ws_size); grid = -1; return; }
        int dev = 0, cus = 0, per_cu = 0;
        hipGetDevice(&dev); hipDeviceGetAttribute(&cus, hipDeviceAttributeMultiprocessorCount, dev);
        if (hipFuncSetAttribute((const void*)hymba_fwd, hipFuncAttributeMaxDynamicSharedMemorySize, LDS_BYTES) != hipSuccess) { fprintf(stderr, "kernel_launch: hipFuncSetAttribute failed\n"); grid = -1; return; }
        if (hipOccupancyMaxActiveBlocksPerMultiprocessor(&per_cu, (const void*)hymba_fwd, NTHREADS, LDS_BYTES) != hipSuccess || per_cu < 1) { fprintf(stderr, "kernel_launch: occupancy query says %d\n", per_cu); (void)hipGetLastError(); per_cu = 1; }
        grid = cus;
    }
    if (grid < 0) return;
    hipMemsetAsync((char*)d_ws + WS_CTL, 0, CTL_BYTES, stream);
    Ctx c{};
    c.x_prompt = (const float*)d_in[0]; c.x_sample = (const float*)d_in[1]; c.cache_k = (const float*)d_in[2]; c.cache_v = (const float*)d_in[3]; c.state = (const float*)d_in[4];
    c.norm_w = (const float*)d_in[5]; c.w_in = (const float*)d_in[6]; c.sinks = (const float*)d_in[7]; c.ret_norm_w = (const float*)d_in[8]; c.w_out = (const float*)d_in[9]; c.final_w = (const float*)d_in[10];
    c.out = (float*)d_out; c.ws = (unsigned char*)d_ws;
#if MK_MULTI
    for (int p = 0; p < N_PHASES; ++p) { c.ph_lo = p; c.ph_hi = p + 1; void* args[] = {&c};
        hipError_t e = hipLaunchCooperativeKernel((const void*)hymba_fwd, dim3(grid), dim3(NTHREADS), args, LDS_BYTES, stream);
        if (e != hipSuccess) { fprintf(stderr, "launch %d failed: %s\n", p, hipGetErrorString(e)); break; } }
#else
    c.ph_lo = 0; c.ph_hi = N_PHASES; void* args[] = {&c};
    hipError_t e = hipLaunchCooperativeKernel((const void*)hymba_fwd, dim3(grid), dim3(NTHREADS), args, LDS_BYTES, stream);
    if (e != hipSuccess) fprintf(stderr, "cooperative launch failed: %s (grid %d)\n", hipGetErrorString(e), grid);
#endif
}
```

```cpp
#include <hip/hip_runtime.h>
#include <hip/hip_cooperative_groups.h>
#include <cstdio>
#include <cstdint>
namespace cg = cooperative_groups;
namespace pg8 {
#define PG8_LAS __attribute__((address_space(3)))
typedef unsigned short bf16_t;
typedef short bf16x8 __attribute__((ext_vector_type(8)));
typedef float f32x4 __attribute__((ext_vector_type(4)));
typedef unsigned u32x4 __attribute__((ext_vector_type(4)));
constexpr int BM = 256, BK = 64, HALF = 128, HTB = HALF * BK * 2  , STAGE_BYTES = 8 * HTB, NXCD = 8, WGM = 8;

__host__ __device__ __forceinline__ int lds_byte(int r, int c) { const int st = (r >> 4) * 2 + (c >> 5), rr = r & 15, cc = c & 31, ob = rr * 64 + cc * 2; return st * 1024 + (ob ^ (((ob >> 9) & 1) << 5)); }
__host__ __device__ __forceinline__ void stage_rc(int b, int& R, int& C) { const int st = b / 1024, sb = b % 1024, swz = sb ^ (((sb >> 9) & 1) << 5); R = (st >> 1) * 16 + swz / 64; C = (st & 1) * 32 + (swz % 64) / 2; }
__host__ __device__ __forceinline__ int perm32(int rho) { const int n = rho >> 4, i = rho & 15; return 8 * (i >> 2) + 4 * n + (i & 3); }

struct Unit { int pm, pn; };
struct Gemm { const bf16_t* A; const bf16_t* Bt; int M, N, K; };

struct StaticOrder {
    int nM, nN, nwg, G, c;
    __host__ __device__ void init(int M, int N, int G_, int c_) { nM = M / BM; nN = N / BM; nwg = nM * nN; G = G_; c = c_; }
    __host__ __device__ bool next(int i, Unit& u) const {
        const long L = (long)i * G + c; if (L >= nwg) return false;
        int wgid = (int)L; { const int q = nwg / NXCD, r = nwg % NXCD, xcd = wgid % NXCD, off = wgid / NXCD; wgid = (xcd < r ? xcd * (q + 1) : r * (q + 1) + (xcd - r) * q) + off; }
        const int nig = WGM * nN, gid = wgid / nig, fm = gid * WGM, gsz = (nM - fm) < WGM ? (nM - fm) : WGM;
        u.pm = fm + ((wgid % nig) % gsz); u.pn = (wgid % nig) / gsz; return true;
    }
    __device__ __forceinline__ void a_ready(const Unit&) const {}
    __device__ __forceinline__ void done(const Unit&) const {}
};


struct SampleFirstOrder {
    int G, c; unsigned* cnt;
    __device__ __forceinline__ bool next(int i, Unit& u) const {
        const int L = i * G + c; if (L >= 850) return false;
        if (L < 50) { u.pm = 32 + L / 25; u.pn = L % 25; return true; }
        int wgid = L - 50; wgid = (wgid % NXCD) * 100 + wgid / NXCD;
        const int r = wgid % 200; u.pm = (wgid / 200) * WGM + (r % WGM); u.pn = r / WGM; return true;
    }
    __device__ __forceinline__ void a_ready(const Unit&) const {}
    __device__ __forceinline__ void done(const Unit& u) const {
        if (u.pm >= 32) {
            asm volatile("s_waitcnt vmcnt(0)" ::: "memory");
            __syncthreads();
            if (threadIdx.x == 0) { __builtin_amdgcn_fence(__ATOMIC_RELEASE, "agent"); asm volatile("s_waitcnt vmcnt(0)" ::: "memory");
                __hip_atomic_fetch_add(cnt, 1u, __ATOMIC_RELAXED, __HIP_MEMORY_SCOPE_AGENT); }
        }
    }
};
__device__ __forceinline__ unsigned cvt_pk_bf16(float lo, float hi) { unsigned r; asm volatile("v_cvt_pk_bf16_f32 %0, %1, %2" : "=v"(r) : "v"(lo), "v"(hi)); return r; }
constexpr int T_ = 8192, NPROJ = 6400, DMODEL = 2048;
struct KArgs { const float* in[11]; float* out; unsigned char* ws; int ph_lo, ph_hi; };
constexpr size_t EMiB = 1u << 20, EWS_XA = 68 * EMiB, EWS_P = 102 * EMiB, EWS_XR = 243 * EMiB, EWS_TAB = 359 * EMiB;
constexpr size_t O_KP = (size_t)8704 * 2048, O_VP = O_KP + 32768, O_RP = O_VP + 32768, O_KS = O_RP + 262144, O_VS = O_KS + 4194304, O_RS = O_VS + 4194304;

struct EpiProj {
    static constexpr bool PERM = true, AFTER_DRAIN = false;
    int layer;
    __device__ __forceinline__ void operator()(const f32x4 (&acc)[2][2][4][2], const Unit& u, int wr, int wc, int fr, int fq) const {
        const KArgs* kp = (const KArgs*)__builtin_amdgcn_kernarg_segment_ptr(); asm volatile("" : "+s"(kp));
        unsigned char* ws = kp->ws; float* out = kp->out;
        bf16_t* P = (bf16_t*)(ws + EWS_P); const float* rss = (const float*)ws + layer * 8704;
        const float* cosA = (const float*)(ws + EWS_TAB); const float* sinA = cosA + 8196 * 32; const float* cosB = sinA + 8196 * 32; const float* sinB = cosB + 8196 * 64;
        float rv[2][4];
#pragma unroll
        for (int ai = 0; ai < 2; ++ai)
#pragma unroll
            for (int m = 0; m < 4; ++m) rv[ai][m] = rsqrtf(rss[u.pm * BM + ai * HALF + wr * 64 + m * 16 + fr] * (1.0f / 2048.0f) + 1e-6f);
#pragma unroll
        for (int bj = 0; bj < 2; ++bj) {
            const int cb = u.pn * BM + bj * HALF;
            const int c0 = cb + wc * 32 + 8 * fq;
            const int mode = (cb < 1152) ? 1 : ((cb >= 2304 && cb < 4352) ? 2 : 0);
            const int kvmode = (cb == 1024) ? 1 : ((cb == 1152) ? 2 : 0);
#pragma unroll
            for (int ai = 0; ai < 2; ++ai)
#pragma unroll
                for (int m = 0; m < 4; ++m) {
                    const int row = u.pm * BM + ai * HALF + wr * 64 + m * 16 + fr;
                    f32x4 v0 = acc[ai][bj][m][0] * rv[ai][m], v1 = acc[ai][bj][m][1] * rv[ai][m];
                    if (mode) {
                        const int pos = row < T_ ? row : T_ + ((row - T_) & 3);
                        f32x4 c, s;
                        if (mode == 1) { const int i = (c0 & 63) >> 3; c = *(const f32x4*)(cosA + pos * 32 + 4 * i); s = *(const f32x4*)(sinA + pos * 32 + 4 * i); }
                        else { const int i = (c0 & 127) >> 3; c = *(const f32x4*)(cosB + pos * 64 + 4 * i); s = *(const f32x4*)(sinB + pos * 64 + 4 * i); }
                        const f32x4 y0 = v0 * c - v1 * s, y1 = v1 * c + v0 * s; v0 = y0; v1 = y1;
                    }
                    u32x4 w; w.x = cvt_pk_bf16(v0[0], v0[1]); w.y = cvt_pk_bf16(v0[2], v0[3]); w.z = cvt_pk_bf16(v1[0], v1[1]); w.w = cvt_pk_bf16(v1[2], v1[3]);
                    *(u32x4*)(P + (size_t)row * NPROJ + c0) = w;
                    if (kvmode && row >= T_ - 128) {
                        const int kvh = (c0 - cb) >> 6, g0 = c0 & 63;
                        float* dst;
                        if (row < T_) dst = out + (kvmode == 1 ? O_KP : O_VP) + ((size_t)(layer * 128 + (row - (T_ - 128))) * 2 + kvh) * 64;
                        else { const int b = (row - T_) >> 2, t = (row - T_) & 3; dst = out + (kvmode == 1 ? O_KS : O_VS) + ((((size_t)layer * 128 + b) * 128 + 124 + t) * 2 + kvh) * 64; }
                        if (kvmode == 1) { const int i = g0 >> 3; *(f32x4*)(dst + 4 * i) = v0; *(f32x4*)(dst + 4 * i + 32) = v1; }
                        else { *(f32x4*)(dst + g0) = v0; *(f32x4*)(dst + g0 + 4) = v1; }
                    }
                }
        }
    }
};

struct EpiRes {
    static constexpr bool PERM = true, AFTER_DRAIN = false;
    int layer;
    __device__ __forceinline__ void operator()(const f32x4 (&acc)[2][2][4][2], const Unit& u, int wr, int wc, int fr, int fq) const {
        const KArgs* kp = (const KArgs*)__builtin_amdgcn_kernarg_segment_ptr(); asm volatile("" : "+s"(kp));
        unsigned char* ws = kp->ws; float* XR = (float*)(ws + EWS_XR);
        const float* base_p = layer == 0 ? kp->in[0] : XR; const float* base_s = layer == 0 ? kp->in[1] : XR + (size_t)T_ * DMODEL;
        float* outx = layer == 0 ? XR : kp->out; bf16_t* xa = layer == 0 ? (bf16_t*)(ws + EWS_XA) : nullptr; float* rss = (float*)ws + (layer + 1) * 8704;
#pragma unroll
        for (int ai = 0; ai < 2; ++ai)
#pragma unroll
            for (int m = 0; m < 4; ++m) {
                const int row = u.pm * BM + ai * HALF + wr * 64 + m * 16 + fr;
                const float* bp = row < T_ ? base_p + (size_t)row * DMODEL : base_s + (size_t)(row - T_) * DMODEL;
                float ss = 0.f;
#pragma unroll
                for (int bj = 0; bj < 2; ++bj) {
                    const int c0 = u.pn * BM + bj * HALF + wc * 32 + 8 * fq;
                    const f32x4 b0 = *(const f32x4*)(bp + c0), b1 = *(const f32x4*)(bp + c0 + 4);
                    const f32x4 v0 = acc[ai][bj][m][0] + b0, v1 = acc[ai][bj][m][1] + b1;
                    *(f32x4*)(outx + (size_t)row * DMODEL + c0) = v0; *(f32x4*)(outx + (size_t)row * DMODEL + c0 + 4) = v1;
                    if (xa) { u32x4 w; w.x = cvt_pk_bf16(v0[0], v0[1]); w.y = cvt_pk_bf16(v0[2], v0[3]); w.z = cvt_pk_bf16(v1[0], v1[1]); w.w = cvt_pk_bf16(v1[2], v1[3]);
                        *(u32x4*)(xa + (size_t)row * DMODEL + c0) = w; }
                    ss += (v0[0] * v0[0] + v0[1] * v0[1]) + (v0[2] * v0[2] + v0[3] * v0[3]) + (v1[0] * v1[0] + v1[1] * v1[1]) + (v1[2] * v1[2] + v1[3] * v1[3]);
                }
                ss += __shfl_xor(ss, 16); ss += __shfl_xor(ss, 32);
                if (fq == 0) atomicAdd(rss + row, ss);
            }
    }
};

template <class Epi, class Sched, bool ALIGN_EPI = false, bool SP2 = false>
__device__ __forceinline__ void gemm_phase(PG8_LAS unsigned char* lds, const Gemm g, const Sched& S, const Epi& E) {
    int tid_ = threadIdx.x; asm volatile("" : "+v"(tid_));
    const int tid = tid_, wid = __builtin_amdgcn_readfirstlane(tid >> 6), lane = tid & 63, wr = wid >> 2, wc = wid & 3, fr = lane & 15, fq = lane >> 4;
    const int K = g.K, nt = K / BK;
    unsigned voffA[2], voffB[2];
#pragma unroll
    for (int i = 0; i < 2; ++i) { int R, C; stage_rc(tid * 16 + i * 8192, R, C); const int Rb = Epi::PERM ? ((R & ~31) + perm32(R & 31)) : R;
        voffA[i] = (unsigned)(R * K + C) * 2u; voffB[i] = (unsigned)(Rb * K + C) * 2u; }
    const size_t kstep = (size_t)(BK * 2);
    const size_t hstep = (size_t)HALF * K * 2;
    const size_t tstep = 2 * hstep;
    const unsigned ldsw = (unsigned)wid * 1024u;
    const int aoff = lds_byte(wr * 64 + fr, fq * 8), boff = lds_byte(wc * 32 + fr, fq * 8);
#define PG8_SA(b, h) (((b) * 2 + (h)) * HTB)
#define PG8_SB(b, h) ((4 + (b) * 2 + (h)) * HTB)
#define PG8_STAGE(bufoff, gbase, voff) do { _Pragma("unroll") for (int _i = 0; _i < 2; ++_i) \
        __builtin_amdgcn_global_load_lds((const unsigned*)((const char*)(gbase) + (voff)[_i]), (PG8_LAS unsigned*)(lds + (bufoff) + ldsw + _i * 8192), 16, 0, 0); } while (0)
#define PG8_LDA(dst, b, h) do { _Pragma("unroll") for (int m = 0; m < 4; ++m) _Pragma("unroll") for (int k = 0; k < 2; ++k) dst[m][k] = *(const PG8_LAS bf16x8*)(lds + PG8_SA(b, h) + aoff + m * 2048 + k * 1024); } while (0)
#define PG8_LDB(dst, b, h) do { _Pragma("unroll") for (int n = 0; n < 2; ++n) _Pragma("unroll") for (int k = 0; k < 2; ++k) dst[n][k] = *(const PG8_LAS bf16x8*)(lds + PG8_SB(b, h) + boff + n * 2048 + k * 1024); } while (0)
#define PG8_MMA(ai, bj, At, Bt) do { __builtin_amdgcn_s_setprio(1); _Pragma("unroll") for (int m = 0; m < 4; ++m) _Pragma("unroll") for (int n = 0; n < 2; ++n) _Pragma("unroll") for (int k = 0; k < 2; ++k) \
        acc[ai][bj][m][n] = __builtin_amdgcn_mfma_f32_16x16x32_bf16(Bt[n][k], At[m][k], acc[ai][bj][m][n], 0, 0, 0); __builtin_amdgcn_s_setprio(0); } while (0)
#define PG8_WAIT_V(n) asm volatile("s_waitcnt vmcnt(" #n ")" ::: "memory")
#define PG8_WAIT_L(n) asm volatile("s_waitcnt lgkmcnt(" #n ")" ::: "memory")
#define PG8_BAR __builtin_amdgcn_s_barrier()
#define PG8_SCHED __builtin_amdgcn_sched_barrier(0)
    Unit cur, nxt; int ui = 0;
    if (!S.next(0, cur)) return;
    f32x4 acc[2][2][4][2];
#pragma unroll
    for (int a = 0; a < 2; ++a)
#pragma unroll
        for (int b = 0; b < 2; ++b)
#pragma unroll
            for (int m = 0; m < 4; ++m)
#pragma unroll
                for (int n = 0; n < 2; ++n) acc[a][b][m][n] = (f32x4){0.f, 0.f, 0.f, 0.f};
    bf16x8 At[4][2], B0[2][2], B1[2][2];
    const char* cA = (const char*)g.A + (size_t)cur.pm * tstep; const char* cB = (const char*)g.Bt + (size_t)cur.pn * tstep;
    S.a_ready(cur);
    if constexpr (SP2) {
        PG8_STAGE(PG8_SB(0, 0), cB, voffB); PG8_STAGE(PG8_SB(0, 1), cB + hstep, voffB); PG8_STAGE(PG8_SA(0, 0), cA, voffA); PG8_STAGE(PG8_SA(0, 1), cA + hstep, voffA);
        if (wr == 1) PG8_BAR;
        PG8_WAIT_V(2); PG8_BAR;
        PG8_STAGE(PG8_SB(1, 0), cB + kstep, voffB); PG8_STAGE(PG8_SA(1, 0), cA + kstep, voffA); PG8_STAGE(PG8_SB(1, 1), cB + hstep + kstep, voffB);
        PG8_WAIT_V(6); PG8_BAR;
    } else {
        PG8_STAGE(PG8_SB(0, 0), cB, voffB); PG8_STAGE(PG8_SA(0, 0), cA, voffA); PG8_STAGE(PG8_SB(0, 1), cB + hstep, voffB); PG8_STAGE(PG8_SA(0, 1), cA + hstep, voffA);
        if (wr == 1) PG8_BAR;
        PG8_WAIT_V(4); PG8_BAR;
        PG8_STAGE(PG8_SB(1, 0), cB + kstep, voffB); PG8_STAGE(PG8_SA(1, 0), cA + kstep, voffA); PG8_STAGE(PG8_SB(1, 1), cB + hstep + kstep, voffB);
        PG8_WAIT_V(6); PG8_BAR;
    }
    for (;;) {
        const bool has_next = S.next(ui + 1, nxt);
        const char* nA = has_next ? (const char*)g.A + (size_t)nxt.pm * tstep : cA; const char* nB = has_next ? (const char*)g.Bt + (size_t)nxt.pn * tstep : cB;
        for (int t = 0; t < nt; t += 2) {
            const bool last = (t == nt - 2);
            const char* a1 = cA + (size_t)(t + 1) * kstep;
            const char* a2 = last ? nA : cA + (size_t)(t + 2) * kstep; const char* b2 = last ? nB : cB + (size_t)(t + 2) * kstep;
            const char* a3 = a2 + kstep; const char* b3 = b2 + kstep;
            if (last && has_next) S.a_ready(nxt);
            if constexpr (SP2) {
            PG8_LDB(B0, 0, 0); PG8_LDB(B1, 0, 1); PG8_SCHED; PG8_LDA(At, 0, 0); PG8_STAGE(PG8_SA(1, 1), a1 + hstep, voffA);
            PG8_WAIT_V(8); PG8_WAIT_L(0); PG8_BAR; PG8_MMA(0, 0, At, B0); PG8_MMA(0, 1, At, B1); PG8_BAR; PG8_SCHED;
            PG8_LDA(At, 0, 1); PG8_STAGE(PG8_SB(0, 0), b2, voffB); PG8_STAGE(PG8_SB(0, 1), b2 + hstep, voffB); PG8_STAGE(PG8_SA(0, 0), a2, voffA);
            PG8_WAIT_V(8); PG8_WAIT_L(0); PG8_BAR; PG8_MMA(1, 0, At, B0); PG8_MMA(1, 1, At, B1); PG8_BAR; PG8_SCHED;
            PG8_LDB(B0, 1, 0); PG8_LDB(B1, 1, 1); PG8_SCHED; PG8_LDA(At, 1, 0); PG8_STAGE(PG8_SA(0, 1), a2 + hstep, voffA);
            PG8_WAIT_V(8); PG8_WAIT_L(0); PG8_BAR; PG8_MMA(0, 0, At, B0); PG8_MMA(0, 1, At, B1); PG8_BAR; PG8_SCHED;
            PG8_LDA(At, 1, 1); PG8_STAGE(PG8_SB(1, 0), b3, voffB); PG8_STAGE(PG8_SB(1, 1), b3 + hstep, voffB); PG8_STAGE(PG8_SA(1, 0), a3, voffA);
            PG8_WAIT_V(8); PG8_WAIT_L(0); PG8_BAR; PG8_MMA(1, 0, At, B0); PG8_MMA(1, 1, At, B1); PG8_BAR; PG8_SCHED;
            } else {
            PG8_LDB(B0, 0, 0); PG8_SCHED; PG8_LDA(At, 0, 0); PG8_STAGE(PG8_SA(1, 1), a1 + hstep, voffA);
            PG8_WAIT_L(8); PG8_BAR; PG8_WAIT_L(0); PG8_MMA(0, 0, At, B0); PG8_BAR; PG8_SCHED;
            PG8_LDB(B1, 0, 1); PG8_STAGE(PG8_SB(0, 0), b2, voffB);
            PG8_BAR; PG8_WAIT_L(0); PG8_MMA(0, 1, At, B1); PG8_BAR;
            PG8_LDA(At, 0, 1); PG8_STAGE(PG8_SA(0, 0), a2, voffA);
            PG8_BAR; PG8_WAIT_L(0); PG8_MMA(1, 0, At, B0); PG8_BAR; PG8_SCHED;
            PG8_STAGE(PG8_SB(0, 1), b2 + hstep, voffB);
            PG8_WAIT_V(6); PG8_BAR; PG8_MMA(1, 1, At, B1); PG8_BAR;
            PG8_LDB(B0, 1, 0); PG8_SCHED; PG8_LDA(At, 1, 0); PG8_STAGE(PG8_SA(0, 1), a2 + hstep, voffA);
            PG8_WAIT_L(8); PG8_BAR; PG8_WAIT_L(0); PG8_MMA(0, 0, At, B0); PG8_BAR; PG8_SCHED;
            PG8_LDB(B1, 1, 1); PG8_STAGE(PG8_SB(1, 0), b3, voffB);
            PG8_BAR; PG8_WAIT_L(0); PG8_MMA(0, 1, At, B1); PG8_BAR;
            PG8_LDA(At, 1, 1); PG8_STAGE(PG8_SA(1, 0), a3, voffA);
            PG8_BAR; PG8_WAIT_L(0); PG8_MMA(1, 0, At, B0); PG8_BAR; PG8_SCHED;
            PG8_STAGE(PG8_SB(1, 1), b3 + hstep, voffB);
            PG8_WAIT_V(6); PG8_BAR; PG8_MMA(1, 1, At, B1); PG8_BAR;
            }
        }
        if constexpr (ALIGN_EPI) { if (wr == 0) PG8_BAR; }
        if constexpr (!Epi::AFTER_DRAIN) { E(acc, cur, wr, wc, fr, fq); S.done(cur); }
        if (!has_next) break;
#pragma unroll
        for (int a = 0; a < 2; ++a)
#pragma unroll
            for (int b = 0; b < 2; ++b)
#pragma unroll
                for (int m = 0; m < 4; ++m)
#pragma unroll
                    for (int n = 0; n < 2; ++n) acc[a][b][m][n] = (f32x4){0.f, 0.f, 0.f, 0.f};
        cur = nxt; cA = nA; cB = nB; ++ui;
        if constexpr (ALIGN_EPI) { if (wr == 1) PG8_BAR; }
    }
    PG8_WAIT_V(0);
    if constexpr (!ALIGN_EPI) { if (wr == 0) PG8_BAR; }
    PG8_BAR;
    if constexpr (Epi::AFTER_DRAIN) { E.fused(acc, cur, wr, wc, fr, fq, lds, wid, lane); S.done(cur); }
#undef PG8_SA
#undef PG8_SB
#undef PG8_STAGE
#undef PG8_LDA
#undef PG8_LDB
#undef PG8_MMA
#undef PG8_WAIT_V
#undef PG8_WAIT_L
#undef PG8_BAR
#undef PG8_SCHED
}
}

typedef unsigned short bf16;
typedef float f32x4 __attribute__((ext_vector_type(4)));
typedef short bf16x8 __attribute__((ext_vector_type(8)));
typedef short s16x4 __attribute__((ext_vector_type(4)));
typedef unsigned u32x4 __attribute__((ext_vector_type(4)));
typedef unsigned u32x2 __attribute__((ext_vector_type(2)));
typedef float f32x2 __attribute__((ext_vector_type(2)));
typedef __bf16 bf16x2_t __attribute__((ext_vector_type(2)));
#define LAS __attribute__((address_space(3)))

constexpr int T = 8192, NS = 512, M = 8704, D = 2048, NP = 6400, DEPTH = 2;
constexpr int C_QA = 0, C_KA = 1024, C_VA = 1152, C_GA = 1280, C_QB = 2304, C_KB = 3328, C_VB = 4352, C_GB = 5376;
constexpr int NPOS = 8196;
constexpr int LDS_BYTES = 147456;
constexpr int NTHREADS = 512;
using pg8::O_KP; using pg8::O_VP; using pg8::O_RP; using pg8::O_KS; using pg8::O_VS; using pg8::O_RS;

constexpr size_t MiB = 1u << 20;
constexpr size_t WS_CTL = 0, CTL_BYTES = 1 * MiB;
constexpr size_t WS_WIN = 2 * MiB;
constexpr size_t WS_WOUT = WS_WIN + 50 * MiB;
constexpr size_t WS_XA = WS_WOUT + 16 * MiB;
constexpr size_t WS_P = WS_XA + 34 * MiB;
constexpr size_t WS_Y = WS_P + 107 * MiB;
constexpr size_t WS_XR = WS_Y + 34 * MiB;
constexpr size_t WS_U = WS_XR + 68 * MiB;
constexpr size_t WS_RT = WS_U + 32 * MiB;
constexpr size_t WS_TAB = WS_RT + 16 * MiB;
constexpr size_t WS_END = WS_TAB + 8 * MiB;
static_assert(WS_XA == pg8::EWS_XA && WS_P == pg8::EWS_P && WS_XR == pg8::EWS_XR && WS_TAB == pg8::EWS_TAB && WS_CTL == 0, "d_ws map vs the epilogues' copy");

static_assert(true, "");
struct Ctx {
    const float *x_prompt, *x_sample, *cache_k, *cache_v, *state, *norm_w, *w_in, *sinks, *ret_norm_w, *w_out, *final_w;
    float* out; unsigned char* ws;
    int ph_lo, ph_hi;
};

__device__ __forceinline__ unsigned cvtpk(float lo, float hi) { f32x2 v = {lo, hi}; bf16x2_t b = __builtin_convertvector(v, bf16x2_t); return __builtin_bit_cast(unsigned, b); }
__device__ __forceinline__ float bf_lo(unsigned u) { return __uint_as_float(u << 16); }
__device__ __forceinline__ float bf_hi(unsigned u) { return __uint_as_float(u & 0xffff0000u); }
__device__ __forceinline__ float silu_f(float x) { return x / (1.0f + __expf(-x)); }
__device__ __forceinline__ s16x4 vtr(const char* p) { typedef short v4i16_t __attribute__((ext_vector_type(4)));
    return __builtin_bit_cast(s16x4, __builtin_amdgcn_ds_read_tr16_b64_v4i16((LAS v4i16_t*)p)); }
__device__ __forceinline__ bf16x8 cat8(s16x4 lo, s16x4 hi) { return (bf16x8){lo[0], lo[1], lo[2], lo[3], hi[0], hi[1], hi[2], hi[3]}; }
__device__ __forceinline__ float ln_gamma(int h) {
    const double x = __builtin_ldexp(1.0, -5 - h);
    double s = 0.0, p = x;
#pragma unroll
    for (int k = 1; k <= 9; ++k) { s += p / (double)k; p *= x; }
    return (float)(-s);
}
#define LDS_WAIT() asm volatile("s_waitcnt lgkmcnt(0)" ::: "memory")
#define LAUNDER_V(x) asm volatile("" : "+v"(x))
#define LAUNDER_S(x) asm volatile("" : "+s"(x))

__device__ __forceinline__ int perm_src_col(int np, float& sc) {
    sc = 1.0f;
    if (np < 1152) { const int hb = np & ~63, g = np & 63; if (np < 1024) sc = 0.125f; return hb + 4 * (g >> 3) + (g & 3) + 32 * ((g >> 2) & 1); }
    if (np >= C_QB && np < C_VB) { const int hb = np & ~127, g = np & 127; if (np >= C_KB) sc = 0.08838834764831845f; return hb + 4 * (g >> 3) + (g & 3) + 64 * ((g >> 2) & 1); }
    return np;
}

template <bool WIN>
__device__ __forceinline__ void transpose_item(const float* W, int N, const float* nw, bf16* WT, float* scr, int kb, int nb, int lane) {
    const int k0 = 64 * kb, n0 = 64 * nb, l16 = lane & 15, r4 = lane >> 4;
    float sc = 1.0f; int srcc = n0 + 4 * l16;
    if (WIN) srcc = perm_src_col(n0 + 4 * l16, sc);
    f32x4 v[16]; float nwv[16];
#pragma unroll
    for (int i = 0; i < 16; ++i) { const int kk = 4 * i + r4; v[i] = __builtin_nontemporal_load((const f32x4*)(W + (size_t)(k0 + kk) * N + srcc)); nwv[i] = WIN ? nw[k0 + kk] : 1.0f; }
#pragma unroll
    for (int i = 0; i < 16; ++i) {
        const int kk = 4 * i + r4; const float s2 = sc * nwv[i];
        float* d = scr + kk * 65 + 4 * l16;
        d[0] = v[i][0] * s2; d[1] = v[i][1] * s2; d[2] = v[i][2] * s2; d[3] = v[i][3] * s2;
    }
    LDS_WAIT();
    const int c = lane & 7;
#pragma unroll
    for (int j = 0; j < 8; ++j) {
        const int n = (lane >> 3) + 8 * j; const float* s = scr + (8 * c) * 65 + n;
        u32x4 o; o.x = cvtpk(s[0], s[65]); o.y = cvtpk(s[130], s[195]); o.z = cvtpk(s[260], s[325]); o.w = cvtpk(s[390], s[455]);
        *(u32x4*)(WT + (size_t)(n0 + n) * 2048 + k0 + 8 * c) = o;
    }
    LDS_WAIT();
}

__device__ __forceinline__ void convert_weights(const Ctx& C, float* scr, int l, int gw, int NGW, int lane) {
    bf16* WIN = (bf16*)(C.ws + WS_WIN); bf16* WOUT = (bf16*)(C.ws + WS_WOUT);
    constexpr int I_IN = 32 * 100, I_OUT = 32 * 32;
    for (int it = gw; it < I_IN + I_OUT; it += NGW) {
        int r = it;
        if (r < I_IN) { const int nb = r % 100, kb = r / 100;
            transpose_item<true>(C.w_in + (size_t)l * D * NP, NP, C.norm_w + l * D, WIN + (size_t)l * NP * D, scr, kb, nb, lane); }
        else { r -= I_IN; const int nb = r & 31, kb = r >> 5;
            transpose_item<false>(C.w_out + (size_t)l * D * D, D, nullptr, WOUT + (size_t)l * D * D, scr, kb, nb, lane); }
    }
}

__device__ __forceinline__ void p0_prologue(const Ctx& C, char* lds, int tid, int wave, int lane, int G) {
    float* scr = (float*)(lds + wave * 16640);
    const int gw = blockIdx.x * 8 + wave, NGW = G * 8;
    convert_weights(C, scr, 0, gw, NGW, lane);
    bf16* XA = (bf16*)(C.ws + WS_XA); float* rss = (float*)(C.ws + WS_CTL);
    for (int m = gw; m < M; m += 2 * NGW) {
        const int m2 = m + NGW; const bool has2 = m2 < M;
        const float* xr = m < T ? C.x_prompt + (size_t)m * D : C.x_sample + (size_t)(m - T) * D;
        const int m2c = has2 ? m2 : m;
        const float* xr2 = m2c < T ? C.x_prompt + (size_t)m2c * D : C.x_sample + (size_t)(m2c - T) * D;
        f32x4 va[8], vb[8];
#pragma unroll
        for (int j = 0; j < 8; ++j) { va[j] = __builtin_nontemporal_load((const f32x4*)xr + lane + 64 * j); vb[j] = __builtin_nontemporal_load((const f32x4*)xr2 + lane + 64 * j); }
        float ss = 0.f, ss2 = 0.f;
#pragma unroll
        for (int j = 0; j < 8; ++j) {
            ss += (va[j][0] * va[j][0] + va[j][1] * va[j][1]) + (va[j][2] * va[j][2] + va[j][3] * va[j][3]);
            ss2 += (vb[j][0] * vb[j][0] + vb[j][1] * vb[j][1]) + (vb[j][2] * vb[j][2] + vb[j][3] * vb[j][3]);
            u32x2 o; o.x = cvtpk(va[j][0], va[j][1]); o.y = cvtpk(va[j][2], va[j][3]);
            *((u32x2*)(XA + (size_t)m * D) + lane + 64 * j) = o;
            if (has2) { u32x2 o2; o2.x = cvtpk(vb[j][0], vb[j][1]); o2.y = cvtpk(vb[j][2], vb[j][3]); *((u32x2*)(XA + (size_t)m2 * D) + lane + 64 * j) = o2; }
        }
#pragma unroll
        for (int o = 1; o < 64; o <<= 1) { ss += __shfl_xor(ss, o); ss2 += __shfl_xor(ss2, o); }
        if (lane == 0) { rss[m] = ss; if (has2) rss[m2] = ss2; }
    }
    float* cosA = (float*)(C.ws + WS_TAB); float* sinA = cosA + NPOS * 32; float* cosB = sinA + NPOS * 32; float* sinB = cosB + NPOS * 64;
    for (int i = blockIdx.x * NTHREADS + tid; i < NPOS * 96; i += G * NTHREADS) {
        int pos, f, half; float *pc, *ps;
        if (i < NPOS * 32) { pos = i >> 5; f = i & 31; half = 32; pc = cosA + i; ps = sinA + i; }
        else { const int k = i - NPOS * 32; pos = k >> 6; f = k & 63; half = 64; pc = cosB + k; ps = sinB + k; }
        const double rr = half == 32 ? 0.7498942093324559 : 0.8659643233600653;
        double inv = 1.0; for (int k = 0; k < f; ++k) inv *= rr;
        const float ang = (float)pos * (float)inv;
        const double a = (double)ang;
        const double qd = __builtin_rint(a * 0.6366197723675814);
        double r = __builtin_fma(-qd, 1.5707963267948966, a); r = __builtin_fma(-qd, 6.123233995736766e-17, r);
        const double r2 = r * r;
        double sp = -1.0 / 39916800.0; sp = sp * r2 + 1.0 / 362880.0; sp = sp * r2 - 1.0 / 5040.0; sp = sp * r2 + 1.0 / 120.0; sp = sp * r2 - 1.0 / 6.0; sp = sp * r2 + 1.0; sp *= r;
        double cp = 1.0 / 479001600.0; cp = cp * r2 - 1.0 / 3628800.0; cp = cp * r2 + 1.0 / 40320.0; cp = cp * r2 - 1.0 / 720.0; cp = cp * r2 + 1.0 / 24.0; cp = cp * r2 - 0.5; cp = cp * r2 + 1.0;
        const int qi = ((int)qd) & 3;
        const double sv = (qi == 0) ? sp : (qi == 1) ? cp : (qi == 2) ? -sp : -cp;
        const double cv = (qi == 0) ? cp : (qi == 1) ? -sp : (qi == 2) ? -cp : sp;
        *pc = (float)cv; *ps = (float)sv;
    }
}

__device__ __forceinline__ void attn_prompt_unit(const Ctx& C, char* lds, int layer, int blk, int kvh, int hq, int tid, int w, int lane) {
    const bf16* P = (const bf16*)(C.ws + WS_P); bf16* Y = (bf16*)(C.ws + WS_Y);
    char* Ks = lds; char* Vs = lds + 36864;
    const int q = lane & 15, g = lane >> 4;
    const int jt0 = w < 6 ? w : 6;
    const int iq = 16 * w + q, row = blk * 128 + iq;
    bf16x8 qfa[4][2]; u32x2 gta[4][4];
#pragma unroll
    for (int hh = 0; hh < 4; ++hh) {
        const int h = kvh * 8 + hq * 4 + hh;
#pragma unroll
        for (int ks = 0; ks < 2; ++ks) qfa[hh][ks] = *(const bf16x8*)(P + (size_t)row * NP + C_QA + h * 64 + 32 * ks + 8 * g);
#pragma unroll
        for (int dt = 0; dt < 4; ++dt) gta[hh][dt] = *(const u32x2*)(P + (size_t)row * NP + C_GA + h * 64 + 16 * dt + 4 * g);
    }
#pragma unroll
    for (int it = 0; it < 4; ++it) {
        const int r = (tid >> 3) + 64 * it, ch = tid & 7, krow = blk * 128 - 128 + r;
        u32x4 kv = (u32x4){0u, 0u, 0u, 0u}, vv = kv;
        if (krow >= 0) { kv = *(const u32x4*)(P + (size_t)krow * NP + C_KA + kvh * 64 + ch * 8); vv = *(const u32x4*)(P + (size_t)krow * NP + C_VA + kvh * 64 + ch * 8); }
        *(u32x4*)(Ks + r * 144 + ch * 16) = kv; *(u32x4*)(Vs + r * 144 + ch * 16) = vv;
    }
    __syncthreads();
#pragma unroll
    for (int hh = 0; hh < 4; ++hh) {
        const int h = kvh * 8 + hq * 4 + hh;
        bf16x8 qf[2]; qf[0] = qfa[hh][0]; qf[1] = qfa[hh][1];
        f32x4 s[10];
        float mx = -INFINITY;
        int lo = (blk > 0 || iq + 1 >= 128) ? iq + 1 : 128; LAUNDER_V(lo);
        const unsigned span = (unsigned)(iq + 128 - lo);
#pragma unroll
        for (int tt = 0; tt < 10; ++tt) {
            const int jt = jt0 + tt;
            f32x4 a = (f32x4){0.f, 0.f, 0.f, 0.f};
#pragma unroll
            for (int ks = 0; ks < 2; ++ks) { const bf16x8 kf = *(const bf16x8*)(Ks + (16 * jt + q) * 144 + (32 * ks + 8 * g) * 2); a = __builtin_amdgcn_mfma_f32_16x16x32_bf16(kf, qf[ks], a, 0, 0, 0); }
#pragma unroll
            for (int j = 0; j < 4; ++j) {
                const int jj = 16 * jt + 4 * g + j;
                a[j] = ((unsigned)(jj - lo) <= span) ? a[j] : -INFINITY; mx = fmaxf(mx, a[j]);
            }
            s[tt] = a;
        }
        mx = fmaxf(mx, __shfl_xor(mx, 16)); mx = fmaxf(mx, __shfl_xor(mx, 32));
        const float sink = C.sinks[layer * 16 + h];
        const float mm = fmaxf(mx, sink);
        float sum = 0.f;
#pragma unroll
        for (int tt = 0; tt < 10; ++tt)
#pragma unroll
            for (int j = 0; j < 4; ++j) { const float e = __expf(s[tt][j] - mm); s[tt][j] = e; sum += e; }
        sum += __shfl_xor(sum, 16); sum += __shfl_xor(sum, 32);
        const float inv = 1.0f / (sum + __expf(sink - mm));
        f32x4 o[4];
#pragma unroll
        for (int dt = 0; dt < 4; ++dt) o[dt] = (f32x4){0.f, 0.f, 0.f, 0.f};
#pragma unroll
        for (int pr = 0; pr < 5; ++pr) {
            const int jt = jt0 + 2 * pr;
            u32x4 pw; pw.x = cvtpk(s[2 * pr][0], s[2 * pr][1]); pw.y = cvtpk(s[2 * pr][2], s[2 * pr][3]); pw.z = cvtpk(s[2 * pr + 1][0], s[2 * pr + 1][1]); pw.w = cvtpk(s[2 * pr + 1][2], s[2 * pr + 1][3]);
            const bf16x8 pf = __builtin_bit_cast(bf16x8, pw);
#pragma unroll
            for (int dt = 0; dt < 4; ++dt) {
                const char* a0 = Vs + (16 * jt + 4 * g + (q >> 2)) * 144 + (16 * dt + 4 * (q & 3)) * 2;
                const s16x4 lo = vtr(a0), hi = vtr(a0 + 16 * 144);
                o[dt] = __builtin_amdgcn_mfma_f32_16x16x32_bf16(cat8(lo, hi), pf, o[dt], 0, 0, 0);
            }
        }
#pragma unroll
        for (int dt = 0; dt < 4; ++dt) {
            const int dcol = h * 64 + 16 * dt + 4 * g;
            const u32x2 gt = gta[hh][dt];
            u32x2 yo; yo.x = cvtpk(o[dt][0] * inv * silu_f(bf_lo(gt.x)), o[dt][1] * inv * silu_f(bf_hi(gt.x)));
            yo.y = cvtpk(o[dt][2] * inv * silu_f(bf_lo(gt.y)), o[dt][3] * inv * silu_f(bf_hi(gt.y)));
            *(u32x2*)(Y + (size_t)row * D + dcol) = yo;
        }
    }
    __syncthreads();
}

__device__ __forceinline__ void stage128_load(u32x4 (&v)[4], const bf16* src, size_t src_pitch, int tid) {
#pragma unroll
    for (int it = 0; it < 4; ++it) { const int r = (tid >> 4) + 32 * it, ch = tid & 15; v[it] = *(const u32x4*)(src + (size_t)r * src_pitch + ch * 8); }
}
template <bool SCALE>
__device__ __forceinline__ void stage128_store(char* dst, const u32x4 (&vin)[4], int tid, float lng) {
#pragma unroll
    for (int it = 0; it < 4; ++it) {
        const int r = (tid >> 4) + 32 * it, ch = tid & 15;
        u32x4 v = vin[it];
        if (SCALE) { const float sc = __expf((float)(127 - r) * lng);
            v.x = cvtpk(bf_lo(v.x) * sc, bf_hi(v.x) * sc); v.y = cvtpk(bf_lo(v.y) * sc, bf_hi(v.y) * sc); v.z = cvtpk(bf_lo(v.z) * sc, bf_hi(v.z) * sc); v.w = cvtpk(bf_lo(v.w) * sc, bf_hi(v.w) * sc); }
        *(u32x4*)(dst + r * 272 + ch * 16) = v;
    }
}

__device__ __forceinline__ void ret_u_unit(const Ctx& C, char* lds, int c, int h, int tid, int w, int lane) {
    const bf16* P = (const bf16*)(C.ws + WS_P); float* U = (float*)(C.ws + WS_U);
    char* Ks = lds; char* Vs = lds + 34816;
    const float lng = ln_gamma(h);
    { u32x4 sk[4], sv[4];
      stage128_load(sk, P + (size_t)(c * 128) * NP + C_KB + h * 128, NP, tid); stage128_load(sv, P + (size_t)(c * 128) * NP + C_VB + h * 128, NP, tid);
      stage128_store<false>(Ks, sk, tid, lng); stage128_store<true>(Vs, sv, tid, lng); }
    __syncthreads();
    const int q = lane & 15, g = lane >> 4;
    f32x4 acc[8];
#pragma unroll
    for (int dt = 0; dt < 8; ++dt) acc[dt] = (f32x4){0.f, 0.f, 0.f, 0.f};
#pragma unroll
    for (int ks = 0; ks < 4; ++ks) {
        const int rbase = (32 * ks + 8 * g + (q >> 2)) * 272 + 4 * (q & 3) * 2;
        const bf16x8 vf = cat8(vtr(Vs + rbase + 32 * w), vtr(Vs + rbase + 32 * w + 4 * 272));
#pragma unroll
        for (int dt = 0; dt < 8; ++dt) {
            const bf16x8 kf = cat8(vtr(Ks + rbase + 32 * dt), vtr(Ks + rbase + 32 * dt + 4 * 272));
            acc[dt] = __builtin_amdgcn_mfma_f32_16x16x32_bf16(vf, kf, acc[dt], 0, 0, 0);
        }
    }
    float* Ub = U + (size_t)(c * 8 + h) * 16384;
#pragma unroll
    for (int dt = 0; dt < 8; ++dt)
#pragma unroll
        for (int j = 0; j < 4; ++j) Ub[(16 * w + 4 * g + j) * 128 + 16 * dt + q] = acc[dt][j];
    __syncthreads();
}

__device__ __forceinline__ void ret_scan(const Ctx& C, int layer, int tid, int G) {
    const float* U = (const float*)(C.ws + WS_U); bf16* Rt = (bf16*)(C.ws + WS_RT);
    for (int i = blockIdx.x * NTHREADS + tid; i < 8 * 16384; i += G * NTHREADS) {
        const int h = i >> 14, e = (i >> 7) & 127, d = i & 127;
        const float gc = __expf(128.0f * ln_gamma(h));
        float r = 0.f;
#pragma unroll 1
        for (int c0 = 0; c0 < 64; c0 += 32) {
            float u[32];
#pragma unroll
            for (int k = 0; k < 32; ++k) u[k] = __builtin_nontemporal_load(U + (size_t)((c0 + k) * 8) * 16384 + i);
#pragma unroll
            for (int k = 0; k < 32; ++k) { Rt[(size_t)((c0 + k) * 8) * 16384 + i] = (bf16)(cvtpk(r, 0.f) & 0xffffu); r = gc * r + u[k]; }
        }
        const int dorig = 4 * (d >> 3) + (d & 3) + 64 * ((d >> 2) & 1);
        C.out[O_RP + ((size_t)(layer * 8 + h) * 128 + dorig) * 128 + e] = r;
    }
}

__device__ __forceinline__ void ret_prompt_unit(const Ctx& C, char* lds, int layer, int c, int h, int tid, int w, int lane) {
    const bf16* P = (const bf16*)(C.ws + WS_P); bf16* Y = (bf16*)(C.ws + WS_Y); const bf16* Rt = (const bf16*)(C.ws + WS_RT);
    char* Ks = lds; char* Vs = lds + 34816; char* Rs = lds + 69632;
    const float lng = ln_gamma(h);
    const int q = lane & 15, g = lane >> 4;
    const int n = 16 * w + q, row = c * 128 + n;
    bf16x8 qf[4]; u32x2 gta[8];
#pragma unroll
    for (int ks = 0; ks < 4; ++ks) qf[ks] = *(const bf16x8*)(P + (size_t)row * NP + C_QB + h * 128 + 32 * ks + 8 * g);
#pragma unroll
    for (int et = 0; et < 8; ++et) gta[et] = *(const u32x2*)(P + (size_t)row * NP + C_GB + h * 128 + 16 * et + 4 * g);
    { u32x4 sk[4], sv[4], sr[4];
      stage128_load(sk, P + (size_t)(c * 128) * NP + C_KB + h * 128, NP, tid); stage128_load(sv, P + (size_t)(c * 128) * NP + C_VB + h * 128, NP, tid);
      stage128_load(sr, Rt + (size_t)(c * 8 + h) * 16384, 128, tid);
      stage128_store<false>(Ks, sk, tid, lng); stage128_store<false>(Vs, sv, tid, lng); stage128_store<false>(Rs, sr, tid, lng); }
    __syncthreads();
    unsigned pk[8][2];
#pragma unroll
    for (int mt = 0; mt < 8; ++mt) {
        pk[mt][0] = 0u; pk[mt][1] = 0u;
        if (mt <= w) {
            f32x4 a = (f32x4){0.f, 0.f, 0.f, 0.f};
#pragma unroll
            for (int ks = 0; ks < 4; ++ks) { const bf16x8 kf = *(const bf16x8*)(Ks + (16 * mt + q) * 272 + (32 * ks + 8 * g) * 2); a = __builtin_amdgcn_mfma_f32_16x16x32_bf16(kf, qf[ks], a, 0, 0, 0); }
            float v[4];
#pragma unroll
            for (int j = 0; j < 4; ++j) { const int dl = n - (16 * mt + 4 * g + j); v[j] = dl >= 0 ? a[j] * __expf((float)dl * lng) : 0.f; }
            pk[mt][0] = cvtpk(v[0], v[1]); pk[mt][1] = cvtpk(v[2], v[3]);
        }
    }
    f32x4 oi[8], ox[8];
#pragma unroll
    for (int et = 0; et < 8; ++et) { oi[et] = (f32x4){0.f, 0.f, 0.f, 0.f}; ox[et] = oi[et]; }
#pragma unroll
    for (int pr = 0; pr < 4; ++pr) {
        if (2 * pr <= w) {
            u32x4 pw; pw.x = pk[2 * pr][0]; pw.y = pk[2 * pr][1]; pw.z = pk[2 * pr + 1][0]; pw.w = pk[2 * pr + 1][1];
            const bf16x8 pf = __builtin_bit_cast(bf16x8, pw);
#pragma unroll
            for (int et = 0; et < 8; ++et) {
                const char* a0 = Vs + (32 * pr + 4 * g + (q >> 2)) * 272 + (16 * et + 4 * (q & 3)) * 2;
                oi[et] = __builtin_amdgcn_mfma_f32_16x16x32_bf16(cat8(vtr(a0), vtr(a0 + 16 * 272)), pf, oi[et], 0, 0, 0);
            }
        }
    }
#pragma unroll
    for (int et = 0; et < 8; ++et)
#pragma unroll
        for (int ks = 0; ks < 4; ++ks) { const bf16x8 rf = *(const bf16x8*)(Rs + (16 * et + q) * 272 + (32 * ks + 8 * g) * 2); ox[et] = __builtin_amdgcn_mfma_f32_16x16x32_bf16(rf, qf[ks], ox[et], 0, 0, 0); }
    const float qdec = __expf((float)(n + 1) * lng);
    float sum = 0.f;
#pragma unroll
    for (int et = 0; et < 8; ++et) { oi[et] = oi[et] + ox[et] * qdec; sum += (oi[et][0] + oi[et][1]) + (oi[et][2] + oi[et][3]); }
    sum += __shfl_xor(sum, 16); sum += __shfl_xor(sum, 32);
    const float mu = sum * (1.0f / 128.0f);
    float var = 0.f;
#pragma unroll
    for (int et = 0; et < 8; ++et) { oi[et] = oi[et] - mu; var += (oi[et][0] * oi[et][0] + oi[et][1] * oi[et][1]) + (oi[et][2] * oi[et][2] + oi[et][3] * oi[et][3]); }
    var += __shfl_xor(var, 16); var += __shfl_xor(var, 32);
    const float rs = rsqrtf(var * (1.0f / 128.0f) + 1e-6f);
    const float* gw = C.ret_norm_w + layer * 1024 + h * 128;
#pragma unroll
    for (int et = 0; et < 8; ++et) {
        const int e0 = 16 * et + 4 * g;
        const u32x2 gt = gta[et];
        const f32x4 wv = *(const f32x4*)(gw + e0);
        u32x2 yo; yo.x = cvtpk(oi[et][0] * rs * wv[0] * silu_f(bf_lo(gt.x)), oi[et][1] * rs * wv[1] * silu_f(bf_hi(gt.x)));
        yo.y = cvtpk(oi[et][2] * rs * wv[2] * silu_f(bf_lo(gt.y)), oi[et][3] * rs * wv[3] * silu_f(bf_hi(gt.y)));
        *(u32x2*)(Y + (size_t)row * D + 1024 + h * 128 + e0) = yo;
    }
    __syncthreads();
}

__device__ __forceinline__ void attn_sample_unit(const Ctx& C, char* lds, int layer, int b, int kvh, int tid) {
    const bf16* P = (const bf16*)(C.ws + WS_P); bf16* Y = (bf16*)(C.ws + WS_Y);
    float* Qs = (float*)lds;
    float* Kl = Qs + 32 * 65;
    float* Vl = Kl + 132 * 68;
    float* Pm = Vl + 132 * 68;
    const float* ck = C.cache_k + ((size_t)(layer * 128 + b) * 128) * 128 + kvh * 64;
    const float* cv = C.cache_v + ((size_t)(layer * 128 + b) * 128) * 128 + kvh * 64;
    float* ok = C.out + O_KS + ((size_t)(layer * 128 + b) * 128) * 128 + kvh * 64;
    float* ov = C.out + O_VS + ((size_t)(layer * 128 + b) * 128) * 128 + kvh * 64;
    {
        f32x4 kq[4], vq[4];
#pragma unroll
        for (int it = 0; it < 4; ++it) { const int i = tid + NTHREADS * it, r = i >> 4, c4 = i & 15;
            kq[it] = __builtin_nontemporal_load((const f32x4*)(ck + (size_t)r * 128 + 4 * c4)); vq[it] = __builtin_nontemporal_load((const f32x4*)(cv + (size_t)r * 128 + 4 * c4)); }
#pragma unroll
        for (int it = 0; it < 4; ++it) { const int i = tid + NTHREADS * it, r = i >> 4, c4 = i & 15;
            *(f32x4*)(Kl + r * 68 + 4 * c4) = kq[it]; *(f32x4*)(Vl + r * 68 + 4 * c4) = vq[it];
            if (r >= 4) { __builtin_nontemporal_store(kq[it], (f32x4*)(ok + (size_t)(r - 4) * 128 + 4 * c4)); __builtin_nontemporal_store(vq[it], (f32x4*)(ov + (size_t)(r - 4) * 128 + 4 * c4)); } }
    }
    if (tid < 256) { const int t = tid >> 6, g = tid & 63; const size_t ro = (size_t)(T + 4 * b + t) * NP;
        const int dk = 4 * (g >> 3) + (g & 3) + 32 * ((g >> 2) & 1);
        Kl[(128 + t) * 68 + dk] = __uint_as_float((unsigned)P[ro + C_KA + kvh * 64 + g] << 16);
        Vl[(128 + t) * 68 + g] = __uint_as_float((unsigned)P[ro + C_VA + kvh * 64 + g] << 16); }
    for (int i = tid; i < 32 * 64; i += NTHREADS) {
        const int r = i >> 6, g = i & 63, hg = r >> 2, t = r & 3;
        const int dk = 4 * (g >> 3) + (g & 3) + 32 * ((g >> 2) & 1);
        Qs[r * 65 + dk] = __uint_as_float((unsigned)P[(size_t)(T + 4 * b + t) * NP + C_QA + (kvh * 8 + hg) * 64 + g] << 16);
    }
    __syncthreads();
    {
        const int r = tid >> 4, kg = tid & 15, t = r & 3, h = kvh * 8 + (r >> 2);
        float mx = -INFINITY;
        f32x4 qr[16];
#pragma unroll
        for (int i = 0; i < 16; ++i) qr[i] = (f32x4){Qs[r * 65 + 4 * i], Qs[r * 65 + 4 * i + 1], Qs[r * 65 + 4 * i + 2], Qs[r * 65 + 4 * i + 3]};
#pragma unroll 1
        for (int it = 0; it < 9; ++it) {
            const int kk = kg + 16 * it;
            float a = -INFINITY;
            if (kk < 132) {
                const bool valid = kk < 128 ? (kk > t) : (kk - 128 <= t);
                if (valid) { f32x4 a4 = (f32x4){0.f, 0.f, 0.f, 0.f};
#pragma unroll
                    for (int i = 0; i < 16; ++i) a4 += qr[i] * *(const f32x4*)(Kl + kk * 68 + 4 * i);
                    a = (a4[0] + a4[1]) + (a4[2] + a4[3]); }
                Pm[r * 133 + kk] = a;
            }
            mx = fmaxf(mx, a);
        }
#pragma unroll
        for (int o = 1; o < 16; o <<= 1) mx = fmaxf(mx, __shfl_xor(mx, o));
        const float sink = C.sinks[layer * 16 + h];
        const float mm = fmaxf(mx, sink);
        float sum = 0.f;
#pragma unroll 1
        for (int it = 0; it < 9; ++it) { const int kk = kg + 16 * it; if (kk < 132) { const float e = __expf(Pm[r * 133 + kk] - mm); Pm[r * 133 + kk] = e; sum += e; } }
#pragma unroll
        for (int o = 1; o < 16; o <<= 1) sum += __shfl_xor(sum, o);
        const float inv = 1.0f / (sum + __expf(sink - mm));
#pragma unroll 1
        for (int it = 0; it < 9; ++it) { const int kk = kg + 16 * it; if (kk < 132) Pm[r * 133 + kk] *= inv; }
    }
    __syncthreads();
    {
        const int r = tid >> 4, dq = tid & 15, t = r & 3, h = kvh * 8 + (r >> 2);
        f32x4 o = (f32x4){0.f, 0.f, 0.f, 0.f};
        for (int kk = 0; kk < 132; ++kk) { const float p = Pm[r * 133 + kk]; const f32x4 v = *(const f32x4*)(Vl + kk * 68 + 4 * dq); o += v * p; }
        const size_t row = (size_t)(T + 4 * b + t);
        const u32x2 gt = *(const u32x2*)(P + row * NP + C_GA + h * 64 + 4 * dq);
        u32x2 yo; yo.x = cvtpk(o[0] * silu_f(bf_lo(gt.x)), o[1] * silu_f(bf_hi(gt.x))); yo.y = cvtpk(o[2] * silu_f(bf_lo(gt.y)), o[3] * silu_f(bf_hi(gt.y)));
        *(u32x2*)(Y + row * D + h * 64 + 4 * dq) = yo;
    }
    __syncthreads();
}

__device__ __forceinline__ void ret_sample_group(const Ctx& C, char* lds, int layer, int ug, int tid, int w, int lane) {
    const bf16* P = (const bf16*)(C.ws + WS_P); bf16* Y = (bf16*)(C.ws + WS_Y);
    const int idx = 4 * ug + (w >> 1), b = idx >> 3, h = idx & 7, eh = w & 1;
    float* qs = (float*)(lds + w * 4096);
    float* ksm = qs + 512;
    float* pst = (float*)(lds + 32768);
    const float lng = ln_gamma(h);
    const size_t ro = (size_t)(T + 4 * b) * NP;
    float qv[4][2], kv[4][2];
    {
        const int g0 = 2 * lane, g1 = g0 + 1;
        const int d0 = 4 * (g0 >> 3) + (g0 & 3) + 64 * ((g0 >> 2) & 1), d1 = 4 * (g1 >> 3) + (g1 & 3) + 64 * ((g1 >> 2) & 1);
#pragma unroll
        for (int t = 0; t < 4; ++t) {
            const unsigned qq = *(const unsigned*)(P + ro + (size_t)t * NP + C_QB + h * 128 + g0), kk = *(const unsigned*)(P + ro + (size_t)t * NP + C_KB + h * 128 + g0);
            qv[t][0] = bf_lo(qq); qv[t][1] = bf_hi(qq); kv[t][0] = bf_lo(kk); kv[t][1] = bf_hi(kk);
            const float kd = __expf((float)(3 - t) * lng);
            qs[t * 128 + d0] = qv[t][0]; qs[t * 128 + d1] = qv[t][1]; ksm[t * 128 + d0] = kv[t][0] * kd; ksm[t * 128 + d1] = kv[t][1] * kd;
        }
    }
    const int e4 = lane & 15, dq = lane >> 4, e = eh * 64 + 4 * e4;
    f32x4 vm[4];
#pragma unroll
    for (int m = 0; m < 4; ++m) { const u32x2 vv = *(const u32x2*)(P + ro + (size_t)m * NP + C_VB + h * 128 + e); vm[m] = (f32x4){bf_lo(vv.x), bf_hi(vv.x), bf_lo(vv.y), bf_hi(vv.y)}; }
    float* Aw = (float*)(lds + 33024) + w * 16;
#pragma unroll
    for (int t = 0; t < 4; ++t)
#pragma unroll
        for (int m = 0; m < 4; ++m) {
            float a = 0.f;
            if (m <= t) { a = qv[t][0] * kv[m][0] + qv[t][1] * kv[m][1];
#pragma unroll
                for (int o = 1; o < 64; o <<= 1) a += __shfl_xor(a, o);
                a *= __expf((float)(t - m) * lng); }
            if (lane == 0) Aw[t * 4 + m] = a;
        }
    LDS_WAIT();
    const float* r0 = C.state + ((size_t)(layer * 128 + b) * 8 + h) * 16384 + e;
    float* rout = C.out + O_RS + ((size_t)(layer * 128 + b) * 8 + h) * 16384 + e;
    const float g4 = __expf(4.0f * lng);
    f32x4 acc[4];
#pragma unroll
    for (int t = 0; t < 4; ++t) acc[t] = (f32x4){0.f, 0.f, 0.f, 0.f};
#pragma unroll 1
    for (int i0 = 0; i0 < 32; i0 += 8) {
        f32x4 r[8];
#pragma unroll
        for (int k = 0; k < 8; ++k) r[k] = __builtin_nontemporal_load((const f32x4*)(r0 + (4 * (i0 + k) + dq) * 128));
#pragma unroll
        for (int k = 0; k < 8; ++k) {
            const int d = 4 * (i0 + k) + dq;
            const f32x4 rn = r[k] * g4 + vm[0] * ksm[d] + vm[1] * ksm[128 + d] + vm[2] * ksm[256 + d] + vm[3] * ksm[384 + d];
            __builtin_nontemporal_store(rn, (f32x4*)(rout + d * 128));
#pragma unroll
            for (int t = 0; t < 4; ++t) acc[t] += r[k] * qs[t * 128 + d];
        }
    }
    float o[4][4]; float s1[4], s2[4];
#pragma unroll
    for (int t = 0; t < 4; ++t) {
        const float qd = __expf((float)(t + 1) * lng);
        s1[t] = 0.f; s2[t] = 0.f;
#pragma unroll
        for (int j = 0; j < 4; ++j) {
            float a = acc[t][j]; a += __shfl_xor(a, 16); a += __shfl_xor(a, 32);
            a *= qd;
#pragma unroll
            for (int m = 0; m < 4; ++m) a += Aw[t * 4 + m] * vm[m][j];
            o[t][j] = a; s1[t] += a; s2[t] += a * a;
        }
#pragma unroll
        for (int k = 1; k < 16; k <<= 1) { s1[t] += __shfl_xor(s1[t], k); s2[t] += __shfl_xor(s2[t], k); }
        if (lane == 0) { pst[(w * 4 + t) * 2] = s1[t]; pst[(w * 4 + t) * 2 + 1] = s2[t]; }
    }
    __syncthreads();
    if (lane < 16) {
        const float* gw = C.ret_norm_w + layer * 1024 + h * 128 + e;
        const f32x4 wv = *(const f32x4*)gw;
#pragma unroll
        for (int t = 0; t < 4; ++t) {
            const float S1 = pst[(w * 4 + t) * 2] + pst[((w ^ 1) * 4 + t) * 2], S2 = pst[(w * 4 + t) * 2 + 1] + pst[((w ^ 1) * 4 + t) * 2 + 1];
            const float mu = S1 * (1.0f / 128.0f), var = fmaxf(S2 * (1.0f / 128.0f) - mu * mu, 0.f), rs = rsqrtf(var + 1e-6f);
            const size_t row = (size_t)(T + 4 * b + t);
            const u32x2 gt = *(const u32x2*)(P + row * NP + C_GB + h * 128 + e);
            u32x2 yo; yo.x = cvtpk((o[t][0] - mu) * rs * wv[0] * silu_f(bf_lo(gt.x)), (o[t][1] - mu) * rs * wv[1] * silu_f(bf_hi(gt.x)));
            yo.y = cvtpk((o[t][2] - mu) * rs * wv[2] * silu_f(bf_lo(gt.y)), (o[t][3] - mu) * rs * wv[3] * silu_f(bf_hi(gt.y)));
            *(u32x2*)(Y + row * D + 1024 + h * 128 + e) = yo;
        }
    }
    __syncthreads();
}

__device__ __forceinline__ void outproj_sample_unit(const Ctx& C, char* lds, int layer, int u, int tid, int w, int lane) {
    const bf16* Yb = (const bf16*)(C.ws + WS_Y) + (size_t)T * D; const bf16* Wt = (const bf16*)(C.ws + WS_WOUT) + (size_t)layer * D * D;
    const int m0 = (u >> 5) * 64, n0 = (u & 31) * 64, q = lane & 15, g = lane >> 4, k0 = 256 * w;
    f32x4 acc[4][4];
#pragma unroll
    for (int nt = 0; nt < 4; ++nt)
#pragma unroll
        for (int mt = 0; mt < 4; ++mt) acc[nt][mt] = (f32x4){0.f, 0.f, 0.f, 0.f};
    const int em = tid >> 3, en8 = (tid & 7) * 8;
    const float* bpz = (layer == 0 ? C.x_sample : (const float*)(C.ws + WS_XR) + (size_t)T * D) + (size_t)(m0 + em) * D + n0 + en8;
    const f32x4 rz0 = *(const f32x4*)bpz, rz1 = *(const f32x4*)(bpz + 4);
    const bf16* ap = Wt + (size_t)(n0 + q) * D + k0 + 8 * g;
    const bf16* bp = Yb + (size_t)(m0 + q) * D + k0 + 8 * g;
    bf16x8 af[2][2][4], bfr[2][2][4];
#define OSU_LOAD(buf, kb) do { _Pragma("unroll") for (int ks = 0; ks < 2; ++ks) _Pragma("unroll") for (int t4 = 0; t4 < 4; ++t4) { \
        af[buf][ks][t4] = *(const bf16x8*)(ap + (size_t)(16 * t4) * D + 64 * (kb) + 32 * ks); bfr[buf][ks][t4] = *(const bf16x8*)(bp + (size_t)(16 * t4) * D + 64 * (kb) + 32 * ks); } } while (0)
    OSU_LOAD(0, 0);
#pragma unroll
    for (int kb = 0; kb < 4; ++kb) {
        if (kb + 1 < 4) { if ((kb & 1) == 0) OSU_LOAD(1, kb + 1); else OSU_LOAD(0, kb + 1); }
#pragma unroll
        for (int ks = 0; ks < 2; ++ks)
#pragma unroll
            for (int nt = 0; nt < 4; ++nt)
#pragma unroll
                for (int mt = 0; mt < 4; ++mt) acc[nt][mt] = __builtin_amdgcn_mfma_f32_16x16x32_bf16(af[kb & 1][ks][nt], bfr[kb & 1][ks][mt], acc[nt][mt], 0, 0, 0);
    }
#undef OSU_LOAD
    float* part = (float*)lds + w * (64 * 68);
#pragma unroll
    for (int nt = 0; nt < 4; ++nt)
#pragma unroll
        for (int mt = 0; mt < 4; ++mt) *(f32x4*)(part + (16 * mt + q) * 68 + 16 * nt + 4 * g) = acc[nt][mt];
    __syncthreads();
    {
        const int m = tid >> 3, n8 = (tid & 7) * 8;
        f32x4 v0 = (f32x4){0.f, 0.f, 0.f, 0.f}, v1 = v0;
#pragma unroll
        for (int ww = 0; ww < 8; ++ww) { const float* pp = (const float*)lds + ww * (64 * 68) + m * 68 + n8; v0 += *(const f32x4*)pp; v1 += *(const f32x4*)(pp + 4); }
        const int rs_ = m0 + m;
        float* XR = (float*)(C.ws + WS_XR);
        float* op = (layer == 0 ? XR : C.out) + (size_t)(T + rs_) * D + n0 + n8;
        v0 += rz0; v1 += rz1;
        *(f32x4*)op = v0; *(f32x4*)(op + 4) = v1;
        if (layer == 0) { u32x4 wv; wv.x = cvtpk(v0[0], v0[1]); wv.y = cvtpk(v0[2], v0[3]); wv.z = cvtpk(v1[0], v1[1]); wv.w = cvtpk(v1[2], v1[3]);
            *(u32x4*)((bf16*)(C.ws + WS_XA) + (size_t)(T + rs_) * D + n0 + n8) = wv; }
        float ss = (v0[0] * v0[0] + v0[1] * v0[1]) + (v0[2] * v0[2] + v0[3] * v0[3]) + (v1[0] * v1[0] + v1[1] * v1[1]) + (v1[2] * v1[2] + v1[3] * v1[3]);
        ss += __shfl_xor(ss, 1); ss += __shfl_xor(ss, 2); ss += __shfl_xor(ss, 4);
        if ((tid & 7) == 0) atomicAdd((float*)(C.ws + WS_CTL) + (layer + 1) * M + T + rs_, ss);
    }
    __syncthreads();
}

#ifndef SKIPM
#define SKIPM 0
#endif
#ifndef REPU
#define REPU 0
#endif
#ifndef REP_P0
#define REP_P0 1
#endif
#ifndef REP_G1
#define REP_G1 1
#endif
#ifndef REP_MX1
#define REP_MX1 1
#endif
#ifndef REP_RP
#define REP_RP 1
#endif
#ifndef REP_G2
#define REP_G2 1
#endif

#define GAS __attribute__((address_space(1)))
typedef GAS unsigned gu32;
#define XB_TMO      128
#define XB_XCNT(j)  (256  + 64 * (j))
#define XB_XSUB(j)  (1280 + 64 * (j))
#define XB_XGEN(j)  (2304 + 64 * (j))
#define XB_TOP      3328
#define XB_TOPGEN   3392
#define XCD_BAR_WORDS 3456
#define XB_SPIN_CAP (1u << 18)

__device__ __forceinline__ unsigned xb_ld(unsigned* p)              { return __hip_atomic_load(p, __ATOMIC_RELAXED, __HIP_MEMORY_SCOPE_AGENT); }
__device__ __forceinline__ unsigned xb_add(unsigned* p, unsigned v) { return __hip_atomic_fetch_add(p, v, __ATOMIC_RELAXED, __HIP_MEMORY_SCOPE_AGENT); }
__device__ __forceinline__ unsigned xb_xcc_id() { return (unsigned)__builtin_amdgcn_s_getreg((3 << 11) | 20) & 0xFu; }
#define XB_SPIN(cond, bar) do { unsigned _sp = 0; while (cond) { __builtin_amdgcn_s_sleep(1); \
    if ((++_sp & 255u) == 0u) { if (xb_ld(&(bar)[XB_TMO])) break; if (_sp > XB_SPIN_CAP) { atomicAdd(&(bar)[XB_TMO], 1u); break; } } } } while (0)

struct XcdBarrier {
    unsigned* bar; unsigned x;
    volatile LAS unsigned* st;
};

__device__ __forceinline__ XcdBarrier xcd_barrier_post(unsigned* bar, volatile LAS unsigned* st) {
    XcdBarrier b; b.bar = bar; b.x = xb_xcc_id(); b.st = st;
    if (threadIdx.x == 0) (void)xb_add(&bar[XB_XCNT(b.x)], 1u);
    return b;
}
__device__ __forceinline__ void xcd_barrier_complete(unsigned* bar, unsigned x, unsigned& nloc, unsigned& nx) {
    const unsigned G = gridDim.x * gridDim.y * gridDim.z;
    unsigned sum, cnt, mine, sp = 0u;
    for (;;) {
        sum = 0u; cnt = 0u; mine = 0u;
#pragma unroll
        for (unsigned j = 0; j < 16; ++j) { const unsigned c = xb_ld(&bar[XB_XCNT(j)]); sum += c; cnt += (c > 0u) ? 1u : 0u; mine = (j == x) ? c : mine; }
        if (sum == G) break;
        __builtin_amdgcn_s_sleep(1);
        if ((++sp & 255u) == 0u) { if (xb_ld(&bar[XB_TMO])) break; if (sp > XB_SPIN_CAP) { atomicAdd(&bar[XB_TMO], 1u); break; } }
    }
    nloc = mine > 0u ? mine : 1u; nx = cnt > 0u ? cnt : 1u;
}

__device__ __forceinline__ void xcd_barrier(const XcdBarrier& b) {
    asm volatile("s_waitcnt vmcnt(0)" ::: "memory");
    __syncthreads();
    if (threadIdx.x == 0) {
        unsigned* bar = b.bar;
        __builtin_amdgcn_s_waitcnt(0);
        unsigned nloc = b.st[0], nx = b.st[1];
        if (nloc == 0u) { xcd_barrier_complete(bar, b.x, nloc, nx); b.st[0] = nloc; b.st[1] = nx; }
        const unsigned old = xb_add(&bar[XB_XSUB(b.x)], 1u);
        const unsigned gen = old / nloc;
        if (old + 1u == (gen + 1u) * nloc) {
            __builtin_amdgcn_fence(__ATOMIC_RELEASE, "agent");
            asm volatile("s_waitcnt vmcnt(0)" ::: "memory");
            const unsigned og = xb_add(&bar[XB_TOP], 1u);
            const unsigned tg = og / nx;
            if (og + 1u == (tg + 1u) * nx) xb_add(&bar[XB_TOPGEN], 1u);
            else XB_SPIN(xb_ld(&bar[XB_TOPGEN]) == tg, bar);
            __builtin_amdgcn_fence(__ATOMIC_ACQUIRE, "agent");
            xb_add(&bar[XB_XGEN(b.x)], 1u);
            asm volatile("s_waitcnt vmcnt(0)" ::: "memory");
        } else {
            XB_SPIN(xb_ld(&bar[XB_XGEN(b.x)]) == gen, bar);
            __builtin_amdgcn_fence(__ATOMIC_ACQUIRE, "agent");
            asm volatile("s_waitcnt vmcnt(0)" ::: "memory");
        }
    }
    __syncthreads();
}

constexpr size_t WS_BAR = WS_CTL + 768 * 1024;
constexpr int LDS_BARST = LDS_BYTES - 64;
__global__ void __launch_bounds__(NTHREADS, 2) hymba_fwd(Ctx C) {
    extern __shared__ __attribute__((aligned(16))) unsigned char lds_raw[];
    cg::grid_group grid = cg::this_grid();
    if (threadIdx.x < 2) ((volatile LAS unsigned*)((LAS unsigned char*)lds_raw + LDS_BARST))[threadIdx.x] = 0u;
    __syncthreads();
    (void)xcd_barrier_post((unsigned*)(C.ws + WS_BAR), (volatile LAS unsigned*)((LAS unsigned char*)lds_raw + LDS_BARST));
    int ph = 0;
#define PHASE_LOCALS2 int tid = threadIdx.x; LAUNDER_V(tid); const int lane = tid & 63, wave = __builtin_amdgcn_readfirstlane(tid >> 6); char* lds = (char*)lds_raw; Ctx Cc = C; LAUNDER_S(Cc.ws); (void)lane; (void)wave; (void)lds
#define TAIL_OK(G_) ((G_) * 4 >= 850 && 850 - 3 * (G_) > 0 && 850 - 3 * (G_) < (G_))
#define PHASE_BEGIN (C.ph_lo <= ph && ph < C.ph_hi)
#define PHASE_END do { if (C.ph_lo <= ph && ph + 1 < C.ph_hi) { if (C.ph_lo < 0) grid.sync(); else { XcdBarrier xb_; xb_.bar = (unsigned*)(C.ws + WS_BAR); xb_.x = xb_xcc_id(); xb_.st = (volatile LAS unsigned*)((LAS unsigned char*)lds_raw + LDS_BARST); xcd_barrier(xb_); } } ++ph; } while (0)
#define PHASE_LOCALS int tid = threadIdx.x; LAUNDER_V(tid); const int lane = tid & 63, wave = __builtin_amdgcn_readfirstlane(tid >> 6); \
    int G = gridDim.x, bid = blockIdx.x; LAUNDER_S(G); LAUNDER_S(bid); char* lds = (char*)lds_raw; Ctx Cc = C; LAUNDER_S(Cc.ws); (void)lane; (void)wave; (void)lds

    if (PHASE_BEGIN) { PHASE_LOCALS; for (int rep = 0; rep < REP_P0; ++rep) { p0_prologue(Cc, lds, tid, wave, lane, G); __syncthreads(); } }
    PHASE_END;

    {
        constexpr int layer = 0;
        if (PHASE_BEGIN) {
            unsigned char* ws = C.ws; const int G = gridDim.x, bid = blockIdx.x;
            float* rss = (float*)(ws + WS_CTL); float* cosA = (float*)(ws + WS_TAB); float* sinA = cosA + NPOS * 32; float* cosB = sinA + NPOS * 32; float* sinB = cosB + NPOS * 64;
            pg8::Gemm g{(const bf16*)(ws + WS_XA), (const bf16*)(ws + WS_WIN) + (size_t)layer * NP * D, M, NP, D};
            pg8::EpiProj E{layer};
            unsigned* scnt = (unsigned*)(ws + WS_CTL) + 28672 + 64 * layer;
            {
                pg8::SampleFirstOrder S{G, bid, scnt};
                pg8::gemm_phase<pg8::EpiProj, pg8::SampleFirstOrder, true, true>((LAS unsigned char*)lds_raw, g, S, E);
                const bool tail = TAIL_OK(G);
                const int nfull = tail ? 850 - 3 * G : 0;
                if (bid >= nfull) {
                    PHASE_LOCALS2; int ly = layer; LAUNDER_S(ly);
                    if (ly == 0) convert_weights(Cc, (float*)(lds + wave * 16640), 1, (bid - nfull) * 8 + wave, (G - nfull) * 8, lane);
                    if (tail) {
                        __syncthreads();
                        if (tid == 0) { unsigned sp = 0u; while (__hip_atomic_load(scnt, __ATOMIC_RELAXED, __HIP_MEMORY_SCOPE_AGENT) < 50u && ++sp < (1u << 24)) __builtin_amdgcn_s_sleep(8);
                            __builtin_amdgcn_fence(__ATOMIC_ACQUIRE, "agent"); asm volatile("s_waitcnt vmcnt(0)" ::: "memory"); }
                        __syncthreads();
                        for (int ug = bid - nfull; ug < 256; ug += G - nfull) { int tu = tid; LAUNDER_V(tu); ret_sample_group(Cc, lds, ly, ug, tu, wave, tu & 63); }
                    }
                }
            }
        }
        PHASE_END;
        if (PHASE_BEGIN) {
            PHASE_LOCALS; int ly = layer; LAUNDER_S(ly);
            const int nunits = TAIL_OK(G) ? 1024 : 1280; const int tid_p = tid;
            for (int rep = 0; rep < REP_MX1; ++rep) for (int u = bid; u < nunits; u += G) {
                int tid = tid_p; LAUNDER_V(tid); const int lane = tid & 63;
                if (u < 512) { for (int r2 = 0; r2 < 1 + (REPU & 1); ++r2) ret_u_unit(Cc, lds, u >> 3, u & 7, tid, wave, lane); }
                else if (u < 768) { const int a = u - 512; for (int r2 = 0; r2 < 1 + ((REPU >> 1) & 1); ++r2) attn_prompt_unit(Cc, lds, ly, a >> 2, (a >> 1) & 1, a & 1, tid, wave, lane); }
                else if (u < 1024) { const int a = u - 768; for (int r2 = 0; r2 < 1 + ((REPU >> 2) & 1); ++r2) attn_sample_unit(Cc, lds, ly, a >> 1, a & 1, tid); }
                else { const int a = u - 1024; ret_sample_group(Cc, lds, ly, a, tid, wave, lane); }
            }
        }
        PHASE_END;
        if (PHASE_BEGIN) { PHASE_LOCALS; int ly = layer; LAUNDER_S(ly); for (int r2 = 0; r2 < 1 + ((REPU >> 4) & 1); ++r2) ret_scan(Cc, ly, tid, G); for (int u = bid; u < 256; u += G) outproj_sample_unit(Cc, lds, ly, u, tid, wave, lane); }
        PHASE_END;
        if (PHASE_BEGIN) { PHASE_LOCALS; int ly = layer; LAUNDER_S(ly); for (int rep = 0; rep < REP_RP; ++rep) for (int u = bid; u < 512; u += G) if (!(SKIPM & 16)) ret_prompt_unit(Cc, lds, ly, u >> 3, u & 7, tid, wave, lane); }
        PHASE_END;
        if (PHASE_BEGIN) {
            unsigned char* ws = C.ws; const int G = gridDim.x, bid = blockIdx.x;
            float* rss = (float*)(ws + WS_CTL); float* XR = (float*)(ws + WS_XR);
            pg8::Gemm g{(const bf16*)(ws + WS_Y), (const bf16*)(ws + WS_WOUT) + (size_t)layer * D * D, T, D, D}; pg8::StaticOrder S; S.init(T, D, G, bid);
            pg8::EpiRes E{layer};
            pg8::gemm_phase<pg8::EpiRes, pg8::StaticOrder, true, true>((LAS unsigned char*)lds_raw, g, S, E);
        }
        PHASE_END;
    }
    {
        constexpr int layer = 1;
        if (PHASE_BEGIN) {
            unsigned char* ws = C.ws; const int G = gridDim.x, bid = blockIdx.x;
            float* rss = (float*)(ws + WS_CTL); float* cosA = (float*)(ws + WS_TAB); float* sinA = cosA + NPOS * 32; float* cosB = sinA + NPOS * 32; float* sinB = cosB + NPOS * 64;
            pg8::Gemm g{(const bf16*)(ws + WS_XA), (const bf16*)(ws + WS_WIN) + (size_t)layer * NP * D, M, NP, D};
            pg8::EpiProj E{layer};
            unsigned* scnt = (unsigned*)(ws + WS_CTL) + 28672 + 64 * layer;
            {
                pg8::SampleFirstOrder S{G, bid, scnt};
                pg8::gemm_phase<pg8::EpiProj, pg8::SampleFirstOrder, true, true>((LAS unsigned char*)lds_raw, g, S, E);
                const bool tail = TAIL_OK(G);
                const int nfull = tail ? 850 - 3 * G : 0;
                if (bid >= nfull) {
                    PHASE_LOCALS2; int ly = layer; LAUNDER_S(ly);
                    if (ly == 0) convert_weights(Cc, (float*)(lds + wave * 16640), 1, (bid - nfull) * 8 + wave, (G - nfull) * 8, lane);
                    if (tail) {
                        __syncthreads();
                        if (tid == 0) { unsigned sp = 0u; while (__hip_atomic_load(scnt, __ATOMIC_RELAXED, __HIP_MEMORY_SCOPE_AGENT) < 50u && ++sp < (1u << 24)) __builtin_amdgcn_s_sleep(8);
                            __builtin_amdgcn_fence(__ATOMIC_ACQUIRE, "agent"); asm volatile("s_waitcnt vmcnt(0)" ::: "memory"); }
                        __syncthreads();
                        for (int ug = bid - nfull; ug < 256; ug += G - nfull) { int tu = tid; LAUNDER_V(tu); ret_sample_group(Cc, lds, ly, ug, tu, wave, tu & 63); }
                    }
                }
            }
        }
        PHASE_END;
        if (PHASE_BEGIN) {
            PHASE_LOCALS; int ly = layer; LAUNDER_S(ly);
            const int nunits = TAIL_OK(G) ? 1024 : 1280; const int tid_p = tid;
            for (int rep = 0; rep < REP_MX1; ++rep) for (int u = bid; u < nunits; u += G) {
                int tid = tid_p; LAUNDER_V(tid); const int lane = tid & 63;
                if (u < 512) { for (int r2 = 0; r2 < 1 + (REPU & 1); ++r2) ret_u_unit(Cc, lds, u >> 3, u & 7, tid, wave, lane); }
                else if (u < 768) { const int a = u - 512; for (int r2 = 0; r2 < 1 + ((REPU >> 1) & 1); ++r2) attn_prompt_unit(Cc, lds, ly, a >> 2, (a >> 1) & 1, a & 1, tid, wave, lane); }
                else if (u < 1024) { const int a = u - 768; for (int r2 = 0; r2 < 1 + ((REPU >> 2) & 1); ++r2) attn_sample_unit(Cc, lds, ly, a >> 1, a & 1, tid); }
                else { const int a = u - 1024; ret_sample_group(Cc, lds, ly, a, tid, wave, lane); }
            }
        }
        PHASE_END;
        if (PHASE_BEGIN) { PHASE_LOCALS; int ly = layer; LAUNDER_S(ly); for (int r2 = 0; r2 < 1 + ((REPU >> 4) & 1); ++r2) ret_scan(Cc, ly, tid, G); for (int u = bid; u < 256; u += G) outproj_sample_unit(Cc, lds, ly, u, tid, wave, lane); }
        PHASE_END;
        if (PHASE_BEGIN) { PHASE_LOCALS; int ly = layer; LAUNDER_S(ly); for (int rep = 0; rep < REP_RP; ++rep) for (int u = bid; u < 512; u += G) if (!(SKIPM & 16)) ret_prompt_unit(Cc, lds, ly, u >> 3, u & 7, tid, wave, lane); }
        PHASE_END;
        if (PHASE_BEGIN) {
            unsigned char* ws = C.ws; const int G = gridDim.x, bid = blockIdx.x;
            float* rss = (float*)(ws + WS_CTL); float* XR = (float*)(ws + WS_XR);
            pg8::Gemm g{(const bf16*)(ws + WS_Y), (const bf16*)(ws + WS_WOUT) + (size_t)layer * D * D, T, D, D}; pg8::StaticOrder S; S.init(T, D, G, bid);
            pg8::EpiRes E{layer};
            pg8::gemm_phase<pg8::EpiRes, pg8::StaticOrder, true, true>((LAS unsigned char*)lds_raw, g, S, E);
        }
        PHASE_END;
    }
#ifdef REP_SYNC
    for (int rep = 0; rep < REP_SYNC; ++rep) { XcdBarrier xb_; xb_.bar = (unsigned*)(C.ws + WS_BAR); xb_.x = xb_xcc_id(); xb_.st = (volatile LAS unsigned*)((LAS unsigned char*)lds_raw + LDS_BARST); xcd_barrier(xb_); }
#endif
    if (PHASE_BEGIN) {
        PHASE_LOCALS;
        const float* rf = (const float*)(Cc.ws + WS_CTL) + 2 * M;
        for (int m = bid * 8 + wave; m < M; m += G * 8) {
            const float rv = rsqrtf(rf[m] * (1.0f / 2048.0f) + 1e-6f);
            f32x4* xr = (f32x4*)(Cc.out + (size_t)m * D);
#pragma unroll
            for (int j = 0; j < 8; ++j) { const f32x4 wv = *((const f32x4*)Cc.final_w + lane + 64 * j); xr[lane + 64 * j] = xr[lane + 64 * j] * rv * wv; }
        }
    }
}

constexpr int N_PHASES = 1 + DEPTH * 5 + 1;
#ifndef MK_MULTI
#define MK_MULTI 0
#endif
extern "C" void kernel_launch(void* const* d_in, const int* in_sizes, int n_in, void* d_out, int out_size, void* d_ws, size_t ws_size, hipStream_t stream) {
    static int grid = 0;
    if (grid == 0) {
        if (n_in != 11 || ws_size < WS_END) { fprintf(stderr, "kernel_launch: unexpected inputs (n_in %d, ws %zu)\n", n_in, ws_size); grid = -1; return; }
        int dev = 0, cus = 0, per_cu = 0;
        hipGetDevice(&dev); hipDeviceGetAttribute(&cus, hipDeviceAttributeMultiprocessorCount, dev);
        if (hipFuncSetAttribute((const void*)hymba_fwd, hipFuncAttributeMaxDynamicSharedMemorySize, LDS_BYTES) != hipSuccess) { fprintf(stderr, "kernel_launch: hipFuncSetAttribute failed\n"); grid = -1; return; }
        if (hipOccupancyMaxActiveBlocksPerMultiprocessor(&per_cu, (const void*)hymba_fwd, NTHREADS, LDS_BYTES) != hipSuccess || per_cu < 1) { fprintf(stderr, "kernel_launch: occupancy query says %d\n", per_cu); (void)hipGetLastError(); per_cu = 1; }
        grid = cus;
    }
    if (grid < 0) return;
    hipMemsetAsync((char*)d_ws + WS_CTL, 0, CTL_BYTES, stream);
    Ctx c{};
    c.x_prompt = (const float*)d_in[0]; c.x_sample = (const float*)d_in[1]; c.cache_k = (const float*)d_in[2]; c.cache_v = (const float*)d_in[3]; c.state = (const float*)d_in[4];
    c.norm_w = (const float*)d_in[5]; c.w_in = (const float*)d_in[6]; c.sinks = (const float*)d_in[7]; c.ret_norm_w = (const float*)d_in[8]; c.w_out = (const float*)d_in[9]; c.final_w = (const float*)d_in[10];
    c.out = (float*)d_out; c.ws = (unsigned char*)d_ws;
#if MK_MULTI
    for (int p = 0; p < N_PHASES; ++p) { c.ph_lo = p; c.ph_hi = p + 1; void* args[] = {&c};
        hipError_t e = hipLaunchCooperativeKernel((const void*)hymba_fwd, dim3(grid), dim3(NTHREADS), args, LDS_BYTES, stream);
        if (e != hipSuccess) { fprintf(stderr, "launch %d failed: %s\n", p, hipGetErrorString(e)); break; } }
#else
    c.ph_lo = 0; c.ph_hi = N_PHASES; void* args[] = {&c};
    hipError_t e = hipLaunchCooperativeKernel((const void*)hymba_fwd, dim3(grid), dim3(NTHREADS), args, LDS_BYTES, stream);
    if (e != hipSuccess) fprintf(stderr, "cooperative launch failed: %s (grid %d)\n", hipGetErrorString(e), grid);
#endif
}
```

```cpp
#include <hip/hip_runtime.h>
#include <hip/hip_cooperative_groups.h>
#include <cstdio>
#include <cstdint>
namespace cg = cooperative_groups;
namespace pg8 {
#define PG8_LAS __attribute__((address_space(3)))
typedef unsigned short bf16_t;
typedef short bf16x8 __attribute__((ext_vector_type(8)));
typedef float f32x4 __attribute__((ext_vector_type(4)));
typedef unsigned u32x4 __attribute__((ext_vector_type(4)));
constexpr int BM = 256, BK = 64, HALF = 128, HTB = HALF * BK * 2  , STAGE_BYTES = 8 * HTB, NXCD = 8, WGM = 8;

__host__ __device__ __forceinline__ int lds_byte(int r, int c) { const int st = (r >> 4) * 2 + (c >> 5), rr = r & 15, cc = c & 31, ob = rr * 64 + cc * 2; return st * 1024 + (ob ^ (((ob >> 9) & 1) << 5)); }
__host__ __device__ __forceinline__ void stage_rc(int b, int& R, int& C) { const int st = b / 1024, sb = b % 1024, swz = sb ^ (((sb >> 9) & 1) << 5); R = (st >> 1) * 16 + swz / 64; C = (st & 1) * 32 + (swz % 64) / 2; }
__host__ __device__ __forceinline__ int perm32(int rho) { const int n = rho >> 4, i = rho & 15; return 8 * (i >> 2) + 4 * n + (i & 3); }

struct Unit { int pm, pn; };
struct Gemm { const bf16_t* A; const bf16_t* Bt; int M, N, K; };

struct StaticOrder {
    int nM, nN, nwg, G, c;
    __host__ __device__ void init(int M, int N, int G_, int c_) { nM = M / BM; nN = N / BM; nwg = nM * nN; G = G_; c = c_; }
    __host__ __device__ bool next(int i, Unit& u) const {
        const long L = (long)i * G + c; if (L >= nwg) return false;
        int wgid = (int)L; { const int q = nwg / NXCD, r = nwg % NXCD, xcd = wgid % NXCD, off = wgid / NXCD; wgid = (xcd < r ? xcd * (q + 1) : r * (q + 1) + (xcd - r) * q) + off; }
        const int nig = WGM * nN, gid = wgid / nig, fm = gid * WGM, gsz = (nM - fm) < WGM ? (nM - fm) : WGM;
        u.pm = fm + ((wgid % nig) % gsz); u.pn = (wgid % nig) / gsz; return true;
    }
    __device__ __forceinline__ void a_ready(const Unit&) const {}
    __device__ __forceinline__ void done(const Unit&) const {}
};


struct SampleFirstOrder {
    int G, c; unsigned* cnt;
    __device__ __forceinline__ bool next(int i, Unit& u) const {
        const int L = i * G + c; if (L >= 850) return false;
        if (L < 50) { u.pm = 32 + L / 25; u.pn = L % 25; return true; }
        int wgid = L - 50; wgid = (wgid % NXCD) * 100 + wgid / NXCD;
        const int r = wgid % 200; u.pm = (wgid / 200) * WGM + (r % WGM); u.pn = r / WGM; return true;
    }
    __device__ __forceinline__ void a_ready(const Unit&) const {}
    __device__ __forceinline__ void done(const Unit& u) const {
        if (u.pm >= 32) {
            asm volatile("s_waitcnt vmcnt(0)" ::: "memory");
            __syncthreads();
            if (threadIdx.x == 0) { __builtin_amdgcn_fence(__ATOMIC_RELEASE, "agent"); asm volatile("s_waitcnt vmcnt(0)" ::: "memory");
                __hip_atomic_fetch_add(cnt, 1u, __ATOMIC_RELAXED, __HIP_MEMORY_SCOPE_AGENT); }
        }
    }
};
__device__ __forceinline__ unsigned cvt_pk_bf16(float lo, float hi) { unsigned r; asm volatile("v_cvt_pk_bf16_f32 %0, %1, %2" : "=v"(r) : "v"(lo), "v"(hi)); return r; }
constexpr int T_ = 8192, NPROJ = 6400, DMODEL = 2048;
struct KArgs { const float* in[11]; float* out; unsigned char* ws; int ph_lo, ph_hi; };
constexpr size_t EMiB = 1u << 20, EWS_XA = 68 * EMiB, EWS_P = 102 * EMiB, EWS_XR = 243 * EMiB, EWS_TAB = 359 * EMiB;
constexpr size_t O_KP = (size_t)8704 * 2048, O_VP = O_KP + 32768, O_RP = O_VP + 32768, O_KS = O_RP + 262144, O_VS = O_KS + 4194304, O_RS = O_VS + 4194304;

struct EpiProj {
    static constexpr bool PERM = true, AFTER_DRAIN = false;
    int layer;
    __device__ __forceinline__ void operator()(const f32x4 (&acc)[2][2][4][2], const Unit& u, int wr, int wc, int fr, int fq) const {
        const KArgs* kp = (const KArgs*)__builtin_amdgcn_kernarg_segment_ptr(); asm volatile("" : "+s"(kp));
        unsigned char* ws = kp->ws; float* out = kp->out;
        bf16_t* P = (bf16_t*)(ws + EWS_P); const float* rss = (const float*)ws + layer * 8704;
        const float* cosA = (const float*)(ws + EWS_TAB); const float* sinA = cosA + 8196 * 32; const float* cosB = sinA + 8196 * 32; const float* sinB = cosB + 8196 * 64;
        float rv[2][4];
#pragma unroll
        for (int ai = 0; ai < 2; ++ai)
#pragma unroll
            for (int m = 0; m < 4; ++m) rv[ai][m] = rsqrtf(rss[u.pm * BM + ai * HALF + wr * 64 + m * 16 + fr] * (1.0f / 2048.0f) + 1e-6f);
#pragma unroll
        for (int bj = 0; bj < 2; ++bj) {
            const int cb = u.pn * BM + bj * HALF;
            const int c0 = cb + wc * 32 + 8 * fq;
            const int mode = (cb < 1152) ? 1 : ((cb >= 2304 && cb < 4352) ? 2 : 0);
            const int kvmode = (cb == 1024) ? 1 : ((cb == 1152) ? 2 : 0);
#pragma unroll
            for (int ai = 0; ai < 2; ++ai)
#pragma unroll
                for (int m = 0; m < 4; ++m) {
                    const int row = u.pm * BM + ai * HALF + wr * 64 + m * 16 + fr;
                    f32x4 v0 = acc[ai][bj][m][0] * rv[ai][m], v1 = acc[ai][bj][m][1] * rv[ai][m];
                    if (mode) {
                        const int pos = row < T_ ? row : T_ + ((row - T_) & 3);
                        f32x4 c, s;
                        if (mode == 1) { const int i = (c0 & 63) >> 3; c = *(const f32x4*)(cosA + pos * 32 + 4 * i); s = *(const f32x4*)(sinA + pos * 32 + 4 * i); }
                        else { const int i = (c0 & 127) >> 3; c = *(const f32x4*)(cosB + pos * 64 + 4 * i); s = *(const f32x4*)(sinB + pos * 64 + 4 * i); }
                        const f32x4 y0 = v0 * c - v1 * s, y1 = v1 * c + v0 * s; v0 = y0; v1 = y1;
                    }
                    u32x4 w; w.x = cvt_pk_bf16(v0[0], v0[1]); w.y = cvt_pk_bf16(v0[2], v0[3]); w.z = cvt_pk_bf16(v1[0], v1[1]); w.w = cvt_pk_bf16(v1[2], v1[3]);
                    *(u32x4*)(P + (size_t)row * NPROJ + c0) = w;
                    if (kvmode && row >= T_ - 128) {
                        const int kvh = (c0 - cb) >> 6, g0 = c0 & 63;
                        float* dst;
                        if (row < T_) dst = out + (kvmode == 1 ? O_KP : O_VP) + ((size_t)(layer * 128 + (row - (T_ - 128))) * 2 + kvh) * 64;
                        else { const int b = (row - T_) >> 2, t = (row - T_) & 3; dst = out + (kvmode == 1 ? O_KS : O_VS) + ((((size_t)layer * 128 + b) * 128 + 124 + t) * 2 + kvh) * 64; }
                        if (kvmode == 1) { const int i = g0 >> 3; *(f32x4*)(dst + 4 * i) = v0; *(f32x4*)(dst + 4 * i + 32) = v1; }
                        else { *(f32x4*)(dst + g0) = v0; *(f32x4*)(dst + g0 + 4) = v1; }
                    }
                }
        }
    }
};

struct EpiRes {
    static constexpr bool PERM = true, AFTER_DRAIN = false;
    int layer;
    __device__ __forceinline__ void operator()(const f32x4 (&acc)[2][2][4][2], const Unit& u, int wr, int wc, int fr, int fq) const {
        const KArgs* kp = (const KArgs*)__builtin_amdgcn_kernarg_segment_ptr(); asm volatile("" : "+s"(kp));
        unsigned char* ws = kp->ws; bf16_t* xa = (bf16_t*)(ws + EWS_XA); float* rss = (float*)ws + (layer + 1) * 8704;
#pragma unroll
        for (int ai = 0; ai < 2; ++ai)
#pragma unroll
            for (int m = 0; m < 4; ++m) {
                const int row = u.pm * BM + ai * HALF + wr * 64 + m * 16 + fr;
                float ss = 0.f;
#pragma unroll
                for (int bj = 0; bj < 2; ++bj) {
                    const int c0 = u.pn * BM + bj * HALF + wc * 32 + 8 * fq;
                    f32x4 b0, b1;
                    if (layer == 0) { const float* bp = (row < T_ ? kp->in[0] + (size_t)row * DMODEL : kp->in[1] + (size_t)(row - T_) * DMODEL) + c0; b0 = *(const f32x4*)bp; b1 = *(const f32x4*)(bp + 4); }
                    else { const u32x4 xb = *(const u32x4*)(xa + (size_t)row * DMODEL + c0);
                        b0 = (f32x4){__uint_as_float(xb.x << 16), __uint_as_float(xb.x & 0xffff0000u), __uint_as_float(xb.y << 16), __uint_as_float(xb.y & 0xffff0000u)};
                        b1 = (f32x4){__uint_as_float(xb.z << 16), __uint_as_float(xb.z & 0xffff0000u), __uint_as_float(xb.w << 16), __uint_as_float(xb.w & 0xffff0000u)}; }
                    const f32x4 v0 = acc[ai][bj][m][0] + b0, v1 = acc[ai][bj][m][1] + b1;
                    if (layer == 0) { u32x4 w; w.x = cvt_pk_bf16(v0[0], v0[1]); w.y = cvt_pk_bf16(v0[2], v0[3]); w.z = cvt_pk_bf16(v1[0], v1[1]); w.w = cvt_pk_bf16(v1[2], v1[3]);
                        *(u32x4*)(xa + (size_t)row * DMODEL + c0) = w; }
                    else { float* op = kp->out + (size_t)row * DMODEL + c0; *(f32x4*)op = v0; *(f32x4*)(op + 4) = v1; }
                    ss += (v0[0] * v0[0] + v0[1] * v0[1]) + (v0[2] * v0[2] + v0[3] * v0[3]) + (v1[0] * v1[0] + v1[1] * v1[1]) + (v1[2] * v1[2] + v1[3] * v1[3]);
                }
                ss += __shfl_xor(ss, 16); ss += __shfl_xor(ss, 32);
                if (fq == 0) atomicAdd(rss + row, ss);
            }
    }
};


struct EpiResFinal {
    static constexpr bool PERM = true, AFTER_DRAIN = true;
    __device__ __forceinline__ void operator()(const f32x4 (&)[2][2][4][2], const Unit&, int, int, int, int) const {}
    __device__ __forceinline__ void fused(f32x4 (&acc)[2][2][4][2], const Unit& u, int wr, int wc, int fr, int fq, PG8_LAS unsigned char* lds, int wid, int lane) const {
        asm volatile("" : "+v"(fr), "+v"(fq));
        const KArgs* kp = (const KArgs*)__builtin_amdgcn_kernarg_segment_ptr(); asm volatile("" : "+s"(kp));
        unsigned char* ws = kp->ws; const bf16_t* xa = (const bf16_t*)(ws + EWS_XA);
        PG8_LAS float* P4 = (PG8_LAS float*)lds;
        PG8_LAS float* S = (PG8_LAS float*)(lds + 4096);
        PG8_LAS unsigned* flag = (PG8_LAS unsigned*)(lds + 8192);
        unsigned* slots = (unsigned*)(ws + EWS_XR);
        unsigned* cnt = (unsigned*)ws + 32768 + 64 * u.pm;
#pragma unroll
        for (int ai = 0; ai < 2; ++ai)
#pragma unroll
            for (int m = 0; m < 4; ++m) {
                const int rl = ai * HALF + wr * 64 + m * 16 + fr, row = u.pm * BM + rl;
                float ss = 0.f;
#pragma unroll
                for (int bj = 0; bj < 2; ++bj) {
                    const int c0 = u.pn * BM + bj * HALF + wc * 32 + 8 * fq;
                    const u32x4 xb = *(const u32x4*)(xa + (size_t)row * DMODEL + c0);
                    const f32x4 b0 = (f32x4){__uint_as_float(xb.x << 16), __uint_as_float(xb.x & 0xffff0000u), __uint_as_float(xb.y << 16), __uint_as_float(xb.y & 0xffff0000u)};
                    const f32x4 b1 = (f32x4){__uint_as_float(xb.z << 16), __uint_as_float(xb.z & 0xffff0000u), __uint_as_float(xb.w << 16), __uint_as_float(xb.w & 0xffff0000u)};
                    const f32x4 v0 = acc[ai][bj][m][0] + b0, v1 = acc[ai][bj][m][1] + b1;
                    acc[ai][bj][m][0] = v0; acc[ai][bj][m][1] = v1;
                    ss += (v0[0] * v0[0] + v0[1] * v0[1]) + (v0[2] * v0[2] + v0[3] * v0[3]) + (v1[0] * v1[0] + v1[1] * v1[1]) + (v1[2] * v1[2] + v1[3] * v1[3]);
                }
                ss += __shfl_xor(ss, 16); ss += __shfl_xor(ss, 32);
                if (fq == 0) P4[rl * 4 + wc] = ss;
            }
        asm volatile("s_waitcnt lgkmcnt(0)" ::: "memory"); __builtin_amdgcn_s_barrier(); asm volatile("" ::: "memory");
        const int tid = wid * 64 + lane;
        if (tid < 256) { const float t = (P4[tid * 4] + P4[tid * 4 + 1]) + (P4[tid * 4 + 2] + P4[tid * 4 + 3]);
            __hip_atomic_store(slots + ((size_t)(u.pm * BM + tid)) * 8 + u.pn, __float_as_uint(t), __ATOMIC_RELAXED, __HIP_MEMORY_SCOPE_AGENT); }
        asm volatile("s_waitcnt vmcnt(0)" ::: "memory");
        if (lane == 0) __hip_atomic_fetch_add(cnt, 1u, __ATOMIC_RELAXED, __HIP_MEMORY_SCOPE_AGENT);
        if (wid == 0) {
            unsigned sp = 0u; bool dead = false;
            while ((unsigned)__builtin_amdgcn_readfirstlane(__hip_atomic_load(cnt, __ATOMIC_RELAXED, __HIP_MEMORY_SCOPE_AGENT)) < 64u) { __builtin_amdgcn_s_sleep(2); if (++sp > (1u << 22)) { dead = true; break; } }
            __builtin_amdgcn_fence(__ATOMIC_ACQUIRE, "agent");
            if (lane == 0) flag[0] = dead ? 1u : 0u;
        }
        asm volatile("s_waitcnt vmcnt(0) lgkmcnt(0)" ::: "memory"); __builtin_amdgcn_s_barrier(); asm volatile("" ::: "memory");
        if (tid < 256) { const unsigned* sl = slots + ((size_t)(u.pm * BM + tid)) * 8; float t = 0.f;
#pragma unroll
            for (int k = 0; k < 8; ++k) t += __uint_as_float(__hip_atomic_load(sl + k, __ATOMIC_RELAXED, __HIP_MEMORY_SCOPE_AGENT));
            S[tid] = flag[0] ? __builtin_nanf("") : rsqrtf(t * (1.0f / 2048.0f) + 1e-6f); }
        asm volatile("s_waitcnt lgkmcnt(0)" ::: "memory"); __builtin_amdgcn_s_barrier(); asm volatile("" ::: "memory");
        const float* fw = kp->in[10];
#pragma unroll
        for (int bj = 0; bj < 2; ++bj) {
            const int c0 = u.pn * BM + bj * HALF + wc * 32 + 8 * fq;
            const f32x4 w0 = *(const f32x4*)(fw + c0), w1 = *(const f32x4*)(fw + c0 + 4);
#pragma unroll
            for (int ai = 0; ai < 2; ++ai)
#pragma unroll
                for (int m = 0; m < 4; ++m) {
                    const int rl = ai * HALF + wr * 64 + m * 16 + fr; const float rv = S[rl];
                    float* op = kp->out + (size_t)(u.pm * BM + rl) * DMODEL + c0;
                    __builtin_nontemporal_store(acc[ai][bj][m][0] * rv * w0, (f32x4*)op); __builtin_nontemporal_store(acc[ai][bj][m][1] * rv * w1, (f32x4*)(op + 4));
                }
        }
    }
};

template <class Epi, class Sched, bool ALIGN_EPI = false, bool SP2 = false>
__device__ __forceinline__ void gemm_phase(PG8_LAS unsigned char* lds, const Gemm g, const Sched& S, const Epi& E) {
    int tid_ = threadIdx.x; asm volatile("" : "+v"(tid_));
    const int tid = tid_, wid = __builtin_amdgcn_readfirstlane(tid >> 6), lane = tid & 63, wr = wid >> 2, wc = wid & 3, fr = lane & 15, fq = lane >> 4;
    const int K = g.K, nt = K / BK;
    unsigned voffA[2], voffB[2];
#pragma unroll
    for (int i = 0; i < 2; ++i) { int R, C; stage_rc(tid * 16 + i * 8192, R, C); const int Rb = Epi::PERM ? ((R & ~31) + perm32(R & 31)) : R;
        voffA[i] = (unsigned)(R * K + C) * 2u; voffB[i] = (unsigned)(Rb * K + C) * 2u; }
    const size_t kstep = (size_t)(BK * 2);
    const size_t hstep = (size_t)HALF * K * 2;
    const size_t tstep = 2 * hstep;
    const unsigned ldsw = (unsigned)wid * 1024u;
    const int aoff = lds_byte(wr * 64 + fr, fq * 8), boff = lds_byte(wc * 32 + fr, fq * 8);
#define PG8_SA(b, h) (((b) * 2 + (h)) * HTB)
#define PG8_SB(b, h) ((4 + (b) * 2 + (h)) * HTB)
#define PG8_STAGE(bufoff, gbase, voff) do { _Pragma("unroll") for (int _i = 0; _i < 2; ++_i) \
        __builtin_amdgcn_global_load_lds((const unsigned*)((const char*)(gbase) + (voff)[_i]), (PG8_LAS unsigned*)(lds + (bufoff) + ldsw + _i * 8192), 16, 0, 0); } while (0)
#define PG8_LDA(dst, b, h) do { _Pragma("unroll") for (int m = 0; m < 4; ++m) _Pragma("unroll") for (int k = 0; k < 2; ++k) dst[m][k] = *(const PG8_LAS bf16x8*)(lds + PG8_SA(b, h) + aoff + m * 2048 + k * 1024); } while (0)
#define PG8_LDB(dst, b, h) do { _Pragma("unroll") for (int n = 0; n < 2; ++n) _Pragma("unroll") for (int k = 0; k < 2; ++k) dst[n][k] = *(const PG8_LAS bf16x8*)(lds + PG8_SB(b, h) + boff + n * 2048 + k * 1024); } while (0)
#define PG8_MMA(ai, bj, At, Bt) do { __builtin_amdgcn_s_setprio(1); _Pragma("unroll") for (int m = 0; m < 4; ++m) _Pragma("unroll") for (int n = 0; n < 2; ++n) _Pragma("unroll") for (int k = 0; k < 2; ++k) \
        acc[ai][bj][m][n] = __builtin_amdgcn_mfma_f32_16x16x32_bf16(Bt[n][k], At[m][k], acc[ai][bj][m][n], 0, 0, 0); __builtin_amdgcn_s_setprio(0); } while (0)
#define PG8_WAIT_V(n) asm volatile("s_waitcnt vmcnt(" #n ")" ::: "memory")
#define PG8_WAIT_L(n) asm volatile("s_waitcnt lgkmcnt(" #n ")" ::: "memory")
#define PG8_BAR __builtin_amdgcn_s_barrier()
#define PG8_SCHED __builtin_amdgcn_sched_barrier(0)
    Unit cur, nxt; int ui = 0;
    if (!S.next(0, cur)) return;
    f32x4 acc[2][2][4][2];
#pragma unroll
    for (int a = 0; a < 2; ++a)
#pragma unroll
        for (int b = 0; b < 2; ++b)
#pragma unroll
            for (int m = 0; m < 4; ++m)
#pragma unroll
                for (int n = 0; n < 2; ++n) acc[a][b][m][n] = (f32x4){0.f, 0.f, 0.f, 0.f};
    bf16x8 At[4][2], B0[2][2], B1[2][2];
    const char* cA = (const char*)g.A + (size_t)cur.pm * tstep; const char* cB = (const char*)g.Bt + (size_t)cur.pn * tstep;
    S.a_ready(cur);
    if constexpr (SP2) {
        PG8_STAGE(PG8_SB(0, 0), cB, voffB); PG8_STAGE(PG8_SB(0, 1), cB + hstep, voffB); PG8_STAGE(PG8_SA(0, 0), cA, voffA); PG8_STAGE(PG8_SA(0, 1), cA + hstep, voffA);
        if (wr == 1) PG8_BAR;
        PG8_WAIT_V(2); PG8_BAR;
        PG8_STAGE(PG8_SB(1, 0), cB + kstep, voffB); PG8_STAGE(PG8_SA(1, 0), cA + kstep, voffA); PG8_STAGE(PG8_SB(1, 1), cB + hstep + kstep, voffB);
        PG8_WAIT_V(6); PG8_BAR;
    } else {
        PG8_STAGE(PG8_SB(0, 0), cB, voffB); PG8_STAGE(PG8_SA(0, 0), cA, voffA); PG8_STAGE(PG8_SB(0, 1), cB + hstep, voffB); PG8_STAGE(PG8_SA(0, 1), cA + hstep, voffA);
        if (wr == 1) PG8_BAR;
        PG8_WAIT_V(4); PG8_BAR;
        PG8_STAGE(PG8_SB(1, 0), cB + kstep, voffB); PG8_STAGE(PG8_SA(1, 0), cA + kstep, voffA); PG8_STAGE(PG8_SB(1, 1), cB + hstep + kstep, voffB);
        PG8_WAIT_V(6); PG8_BAR;
    }
    for (;;) {
        const bool has_next = S.next(ui + 1, nxt);
        const char* nA = has_next ? (const char*)g.A + (size_t)nxt.pm * tstep : cA; const char* nB = has_next ? (const char*)g.Bt + (size_t)nxt.pn * tstep : cB;
        for (int t = 0; t < nt; t += 2) {
            const bool last = (t == nt - 2);
            const char* a1 = cA + (size_t)(t + 1) * kstep;
            const char* a2 = last ? nA : cA + (size_t)(t + 2) * kstep; const char* b2 = last ? nB : cB + (size_t)(t + 2) * kstep;
            const char* a3 = a2 + kstep; const char* b3 = b2 + kstep;
            if (last && has_next) S.a_ready(nxt);
            if constexpr (SP2) {
            PG8_LDB(B0, 0, 0); PG8_LDB(B1, 0, 1); PG8_SCHED; PG8_LDA(At, 0, 0); PG8_STAGE(PG8_SA(1, 1), a1 + hstep, voffA);
            PG8_WAIT_V(8); PG8_WAIT_L(0); PG8_BAR; PG8_MMA(0, 0, At, B0); PG8_MMA(0, 1, At, B1); PG8_BAR; PG8_SCHED;
            PG8_LDA(At, 0, 1); PG8_STAGE(PG8_SB(0, 0), b2, voffB); PG8_STAGE(PG8_SB(0, 1), b2 + hstep, voffB); PG8_STAGE(PG8_SA(0, 0), a2, voffA);
            PG8_WAIT_V(8); PG8_WAIT_L(0); PG8_BAR; PG8_MMA(1, 0, At, B0); PG8_MMA(1, 1, At, B1); PG8_BAR; PG8_SCHED;
            PG8_LDB(B0, 1, 0); PG8_LDB(B1, 1, 1); PG8_SCHED; PG8_LDA(At, 1, 0); PG8_STAGE(PG8_SA(0, 1), a2 + hstep, voffA);
            PG8_WAIT_V(8); PG8_WAIT_L(0); PG8_BAR; PG8_MMA(0, 0, At, B0); PG8_MMA(0, 1, At, B1); PG8_BAR; PG8_SCHED;
            PG8_LDA(At, 1, 1); PG8_STAGE(PG8_SB(1, 0), b3, voffB); PG8_STAGE(PG8_SB(1, 1), b3 + hstep, voffB); PG8_STAGE(PG8_SA(1, 0), a3, voffA);
            PG8_WAIT_V(8); PG8_WAIT_L(0); PG8_BAR; PG8_MMA(1, 0, At, B0); PG8_MMA(1, 1, At, B1); PG8_BAR; PG8_SCHED;
            } else {
            PG8_LDB(B0, 0, 0); PG8_SCHED; PG8_LDA(At, 0, 0); PG8_STAGE(PG8_SA(1, 1), a1 + hstep, voffA);
            PG8_WAIT_L(8); PG8_BAR; PG8_WAIT_L(0); PG8_MMA(0, 0, At, B0); PG8_BAR; PG8_SCHED;
            PG8_LDB(B1, 0, 1); PG8_STAGE(PG8_SB(0, 0), b2, voffB);
            PG8_BAR; PG8_WAIT_L(0); PG8_MMA(0, 1, At, B1); PG8_BAR;
            PG8_LDA(At, 0, 1); PG8_STAGE(PG8_SA(0, 0), a2, voffA);
            PG8_BAR; PG8_WAIT_L(0); PG8_MMA(1, 0, At, B0); PG8_BAR; PG8_SCHED;
            PG8_STAGE(PG8_SB(0, 1), b2 + hstep, voffB);
            PG8_WAIT_V(6); PG8_BAR; PG8_MMA(1, 1, At, B1); PG8_BAR;
            PG8_LDB(B0, 1, 0); PG8_SCHED; PG8_LDA(At, 1, 0); PG8_STAGE(PG8_SA(0, 1), a2 + hstep, voffA);
            PG8_WAIT_L(8); PG8_BAR; PG8_WAIT_L(0); PG8_MMA(0, 0, At, B0); PG8_BAR; PG8_SCHED;
            PG8_LDB(B1, 1, 1); PG8_STAGE(PG8_SB(1, 0), b3, voffB);
            PG8_BAR; PG8_WAIT_L(0); PG8_MMA(0, 1, At, B1); PG8_BAR;
            PG8_LDA(At, 1, 1); PG8_STAGE(PG8_SA(1, 0), a3, voffA);
            PG8_BAR; PG8_WAIT_L(0); PG8_MMA(1, 0, At, B0); PG8_BAR; PG8_SCHED;
            PG8_STAGE(PG8_SB(1, 1), b3 + hstep, voffB);
            PG8_WAIT_V(6); PG8_BAR; PG8_MMA(1, 1, At, B1); PG8_BAR;
            }
        }
        if constexpr (ALIGN_EPI) { if (wr == 0) PG8_BAR; }
        if constexpr (!Epi::AFTER_DRAIN) { E(acc, cur, wr, wc, fr, fq); S.done(cur); }
        if (!has_next) break;
#pragma unroll
        for (int a = 0; a < 2; ++a)
#pragma unroll
            for (int b = 0; b < 2; ++b)
#pragma unroll
                for (int m = 0; m < 4; ++m)
#pragma unroll
                    for (int n = 0; n < 2; ++n) acc[a][b][m][n] = (f32x4){0.f, 0.f, 0.f, 0.f};
        cur = nxt; cA = nA; cB = nB; ++ui;
        if constexpr (ALIGN_EPI) { if (wr == 1) PG8_BAR; }
    }
    PG8_WAIT_V(0);
    if constexpr (!ALIGN_EPI) { if (wr == 0) PG8_BAR; }
    PG8_BAR;
    if constexpr (Epi::AFTER_DRAIN) { E.fused(acc, cur, wr, wc, fr, fq, lds, wid, lane); S.done(cur); }
#undef PG8_SA
#undef PG8_SB
#undef PG8_STAGE
#undef PG8_LDA
#undef PG8_LDB
#undef PG8_MMA
#undef PG8_WAIT_V
#undef PG8_WAIT_L
#undef PG8_BAR
#undef PG8_SCHED
}
}

typedef unsigned short bf16;
typedef float f32x4 __attribute__((ext_vector_type(4)));
typedef short bf16x8 __attribute__((ext_vector_type(8)));
typedef short s16x4 __attribute__((ext_vector_type(4)));
typedef unsigned u32x4 __attribute__((ext_vector_type(4)));
typedef unsigned u32x2 __attribute__((ext_vector_type(2)));
typedef float f32x2 __attribute__((ext_vector_type(2)));
typedef __bf16 bf16x2_t __attribute__((ext_vector_type(2)));
#define LAS __attribute__((address_space(3)))

constexpr int T = 8192, NS = 512, M = 8704, D = 2048, NP = 6400, DEPTH = 2;
constexpr int C_QA = 0, C_KA = 1024, C_VA = 1152, C_GA = 1280, C_QB = 2304, C_KB = 3328, C_VB = 4352, C_GB = 5376;
constexpr int NPOS = 8196;
constexpr int LDS_BYTES = 147456;
constexpr int NTHREADS = 512;
using pg8::O_KP; using pg8::O_VP; using pg8::O_RP; using pg8::O_KS; using pg8::O_VS; using pg8::O_RS;

constexpr size_t MiB = 1u << 20;
constexpr size_t WS_CTL = 0, CTL_BYTES = 1 * MiB;
constexpr size_t WS_WIN = 2 * MiB;
constexpr size_t WS_WOUT = WS_WIN + 50 * MiB;
constexpr size_t WS_XA = WS_WOUT + 16 * MiB;
constexpr size_t WS_P = WS_XA + 34 * MiB;
constexpr size_t WS_Y = WS_P + 107 * MiB;
constexpr size_t WS_XR = WS_Y + 34 * MiB;
constexpr size_t WS_U = WS_XR + 68 * MiB;
constexpr size_t WS_RT = WS_U + 32 * MiB;
constexpr size_t WS_TAB = WS_RT + 16 * MiB;
constexpr size_t WS_END = WS_TAB + 8 * MiB;
static_assert(WS_XA == pg8::EWS_XA && WS_P == pg8::EWS_P && WS_XR == pg8::EWS_XR && WS_TAB == pg8::EWS_TAB && WS_CTL == 0, "d_ws map vs the epilogues' copy");

static_assert(true, "");
struct Ctx {
    const float *x_prompt, *x_sample, *cache_k, *cache_v, *state, *norm_w, *w_in, *sinks, *ret_norm_w, *w_out, *final_w;
    float* out; unsigned char* ws;
    int ph_lo, ph_hi;
};

__device__ __forceinline__ unsigned cvtpk(float lo, float hi) { f32x2 v = {lo, hi}; bf16x2_t b = __builtin_convertvector(v, bf16x2_t); return __builtin_bit_cast(unsigned, b); }
__device__ __forceinline__ float bf_lo(unsigned u) { return __uint_as_float(u << 16); }
__device__ __forceinline__ float bf_hi(unsigned u) { return __uint_as_float(u & 0xffff0000u); }
__device__ __forceinline__ float silu_f(float x) { return x / (1.0f + __expf(-x)); }
__device__ __forceinline__ s16x4 vtr(const char* p) { typedef short v4i16_t __attribute__((ext_vector_type(4)));
    return __builtin_bit_cast(s16x4, __builtin_amdgcn_ds_read_tr16_b64_v4i16((LAS v4i16_t*)p)); }
__device__ __forceinline__ bf16x8 cat8(s16x4 lo, s16x4 hi) { return (bf16x8){lo[0], lo[1], lo[2], lo[3], hi[0], hi[1], hi[2], hi[3]}; }
__device__ __forceinline__ float ln_gamma(int h) {
    const double x = __builtin_ldexp(1.0, -5 - h);
    double s = 0.0, p = x;
#pragma unroll
    for (int k = 1; k <= 9; ++k) { s += p / (double)k; p *= x; }
    return (float)(-s);
}
#define LDS_WAIT() asm volatile("s_waitcnt lgkmcnt(0)" ::: "memory")
#define LAUNDER_V(x) asm volatile("" : "+v"(x))
#define LAUNDER_S(x) asm volatile("" : "+s"(x))

__device__ __forceinline__ int perm_src_col(int np, float& sc) {
    sc = 1.0f;
    if (np < 1152) { const int hb = np & ~63, g = np & 63; if (np < 1024) sc = 0.125f; return hb + 4 * (g >> 3) + (g & 3) + 32 * ((g >> 2) & 1); }
    if (np >= C_QB && np < C_VB) { const int hb = np & ~127, g = np & 127; if (np >= C_KB) sc = 0.08838834764831845f; return hb + 4 * (g >> 3) + (g & 3) + 64 * ((g >> 2) & 1); }
    return np;
}

template <bool WIN>
__device__ __forceinline__ void transpose_item(const float* W, int N, const float* nw, bf16* WT, float* scr, int kb, int nb, int lane) {
    const int k0 = 64 * kb, n0 = 64 * nb, l16 = lane & 15, r4 = lane >> 4;
    float sc = 1.0f; int srcc = n0 + 4 * l16;
    if (WIN) srcc = perm_src_col(n0 + 4 * l16, sc);
    f32x4 v[16]; float nwv[16];
#pragma unroll
    for (int i = 0; i < 16; ++i) { const int kk = 4 * i + r4; v[i] = __builtin_nontemporal_load((const f32x4*)(W + (size_t)(k0 + kk) * N + srcc)); nwv[i] = WIN ? nw[k0 + kk] : 1.0f; }
#pragma unroll
    for (int i = 0; i < 16; ++i) {
        const int kk = 4 * i + r4; const float s2 = sc * nwv[i];
        float* d = scr + kk * 65 + 4 * l16;
        d[0] = v[i][0] * s2; d[1] = v[i][1] * s2; d[2] = v[i][2] * s2; d[3] = v[i][3] * s2;
    }
    LDS_WAIT();
    const int c = lane & 7;
#pragma unroll
    for (int j = 0; j < 8; ++j) {
        const int n = (lane >> 3) + 8 * j; const float* s = scr + (8 * c) * 65 + n;
        u32x4 o; o.x = cvtpk(s[0], s[65]); o.y = cvtpk(s[130], s[195]); o.z = cvtpk(s[260], s[325]); o.w = cvtpk(s[390], s[455]);
        *(u32x4*)(WT + (size_t)(n0 + n) * 2048 + k0 + 8 * c) = o;
    }
    LDS_WAIT();
}

__device__ __forceinline__ void convert_weights(const Ctx& C, float* scr, int l, int gw, int NGW, int lane) {
    bf16* WIN = (bf16*)(C.ws + WS_WIN); bf16* WOUT = (bf16*)(C.ws + WS_WOUT);
    constexpr int I_IN = 32 * 100, I_OUT = 32 * 32;
    for (int it = gw; it < I_IN + I_OUT; it += NGW) {
        int r = it;
        if (r < I_IN) { const int nb = r % 100, kb = r / 100;
            transpose_item<true>(C.w_in + (size_t)l * D * NP, NP, C.norm_w + l * D, WIN + (size_t)l * NP * D, scr, kb, nb, lane); }
        else { r -= I_IN; const int nb = r & 31, kb = r >> 5;
            transpose_item<false>(C.w_out + (size_t)l * D * D, D, nullptr, WOUT + (size_t)l * D * D, scr, kb, nb, lane); }
    }
}

__device__ __forceinline__ void p0_prologue(const Ctx& C, char* lds, int tid, int wave, int lane, int G) {
    float* scr = (float*)(lds + wave * 16640);
    const int gw = blockIdx.x * 8 + wave, NGW = G * 8;
    convert_weights(C, scr, 0, gw, NGW, lane);
    bf16* XA = (bf16*)(C.ws + WS_XA); float* rss = (float*)(C.ws + WS_CTL);
    for (int m = gw; m < M; m += 2 * NGW) {
        const int m2 = m + NGW; const bool has2 = m2 < M;
        const float* xr = m < T ? C.x_prompt + (size_t)m * D : C.x_sample + (size_t)(m - T) * D;
        const int m2c = has2 ? m2 : m;
        const float* xr2 = m2c < T ? C.x_prompt + (size_t)m2c * D : C.x_sample + (size_t)(m2c - T) * D;
        f32x4 va[8], vb[8];
#pragma unroll
        for (int j = 0; j < 8; ++j) { va[j] = __builtin_nontemporal_load((const f32x4*)xr + lane + 64 * j); vb[j] = __builtin_nontemporal_load((const f32x4*)xr2 + lane + 64 * j); }
        float ss = 0.f, ss2 = 0.f;
#pragma unroll
        for (int j = 0; j < 8; ++j) {
            ss += (va[j][0] * va[j][0] + va[j][1] * va[j][1]) + (va[j][2] * va[j][2] + va[j][3] * va[j][3]);
            ss2 += (vb[j][0] * vb[j][0] + vb[j][1] * vb[j][1]) + (vb[j][2] * vb[j][2] + vb[j][3] * vb[j][3]);
            u32x2 o; o.x = cvtpk(va[j][0], va[j][1]); o.y = cvtpk(va[j][2], va[j][3]);
            *((u32x2*)(XA + (size_t)m * D) + lane + 64 * j) = o;
            if (has2) { u32x2 o2; o2.x = cvtpk(vb[j][0], vb[j][1]); o2.y = cvtpk(vb[j][2], vb[j][3]); *((u32x2*)(XA + (size_t)m2 * D) + lane + 64 * j) = o2; }
        }
#pragma unroll
        for (int o = 1; o < 64; o <<= 1) { ss += __shfl_xor(ss, o); ss2 += __shfl_xor(ss2, o); }
        if (lane == 0) { rss[m] = ss; if (has2) rss[m2] = ss2; }
    }
    float* cosA = (float*)(C.ws + WS_TAB); float* sinA = cosA + NPOS * 32; float* cosB = sinA + NPOS * 32; float* sinB = cosB + NPOS * 64;
    for (int i = blockIdx.x * NTHREADS + tid; i < NPOS * 96; i += G * NTHREADS) {
        int pos, f, half; float *pc, *ps;
        if (i < NPOS * 32) { pos = i >> 5; f = i & 31; half = 32; pc = cosA + i; ps = sinA + i; }
        else { const int k = i - NPOS * 32; pos = k >> 6; f = k & 63; half = 64; pc = cosB + k; ps = sinB + k; }
        const double rr = half == 32 ? 0.7498942093324559 : 0.8659643233600653;
        double inv = 1.0; for (int k = 0; k < f; ++k) inv *= rr;
        const float ang = (float)pos * (float)inv;
        const double a = (double)ang;
        const double qd = __builtin_rint(a * 0.6366197723675814);
        double r = __builtin_fma(-qd, 1.5707963267948966, a); r = __builtin_fma(-qd, 6.123233995736766e-17, r);
        const double r2 = r * r;
        double sp = -1.0 / 39916800.0; sp = sp * r2 + 1.0 / 362880.0; sp = sp * r2 - 1.0 / 5040.0; sp = sp * r2 + 1.0 / 120.0; sp = sp * r2 - 1.0 / 6.0; sp = sp * r2 + 1.0; sp *= r;
        double cp = 1.0 / 479001600.0; cp = cp * r2 - 1.0 / 3628800.0; cp = cp * r2 + 1.0 / 40320.0; cp = cp * r2 - 1.0 / 720.0; cp = cp * r2 + 1.0 / 24.0; cp = cp * r2 - 0.5; cp = cp * r2 + 1.0;
        const int qi = ((int)qd) & 3;
        const double sv = (qi == 0) ? sp : (qi == 1) ? cp : (qi == 2) ? -sp : -cp;
        const double cv = (qi == 0) ? cp : (qi == 1) ? -sp : (qi == 2) ? -cp : sp;
        *pc = (float)cv; *ps = (float)sv;
    }
}

__device__ __forceinline__ void attn_prompt_unit(const Ctx& C, char* lds, int layer, int blk, int kvh, int hq, int tid, int w, int lane) {
    const bf16* P = (const bf16*)(C.ws + WS_P); bf16* Y = (bf16*)(C.ws + WS_Y);
    char* Ks = lds; char* Vs = lds + 36864;
    const int q = lane & 15, g = lane >> 4;
    const int jt0 = w < 6 ? w : 6;
    const int iq = 16 * w + q, row = blk * 128 + iq;
    bf16x8 qfa[4][2]; u32x2 gta[4][4];
#pragma unroll
    for (int hh = 0; hh < 4; ++hh) {
        const int h = kvh * 8 + hq * 4 + hh;
#pragma unroll
        for (int ks = 0; ks < 2; ++ks) qfa[hh][ks] = *(const bf16x8*)(P + (size_t)row * NP + C_QA + h * 64 + 32 * ks + 8 * g);
#pragma unroll
        for (int dt = 0; dt < 4; ++dt) gta[hh][dt] = *(const u32x2*)(P + (size_t)row * NP + C_GA + h * 64 + 16 * dt + 4 * g);
    }
#pragma unroll
    for (int it = 0; it < 4; ++it) {
        const int r = (tid >> 3) + 64 * it, ch = tid & 7, krow = blk * 128 - 128 + r;
        u32x4 kv = (u32x4){0u, 0u, 0u, 0u}, vv = kv;
        if (krow >= 0) { kv = *(const u32x4*)(P + (size_t)krow * NP + C_KA + kvh * 64 + ch * 8); vv = *(const u32x4*)(P + (size_t)krow * NP + C_VA + kvh * 64 + ch * 8); }
        *(u32x4*)(Ks + r * 144 + ch * 16) = kv; *(u32x4*)(Vs + r * 144 + ch * 16) = vv;
    }
    __syncthreads();
#pragma unroll
    for (int hh = 0; hh < 4; ++hh) {
        const int h = kvh * 8 + hq * 4 + hh;
        bf16x8 qf[2]; qf[0] = qfa[hh][0]; qf[1] = qfa[hh][1];
        f32x4 s[10];
        float mx = -INFINITY;
        int lo = (blk > 0 || iq + 1 >= 128) ? iq + 1 : 128; LAUNDER_V(lo);
        const unsigned span = (unsigned)(iq + 128 - lo);
#pragma unroll
        for (int tt = 0; tt < 10; ++tt) {
            const int jt = jt0 + tt;
            f32x4 a = (f32x4){0.f, 0.f, 0.f, 0.f};
#pragma unroll
            for (int ks = 0; ks < 2; ++ks) { const bf16x8 kf = *(const bf16x8*)(Ks + (16 * jt + q) * 144 + (32 * ks + 8 * g) * 2); a = __builtin_amdgcn_mfma_f32_16x16x32_bf16(kf, qf[ks], a, 0, 0, 0); }
#pragma unroll
            for (int j = 0; j < 4; ++j) {
                const int jj = 16 * jt + 4 * g + j;
                a[j] = ((unsigned)(jj - lo) <= span) ? a[j] : -INFINITY; mx = fmaxf(mx, a[j]);
            }
            s[tt] = a;
        }
        mx = fmaxf(mx, __shfl_xor(mx, 16)); mx = fmaxf(mx, __shfl_xor(mx, 32));
        const float sink = C.sinks[layer * 16 + h];
        const float mm = fmaxf(mx, sink);
        float sum = 0.f;
#pragma unroll
        for (int tt = 0; tt < 10; ++tt)
#pragma unroll
            for (int j = 0; j < 4; ++j) { const float e = __expf(s[tt][j] - mm); s[tt][j] = e; sum += e; }
        sum += __shfl_xor(sum, 16); sum += __shfl_xor(sum, 32);
        const float inv = 1.0f / (sum + __expf(sink - mm));
        f32x4 o[4];
#pragma unroll
        for (int dt = 0; dt < 4; ++dt) o[dt] = (f32x4){0.f, 0.f, 0.f, 0.f};
#pragma unroll
        for (int pr = 0; pr < 5; ++pr) {
            const int jt = jt0 + 2 * pr;
            u32x4 pw; pw.x = cvtpk(s[2 * pr][0], s[2 * pr][1]); pw.y = cvtpk(s[2 * pr][2], s[2 * pr][3]); pw.z = cvtpk(s[2 * pr + 1][0], s[2 * pr + 1][1]); pw.w = cvtpk(s[2 * pr + 1][2], s[2 * pr + 1][3]);
            const bf16x8 pf = __builtin_bit_cast(bf16x8, pw);
#pragma unroll
            for (int dt = 0; dt < 4; ++dt) {
                const char* a0 = Vs + (16 * jt + 4 * g + (q >> 2)) * 144 + (16 * dt + 4 * (q & 3)) * 2;
                const s16x4 lo = vtr(a0), hi = vtr(a0 + 16 * 144);
                o[dt] = __builtin_amdgcn_mfma_f32_16x16x32_bf16(cat8(lo, hi), pf, o[dt], 0, 0, 0);
            }
        }
#pragma unroll
        for (int dt = 0; dt < 4; ++dt) {
            const int dcol = h * 64 + 16 * dt + 4 * g;
            const u32x2 gt = gta[hh][dt];
            u32x2 yo; yo.x = cvtpk(o[dt][0] * inv * silu_f(bf_lo(gt.x)), o[dt][1] * inv * silu_f(bf_hi(gt.x)));
            yo.y = cvtpk(o[dt][2] * inv * silu_f(bf_lo(gt.y)), o[dt][3] * inv * silu_f(bf_hi(gt.y)));
            *(u32x2*)(Y + (size_t)row * D + dcol) = yo;
        }
    }
    __syncthreads();
}

__device__ __forceinline__ void stage128_load(u32x4 (&v)[4], const bf16* src, size_t src_pitch, int tid) {
#pragma unroll
    for (int it = 0; it < 4; ++it) { const int r = (tid >> 4) + 32 * it, ch = tid & 15; v[it] = *(const u32x4*)(src + (size_t)r * src_pitch + ch * 8); }
}
template <bool SCALE>
__device__ __forceinline__ void stage128_store(char* dst, const u32x4 (&vin)[4], int tid, float lng) {
#pragma unroll
    for (int it = 0; it < 4; ++it) {
        const int r = (tid >> 4) + 32 * it, ch = tid & 15;
        u32x4 v = vin[it];
        if (SCALE) { const float sc = __expf((float)(127 - r) * lng);
            v.x = cvtpk(bf_lo(v.x) * sc, bf_hi(v.x) * sc); v.y = cvtpk(bf_lo(v.y) * sc, bf_hi(v.y) * sc); v.z = cvtpk(bf_lo(v.z) * sc, bf_hi(v.z) * sc); v.w = cvtpk(bf_lo(v.w) * sc, bf_hi(v.w) * sc); }
        *(u32x4*)(dst + r * 272 + ch * 16) = v;
    }
}

__device__ __forceinline__ void ret_u_unit(const Ctx& C, char* lds, int c, int h, int tid, int w, int lane) {
    const bf16* P = (const bf16*)(C.ws + WS_P); float* U = (float*)(C.ws + WS_U);
    char* Ks = lds; char* Vs = lds + 34816;
    const float lng = ln_gamma(h);
    { u32x4 sk[4], sv[4];
      stage128_load(sk, P + (size_t)(c * 128) * NP + C_KB + h * 128, NP, tid); stage128_load(sv, P + (size_t)(c * 128) * NP + C_VB + h * 128, NP, tid);
      stage128_store<false>(Ks, sk, tid, lng); stage128_store<true>(Vs, sv, tid, lng); }
    __syncthreads();
    const int q = lane & 15, g = lane >> 4;
    f32x4 acc[8];
#pragma unroll
    for (int dt = 0; dt < 8; ++dt) acc[dt] = (f32x4){0.f, 0.f, 0.f, 0.f};
#pragma unroll
    for (int ks = 0; ks < 4; ++ks) {
        const int rbase = (32 * ks + 8 * g + (q >> 2)) * 272 + 4 * (q & 3) * 2;
        const bf16x8 vf = cat8(vtr(Vs + rbase + 32 * w), vtr(Vs + rbase + 32 * w + 4 * 272));
#pragma unroll
        for (int dt = 0; dt < 8; ++dt) {
            const bf16x8 kf = cat8(vtr(Ks + rbase + 32 * dt), vtr(Ks + rbase + 32 * dt + 4 * 272));
            acc[dt] = __builtin_amdgcn_mfma_f32_16x16x32_bf16(vf, kf, acc[dt], 0, 0, 0);
        }
    }
    float* Ub = U + (size_t)(c * 8 + h) * 16384;
#pragma unroll
    for (int dt = 0; dt < 8; ++dt)
#pragma unroll
        for (int j = 0; j < 4; ++j) Ub[(16 * w + 4 * g + j) * 128 + 16 * dt + q] = acc[dt][j];
    __syncthreads();
}

__device__ __forceinline__ void ret_scan(const Ctx& C, int layer, int tid, int G) {
    const float* U = (const float*)(C.ws + WS_U); bf16* Rt = (bf16*)(C.ws + WS_RT);
    for (int i = blockIdx.x * NTHREADS + tid; i < 8 * 16384; i += G * NTHREADS) {
        const int h = i >> 14, e = (i >> 7) & 127, d = i & 127;
        const float gc = __expf(128.0f * ln_gamma(h));
        float r = 0.f;
#pragma unroll 1
        for (int c0 = 0; c0 < 64; c0 += 32) {
            float u[32];
#pragma unroll
            for (int k = 0; k < 32; ++k) u[k] = __builtin_nontemporal_load(U + (size_t)((c0 + k) * 8) * 16384 + i);
#pragma unroll
            for (int k = 0; k < 32; ++k) { Rt[(size_t)((c0 + k) * 8) * 16384 + i] = (bf16)(cvtpk(r, 0.f) & 0xffffu); r = gc * r + u[k]; }
        }
        const int dorig = 4 * (d >> 3) + (d & 3) + 64 * ((d >> 2) & 1);
        C.out[O_RP + ((size_t)(layer * 8 + h) * 128 + dorig) * 128 + e] = r;
    }
}

__device__ __forceinline__ void ret_prompt_unit(const Ctx& C, char* lds, int layer, int c, int h, int tid, int w, int lane) {
    const bf16* P = (const bf16*)(C.ws + WS_P); bf16* Y = (bf16*)(C.ws + WS_Y); const bf16* Rt = (const bf16*)(C.ws + WS_RT);
    char* Ks = lds; char* Vs = lds + 34816; char* Rs = lds + 69632;
    const float lng = ln_gamma(h);
    const int q = lane & 15, g = lane >> 4;
    const int n = 16 * w + q, row = c * 128 + n;
    bf16x8 qf[4]; u32x2 gta[8];
#pragma unroll
    for (int ks = 0; ks < 4; ++ks) qf[ks] = *(const bf16x8*)(P + (size_t)row * NP + C_QB + h * 128 + 32 * ks + 8 * g);
#pragma unroll
    for (int et = 0; et < 8; ++et) gta[et] = *(const u32x2*)(P + (size_t)row * NP + C_GB + h * 128 + 16 * et + 4 * g);
    { u32x4 sk[4], sv[4], sr[4];
      stage128_load(sk, P + (size_t)(c * 128) * NP + C_KB + h * 128, NP, tid); stage128_load(sv, P + (size_t)(c * 128) * NP + C_VB + h * 128, NP, tid);
      stage128_load(sr, Rt + (size_t)(c * 8 + h) * 16384, 128, tid);
      stage128_store<false>(Ks, sk, tid, lng); stage128_store<false>(Vs, sv, tid, lng); stage128_store<false>(Rs, sr, tid, lng); }
    __syncthreads();
    unsigned pk[8][2];
#pragma unroll
    for (int mt = 0; mt < 8; ++mt) {
        pk[mt][0] = 0u; pk[mt][1] = 0u;
        if (mt <= w) {
            f32x4 a = (f32x4){0.f, 0.f, 0.f, 0.f};
#pragma unroll
            for (int ks = 0; ks < 4; ++ks) { const bf16x8 kf = *(const bf16x8*)(Ks + (16 * mt + q) * 272 + (32 * ks + 8 * g) * 2); a = __builtin_amdgcn_mfma_f32_16x16x32_bf16(kf, qf[ks], a, 0, 0, 0); }
            float v[4];
#pragma unroll
            for (int j = 0; j < 4; ++j) { const int dl = n - (16 * mt + 4 * g + j); v[j] = dl >= 0 ? a[j] * __expf((float)dl * lng) : 0.f; }
            pk[mt][0] = cvtpk(v[0], v[1]); pk[mt][1] = cvtpk(v[2], v[3]);
        }
    }
    f32x4 oi[8], ox[8];
#pragma unroll
    for (int et = 0; et < 8; ++et) { oi[et] = (f32x4){0.f, 0.f, 0.f, 0.f}; ox[et] = oi[et]; }
#pragma unroll
    for (int pr = 0; pr < 4; ++pr) {
        if (2 * pr <= w) {
            u32x4 pw; pw.x = pk[2 * pr][0]; pw.y = pk[2 * pr][1]; pw.z = pk[2 * pr + 1][0]; pw.w = pk[2 * pr + 1][1];
            const bf16x8 pf = __builtin_bit_cast(bf16x8, pw);
#pragma unroll
            for (int et = 0; et < 8; ++et) {
                const char* a0 = Vs + (32 * pr + 4 * g + (q >> 2)) * 272 + (16 * et + 4 * (q & 3)) * 2;
                oi[et] = __builtin_amdgcn_mfma_f32_16x16x32_bf16(cat8(vtr(a0), vtr(a0 + 16 * 272)), pf, oi[et], 0, 0, 0);
            }
        }
    }
#pragma unroll
    for (int et = 0; et < 8; ++et)
#pragma unroll
        for (int ks = 0; ks < 4; ++ks) { const bf16x8 rf = *(const bf16x8*)(Rs + (16 * et + q) * 272 + (32 * ks + 8 * g) * 2); ox[et] = __builtin_amdgcn_mfma_f32_16x16x32_bf16(rf, qf[ks], ox[et], 0, 0, 0); }
    const float qdec = __expf((float)(n + 1) * lng);
    float sum = 0.f;
#pragma unroll
    for (int et = 0; et < 8; ++et) { oi[et] = oi[et] + ox[et] * qdec; sum += (oi[et][0] + oi[et][1]) + (oi[et][2] + oi[et][3]); }
    sum += __shfl_xor(sum, 16); sum += __shfl_xor(sum, 32);
    const float mu = sum * (1.0f / 128.0f);
    float var = 0.f;
#pragma unroll
    for (int et = 0; et < 8; ++et) { oi[et] = oi[et] - mu; var += (oi[et][0] * oi[et][0] + oi[et][1] * oi[et][1]) + (oi[et][2] * oi[et][2] + oi[et][3] * oi[et][3]); }
    var += __shfl_xor(var, 16); var += __shfl_xor(var, 32);
    const float rs = rsqrtf(var * (1.0f / 128.0f) + 1e-6f);
    const float* gw = C.ret_norm_w + layer * 1024 + h * 128;
#pragma unroll
    for (int et = 0; et < 8; ++et) {
        const int e0 = 16 * et + 4 * g;
        const u32x2 gt = gta[et];
        const f32x4 wv = *(const f32x4*)(gw + e0);
        u32x2 yo; yo.x = cvtpk(oi[et][0] * rs * wv[0] * silu_f(bf_lo(gt.x)), oi[et][1] * rs * wv[1] * silu_f(bf_hi(gt.x)));
        yo.y = cvtpk(oi[et][2] * rs * wv[2] * silu_f(bf_lo(gt.y)), oi[et][3] * rs * wv[3] * silu_f(bf_hi(gt.y)));
        *(u32x2*)(Y + (size_t)row * D + 1024 + h * 128 + e0) = yo;
    }
    __syncthreads();
}

__device__ __forceinline__ void attn_sample_unit(const Ctx& C, char* lds, int layer, int b, int kvh, int tid) {
    const bf16* P = (const bf16*)(C.ws + WS_P); bf16* Y = (bf16*)(C.ws + WS_Y);
    float* Qs = (float*)lds;
    float* Kl = Qs + 32 * 65;
    float* Vl = Kl + 132 * 68;
    float* Pm = Vl + 132 * 68;
    const float* ck = C.cache_k + ((size_t)(layer * 128 + b) * 128) * 128 + kvh * 64;
    const float* cv = C.cache_v + ((size_t)(layer * 128 + b) * 128) * 128 + kvh * 64;
    float* ok = C.out + O_KS + ((size_t)(layer * 128 + b) * 128) * 128 + kvh * 64;
    float* ov = C.out + O_VS + ((size_t)(layer * 128 + b) * 128) * 128 + kvh * 64;
    {
        f32x4 kq[4], vq[4];
#pragma unroll
        for (int it = 0; it < 4; ++it) { const int i = tid + NTHREADS * it, r = i >> 4, c4 = i & 15;
            kq[it] = __builtin_nontemporal_load((const f32x4*)(ck + (size_t)r * 128 + 4 * c4)); vq[it] = __builtin_nontemporal_load((const f32x4*)(cv + (size_t)r * 128 + 4 * c4)); }
#pragma unroll
        for (int it = 0; it < 4; ++it) { const int i = tid + NTHREADS * it, r = i >> 4, c4 = i & 15;
            *(f32x4*)(Kl + r * 68 + 4 * c4) = kq[it]; *(f32x4*)(Vl + r * 68 + 4 * c4) = vq[it];
            if (r >= 4) { __builtin_nontemporal_store(kq[it], (f32x4*)(ok + (size_t)(r - 4) * 128 + 4 * c4)); __builtin_nontemporal_store(vq[it], (f32x4*)(ov + (size_t)(r - 4) * 128 + 4 * c4)); } }
    }
    if (tid < 256) { const int t = tid >> 6, g = tid & 63; const size_t ro = (size_t)(T + 4 * b + t) * NP;
        const int dk = 4 * (g >> 3) + (g & 3) + 32 * ((g >> 2) & 1);
        Kl[(128 + t) * 68 + dk] = __uint_as_float((unsigned)P[ro + C_KA + kvh * 64 + g] << 16);
        Vl[(128 + t) * 68 + g] = __uint_as_float((unsigned)P[ro + C_VA + kvh * 64 + g] << 16); }
    for (int i = tid; i < 32 * 64; i += NTHREADS) {
        const int r = i >> 6, g = i & 63, hg = r >> 2, t = r & 3;
        const int dk = 4 * (g >> 3) + (g & 3) + 32 * ((g >> 2) & 1);
        Qs[r * 65 + dk] = __uint_as_float((unsigned)P[(size_t)(T + 4 * b + t) * NP + C_QA + (kvh * 8 + hg) * 64 + g] << 16);
    }
    __syncthreads();
    {
        const int r = tid >> 4, kg = tid & 15, t = r & 3, h = kvh * 8 + (r >> 2);
        float mx = -INFINITY;
        f32x4 qr[16];
#pragma unroll
        for (int i = 0; i < 16; ++i) qr[i] = (f32x4){Qs[r * 65 + 4 * i], Qs[r * 65 + 4 * i + 1], Qs[r * 65 + 4 * i + 2], Qs[r * 65 + 4 * i + 3]};
#pragma unroll 1
        for (int it = 0; it < 9; ++it) {
            const int kk = kg + 16 * it;
            float a = -INFINITY;
            if (kk < 132) {
                const bool valid = kk < 128 ? (kk > t) : (kk - 128 <= t);
                if (valid) { f32x4 a4 = (f32x4){0.f, 0.f, 0.f, 0.f};
#pragma unroll
                    for (int i = 0; i < 16; ++i) a4 += qr[i] * *(const f32x4*)(Kl + kk * 68 + 4 * i);
                    a = (a4[0] + a4[1]) + (a4[2] + a4[3]); }
                Pm[r * 133 + kk] = a;
            }
            mx = fmaxf(mx, a);
        }
#pragma unroll
        for (int o = 1; o < 16; o <<= 1) mx = fmaxf(mx, __shfl_xor(mx, o));
        const float sink = C.sinks[layer * 16 + h];
        const float mm = fmaxf(mx, sink);
        float sum = 0.f;
#pragma unroll 1
        for (int it = 0; it < 9; ++it) { const int kk = kg + 16 * it; if (kk < 132) { const float e = __expf(Pm[r * 133 + kk] - mm); Pm[r * 133 + kk] = e; sum += e; } }
#pragma unroll
        for (int o = 1; o < 16; o <<= 1) sum += __shfl_xor(sum, o);
        const float inv = 1.0f / (sum + __expf(sink - mm));
#pragma unroll 1
        for (int it = 0; it < 9; ++it) { const int kk = kg + 16 * it; if (kk < 132) Pm[r * 133 + kk] *= inv; }
    }
    __syncthreads();
    {
        const int r = tid >> 4, dq = tid & 15, t = r & 3, h = kvh * 8 + (r >> 2);
        f32x4 o = (f32x4){0.f, 0.f, 0.f, 0.f};
        for (int kk = 0; kk < 132; ++kk) { const float p = Pm[r * 133 + kk]; const f32x4 v = *(const f32x4*)(Vl + kk * 68 + 4 * dq); o += v * p; }
        const size_t row = (size_t)(T + 4 * b + t);
        const u32x2 gt = *(const u32x2*)(P + row * NP + C_GA + h * 64 + 4 * dq);
        u32x2 yo; yo.x = cvtpk(o[0] * silu_f(bf_lo(gt.x)), o[1] * silu_f(bf_hi(gt.x))); yo.y = cvtpk(o[2] * silu_f(bf_lo(gt.y)), o[3] * silu_f(bf_hi(gt.y)));
        *(u32x2*)(Y + row * D + h * 64 + 4 * dq) = yo;
    }
    __syncthreads();
}

__device__ __forceinline__ void ret_sample_group(const Ctx& C, char* lds, int layer, int ug, int tid, int w, int lane) {
    const bf16* P = (const bf16*)(C.ws + WS_P); bf16* Y = (bf16*)(C.ws + WS_Y);
    const int idx = 4 * ug + (w >> 1), b = idx >> 3, h = idx & 7, eh = w & 1;
    float* qs = (float*)(lds + w * 4096);
    float* ksm = qs + 512;
    float* pst = (float*)(lds + 32768);
    const float lng = ln_gamma(h);
    const size_t ro = (size_t)(T + 4 * b) * NP;
    float qv[4][2], kv[4][2];
    {
        const int g0 = 2 * lane, g1 = g0 + 1;
        const int d0 = 4 * (g0 >> 3) + (g0 & 3) + 64 * ((g0 >> 2) & 1), d1 = 4 * (g1 >> 3) + (g1 & 3) + 64 * ((g1 >> 2) & 1);
#pragma unroll
        for (int t = 0; t < 4; ++t) {
            const unsigned qq = *(const unsigned*)(P + ro + (size_t)t * NP + C_QB + h * 128 + g0), kk = *(const unsigned*)(P + ro + (size_t)t * NP + C_KB + h * 128 + g0);
            qv[t][0] = bf_lo(qq); qv[t][1] = bf_hi(qq); kv[t][0] = bf_lo(kk); kv[t][1] = bf_hi(kk);
            const float kd = __expf((float)(3 - t) * lng);
            qs[t * 128 + d0] = qv[t][0]; qs[t * 128 + d1] = qv[t][1]; ksm[t * 128 + d0] = kv[t][0] * kd; ksm[t * 128 + d1] = kv[t][1] * kd;
        }
    }
    const int e4 = lane & 15, dq = lane >> 4, e = eh * 64 + 4 * e4;
    f32x4 vm[4];
#pragma unroll
    for (int m = 0; m < 4; ++m) { const u32x2 vv = *(const u32x2*)(P + ro + (size_t)m * NP + C_VB + h * 128 + e); vm[m] = (f32x4){bf_lo(vv.x), bf_hi(vv.x), bf_lo(vv.y), bf_hi(vv.y)}; }
    float* Aw = (float*)(lds + 33024) + w * 16;
#pragma unroll
    for (int t = 0; t < 4; ++t)
#pragma unroll
        for (int m = 0; m < 4; ++m) {
            float a = 0.f;
            if (m <= t) { a = qv[t][0] * kv[m][0] + qv[t][1] * kv[m][1];
#pragma unroll
                for (int o = 1; o < 64; o <<= 1) a += __shfl_xor(a, o);
                a *= __expf((float)(t - m) * lng); }
            if (lane == 0) Aw[t * 4 + m] = a;
        }
    LDS_WAIT();
    const float* r0 = C.state + ((size_t)(layer * 128 + b) * 8 + h) * 16384 + e;
    float* rout = C.out + O_RS + ((size_t)(layer * 128 + b) * 8 + h) * 16384 + e;
    const float g4 = __expf(4.0f * lng);
    f32x4 acc[4];
#pragma unroll
    for (int t = 0; t < 4; ++t) acc[t] = (f32x4){0.f, 0.f, 0.f, 0.f};
#pragma unroll 1
    for (int i0 = 0; i0 < 32; i0 += 8) {
        f32x4 r[8];
#pragma unroll
        for (int k = 0; k < 8; ++k) r[k] = __builtin_nontemporal_load((const f32x4*)(r0 + (4 * (i0 + k) + dq) * 128));
#pragma unroll
        for (int k = 0; k < 8; ++k) {
            const int d = 4 * (i0 + k) + dq;
            const f32x4 rn = r[k] * g4 + vm[0] * ksm[d] + vm[1] * ksm[128 + d] + vm[2] * ksm[256 + d] + vm[3] * ksm[384 + d];
            __builtin_nontemporal_store(rn, (f32x4*)(rout + d * 128));
#pragma unroll
            for (int t = 0; t < 4; ++t) acc[t] += r[k] * qs[t * 128 + d];
        }
    }
    float o[4][4]; float s1[4], s2[4];
#pragma unroll
    for (int t = 0; t < 4; ++t) {
        const float qd = __expf((float)(t + 1) * lng);
        s1[t] = 0.f; s2[t] = 0.f;
#pragma unroll
        for (int j = 0; j < 4; ++j) {
            float a = acc[t][j]; a += __shfl_xor(a, 16); a += __shfl_xor(a, 32);
            a *= qd;
#pragma unroll
            for (int m = 0; m < 4; ++m) a += Aw[t * 4 + m] * vm[m][j];
            o[t][j] = a; s1[t] += a; s2[t] += a * a;
        }
#pragma unroll
        for (int k = 1; k < 16; k <<= 1) { s1[t] += __shfl_xor(s1[t], k); s2[t] += __shfl_xor(s2[t], k); }
        if (lane == 0) { pst[(w * 4 + t) * 2] = s1[t]; pst[(w * 4 + t) * 2 + 1] = s2[t]; }
    }
    __syncthreads();
    if (lane < 16) {
        const float* gw = C.ret_norm_w + layer * 1024 + h * 128 + e;
        const f32x4 wv = *(const f32x4*)gw;
#pragma unroll
        for (int t = 0; t < 4; ++t) {
            const float S1 = pst[(w * 4 + t) * 2] + pst[((w ^ 1) * 4 + t) * 2], S2 = pst[(w * 4 + t) * 2 + 1] + pst[((w ^ 1) * 4 + t) * 2 + 1];
            const float mu = S1 * (1.0f / 128.0f), var = fmaxf(S2 * (1.0f / 128.0f) - mu * mu, 0.f), rs = rsqrtf(var + 1e-6f);
            const size_t row = (size_t)(T + 4 * b + t);
            const u32x2 gt = *(const u32x2*)(P + row * NP + C_GB + h * 128 + e);
            u32x2 yo; yo.x = cvtpk((o[t][0] - mu) * rs * wv[0] * silu_f(bf_lo(gt.x)), (o[t][1] - mu) * rs * wv[1] * silu_f(bf_hi(gt.x)));
            yo.y = cvtpk((o[t][2] - mu) * rs * wv[2] * silu_f(bf_lo(gt.y)), (o[t][3] - mu) * rs * wv[3] * silu_f(bf_hi(gt.y)));
            *(u32x2*)(Y + row * D + 1024 + h * 128 + e) = yo;
        }
    }
    __syncthreads();
}

__device__ __forceinline__ void outproj_sample_unit(const Ctx& C, char* lds, int layer, int u, int tid, int w, int lane) {
    const bf16* Yb = (const bf16*)(C.ws + WS_Y) + (size_t)T * D; const bf16* Wt = (const bf16*)(C.ws + WS_WOUT) + (size_t)layer * D * D;
    const int m0 = (u >> 5) * 64, n0 = (u & 31) * 64, q = lane & 15, g = lane >> 4, k0 = 256 * w;
    f32x4 acc[4][4];
#pragma unroll
    for (int nt = 0; nt < 4; ++nt)
#pragma unroll
        for (int mt = 0; mt < 4; ++mt) acc[nt][mt] = (f32x4){0.f, 0.f, 0.f, 0.f};
    const int em = tid >> 3, en8 = (tid & 7) * 8;
    f32x4 rz0, rz1;
    if (layer == 0) { const float* bpz = C.x_sample + (size_t)(m0 + em) * D + n0 + en8; rz0 = *(const f32x4*)bpz; rz1 = *(const f32x4*)(bpz + 4); }
    else { const u32x4 xb = *(const u32x4*)((const bf16*)(C.ws + WS_XA) + (size_t)(T + m0 + em) * D + n0 + en8);
        rz0 = (f32x4){bf_lo(xb.x), bf_hi(xb.x), bf_lo(xb.y), bf_hi(xb.y)}; rz1 = (f32x4){bf_lo(xb.z), bf_hi(xb.z), bf_lo(xb.w), bf_hi(xb.w)}; }
    const bf16* ap = Wt + (size_t)(n0 + q) * D + k0 + 8 * g;
    const bf16* bp = Yb + (size_t)(m0 + q) * D + k0 + 8 * g;
    bf16x8 af[2][2][4], bfr[2][2][4];
#define OSU_LOAD(buf, kb) do { _Pragma("unroll") for (int ks = 0; ks < 2; ++ks) _Pragma("unroll") for (int t4 = 0; t4 < 4; ++t4) { \
        af[buf][ks][t4] = *(const bf16x8*)(ap + (size_t)(16 * t4) * D + 64 * (kb) + 32 * ks); bfr[buf][ks][t4] = *(const bf16x8*)(bp + (size_t)(16 * t4) * D + 64 * (kb) + 32 * ks); } } while (0)
    OSU_LOAD(0, 0);
#pragma unroll
    for (int kb = 0; kb < 4; ++kb) {
        if (kb + 1 < 4) { if ((kb & 1) == 0) OSU_LOAD(1, kb + 1); else OSU_LOAD(0, kb + 1); }
#pragma unroll
        for (int ks = 0; ks < 2; ++ks)
#pragma unroll
            for (int nt = 0; nt < 4; ++nt)
#pragma unroll
                for (int mt = 0; mt < 4; ++mt) acc[nt][mt] = __builtin_amdgcn_mfma_f32_16x16x32_bf16(af[kb & 1][ks][nt], bfr[kb & 1][ks][mt], acc[nt][mt], 0, 0, 0);
    }
#undef OSU_LOAD
    float* part = (float*)lds + w * (64 * 68);
#pragma unroll
    for (int nt = 0; nt < 4; ++nt)
#pragma unroll
        for (int mt = 0; mt < 4; ++mt) *(f32x4*)(part + (16 * mt + q) * 68 + 16 * nt + 4 * g) = acc[nt][mt];
    __syncthreads();
    {
        const int m = tid >> 3, n8 = (tid & 7) * 8;
        f32x4 v0 = (f32x4){0.f, 0.f, 0.f, 0.f}, v1 = v0;
#pragma unroll
        for (int ww = 0; ww < 8; ++ww) { const float* pp = (const float*)lds + ww * (64 * 68) + m * 68 + n8; v0 += *(const f32x4*)pp; v1 += *(const f32x4*)(pp + 4); }
        const int rs_ = m0 + m;
        v0 += rz0; v1 += rz1;
        if (layer != 0) { float* op = C.out + (size_t)(T + rs_) * D + n0 + n8; *(f32x4*)op = v0; *(f32x4*)(op + 4) = v1; }
        if (layer == 0) { u32x4 wv; wv.x = cvtpk(v0[0], v0[1]); wv.y = cvtpk(v0[2], v0[3]); wv.z = cvtpk(v1[0], v1[1]); wv.w = cvtpk(v1[2], v1[3]);
            *(u32x4*)((bf16*)(C.ws + WS_XA) + (size_t)(T + rs_) * D + n0 + n8) = wv; }
        float ss = (v0[0] * v0[0] + v0[1] * v0[1]) + (v0[2] * v0[2] + v0[3] * v0[3]) + (v1[0] * v1[0] + v1[1] * v1[1]) + (v1[2] * v1[2] + v1[3] * v1[3]);
        ss += __shfl_xor(ss, 1); ss += __shfl_xor(ss, 2); ss += __shfl_xor(ss, 4);
        if ((tid & 7) == 0) atomicAdd((float*)(C.ws + WS_CTL) + (layer + 1) * M + T + rs_, ss);
    }
    __syncthreads();
}

#ifndef SKIPM
#define SKIPM 0
#endif
#ifndef REPU
#define REPU 0
#endif
#ifndef REP_P0
#define REP_P0 1
#endif
#ifndef REP_G1
#define REP_G1 1
#endif
#ifndef REP_MX1
#define REP_MX1 1
#endif
#ifndef REP_RP
#define REP_RP 1
#endif
#ifndef REP_G2
#define REP_G2 1
#endif

#define GAS __attribute__((address_space(1)))
typedef GAS unsigned gu32;
#define XB_TMO      128
#define XB_XCNT(j)  (256  + 64 * (j))
#define XB_XSUB(j)  (1280 + 64 * (j))
#define XB_XGEN(j)  (2304 + 64 * (j))
#define XB_TOP      3328
#define XB_TOPGEN   3392
#define XCD_BAR_WORDS 3456
#define XB_SPIN_CAP (1u << 18)

__device__ __forceinline__ unsigned xb_ld(unsigned* p)              { return __hip_atomic_load(p, __ATOMIC_RELAXED, __HIP_MEMORY_SCOPE_AGENT); }
__device__ __forceinline__ unsigned xb_add(unsigned* p, unsigned v) { return __hip_atomic_fetch_add(p, v, __ATOMIC_RELAXED, __HIP_MEMORY_SCOPE_AGENT); }
__device__ __forceinline__ unsigned xb_xcc_id() { return (unsigned)__builtin_amdgcn_s_getreg((3 << 11) | 20) & 0xFu; }
#define XB_SPIN(cond, bar) do { unsigned _sp = 0; while (cond) { __builtin_amdgcn_s_sleep(1); \
    if ((++_sp & 255u) == 0u) { if (xb_ld(&(bar)[XB_TMO])) break; if (_sp > XB_SPIN_CAP) { atomicAdd(&(bar)[XB_TMO], 1u); break; } } } } while (0)

struct XcdBarrier {
    unsigned* bar; unsigned x;
    volatile LAS unsigned* st;
};

__device__ __forceinline__ XcdBarrier xcd_barrier_post(unsigned* bar, volatile LAS unsigned* st) {
    XcdBarrier b; b.bar = bar; b.x = xb_xcc_id(); b.st = st;
    if (threadIdx.x == 0) (void)xb_add(&bar[XB_XCNT(b.x)], 1u);
    return b;
}
__device__ __forceinline__ void xcd_barrier_complete(unsigned* bar, unsigned x, unsigned& nloc, unsigned& nx) {
    const unsigned G = gridDim.x * gridDim.y * gridDim.z;
    unsigned sum, cnt, mine, sp = 0u;
    for (;;) {
        sum = 0u; cnt = 0u; mine = 0u;
#pragma unroll
        for (unsigned j = 0; j < 16; ++j) { const unsigned c = xb_ld(&bar[XB_XCNT(j)]); sum += c; cnt += (c > 0u) ? 1u : 0u; mine = (j == x) ? c : mine; }
        if (sum == G) break;
        __builtin_amdgcn_s_sleep(1);
        if ((++sp & 255u) == 0u) { if (xb_ld(&bar[XB_TMO])) break; if (sp > XB_SPIN_CAP) { atomicAdd(&bar[XB_TMO], 1u); break; } }
    }
    nloc = mine > 0u ? mine : 1u; nx = cnt > 0u ? cnt : 1u;
}

__device__ __forceinline__ void xcd_barrier(const XcdBarrier& b) {
    asm volatile("s_waitcnt vmcnt(0)" ::: "memory");
    __syncthreads();
    if (threadIdx.x == 0) {
        unsigned* bar = b.bar;
        __builtin_amdgcn_s_waitcnt(0);
        unsigned nloc = b.st[0], nx = b.st[1];
        if (nloc == 0u) { xcd_barrier_complete(bar, b.x, nloc, nx); b.st[0] = nloc; b.st[1] = nx; }
        const unsigned old = xb_add(&bar[XB_XSUB(b.x)], 1u);
        const unsigned gen = old / nloc;
        if (old + 1u == (gen + 1u) * nloc) {
            __builtin_amdgcn_fence(__ATOMIC_RELEASE, "agent");
            asm volatile("s_waitcnt vmcnt(0)" ::: "memory");
            const unsigned og = xb_add(&bar[XB_TOP], 1u);
            const unsigned tg = og / nx;
            if (og + 1u == (tg + 1u) * nx) xb_add(&bar[XB_TOPGEN], 1u);
            else XB_SPIN(xb_ld(&bar[XB_TOPGEN]) == tg, bar);
            __builtin_amdgcn_fence(__ATOMIC_ACQUIRE, "agent");
            xb_add(&bar[XB_XGEN(b.x)], 1u);
            asm volatile("s_waitcnt vmcnt(0)" ::: "memory");
        } else {
            XB_SPIN(xb_ld(&bar[XB_XGEN(b.x)]) == gen, bar);
            __builtin_amdgcn_fence(__ATOMIC_ACQUIRE, "agent");
            asm volatile("s_waitcnt vmcnt(0)" ::: "memory");
        }
    }
    __syncthreads();
}

constexpr size_t WS_BAR = WS_CTL + 768 * 1024;
constexpr int LDS_BARST = LDS_BYTES - 64;
__global__ void __launch_bounds__(NTHREADS, 2) hymba_fwd(Ctx C) {
    extern __shared__ __attribute__((aligned(16))) unsigned char lds_raw[];
    cg::grid_group grid = cg::this_grid();
    if (threadIdx.x < 2) ((volatile LAS unsigned*)((LAS unsigned char*)lds_raw + LDS_BARST))[threadIdx.x] = 0u;
    __syncthreads();
    (void)xcd_barrier_post((unsigned*)(C.ws + WS_BAR), (volatile LAS unsigned*)((LAS unsigned char*)lds_raw + LDS_BARST));
    int ph = 0;
#define PHASE_LOCALS2 int tid = threadIdx.x; LAUNDER_V(tid); const int lane = tid & 63, wave = __builtin_amdgcn_readfirstlane(tid >> 6); char* lds = (char*)lds_raw; Ctx Cc = C; LAUNDER_S(Cc.ws); (void)lane; (void)wave; (void)lds
#define TAIL_OK(G_) ((G_) * 4 >= 850 && 850 - 3 * (G_) > 0 && 850 - 3 * (G_) < (G_))
#define PHASE_BEGIN (C.ph_lo <= ph && ph < C.ph_hi)
#define PHASE_END do { if (C.ph_lo <= ph && ph + 1 < C.ph_hi) { if (C.ph_lo < 0) grid.sync(); else { XcdBarrier xb_; xb_.bar = (unsigned*)(C.ws + WS_BAR); xb_.x = xb_xcc_id(); xb_.st = (volatile LAS unsigned*)((LAS unsigned char*)lds_raw + LDS_BARST); xcd_barrier(xb_); } } ++ph; } while (0)
#define PHASE_LOCALS int tid = threadIdx.x; LAUNDER_V(tid); const int lane = tid & 63, wave = __builtin_amdgcn_readfirstlane(tid >> 6); \
    int G = gridDim.x, bid = blockIdx.x; LAUNDER_S(G); LAUNDER_S(bid); char* lds = (char*)lds_raw; Ctx Cc = C; LAUNDER_S(Cc.ws); (void)lane; (void)wave; (void)lds

    if (PHASE_BEGIN) { PHASE_LOCALS; for (int rep = 0; rep < REP_P0; ++rep) { p0_prologue(Cc, lds, tid, wave, lane, G); __syncthreads(); } }
    PHASE_END;

    {
        constexpr int layer = 0;
        if (PHASE_BEGIN) {
            unsigned char* ws = C.ws; const int G = gridDim.x, bid = blockIdx.x;
            float* rss = (float*)(ws + WS_CTL); float* cosA = (float*)(ws + WS_TAB); float* sinA = cosA + NPOS * 32; float* cosB = sinA + NPOS * 32; float* sinB = cosB + NPOS * 64;
            pg8::Gemm g{(const bf16*)(ws + WS_XA), (const bf16*)(ws + WS_WIN) + (size_t)layer * NP * D, M, NP, D};
            pg8::EpiProj E{layer};
            unsigned* scnt = (unsigned*)(ws + WS_CTL) + 28672 + 64 * layer;
            {
                pg8::SampleFirstOrder S{G, bid, scnt};
                pg8::gemm_phase<pg8::EpiProj, pg8::SampleFirstOrder, true, true>((LAS unsigned char*)lds_raw, g, S, E);
                const bool tail = TAIL_OK(G);
                const int nfull = tail ? 850 - 3 * G : 0;
                if (bid >= nfull) {
                    PHASE_LOCALS2; int ly = layer; LAUNDER_S(ly);
                    if (ly == 0) convert_weights(Cc, (float*)(lds + wave * 16640), 1, (bid - nfull) * 8 + wave, (G - nfull) * 8, lane);
                    if (tail) {
                        __syncthreads();
                        if (tid == 0) { unsigned sp = 0u; while (__hip_atomic_load(scnt, __ATOMIC_RELAXED, __HIP_MEMORY_SCOPE_AGENT) < 50u && ++sp < (1u << 24)) __builtin_amdgcn_s_sleep(8);
                            __builtin_amdgcn_fence(__ATOMIC_ACQUIRE, "agent"); asm volatile("s_waitcnt vmcnt(0)" ::: "memory"); }
                        __syncthreads();
                        for (int ug = bid - nfull; ug < 256; ug += G - nfull) { int tu = tid; LAUNDER_V(tu); ret_sample_group(Cc, lds, ly, ug, tu, wave, tu & 63); }
                    }
                }
            }
        }
        PHASE_END;
        if (PHASE_BEGIN) {
            PHASE_LOCALS; int ly = layer; LAUNDER_S(ly);
            const int nunits = TAIL_OK(G) ? 1024 : 1280; const int tid_p = tid;
            for (int rep = 0; rep < REP_MX1; ++rep) for (int u = bid; u < nunits; u += G) {
                int tid = tid_p; LAUNDER_V(tid); const int lane = tid & 63;
                if (u < 512) { for (int r2 = 0; r2 < 1 + (REPU & 1); ++r2) ret_u_unit(Cc, lds, u >> 3, u & 7, tid, wave, lane); }
                else if (u < 768) { const int a = u - 512; for (int r2 = 0; r2 < 1 + ((REPU >> 1) & 1); ++r2) attn_prompt_unit(Cc, lds, ly, a >> 2, (a >> 1) & 1, a & 1, tid, wave, lane); }
                else if (u < 1024) { const int a = u - 768; for (int r2 = 0; r2 < 1 + ((REPU >> 2) & 1); ++r2) attn_sample_unit(Cc, lds, ly, a >> 1, a & 1, tid); }
                else { const int a = u - 1024; ret_sample_group(Cc, lds, ly, a, tid, wave, lane); }
            }
        }
        PHASE_END;
        if (PHASE_BEGIN) { PHASE_LOCALS; int ly = layer; LAUNDER_S(ly); for (int r2 = 0; r2 < 1 + ((REPU >> 4) & 1); ++r2) ret_scan(Cc, ly, tid, G); for (int u = bid; u < 256; u += G) outproj_sample_unit(Cc, lds, ly, u, tid, wave, lane); }
        PHASE_END;
        if (PHASE_BEGIN) { PHASE_LOCALS; int ly = layer; LAUNDER_S(ly); for (int rep = 0; rep < REP_RP; ++rep) for (int u = bid; u < 512; u += G) if (!(SKIPM & 16)) ret_prompt_unit(Cc, lds, ly, u >> 3, u & 7, tid, wave, lane); }
        PHASE_END;
        if (PHASE_BEGIN) {
            unsigned char* ws = C.ws; const int G = gridDim.x, bid = blockIdx.x;
            float* rss = (float*)(ws + WS_CTL); float* XR = (float*)(ws + WS_XR);
            pg8::Gemm g{(const bf16*)(ws + WS_Y), (const bf16*)(ws + WS_WOUT) + (size_t)layer * D * D, T, D, D}; pg8::StaticOrder S; S.init(T, D, G, bid);
            pg8::EpiRes E{layer};
            pg8::gemm_phase<pg8::EpiRes, pg8::StaticOrder, true, true>((LAS unsigned char*)lds_raw, g, S, E);
        }
        PHASE_END;
    }
    {
        constexpr int layer = 1;
        if (PHASE_BEGIN) {
            unsigned char* ws = C.ws; const int G = gridDim.x, bid = blockIdx.x;
            float* rss = (float*)(ws + WS_CTL); float* cosA = (float*)(ws + WS_TAB); float* sinA = cosA + NPOS * 32; float* cosB = sinA + NPOS * 32; float* sinB = cosB + NPOS * 64;
            pg8::Gemm g{(const bf16*)(ws + WS_XA), (const bf16*)(ws + WS_WIN) + (size_t)layer * NP * D, M, NP, D};
            pg8::EpiProj E{layer};
            unsigned* scnt = (unsigned*)(ws + WS_CTL) + 28672 + 64 * layer;
            {
                pg8::SampleFirstOrder S{G, bid, scnt};
                pg8::gemm_phase<pg8::EpiProj, pg8::SampleFirstOrder, true, true>((LAS unsigned char*)lds_raw, g, S, E);
                const bool tail = TAIL_OK(G);
                const int nfull = tail ? 850 - 3 * G : 0;
                if (bid >= nfull) {
                    PHASE_LOCALS2; int ly = layer; LAUNDER_S(ly);
                    if (ly == 0) convert_weights(Cc, (float*)(lds + wave * 16640), 1, (bid - nfull) * 8 + wave, (G - nfull) * 8, lane);
                    if (tail) {
                        __syncthreads();
                        if (tid == 0) { unsigned sp = 0u; while (__hip_atomic_load(scnt, __ATOMIC_RELAXED, __HIP_MEMORY_SCOPE_AGENT) < 50u && ++sp < (1u << 24)) __builtin_amdgcn_s_sleep(8);
                            __builtin_amdgcn_fence(__ATOMIC_ACQUIRE, "agent"); asm volatile("s_waitcnt vmcnt(0)" ::: "memory"); }
                        __syncthreads();
                        for (int ug = bid - nfull; ug < 256; ug += G - nfull) { int tu = tid; LAUNDER_V(tu); ret_sample_group(Cc, lds, ly, ug, tu, wave, tu & 63); }
                    }
                }
            }
        }
        PHASE_END;
        if (PHASE_BEGIN) {
            PHASE_LOCALS; int ly = layer; LAUNDER_S(ly);
            const int nunits = TAIL_OK(G) ? 1024 : 1280; const int tid_p = tid;
            for (int rep = 0; rep < REP_MX1; ++rep) for (int u = bid; u < nunits; u += G) {
                int tid = tid_p; LAUNDER_V(tid); const int lane = tid & 63;
                if (u < 512) { for (int r2 = 0; r2 < 1 + (REPU & 1); ++r2) ret_u_unit(Cc, lds, u >> 3, u & 7, tid, wave, lane); }
                else if (u < 768) { const int a = u - 512; for (int r2 = 0; r2 < 1 + ((REPU >> 1) & 1); ++r2) attn_prompt_unit(Cc, lds, ly, a >> 2, (a >> 1) & 1, a & 1, tid, wave, lane); }
                else if (u < 1024) { const int a = u - 768; for (int r2 = 0; r2 < 1 + ((REPU >> 2) & 1); ++r2) attn_sample_unit(Cc, lds, ly, a >> 1, a & 1, tid); }
                else { const int a = u - 1024; ret_sample_group(Cc, lds, ly, a, tid, wave, lane); }
            }
        }
        PHASE_END;
        if (PHASE_BEGIN) { PHASE_LOCALS; int ly = layer; LAUNDER_S(ly); for (int r2 = 0; r2 < 1 + ((REPU >> 4) & 1); ++r2) ret_scan(Cc, ly, tid, G); for (int u = bid; u < 256; u += G) outproj_sample_unit(Cc, lds, ly, u, tid, wave, lane); }
        PHASE_END;
        if (PHASE_BEGIN) { PHASE_LOCALS; int ly = layer; LAUNDER_S(ly); for (int rep = 0; rep < REP_RP; ++rep) for (int u = bid; u < 512; u += G) if (!(SKIPM & 16)) ret_prompt_unit(Cc, lds, ly, u >> 3, u & 7, tid, wave, lane); }
        PHASE_END;
        if (PHASE_BEGIN) {
            unsigned char* ws = C.ws; const int G = gridDim.x, bid = blockIdx.x;
            float* rss = (float*)(ws + WS_CTL); float* XR = (float*)(ws + WS_XR);
            pg8::Gemm g{(const bf16*)(ws + WS_Y), (const bf16*)(ws + WS_WOUT) + (size_t)layer * D * D, T, D, D}; pg8::StaticOrder S; S.init(T, D, G, bid);
            if (G == 256) {
                pg8::EpiResFinal EF;
                pg8::gemm_phase<pg8::EpiResFinal, pg8::StaticOrder, true, true>((LAS unsigned char*)lds_raw, g, S, EF);
                PHASE_LOCALS2;
                const float* rf = (const float*)(Cc.ws + WS_CTL) + 2 * M;
                for (int m = T + bid * 8 + wave; m < M; m += G * 8) {
                    const float rv = rsqrtf(rf[m] * (1.0f / 2048.0f) + 1e-6f);
                    f32x4* xr = (f32x4*)(Cc.out + (size_t)m * D);
#pragma unroll
                    for (int j = 0; j < 8; ++j) { const f32x4 wv = *((const f32x4*)Cc.final_w + lane + 64 * j); xr[lane + 64 * j] = xr[lane + 64 * j] * rv * wv; }
                }
            } else {
                pg8::EpiRes E{layer};
                pg8::gemm_phase<pg8::EpiRes, pg8::StaticOrder, true, true>((LAS unsigned char*)lds_raw, g, S, E);
            }
        }
        if (gridDim.x != 256) { PHASE_END; } else ++ph;
    }
#ifdef REP_SYNC
    for (int rep = 0; rep < REP_SYNC; ++rep) { XcdBarrier xb_; xb_.bar = (unsigned*)(C.ws + WS_BAR); xb_.x = xb_xcc_id(); xb_.st = (volatile LAS unsigned*)((LAS unsigned char*)lds_raw + LDS_BARST); xcd_barrier(xb_); }
#endif
    if (PHASE_BEGIN && gridDim.x != 256) {
        PHASE_LOCALS;
        const float* rf = (const float*)(Cc.ws + WS_CTL) + 2 * M;
        for (int m = bid * 8 + wave; m < M; m += G * 8) {
            const float rv = rsqrtf(rf[m] * (1.0f / 2048.0f) + 1e-6f);
            f32x4* xr = (f32x4*)(Cc.out + (size_t)m * D);
#pragma unroll
            for (int j = 0; j < 8; ++j) { const f32x4 wv = *((const f32x4*)Cc.final_w + lane + 64 * j); xr[lane + 64 * j] = xr[lane + 64 * j] * rv * wv; }
        }
    }
}

constexpr int N_PHASES = 1 + DEPTH * 5 + 1;
#ifndef MK_MULTI
#define MK_MULTI 0
#endif
extern "C" void kernel_launch(void* const* d_in, const int* in_sizes, int n_in, void* d_out, int out_size, void* d_ws, size_t ws_size, hipStream_t stream) {
    static int grid = 0;
    if (grid == 0) {
        if (n_in != 11 || ws_size < WS_END) { fprintf(stderr, "kernel_launch: unexpected inputs (n_in %d, ws %zu)\n", n_in, ws_size); grid = -1; return; }
        int dev = 0, cus = 0, per_cu = 0;
        hipGetDevice(&dev); hipDeviceGetAttribute(&cus, hipDeviceAttributeMultiprocessorCount, dev);
        if (hipFuncSetAttribute((const void*)hymba_fwd, hipFuncAttributeMaxDynamicSharedMemorySize, LDS_BYTES) != hipSuccess) { fprintf(stderr, "kernel_launch: hipFuncSetAttribute failed\n"); grid = -1; return; }
        if (hipOccupancyMaxActiveBlocksPerMultiprocessor(&per_cu, (const void*)hymba_fwd, NTHREADS, LDS_BYTES) != hipSuccess || per_cu < 1) { fprintf(stderr, "kernel_launch: occupancy query says %d\n", per_cu); (void)hipGetLastError(); per_cu = 1; }
        grid = cus;
    }
    if (grid < 0) return;
    hipMemsetAsync((char*)d_ws + WS_CTL, 0, CTL_BYTES, stream);
    Ctx c{};
    c.x_prompt = (const float*)d_in[0]; c.x_sample = (const float*)d_in[1]; c.cache_k = (const float*)d_in[2]; c.cache_v = (const float*)d_in[3]; c.state = (const float*)d_in[4];
    c.norm_w = (const float*)d_in[5]; c.w_in = (const float*)d_in[6]; c.sinks = (const float*)d_in[7]; c.ret_norm_w = (const float*)d_in[8]; c.w_out = (const float*)d_in[9]; c.final_w = (const float*)d_in[10];
    c.out = (float*)d_out; c.ws = (unsigned char*)d_ws;
#if MK_MULTI
    for (int p = 0; p < N_PHASES; ++p) { c.ph_lo = p; c.ph_hi = p + 1; void* args[] = {&c};
        hipError_t e = hipLaunchCooperativeKernel((const void*)hymba_fwd, dim3(grid), dim3(NTHREADS), args, LDS_BYTES, stream);
        if (e != hipSuccess) { fprintf(stderr, "launch %d failed: %s\n", p, hipGetErrorString(e)); break; } }
#else
    c.ph_lo = 0; c.ph_hi = N_PHASES; void* args[] = {&c};
    hipError_t e = hipLaunchCooperativeKernel((const void*)hymba_fwd, dim3(grid), dim3(NTHREADS), args, LDS_BYTES, stream);
    if (e != hipSuccess) fprintf(stderr, "cooperative launch failed: %s (grid %d)\n", hipGetErrorString(e), grid);
#endif
}
```

```cpp
#include <hip/hip_runtime.h>
#include <hip/hip_cooperative_groups.h>
#include <cstdio>
#include <cstdint>
namespace cg = cooperative_groups;
namespace pg8 {
#define PG8_LAS __attribute__((address_space(3)))
typedef unsigned short bf16_t;
typedef short bf16x8 __attribute__((ext_vector_type(8)));
typedef float f32x4 __attribute__((ext_vector_type(4)));
typedef unsigned u32x4 __attribute__((ext_vector_type(4)));
constexpr int BM = 256, BK = 64, HALF = 128, HTB = HALF * BK * 2  , STAGE_BYTES = 8 * HTB, NXCD = 8, WGM = 8;

__host__ __device__ __forceinline__ int lds_byte(int r, int c) { const int st = (r >> 4) * 2 + (c >> 5), rr = r & 15, cc = c & 31, ob = rr * 64 + cc * 2; return st * 1024 + (ob ^ (((ob >> 9) & 1) << 5)); }
__host__ __device__ __forceinline__ void stage_rc(int b, int& R, int& C) { const int st = b / 1024, sb = b % 1024, swz = sb ^ (((sb >> 9) & 1) << 5); R = (st >> 1) * 16 + swz / 64; C = (st & 1) * 32 + (swz % 64) / 2; }
__host__ __device__ __forceinline__ int perm32(int rho) { const int n = rho >> 4, i = rho & 15; return 8 * (i >> 2) + 4 * n + (i & 3); }

struct Unit { int pm, pn; };
struct Gemm { const bf16_t* A; const bf16_t* Bt; int M, N, K; };

struct StaticOrder {
    int nM, nN, nwg, G, c;
    __host__ __device__ void init(int M, int N, int G_, int c_) { nM = M / BM; nN = N / BM; nwg = nM * nN; G = G_; c = c_; }
    __host__ __device__ bool next(int i, Unit& u) const {
        const long L = (long)i * G + c; if (L >= nwg) return false;
        int wgid = (int)L; { const int q = nwg / NXCD, r = nwg % NXCD, xcd = wgid % NXCD, off = wgid / NXCD; wgid = (xcd < r ? xcd * (q + 1) : r * (q + 1) + (xcd - r) * q) + off; }
        const int nig = WGM * nN, gid = wgid / nig, fm = gid * WGM, gsz = (nM - fm) < WGM ? (nM - fm) : WGM;
        u.pm = fm + ((wgid % nig) % gsz); u.pn = (wgid % nig) / gsz; return true;
    }
    __device__ __forceinline__ void a_ready(const Unit&) const {}
    __device__ __forceinline__ void done(const Unit&) const {}
};


struct SampleFirstOrder {
    int G, c; unsigned* cnt;
    __device__ __forceinline__ bool next(int i, Unit& u) const {
        const int L = i * G + c; if (L >= 850) return false;
        if (L < 50) { u.pm = 32 + L / 25; u.pn = L % 25; return true; }
        int wgid = L - 50; wgid = (wgid % NXCD) * 100 + wgid / NXCD;
        const int r = wgid % 200; u.pm = (wgid / 200) * WGM + (r % WGM); u.pn = r / WGM; return true;
    }
    __device__ __forceinline__ void a_ready(const Unit&) const {}
    __device__ __forceinline__ void done(const Unit& u) const {
        if (u.pm >= 32) {
            asm volatile("s_waitcnt vmcnt(0)" ::: "memory");
            __syncthreads();
            if (threadIdx.x == 0) { __builtin_amdgcn_fence(__ATOMIC_RELEASE, "agent"); asm volatile("s_waitcnt vmcnt(0)" ::: "memory");
                __hip_atomic_fetch_add(cnt, 1u, __ATOMIC_RELAXED, __HIP_MEMORY_SCOPE_AGENT); }
        }
    }
};
__device__ __forceinline__ unsigned cvt_pk_bf16(float lo, float hi) { unsigned r; asm volatile("v_cvt_pk_bf16_f32 %0, %1, %2" : "=v"(r) : "v"(lo), "v"(hi)); return r; }
constexpr int T_ = 8192, NPROJ = 6400, DMODEL = 2048;
struct KArgs { const float* in[11]; float* out; unsigned char* ws; int ph_lo, ph_hi; };
constexpr size_t EMiB = 1u << 20, EWS_XA = 68 * EMiB, EWS_P = 102 * EMiB, EWS_XR = 243 * EMiB, EWS_TAB = 359 * EMiB;
constexpr size_t O_KP = (size_t)8704 * 2048, O_VP = O_KP + 32768, O_RP = O_VP + 32768, O_KS = O_RP + 262144, O_VS = O_KS + 4194304, O_RS = O_VS + 4194304;

struct EpiProj {
    static constexpr bool PERM = true, AFTER_DRAIN = false;
    int layer;
    __device__ __forceinline__ void operator()(const f32x4 (&acc)[2][2][4][2], const Unit& u, int wr, int wc, int fr, int fq) const {
        const KArgs* kp = (const KArgs*)__builtin_amdgcn_kernarg_segment_ptr(); asm volatile("" : "+s"(kp));
        unsigned char* ws = kp->ws; float* out = kp->out;
        bf16_t* P = (bf16_t*)(ws + EWS_P); const float* rss = (const float*)ws + layer * 8704;
        const float* cosA = (const float*)(ws + EWS_TAB); const float* sinA = cosA + 8196 * 32; const float* cosB = sinA + 8196 * 32; const float* sinB = cosB + 8196 * 64;
        float rv[2][4];
#pragma unroll
        for (int ai = 0; ai < 2; ++ai)
#pragma unroll
            for (int m = 0; m < 4; ++m) rv[ai][m] = rsqrtf(rss[u.pm * BM + ai * HALF + wr * 64 + m * 16 + fr] * (1.0f / 2048.0f) + 1e-6f);
#pragma unroll
        for (int bj = 0; bj < 2; ++bj) {
            const int cb = u.pn * BM + bj * HALF;
            const int c0 = cb + wc * 32 + 8 * fq;
            const int mode = (cb < 1152) ? 1 : ((cb >= 2304 && cb < 4352) ? 2 : 0);
            const int kvmode = (cb == 1024) ? 1 : ((cb == 1152) ? 2 : 0);
#pragma unroll
            for (int ai = 0; ai < 2; ++ai)
#pragma unroll
                for (int m = 0; m < 4; ++m) {
                    const int row = u.pm * BM + ai * HALF + wr * 64 + m * 16 + fr;
                    f32x4 v0 = acc[ai][bj][m][0] * rv[ai][m], v1 = acc[ai][bj][m][1] * rv[ai][m];
                    if (mode) {
                        const int pos = row < T_ ? row : T_ + ((row - T_) & 3);
                        f32x4 c, s;
                        if (mode == 1) { const int i = (c0 & 63) >> 3; c = *(const f32x4*)(cosA + pos * 32 + 4 * i); s = *(const f32x4*)(sinA + pos * 32 + 4 * i); }
                        else { const int i = (c0 & 127) >> 3; c = *(const f32x4*)(cosB + pos * 64 + 4 * i); s = *(const f32x4*)(sinB + pos * 64 + 4 * i); }
                        const f32x4 y0 = v0 * c - v1 * s, y1 = v1 * c + v0 * s; v0 = y0; v1 = y1;
                    }
                    u32x4 w; w.x = cvt_pk_bf16(v0[0], v0[1]); w.y = cvt_pk_bf16(v0[2], v0[3]); w.z = cvt_pk_bf16(v1[0], v1[1]); w.w = cvt_pk_bf16(v1[2], v1[3]);
                    *(u32x4*)(P + (size_t)row * NPROJ + c0) = w;
                    if (kvmode && row >= T_ - 128) {
                        const int kvh = (c0 - cb) >> 6, g0 = c0 & 63;
                        float* dst;
                        if (row < T_) dst = out + (kvmode == 1 ? O_KP : O_VP) + ((size_t)(layer * 128 + (row - (T_ - 128))) * 2 + kvh) * 64;
                        else { const int b = (row - T_) >> 2, t = (row - T_) & 3; dst = out + (kvmode == 1 ? O_KS : O_VS) + ((((size_t)layer * 128 + b) * 128 + 124 + t) * 2 + kvh) * 64; }
                        if (kvmode == 1) { const int i = g0 >> 3; *(f32x4*)(dst + 4 * i) = v0; *(f32x4*)(dst + 4 * i + 32) = v1; }
                        else { *(f32x4*)(dst + g0) = v0; *(f32x4*)(dst + g0 + 4) = v1; }
                    }
                }
        }
    }
};

struct EpiRes {
    static constexpr bool PERM = true, AFTER_DRAIN = false;
    int layer;
    __device__ __forceinline__ void operator()(const f32x4 (&acc)[2][2][4][2], const Unit& u, int wr, int wc, int fr, int fq) const {
        const KArgs* kp = (const KArgs*)__builtin_amdgcn_kernarg_segment_ptr(); asm volatile("" : "+s"(kp));
        unsigned char* ws = kp->ws; bf16_t* xa = (bf16_t*)(ws + EWS_XA); float* rss = (float*)ws + (layer + 1) * 8704;
#pragma unroll
        for (int ai = 0; ai < 2; ++ai)
#pragma unroll
            for (int m = 0; m < 4; ++m) {
                const int row = u.pm * BM + ai * HALF + wr * 64 + m * 16 + fr;
                float ss = 0.f;
#pragma unroll
                for (int bj = 0; bj < 2; ++bj) {
                    const int c0 = u.pn * BM + bj * HALF + wc * 32 + 8 * fq;
                    f32x4 b0, b1;
                    if (layer == 0) { const float* bp = (row < T_ ? kp->in[0] + (size_t)row * DMODEL : kp->in[1] + (size_t)(row - T_) * DMODEL) + c0; b0 = *(const f32x4*)bp; b1 = *(const f32x4*)(bp + 4); }
                    else { const u32x4 xb = *(const u32x4*)(xa + (size_t)row * DMODEL + c0);
                        b0 = (f32x4){__uint_as_float(xb.x << 16), __uint_as_float(xb.x & 0xffff0000u), __uint_as_float(xb.y << 16), __uint_as_float(xb.y & 0xffff0000u)};
                        b1 = (f32x4){__uint_as_float(xb.z << 16), __uint_as_float(xb.z & 0xffff0000u), __uint_as_float(xb.w << 16), __uint_as_float(xb.w & 0xffff0000u)}; }
                    const f32x4 v0 = acc[ai][bj][m][0] + b0, v1 = acc[ai][bj][m][1] + b1;
                    if (layer == 0) { u32x4 w; w.x = cvt_pk_bf16(v0[0], v0[1]); w.y = cvt_pk_bf16(v0[2], v0[3]); w.z = cvt_pk_bf16(v1[0], v1[1]); w.w = cvt_pk_bf16(v1[2], v1[3]);
                        *(u32x4*)(xa + (size_t)row * DMODEL + c0) = w; }
                    else { float* op = kp->out + (size_t)row * DMODEL + c0; *(f32x4*)op = v0; *(f32x4*)(op + 4) = v1; }
                    ss += (v0[0] * v0[0] + v0[1] * v0[1]) + (v0[2] * v0[2] + v0[3] * v0[3]) + (v1[0] * v1[0] + v1[1] * v1[1]) + (v1[2] * v1[2] + v1[3] * v1[3]);
                }
                ss += __shfl_xor(ss, 16); ss += __shfl_xor(ss, 32);
                if (fq == 0) atomicAdd(rss + row, ss);
            }
    }
};


struct EpiResFinal {
    static constexpr bool PERM = true, AFTER_DRAIN = true;
    __device__ __forceinline__ void operator()(const f32x4 (&)[2][2][4][2], const Unit&, int, int, int, int) const {}
    __device__ __forceinline__ void fused(f32x4 (&acc)[2][2][4][2], const Unit& u, int wr, int wc, int fr, int fq, PG8_LAS unsigned char* lds, int wid, int lane) const {
        asm volatile("" : "+v"(fr), "+v"(fq));
        const KArgs* kp = (const KArgs*)__builtin_amdgcn_kernarg_segment_ptr(); asm volatile("" : "+s"(kp));
        unsigned char* ws = kp->ws; const bf16_t* xa = (const bf16_t*)(ws + EWS_XA);
        PG8_LAS float* P4 = (PG8_LAS float*)lds;
        PG8_LAS float* S = (PG8_LAS float*)(lds + 4096);
        PG8_LAS unsigned* flag = (PG8_LAS unsigned*)(lds + 8192);
        unsigned* slots = (unsigned*)(ws + EWS_XR);
        unsigned* cnt = (unsigned*)ws + 32768 + 64 * u.pm;
#pragma unroll
        for (int ai = 0; ai < 2; ++ai)
#pragma unroll
            for (int m = 0; m < 4; ++m) {
                const int rl = ai * HALF + wr * 64 + m * 16 + fr, row = u.pm * BM + rl;
                float ss = 0.f;
#pragma unroll
                for (int bj = 0; bj < 2; ++bj) {
                    const int c0 = u.pn * BM + bj * HALF + wc * 32 + 8 * fq;
                    const u32x4 xb = *(const u32x4*)(xa + (size_t)row * DMODEL + c0);
                    const f32x4 b0 = (f32x4){__uint_as_float(xb.x << 16), __uint_as_float(xb.x & 0xffff0000u), __uint_as_float(xb.y << 16), __uint_as_float(xb.y & 0xffff0000u)};
                    const f32x4 b1 = (f32x4){__uint_as_float(xb.z << 16), __uint_as_float(xb.z & 0xffff0000u), __uint_as_float(xb.w << 16), __uint_as_float(xb.w & 0xffff0000u)};
                    const f32x4 v0 = acc[ai][bj][m][0] + b0, v1 = acc[ai][bj][m][1] + b1;
                    acc[ai][bj][m][0] = v0; acc[ai][bj][m][1] = v1;
                    ss += (v0[0] * v0[0] + v0[1] * v0[1]) + (v0[2] * v0[2] + v0[3] * v0[3]) + (v1[0] * v1[0] + v1[1] * v1[1]) + (v1[2] * v1[2] + v1[3] * v1[3]);
                }
                ss += __shfl_xor(ss, 16); ss += __shfl_xor(ss, 32);
                if (fq == 0) P4[rl * 4 + wc] = ss;
            }
        asm volatile("s_waitcnt lgkmcnt(0)" ::: "memory"); __builtin_amdgcn_s_barrier(); asm volatile("" ::: "memory");
        const int tid = wid * 64 + lane;
        if (tid < 256) { const float t = (P4[tid * 4] + P4[tid * 4 + 1]) + (P4[tid * 4 + 2] + P4[tid * 4 + 3]);
            __hip_atomic_store(slots + ((size_t)(u.pm * BM + tid)) * 8 + u.pn, __float_as_uint(t), __ATOMIC_RELAXED, __HIP_MEMORY_SCOPE_AGENT); }
        asm volatile("s_waitcnt vmcnt(0)" ::: "memory");
        if (lane == 0) __hip_atomic_fetch_add(cnt, 1u, __ATOMIC_RELAXED, __HIP_MEMORY_SCOPE_AGENT);
        if (wid == 0) {
            unsigned sp = 0u; bool dead = false;
            while ((unsigned)__builtin_amdgcn_readfirstlane(__hip_atomic_load(cnt, __ATOMIC_RELAXED, __HIP_MEMORY_SCOPE_AGENT)) < 64u) { __builtin_amdgcn_s_sleep(2); if (++sp > (1u << 22)) { dead = true; break; } }
            __builtin_amdgcn_fence(__ATOMIC_ACQUIRE, "agent");
            if (lane == 0) flag[0] = dead ? 1u : 0u;
        }
        asm volatile("s_waitcnt vmcnt(0) lgkmcnt(0)" ::: "memory"); __builtin_amdgcn_s_barrier(); asm volatile("" ::: "memory");
        if (tid < 256) { const unsigned* sl = slots + ((size_t)(u.pm * BM + tid)) * 8; float t = 0.f;
#pragma unroll
            for (int k = 0; k < 8; ++k) t += __uint_as_float(__hip_atomic_load(sl + k, __ATOMIC_RELAXED, __HIP_MEMORY_SCOPE_AGENT));
            S[tid] = flag[0] ? __builtin_nanf("") : rsqrtf(t * (1.0f / 2048.0f) + 1e-6f); }
        asm volatile("s_waitcnt lgkmcnt(0)" ::: "memory"); __builtin_amdgcn_s_barrier(); asm volatile("" ::: "memory");
        const float* fw = kp->in[10];
#pragma unroll
        for (int bj = 0; bj < 2; ++bj) {
            const int c0 = u.pn * BM + bj * HALF + wc * 32 + 8 * fq;
            const f32x4 w0 = *(const f32x4*)(fw + c0), w1 = *(const f32x4*)(fw + c0 + 4);
#pragma unroll
            for (int ai = 0; ai < 2; ++ai)
#pragma unroll
                for (int m = 0; m < 4; ++m) {
                    const int rl = ai * HALF + wr * 64 + m * 16 + fr; const float rv = S[rl];
                    float* op = kp->out + (size_t)(u.pm * BM + rl) * DMODEL + c0;
                    __builtin_nontemporal_store(acc[ai][bj][m][0] * rv * w0, (f32x4*)op); __builtin_nontemporal_store(acc[ai][bj][m][1] * rv * w1, (f32x4*)(op + 4));
                }
        }
    }
};

template <class Epi, class Sched, bool ALIGN_EPI = false, bool SP2 = false>
__device__ __forceinline__ void gemm_phase(PG8_LAS unsigned char* lds, const Gemm g, const Sched& S, const Epi& E) {
    int tid_ = threadIdx.x; asm volatile("" : "+v"(tid_));
    const int tid = tid_, wid = __builtin_amdgcn_readfirstlane(tid >> 6), lane = tid & 63, wr = wid >> 2, wc = wid & 3, fr = lane & 15, fq = lane >> 4;
    const int K = g.K, nt = K / BK;
    unsigned voffA[2], voffB[2];
#pragma unroll
    for (int i = 0; i < 2; ++i) { int R, C; stage_rc(tid * 16 + i * 8192, R, C); const int Rb = Epi::PERM ? ((R & ~31) + perm32(R & 31)) : R;
        voffA[i] = (unsigned)(R * K + C) * 2u; voffB[i] = (unsigned)(Rb * K + C) * 2u; }
    const size_t kstep = (size_t)(BK * 2);
    const size_t hstep = (size_t)HALF * K * 2;
    const size_t tstep = 2 * hstep;
    const unsigned ldsw = (unsigned)wid * 1024u;
    const int aoff = lds_byte(wr * 64 + fr, fq * 8), boff = lds_byte(wc * 32 + fr, fq * 8);
#define PG8_SA(b, h) (((b) * 2 + (h)) * HTB)
#define PG8_SB(b, h) ((4 + (b) * 2 + (h)) * HTB)
#define PG8_STAGE(bufoff, gbase, voff) do { _Pragma("unroll") for (int _i = 0; _i < 2; ++_i) \
        __builtin_amdgcn_global_load_lds((const unsigned*)((const char*)(gbase) + (voff)[_i]), (PG8_LAS unsigned*)(lds + (bufoff) + ldsw + _i * 8192), 16, 0, 0); } while (0)
#define PG8_LDA(dst, b, h) do { _Pragma("unroll") for (int m = 0; m < 4; ++m) _Pragma("unroll") for (int k = 0; k < 2; ++k) dst[m][k] = *(const PG8_LAS bf16x8*)(lds + PG8_SA(b, h) + aoff + m * 2048 + k * 1024); } while (0)
#define PG8_LDB(dst, b, h) do { _Pragma("unroll") for (int n = 0; n < 2; ++n) _Pragma("unroll") for (int k = 0; k < 2; ++k) dst[n][k] = *(const PG8_LAS bf16x8*)(lds + PG8_SB(b, h) + boff + n * 2048 + k * 1024); } while (0)
#define PG8_MMA(ai, bj, At, Bt) do { __builtin_amdgcn_s_setprio(1); _Pragma("unroll") for (int m = 0; m < 4; ++m) _Pragma("unroll") for (int n = 0; n < 2; ++n) _Pragma("unroll") for (int k = 0; k < 2; ++k) \
        acc[ai][bj][m][n] = __builtin_amdgcn_mfma_f32_16x16x32_bf16(Bt[n][k], At[m][k], acc[ai][bj][m][n], 0, 0, 0); __builtin_amdgcn_s_setprio(0); } while (0)
#define PG8_WAIT_V(n) asm volatile("s_waitcnt vmcnt(" #n ")" ::: "memory")
#define PG8_WAIT_L(n) asm volatile("s_waitcnt lgkmcnt(" #n ")" ::: "memory")
#define PG8_BAR __builtin_amdgcn_s_barrier()
#define PG8_SCHED __builtin_amdgcn_sched_barrier(0)
    Unit cur, nxt; int ui = 0;
    if (!S.next(0, cur)) return;
    f32x4 acc[2][2][4][2];
#pragma unroll
    for (int a = 0; a < 2; ++a)
#pragma unroll
        for (int b = 0; b < 2; ++b)
#pragma unroll
            for (int m = 0; m < 4; ++m)
#pragma unroll
                for (int n = 0; n < 2; ++n) acc[a][b][m][n] = (f32x4){0.f, 0.f, 0.f, 0.f};
    bf16x8 At[4][2], B0[2][2], B1[2][2];
    const char* cA = (const char*)g.A + (size_t)cur.pm * tstep; const char* cB = (const char*)g.Bt + (size_t)cur.pn * tstep;
    S.a_ready(cur);
    if constexpr (SP2) {
        PG8_STAGE(PG8_SB(0, 0), cB, voffB); PG8_STAGE(PG8_SB(0, 1), cB + hstep, voffB); PG8_STAGE(PG8_SA(0, 0), cA, voffA); PG8_STAGE(PG8_SA(0, 1), cA + hstep, voffA);
        if (wr == 1) PG8_BAR;
        PG8_WAIT_V(2); PG8_BAR;
        PG8_STAGE(PG8_SB(1, 0), cB + kstep, voffB); PG8_STAGE(PG8_SA(1, 0), cA + kstep, voffA); PG8_STAGE(PG8_SB(1, 1), cB + hstep + kstep, voffB);
        PG8_WAIT_V(6); PG8_BAR;
    } else {
        PG8_STAGE(PG8_SB(0, 0), cB, voffB); PG8_STAGE(PG8_SA(0, 0), cA, voffA); PG8_STAGE(PG8_SB(0, 1), cB + hstep, voffB); PG8_STAGE(PG8_SA(0, 1), cA + hstep, voffA);
        if (wr == 1) PG8_BAR;
        PG8_WAIT_V(4); PG8_BAR;
        PG8_STAGE(PG8_SB(1, 0), cB + kstep, voffB); PG8_STAGE(PG8_SA(1, 0), cA + kstep, voffA); PG8_STAGE(PG8_SB(1, 1), cB + hstep + kstep, voffB);
        PG8_WAIT_V(6); PG8_BAR;
    }
    for (;;) {
        const bool has_next = S.next(ui + 1, nxt);
        const char* nA = has_next ? (const char*)g.A + (size_t)nxt.pm * tstep : cA; const char* nB = has_next ? (const char*)g.Bt + (size_t)nxt.pn * tstep : cB;
        for (int t = 0; t < nt; t += 2) {
            const bool last = (t == nt - 2);
            const char* a1 = cA + (size_t)(t + 1) * kstep;
            const char* a2 = last ? nA : cA + (size_t)(t + 2) * kstep; const char* b2 = last ? nB : cB + (size_t)(t + 2) * kstep;
            const char* a3 = a2 + kstep; const char* b3 = b2 + kstep;
            if (last && has_next) S.a_ready(nxt);
            if constexpr (SP2) {
            PG8_LDB(B0, 0, 0); PG8_LDB(B1, 0, 1); PG8_SCHED; PG8_LDA(At, 0, 0); PG8_STAGE(PG8_SA(1, 1), a1 + hstep, voffA);
            PG8_WAIT_V(8); PG8_WAIT_L(0); PG8_BAR; PG8_MMA(0, 0, At, B0); PG8_MMA(0, 1, At, B1); PG8_BAR; PG8_SCHED;
            PG8_LDA(At, 0, 1); PG8_STAGE(PG8_SB(0, 0), b2, voffB); PG8_STAGE(PG8_SB(0, 1), b2 + hstep, voffB); PG8_STAGE(PG8_SA(0, 0), a2, voffA);
            PG8_WAIT_V(8); PG8_WAIT_L(0); PG8_BAR; PG8_MMA(1, 0, At, B0); PG8_MMA(1, 1, At, B1); PG8_BAR; PG8_SCHED;
            PG8_LDB(B0, 1, 0); PG8_LDB(B1, 1, 1); PG8_SCHED; PG8_LDA(At, 1, 0); PG8_STAGE(PG8_SA(0, 1), a2 + hstep, voffA);
            PG8_WAIT_V(8); PG8_WAIT_L(0); PG8_BAR; PG8_MMA(0, 0, At, B0); PG8_MMA(0, 1, At, B1); PG8_BAR; PG8_SCHED;
            PG8_LDA(At, 1, 1); PG8_STAGE(PG8_SB(1, 0), b3, voffB); PG8_STAGE(PG8_SB(1, 1), b3 + hstep, voffB); PG8_STAGE(PG8_SA(1, 0), a3, voffA);
            PG8_WAIT_V(8); PG8_WAIT_L(0); PG8_BAR; PG8_MMA(1, 0, At, B0); PG8_MMA(1, 1, At, B1); PG8_BAR; PG8_SCHED;
            } else {
            PG8_LDB(B0, 0, 0); PG8_SCHED; PG8_LDA(At, 0, 0); PG8_STAGE(PG8_SA(1, 1), a1 + hstep, voffA);
            PG8_WAIT_L(8); PG8_BAR; PG8_WAIT_L(0); PG8_MMA(0, 0, At, B0); PG8_BAR; PG8_SCHED;
            PG8_LDB(B1, 0, 1); PG8_STAGE(PG8_SB(0, 0), b2, voffB);
            PG8_BAR; PG8_WAIT_L(0); PG8_MMA(0, 1, At, B1); PG8_BAR;
            PG8_LDA(At, 0, 1); PG8_STAGE(PG8_SA(0, 0), a2, voffA);
            PG8_BAR; PG8_WAIT_L(0); PG8_MMA(1, 0, At, B0); PG8_BAR; PG8_SCHED;
            PG8_STAGE(PG8_SB(0, 1), b2 + hstep, voffB);
            PG8_WAIT_V(6); PG8_BAR; PG8_MMA(1, 1, At, B1); PG8_BAR;
            PG8_LDB(B0, 1, 0); PG8_SCHED; PG8_LDA(At, 1, 0); PG8_STAGE(PG8_SA(0, 1), a2 + hstep, voffA);
            PG8_WAIT_L(8); PG8_BAR; PG8_WAIT_L(0); PG8_MMA(0, 0, At, B0); PG8_BAR; PG8_SCHED;
            PG8_LDB(B1, 1, 1); PG8_STAGE(PG8_SB(1, 0), b3, voffB);
            PG8_BAR; PG8_WAIT_L(0); PG8_MMA(0, 1, At, B1); PG8_BAR;
            PG8_LDA(At, 1, 1); PG8_STAGE(PG8_SA(1, 0), a3, voffA);
            PG8_BAR; PG8_WAIT_L(0); PG8_MMA(1, 0, At, B0); PG8_BAR; PG8_SCHED;
            PG8_STAGE(PG8_SB(1, 1), b3 + hstep, voffB);
            PG8_WAIT_V(6); PG8_BAR; PG8_MMA(1, 1, At, B1); PG8_BAR;
            }
        }
        if constexpr (ALIGN_EPI) { if (wr == 0) PG8_BAR; }
        if constexpr (!Epi::AFTER_DRAIN) { E(acc, cur, wr, wc, fr, fq); S.done(cur); }
        if (!has_next) break;
#pragma unroll
        for (int a = 0; a < 2; ++a)
#pragma unroll
            for (int b = 0; b < 2; ++b)
#pragma unroll
                for (int m = 0; m < 4; ++m)
#pragma unroll
                    for (int n = 0; n < 2; ++n) acc[a][b][m][n] = (f32x4){0.f, 0.f, 0.f, 0.f};
        cur = nxt; cA = nA; cB = nB; ++ui;
        if constexpr (ALIGN_EPI) { if (wr == 1) PG8_BAR; }
    }
    PG8_WAIT_V(0);
    if constexpr (!ALIGN_EPI) { if (wr == 0) PG8_BAR; }
    PG8_BAR;
    if constexpr (Epi::AFTER_DRAIN) { E.fused(acc, cur, wr, wc, fr, fq, lds, wid, lane); S.done(cur); }
#undef PG8_SA
#undef PG8_SB
#undef PG8_STAGE
#undef PG8_LDA
#undef PG8_LDB
#undef PG8_MMA
#undef PG8_WAIT_V
#undef PG8_WAIT_L
#undef PG8_BAR
#undef PG8_SCHED
}
}

typedef unsigned short bf16;
typedef float f32x4 __attribute__((ext_vector_type(4)));
typedef short bf16x8 __attribute__((ext_vector_type(8)));
typedef short s16x4 __attribute__((ext_vector_type(4)));
typedef unsigned u32x4 __attribute__((ext_vector_type(4)));
typedef unsigned u32x2 __attribute__((ext_vector_type(2)));
typedef float f32x2 __attribute__((ext_vector_type(2)));
typedef __bf16 bf16x2_t __attribute__((ext_vector_type(2)));
#define LAS __attribute__((address_space(3)))

constexpr int T = 8192, NS = 512, M = 8704, D = 2048, NP = 6400, DEPTH = 2;
constexpr int C_QA = 0, C_KA = 1024, C_VA = 1152, C_GA = 1280, C_QB = 2304, C_KB = 3328, C_VB = 4352, C_GB = 5376;
constexpr int NPOS = 8196;
constexpr int LDS_BYTES = 147456;
constexpr int NTHREADS = 512;
using pg8::O_KP; using pg8::O_VP; using pg8::O_RP; using pg8::O_KS; using pg8::O_VS; using pg8::O_RS;

constexpr size_t MiB = 1u << 20;
constexpr size_t WS_CTL = 0, CTL_BYTES = 1 * MiB;
constexpr size_t WS_WIN = 2 * MiB;
constexpr size_t WS_WOUT = WS_WIN + 50 * MiB;
constexpr size_t WS_XA = WS_WOUT + 16 * MiB;
constexpr size_t WS_P = WS_XA + 34 * MiB;
constexpr size_t WS_Y = WS_P + 107 * MiB;
constexpr size_t WS_XR = WS_Y + 34 * MiB;
constexpr size_t WS_U = WS_XR + 68 * MiB;
constexpr size_t WS_RT = WS_U + 32 * MiB;
constexpr size_t WS_TAB = WS_RT + 16 * MiB;
constexpr size_t WS_END = WS_TAB + 8 * MiB;
static_assert(WS_XA == pg8::EWS_XA && WS_P == pg8::EWS_P && WS_XR == pg8::EWS_XR && WS_TAB == pg8::EWS_TAB && WS_CTL == 0, "d_ws map vs the epilogues' copy");

static_assert(true, "");
struct Ctx {
    const float *x_prompt, *x_sample, *cache_k, *cache_v, *state, *norm_w, *w_in, *sinks, *ret_norm_w, *w_out, *final_w;
    float* out; unsigned char* ws;
    int ph_lo, ph_hi;
};

__device__ __forceinline__ unsigned cvtpk(float lo, float hi) { f32x2 v = {lo, hi}; bf16x2_t b = __builtin_convertvector(v, bf16x2_t); return __builtin_bit_cast(unsigned, b); }
__device__ __forceinline__ float bf_lo(unsigned u) { return __uint_as_float(u << 16); }
__device__ __forceinline__ float bf_hi(unsigned u) { return __uint_as_float(u & 0xffff0000u); }
__device__ __forceinline__ float silu_f(float x) { return x / (1.0f + __expf(-x)); }
__device__ __forceinline__ s16x4 vtr(const char* p) { typedef short v4i16_t __attribute__((ext_vector_type(4)));
    return __builtin_bit_cast(s16x4, __builtin_amdgcn_ds_read_tr16_b64_v4i16((LAS v4i16_t*)p)); }
__device__ __forceinline__ bf16x8 cat8(s16x4 lo, s16x4 hi) { return (bf16x8){lo[0], lo[1], lo[2], lo[3], hi[0], hi[1], hi[2], hi[3]}; }
__device__ __forceinline__ float ln_gamma(int h) {
    const double x = __builtin_ldexp(1.0, -5 - h);
    double s = 0.0, p = x;
#pragma unroll
    for (int k = 1; k <= 9; ++k) { s += p / (double)k; p *= x; }
    return (float)(-s);
}
#define LDS_WAIT() asm volatile("s_waitcnt lgkmcnt(0)" ::: "memory")
#define LAUNDER_V(x) asm volatile("" : "+v"(x))
#define LAUNDER_S(x) asm volatile("" : "+s"(x))

__device__ __forceinline__ int perm_src_col(int np, float& sc) {
    sc = 1.0f;
    if (np < 1152) { const int hb = np & ~63, g = np & 63; if (np < 1024) sc = 0.125f; return hb + 4 * (g >> 3) + (g & 3) + 32 * ((g >> 2) & 1); }
    if (np >= C_QB && np < C_VB) { const int hb = np & ~127, g = np & 127; if (np >= C_KB) sc = 0.08838834764831845f; return hb + 4 * (g >> 3) + (g & 3) + 64 * ((g >> 2) & 1); }
    return np;
}

template <bool WIN>
__device__ __forceinline__ void transpose_item(const float* W, int N, const float* nw, bf16* WT, float* scr, int kb, int nb, int lane) {
    const int k0 = 64 * kb, n0 = 64 * nb, l16 = lane & 15, r4 = lane >> 4;
    float sc = 1.0f; int srcc = n0 + 4 * l16;
    if (WIN) srcc = perm_src_col(n0 + 4 * l16, sc);
    f32x4 v[16]; float nwv[16];
#pragma unroll
    for (int i = 0; i < 16; ++i) { const int kk = 4 * i + r4; v[i] = __builtin_nontemporal_load((const f32x4*)(W + (size_t)(k0 + kk) * N + srcc)); nwv[i] = WIN ? nw[k0 + kk] : 1.0f; }
#pragma unroll
    for (int i = 0; i < 16; ++i) {
        const int kk = 4 * i + r4; const float s2 = sc * nwv[i];
        float* d = scr + kk * 65 + 4 * l16;
        d[0] = v[i][0] * s2; d[1] = v[i][1] * s2; d[2] = v[i][2] * s2; d[3] = v[i][3] * s2;
    }
    LDS_WAIT();
    const int c = lane & 7;
#pragma unroll
    for (int j = 0; j < 8; ++j) {
        const int n = (lane >> 3) + 8 * j; const float* s = scr + (8 * c) * 65 + n;
        u32x4 o; o.x = cvtpk(s[0], s[65]); o.y = cvtpk(s[130], s[195]); o.z = cvtpk(s[260], s[325]); o.w = cvtpk(s[390], s[455]);
        *(u32x4*)(WT + (size_t)(n0 + n) * 2048 + k0 + 8 * c) = o;
    }
    LDS_WAIT();
}

__device__ __forceinline__ void convert_weights(const Ctx& C, float* scr, int l, int gw, int NGW, int lane) {
    bf16* WIN = (bf16*)(C.ws + WS_WIN); bf16* WOUT = (bf16*)(C.ws + WS_WOUT);
    constexpr int I_IN = 32 * 100, I_OUT = 32 * 32;
    for (int it = gw; it < I_IN + I_OUT; it += NGW) {
        int r = it;
        if (r < I_IN) { const int nb = r % 100, kb = r / 100;
            transpose_item<true>(C.w_in + (size_t)l * D * NP, NP, C.norm_w + l * D, WIN + (size_t)l * NP * D, scr, kb, nb, lane); }
        else { r -= I_IN; const int nb = r & 31, kb = r >> 5;
            transpose_item<false>(C.w_out + (size_t)l * D * D, D, nullptr, WOUT + (size_t)l * D * D, scr, kb, nb, lane); }
    }
}

__device__ __forceinline__ void p0_prologue(const Ctx& C, char* lds, int tid, int wave, int lane, int G) {
    float* scr = (float*)(lds + wave * 16640);
    const int gw = blockIdx.x * 8 + wave, NGW = G * 8;
    convert_weights(C, scr, 0, gw, NGW, lane);
    bf16* XA = (bf16*)(C.ws + WS_XA); float* rss = (float*)(C.ws + WS_CTL);
    for (int m = gw; m < M; m += 2 * NGW) {
        const int m2 = m + NGW; const bool has2 = m2 < M;
        const float* xr = m < T ? C.x_prompt + (size_t)m * D : C.x_sample + (size_t)(m - T) * D;
        const int m2c = has2 ? m2 : m;
        const float* xr2 = m2c < T ? C.x_prompt + (size_t)m2c * D : C.x_sample + (size_t)(m2c - T) * D;
        f32x4 va[8], vb[8];
#pragma unroll
        for (int j = 0; j < 8; ++j) { va[j] = __builtin_nontemporal_load((const f32x4*)xr + lane + 64 * j); vb[j] = __builtin_nontemporal_load((const f32x4*)xr2 + lane + 64 * j); }
        float ss = 0.f, ss2 = 0.f;
#pragma unroll
        for (int j = 0; j < 8; ++j) {
            ss += (va[j][0] * va[j][0] + va[j][1] * va[j][1]) + (va[j][2] * va[j][2] + va[j][3] * va[j][3]);
            ss2 += (vb[j][0] * vb[j][0] + vb[j][1] * vb[j][1]) + (vb[j][2] * vb[j][2] + vb[j][3] * vb[j][3]);
            u32x2 o; o.x = cvtpk(va[j][0], va[j][1]); o.y = cvtpk(va[j][2], va[j][3]);
            *((u32x2*)(XA + (size_t)m * D) + lane + 64 * j) = o;
            if (has2) { u32x2 o2; o2.x = cvtpk(vb[j][0], vb[j][1]); o2.y = cvtpk(vb[j][2], vb[j][3]); *((u32x2*)(XA + (size_t)m2 * D) + lane + 64 * j) = o2; }
        }
#pragma unroll
        for (int o = 1; o < 64; o <<= 1) { ss += __shfl_xor(ss, o); ss2 += __shfl_xor(ss2, o); }
        if (lane == 0) { rss[m] = ss; if (has2) rss[m2] = ss2; }
    }
    float* cosA = (float*)(C.ws + WS_TAB); float* sinA = cosA + NPOS * 32; float* cosB = sinA + NPOS * 32; float* sinB = cosB + NPOS * 64;
    for (int i = blockIdx.x * NTHREADS + tid; i < NPOS * 96; i += G * NTHREADS) {
        int pos, f, half; float *pc, *ps;
        if (i < NPOS * 32) { pos = i >> 5; f = i & 31; half = 32; pc = cosA + i; ps = sinA + i; }
        else { const int k = i - NPOS * 32; pos = k >> 6; f = k & 63; half = 64; pc = cosB + k; ps = sinB + k; }
        const double rr = half == 32 ? 0.7498942093324559 : 0.8659643233600653;
        double inv = 1.0; for (int k = 0; k < f; ++k) inv *= rr;
        const float ang = (float)pos * (float)inv;
        const double a = (double)ang;
        const double qd = __builtin_rint(a * 0.6366197723675814);
        double r = __builtin_fma(-qd, 1.5707963267948966, a); r = __builtin_fma(-qd, 6.123233995736766e-17, r);
        const double r2 = r * r;
        double sp = -1.0 / 39916800.0; sp = sp * r2 + 1.0 / 362880.0; sp = sp * r2 - 1.0 / 5040.0; sp = sp * r2 + 1.0 / 120.0; sp = sp * r2 - 1.0 / 6.0; sp = sp * r2 + 1.0; sp *= r;
        double cp = 1.0 / 479001600.0; cp = cp * r2 - 1.0 / 3628800.0; cp = cp * r2 + 1.0 / 40320.0; cp = cp * r2 - 1.0 / 720.0; cp = cp * r2 + 1.0 / 24.0; cp = cp * r2 - 0.5; cp = cp * r2 + 1.0;
        const int qi = ((int)qd) & 3;
        const double sv = (qi == 0) ? sp : (qi == 1) ? cp : (qi == 2) ? -sp : -cp;
        const double cv = (qi == 0) ? cp : (qi == 1) ? -sp : (qi == 2) ? -cp : sp;
        *pc = (float)cv; *ps = (float)sv;
    }
}

__device__ __forceinline__ void attn_prompt_unit(const Ctx& C, char* lds, int layer, int blk, int kvh, int hq, int tid, int w, int lane) {
    const bf16* P = (const bf16*)(C.ws + WS_P); bf16* Y = (bf16*)(C.ws + WS_Y);
    char* Ks = lds; char* Vs = lds + 36864;
    const int q = lane & 15, g = lane >> 4;
    const int jt0 = w < 6 ? w : 6;
    const int iq = 16 * w + q, row = blk * 128 + iq;
    bf16x8 qfa[4][2]; u32x2 gta[4][4];
#pragma unroll
    for (int hh = 0; hh < 4; ++hh) {
        const int h = kvh * 8 + hq * 4 + hh;
#pragma unroll
        for (int ks = 0; ks < 2; ++ks) qfa[hh][ks] = *(const bf16x8*)(P + (size_t)row * NP + C_QA + h * 64 + 32 * ks + 8 * g);
#pragma unroll
        for (int dt = 0; dt < 4; ++dt) gta[hh][dt] = *(const u32x2*)(P + (size_t)row * NP + C_GA + h * 64 + 16 * dt + 4 * g);
    }
#pragma unroll
    for (int it = 0; it < 4; ++it) {
        const int r = (tid >> 3) + 64 * it, ch = tid & 7, krow = blk * 128 - 128 + r;
        u32x4 kv = (u32x4){0u, 0u, 0u, 0u}, vv = kv;
        if (krow >= 0) { kv = *(const u32x4*)(P + (size_t)krow * NP + C_KA + kvh * 64 + ch * 8); vv = *(const u32x4*)(P + (size_t)krow * NP + C_VA + kvh * 64 + ch * 8); }
        *(u32x4*)(Ks + r * 144 + ch * 16) = kv; *(u32x4*)(Vs + r * 144 + ch * 16) = vv;
    }
    __syncthreads();
#pragma unroll
    for (int hh = 0; hh < 4; ++hh) {
        const int h = kvh * 8 + hq * 4 + hh;
        bf16x8 qf[2]; qf[0] = qfa[hh][0]; qf[1] = qfa[hh][1];
        f32x4 s[10];
        float mx = -INFINITY;
        int lo = (blk > 0 || iq + 1 >= 128) ? iq + 1 : 128; LAUNDER_V(lo);
        const unsigned span = (unsigned)(iq + 128 - lo);
#pragma unroll
        for (int tt = 0; tt < 10; ++tt) {
            const int jt = jt0 + tt;
            f32x4 a = (f32x4){0.f, 0.f, 0.f, 0.f};
#pragma unroll
            for (int ks = 0; ks < 2; ++ks) { const bf16x8 kf = *(const bf16x8*)(Ks + (16 * jt + q) * 144 + (32 * ks + 8 * g) * 2); a = __builtin_amdgcn_mfma_f32_16x16x32_bf16(kf, qf[ks], a, 0, 0, 0); }
#pragma unroll
            for (int j = 0; j < 4; ++j) {
                const int jj = 16 * jt + 4 * g + j;
                a[j] = ((unsigned)(jj - lo) <= span) ? a[j] : -INFINITY; mx = fmaxf(mx, a[j]);
            }
            s[tt] = a;
        }
        mx = fmaxf(mx, __shfl_xor(mx, 16)); mx = fmaxf(mx, __shfl_xor(mx, 32));
        const float sink = C.sinks[layer * 16 + h];
        const float mm = fmaxf(mx, sink);
        float sum = 0.f;
#pragma unroll
        for (int tt = 0; tt < 10; ++tt)
#pragma unroll
            for (int j = 0; j < 4; ++j) { const float e = __expf(s[tt][j] - mm); s[tt][j] = e; sum += e; }
        sum += __shfl_xor(sum, 16); sum += __shfl_xor(sum, 32);
        const float inv = 1.0f / (sum + __expf(sink - mm));
        f32x4 o[4];
#pragma unroll
        for (int dt = 0; dt < 4; ++dt) o[dt] = (f32x4){0.f, 0.f, 0.f, 0.f};
#pragma unroll
        for (int pr = 0; pr < 5; ++pr) {
            const int jt = jt0 + 2 * pr;
            u32x4 pw; pw.x = cvtpk(s[2 * pr][0], s[2 * pr][1]); pw.y = cvtpk(s[2 * pr][2], s[2 * pr][3]); pw.z = cvtpk(s[2 * pr + 1][0], s[2 * pr + 1][1]); pw.w = cvtpk(s[2 * pr + 1][2], s[2 * pr + 1][3]);
            const bf16x8 pf = __builtin_bit_cast(bf16x8, pw);
#pragma unroll
            for (int dt = 0; dt < 4; ++dt) {
                const char* a0 = Vs + (16 * jt + 4 * g + (q >> 2)) * 144 + (16 * dt + 4 * (q & 3)) * 2;
                const s16x4 lo = vtr(a0), hi = vtr(a0 + 16 * 144);
                o[dt] = __builtin_amdgcn_mfma_f32_16x16x32_bf16(cat8(lo, hi), pf, o[dt], 0, 0, 0);
            }
        }
#pragma unroll
        for (int dt = 0; dt < 4; ++dt) {
            const int dcol = h * 64 + 16 * dt + 4 * g;
            const u32x2 gt = gta[hh][dt];
            u32x2 yo; yo.x = cvtpk(o[dt][0] * inv * silu_f(bf_lo(gt.x)), o[dt][1] * inv * silu_f(bf_hi(gt.x)));
            yo.y = cvtpk(o[dt][2] * inv * silu_f(bf_lo(gt.y)), o[dt][3] * inv * silu_f(bf_hi(gt.y)));
            *(u32x2*)(Y + (size_t)row * D + dcol) = yo;
        }
    }
    __syncthreads();
}

__device__ __forceinline__ void stage128_load(u32x4 (&v)[4], const bf16* src, size_t src_pitch, int tid) {
#pragma unroll
    for (int it = 0; it < 4; ++it) { const int r = (tid >> 4) + 32 * it, ch = tid & 15; v[it] = *(const u32x4*)(src + (size_t)r * src_pitch + ch * 8); }
}
template <bool SCALE>
__device__ __forceinline__ void stage128_store(char* dst, const u32x4 (&vin)[4], int tid, float lng) {
#pragma unroll
    for (int it = 0; it < 4; ++it) {
        const int r = (tid >> 4) + 32 * it, ch = tid & 15;
        u32x4 v = vin[it];
        if (SCALE) { const float sc = __expf((float)(127 - r) * lng);
            v.x = cvtpk(bf_lo(v.x) * sc, bf_hi(v.x) * sc); v.y = cvtpk(bf_lo(v.y) * sc, bf_hi(v.y) * sc); v.z = cvtpk(bf_lo(v.z) * sc, bf_hi(v.z) * sc); v.w = cvtpk(bf_lo(v.w) * sc, bf_hi(v.w) * sc); }
        *(u32x4*)(dst + r * 272 + ch * 16) = v;
    }
}

__device__ __forceinline__ void ret_u_unit(const Ctx& C, char* lds, int c, int h, int tid, int w, int lane, unsigned* ucnt) {
    const bf16* P = (const bf16*)(C.ws + WS_P); float* U = (float*)(C.ws + WS_U);
    char* Ks = lds; char* Vs = lds + 34816;
    const float lng = ln_gamma(h);
    { u32x4 sk[4], sv[4];
      stage128_load(sk, P + (size_t)(c * 128) * NP + C_KB + h * 128, NP, tid); stage128_load(sv, P + (size_t)(c * 128) * NP + C_VB + h * 128, NP, tid);
      stage128_store<false>(Ks, sk, tid, lng); stage128_store<true>(Vs, sv, tid, lng); }
    __syncthreads();
    const int q = lane & 15, g = lane >> 4;
    f32x4 acc[8];
#pragma unroll
    for (int dt = 0; dt < 8; ++dt) acc[dt] = (f32x4){0.f, 0.f, 0.f, 0.f};
#pragma unroll
    for (int ks = 0; ks < 4; ++ks) {
        const int rbase = (32 * ks + 8 * g + (q >> 2)) * 272 + 4 * (q & 3) * 2;
        const bf16x8 vf = cat8(vtr(Vs + rbase + 32 * w), vtr(Vs + rbase + 32 * w + 4 * 272));
#pragma unroll
        for (int dt = 0; dt < 8; ++dt) {
            const bf16x8 kf = cat8(vtr(Ks + rbase + 32 * dt), vtr(Ks + rbase + 32 * dt + 4 * 272));
            acc[dt] = __builtin_amdgcn_mfma_f32_16x16x32_bf16(vf, kf, acc[dt], 0, 0, 0);
        }
    }
    float* Ub = U + (size_t)(c * 8 + h) * 16384;
#pragma unroll
    for (int dt = 0; dt < 8; ++dt)
#pragma unroll
        for (int j = 0; j < 4; ++j) __hip_atomic_store(Ub + (16 * w + 4 * g + j) * 128 + 16 * dt + q, acc[dt][j], __ATOMIC_RELAXED, __HIP_MEMORY_SCOPE_AGENT);
    asm volatile("s_waitcnt vmcnt(0)" ::: "memory");
    __syncthreads();
    if (tid == 0) __hip_atomic_fetch_add(ucnt, 1u, __ATOMIC_RELAXED, __HIP_MEMORY_SCOPE_AGENT);
}

__device__ __forceinline__ void ret_scan(const Ctx& C, int layer, int tid, int G) {
    const float* U = (const float*)(C.ws + WS_U); bf16* Rt = (bf16*)(C.ws + WS_RT);
    for (int i = blockIdx.x * NTHREADS + tid; i < 8 * 16384; i += G * NTHREADS) {
        const int h = i >> 14, e = (i >> 7) & 127, d = i & 127;
        const float gc = __expf(128.0f * ln_gamma(h));
        float r = 0.f;
#pragma unroll 1
        for (int c0 = 0; c0 < 64; c0 += 32) {
            float u[32];
#pragma unroll
            for (int k = 0; k < 32; ++k) u[k] = __builtin_nontemporal_load(U + (size_t)((c0 + k) * 8) * 16384 + i);
#pragma unroll
            for (int k = 0; k < 32; ++k) { Rt[(size_t)((c0 + k) * 8) * 16384 + i] = (bf16)(cvtpk(r, 0.f) & 0xffffu); r = gc * r + u[k]; }
        }
        const int dorig = 4 * (d >> 3) + (d & 3) + 64 * ((d >> 2) & 1);
        C.out[O_RP + ((size_t)(layer * 8 + h) * 128 + dorig) * 128 + e] = r;
    }
}

__device__ __forceinline__ void ret_prompt_unit(const Ctx& C, char* lds, int layer, int c, int h, int tid, int w, int lane) {
    const bf16* P = (const bf16*)(C.ws + WS_P); bf16* Y = (bf16*)(C.ws + WS_Y); const bf16* Rt = (const bf16*)(C.ws + WS_RT);
    char* Ks = lds; char* Vs = lds + 34816; char* Rs = lds + 69632;
    const float lng = ln_gamma(h);
    const int q = lane & 15, g = lane >> 4;
    const int n = 16 * w + q, row = c * 128 + n;
    bf16x8 qf[4]; u32x2 gta[8];
#pragma unroll
    for (int ks = 0; ks < 4; ++ks) qf[ks] = *(const bf16x8*)(P + (size_t)row * NP + C_QB + h * 128 + 32 * ks + 8 * g);
#pragma unroll
    for (int et = 0; et < 8; ++et) gta[et] = *(const u32x2*)(P + (size_t)row * NP + C_GB + h * 128 + 16 * et + 4 * g);
    { u32x4 sk[4], sv[4], sr[4];
      stage128_load(sk, P + (size_t)(c * 128) * NP + C_KB + h * 128, NP, tid); stage128_load(sv, P + (size_t)(c * 128) * NP + C_VB + h * 128, NP, tid);
      stage128_load(sr, Rt + (size_t)(c * 8 + h) * 16384, 128, tid);
      stage128_store<false>(Ks, sk, tid, lng); stage128_store<false>(Vs, sv, tid, lng); stage128_store<false>(Rs, sr, tid, lng); }
    __syncthreads();
    unsigned pk[8][2];
#pragma unroll
    for (int mt = 0; mt < 8; ++mt) {
        pk[mt][0] = 0u; pk[mt][1] = 0u;
        if (mt <= w) {
            f32x4 a = (f32x4){0.f, 0.f, 0.f, 0.f};
#pragma unroll
            for (int ks = 0; ks < 4; ++ks) { const bf16x8 kf = *(const bf16x8*)(Ks + (16 * mt + q) * 272 + (32 * ks + 8 * g) * 2); a = __builtin_amdgcn_mfma_f32_16x16x32_bf16(kf, qf[ks], a, 0, 0, 0); }
            float v[4];
#pragma unroll
            for (int j = 0; j < 4; ++j) { const int dl = n - (16 * mt + 4 * g + j); v[j] = dl >= 0 ? a[j] * __expf((float)dl * lng) : 0.f; }
            pk[mt][0] = cvtpk(v[0], v[1]); pk[mt][1] = cvtpk(v[2], v[3]);
        }
    }
    f32x4 oi[8], ox[8];
#pragma unroll
    for (int et = 0; et < 8; ++et) { oi[et] = (f32x4){0.f, 0.f, 0.f, 0.f}; ox[et] = oi[et]; }
#pragma unroll
    for (int pr = 0; pr < 4; ++pr) {
        if (2 * pr <= w) {
            u32x4 pw; pw.x = pk[2 * pr][0]; pw.y = pk[2 * pr][1]; pw.z = pk[2 * pr + 1][0]; pw.w = pk[2 * pr + 1][1];
            const bf16x8 pf = __builtin_bit_cast(bf16x8, pw);
#pragma unroll
            for (int et = 0; et < 8; ++et) {
                const char* a0 = Vs + (32 * pr + 4 * g + (q >> 2)) * 272 + (16 * et + 4 * (q & 3)) * 2;
                oi[et] = __builtin_amdgcn_mfma_f32_16x16x32_bf16(cat8(vtr(a0), vtr(a0 + 16 * 272)), pf, oi[et], 0, 0, 0);
            }
        }
    }
#pragma unroll
    for (int et = 0; et < 8; ++et)
#pragma unroll
        for (int ks = 0; ks < 4; ++ks) { const bf16x8 rf = *(const bf16x8*)(Rs + (16 * et + q) * 272 + (32 * ks + 8 * g) * 2); ox[et] = __builtin_amdgcn_mfma_f32_16x16x32_bf16(rf, qf[ks], ox[et], 0, 0, 0); }
    const float qdec = __expf((float)(n + 1) * lng);
    float sum = 0.f;
#pragma unroll
    for (int et = 0; et < 8; ++et) { oi[et] = oi[et] + ox[et] * qdec; sum += (oi[et][0] + oi[et][1]) + (oi[et][2] + oi[et][3]); }
    sum += __shfl_xor(sum, 16); sum += __shfl_xor(sum, 32);
    const float mu = sum * (1.0f / 128.0f);
    float var = 0.f;
#pragma unroll
    for (int et = 0; et < 8; ++et) { oi[et] = oi[et] - mu; var += (oi[et][0] * oi[et][0] + oi[et][1] * oi[et][1]) + (oi[et][2] * oi[et][2] + oi[et][3] * oi[et][3]); }
    var += __shfl_xor(var, 16); var += __shfl_xor(var, 32);
    const float rs = rsqrtf(var * (1.0f / 128.0f) + 1e-6f);
    const float* gw = C.ret_norm_w + layer * 1024 + h * 128;
#pragma unroll
    for (int et = 0; et < 8; ++et) {
        const int e0 = 16 * et + 4 * g;
        const u32x2 gt = gta[et];
        const f32x4 wv = *(const f32x4*)(gw + e0);
        u32x2 yo; yo.x = cvtpk(oi[et][0] * rs * wv[0] * silu_f(bf_lo(gt.x)), oi[et][1] * rs * wv[1] * silu_f(bf_hi(gt.x)));
        yo.y = cvtpk(oi[et][2] * rs * wv[2] * silu_f(bf_lo(gt.y)), oi[et][3] * rs * wv[3] * silu_f(bf_hi(gt.y)));
        *(u32x2*)(Y + (size_t)row * D + 1024 + h * 128 + e0) = yo;
    }
    __syncthreads();
}

__device__ __forceinline__ void attn_sample_unit(const Ctx& C, char* lds, int layer, int b, int kvh, int tid) {
    const bf16* P = (const bf16*)(C.ws + WS_P); bf16* Y = (bf16*)(C.ws + WS_Y);
    float* Qs = (float*)lds;
    float* Kl = Qs + 32 * 65;
    float* Vl = Kl + 132 * 68;
    float* Pm = Vl + 132 * 68;
    const float* ck = C.cache_k + ((size_t)(layer * 128 + b) * 128) * 128 + kvh * 64;
    const float* cv = C.cache_v + ((size_t)(layer * 128 + b) * 128) * 128 + kvh * 64;
    float* ok = C.out + O_KS + ((size_t)(layer * 128 + b) * 128) * 128 + kvh * 64;
    float* ov = C.out + O_VS + ((size_t)(layer * 128 + b) * 128) * 128 + kvh * 64;
    {
        f32x4 kq[4], vq[4];
#pragma unroll
        for (int it = 0; it < 4; ++it) { const int i = tid + NTHREADS * it, r = i >> 4, c4 = i & 15;
            kq[it] = __builtin_nontemporal_load((const f32x4*)(ck + (size_t)r * 128 + 4 * c4)); vq[it] = __builtin_nontemporal_load((const f32x4*)(cv + (size_t)r * 128 + 4 * c4)); }
#pragma unroll
        for (int it = 0; it < 4; ++it) { const int i = tid + NTHREADS * it, r = i >> 4, c4 = i & 15;
            *(f32x4*)(Kl + r * 68 + 4 * c4) = kq[it]; *(f32x4*)(Vl + r * 68 + 4 * c4) = vq[it];
            if (r >= 4) { __builtin_nontemporal_store(kq[it], (f32x4*)(ok + (size_t)(r - 4) * 128 + 4 * c4)); __builtin_nontemporal_store(vq[it], (f32x4*)(ov + (size_t)(r - 4) * 128 + 4 * c4)); } }
    }
    if (tid < 256) { const int t = tid >> 6, g = tid & 63; const size_t ro = (size_t)(T + 4 * b + t) * NP;
        const int dk = 4 * (g >> 3) + (g & 3) + 32 * ((g >> 2) & 1);
        Kl[(128 + t) * 68 + dk] = __uint_as_float((unsigned)P[ro + C_KA + kvh * 64 + g] << 16);
        Vl[(128 + t) * 68 + g] = __uint_as_float((unsigned)P[ro + C_VA + kvh * 64 + g] << 16); }
    for (int i = tid; i < 32 * 64; i += NTHREADS) {
        const int r = i >> 6, g = i & 63, hg = r >> 2, t = r & 3;
        const int dk = 4 * (g >> 3) + (g & 3) + 32 * ((g >> 2) & 1);
        Qs[r * 65 + dk] = __uint_as_float((unsigned)P[(size_t)(T + 4 * b + t) * NP + C_QA + (kvh * 8 + hg) * 64 + g] << 16);
    }
    __syncthreads();
    {
        const int r = tid >> 4, kg = tid & 15, t = r & 3, h = kvh * 8 + (r >> 2);
        float mx = -INFINITY;
        f32x4 qr[16];
#pragma unroll
        for (int i = 0; i < 16; ++i) qr[i] = (f32x4){Qs[r * 65 + 4 * i], Qs[r * 65 + 4 * i + 1], Qs[r * 65 + 4 * i + 2], Qs[r * 65 + 4 * i + 3]};
#pragma unroll 1
        for (int it = 0; it < 9; ++it) {
            const int kk = kg + 16 * it;
            float a = -INFINITY;
            if (kk < 132) {
                const bool valid = kk < 128 ? (kk > t) : (kk - 128 <= t);
                if (valid) { f32x4 a4 = (f32x4){0.f, 0.f, 0.f, 0.f};
#pragma unroll
                    for (int i = 0; i < 16; ++i) a4 += qr[i] * *(const f32x4*)(Kl + kk * 68 + 4 * i);
                    a = (a4[0] + a4[1]) + (a4[2] + a4[3]); }
                Pm[r * 133 + kk] = a;
            }
            mx = fmaxf(mx, a);
        }
#pragma unroll
        for (int o = 1; o < 16; o <<= 1) mx = fmaxf(mx, __shfl_xor(mx, o));
        const float sink = C.sinks[layer * 16 + h];
        const float mm = fmaxf(mx, sink);
        float sum = 0.f;
#pragma unroll 1
        for (int it = 0; it < 9; ++it) { const int kk = kg + 16 * it; if (kk < 132) { const float e = __expf(Pm[r * 133 + kk] - mm); Pm[r * 133 + kk] = e; sum += e; } }
#pragma unroll
        for (int o = 1; o < 16; o <<= 1) sum += __shfl_xor(sum, o);
        const float inv = 1.0f / (sum + __expf(sink - mm));
#pragma unroll 1
        for (int it = 0; it < 9; ++it) { const int kk = kg + 16 * it; if (kk < 132) Pm[r * 133 + kk] *= inv; }
    }
    __syncthreads();
    {
        const int r = tid >> 4, dq = tid & 15, t = r & 3, h = kvh * 8 + (r >> 2);
        f32x4 o = (f32x4){0.f, 0.f, 0.f, 0.f};
        for (int kk = 0; kk < 132; ++kk) { const float p = Pm[r * 133 + kk]; const f32x4 v = *(const f32x4*)(Vl + kk * 68 + 4 * dq); o += v * p; }
        const size_t row = (size_t)(T + 4 * b + t);
        const u32x2 gt = *(const u32x2*)(P + row * NP + C_GA + h * 64 + 4 * dq);
        u32x2 yo; yo.x = cvtpk(o[0] * silu_f(bf_lo(gt.x)), o[1] * silu_f(bf_hi(gt.x))); yo.y = cvtpk(o[2] * silu_f(bf_lo(gt.y)), o[3] * silu_f(bf_hi(gt.y)));
        *(u32x2*)(Y + row * D + h * 64 + 4 * dq) = yo;
    }
    __syncthreads();
}

__device__ __forceinline__ void ret_sample_group(const Ctx& C, char* lds, int layer, int ug, int tid, int w, int lane) {
    const bf16* P = (const bf16*)(C.ws + WS_P); bf16* Y = (bf16*)(C.ws + WS_Y);
    const int idx = 4 * ug + (w >> 1), b = idx >> 3, h = idx & 7, eh = w & 1;
    float* qs = (float*)(lds + w * 4096);
    float* ksm = qs + 512;
    float* pst = (float*)(lds + 32768);
    const float lng = ln_gamma(h);
    const size_t ro = (size_t)(T + 4 * b) * NP;
    float qv[4][2], kv[4][2];
    {
        const int g0 = 2 * lane, g1 = g0 + 1;
        const int d0 = 4 * (g0 >> 3) + (g0 & 3) + 64 * ((g0 >> 2) & 1), d1 = 4 * (g1 >> 3) + (g1 & 3) + 64 * ((g1 >> 2) & 1);
#pragma unroll
        for (int t = 0; t < 4; ++t) {
            const unsigned qq = *(const unsigned*)(P + ro + (size_t)t * NP + C_QB + h * 128 + g0), kk = *(const unsigned*)(P + ro + (size_t)t * NP + C_KB + h * 128 + g0);
            qv[t][0] = bf_lo(qq); qv[t][1] = bf_hi(qq); kv[t][0] = bf_lo(kk); kv[t][1] = bf_hi(kk);
            const float kd = __expf((float)(3 - t) * lng);
            qs[t * 128 + d0] = qv[t][0]; qs[t * 128 + d1] = qv[t][1]; ksm[t * 128 + d0] = kv[t][0] * kd; ksm[t * 128 + d1] = kv[t][1] * kd;
        }
    }
    const int e4 = lane & 15, dq = lane >> 4, e = eh * 64 + 4 * e4;
    f32x4 vm[4];
#pragma unroll
    for (int m = 0; m < 4; ++m) { const u32x2 vv = *(const u32x2*)(P + ro + (size_t)m * NP + C_VB + h * 128 + e); vm[m] = (f32x4){bf_lo(vv.x), bf_hi(vv.x), bf_lo(vv.y), bf_hi(vv.y)}; }
    float* Aw = (float*)(lds + 33024) + w * 16;
#pragma unroll
    for (int t = 0; t < 4; ++t)
#pragma unroll
        for (int m = 0; m < 4; ++m) {
            float a = 0.f;
            if (m <= t) { a = qv[t][0] * kv[m][0] + qv[t][1] * kv[m][1];
#pragma unroll
                for (int o = 1; o < 64; o <<= 1) a += __shfl_xor(a, o);
                a *= __expf((float)(t - m) * lng); }
            if (lane == 0) Aw[t * 4 + m] = a;
        }
    LDS_WAIT();
    const float* r0 = C.state + ((size_t)(layer * 128 + b) * 8 + h) * 16384 + e;
    float* rout = C.out + O_RS + ((size_t)(layer * 128 + b) * 8 + h) * 16384 + e;
    const float g4 = __expf(4.0f * lng);
    f32x4 acc[4];
#pragma unroll
    for (int t = 0; t < 4; ++t) acc[t] = (f32x4){0.f, 0.f, 0.f, 0.f};
#pragma unroll 1
    for (int i0 = 0; i0 < 32; i0 += 8) {
        f32x4 r[8];
#pragma unroll
        for (int k = 0; k < 8; ++k) r[k] = __builtin_nontemporal_load((const f32x4*)(r0 + (4 * (i0 + k) + dq) * 128));
#pragma unroll
        for (int k = 0; k < 8; ++k) {
            const int d = 4 * (i0 + k) + dq;
            const f32x4 rn = r[k] * g4 + vm[0] * ksm[d] + vm[1] * ksm[128 + d] + vm[2] * ksm[256 + d] + vm[3] * ksm[384 + d];
            __builtin_nontemporal_store(rn, (f32x4*)(rout + d * 128));
#pragma unroll
            for (int t = 0; t < 4; ++t) acc[t] += r[k] * qs[t * 128 + d];
        }
    }
    float o[4][4]; float s1[4], s2[4];
#pragma unroll
    for (int t = 0; t < 4; ++t) {
        const float qd = __expf((float)(t + 1) * lng);
        s1[t] = 0.f; s2[t] = 0.f;
#pragma unroll
        for (int j = 0; j < 4; ++j) {
            float a = acc[t][j]; a += __shfl_xor(a, 16); a += __shfl_xor(a, 32);
            a *= qd;
#pragma unroll
            for (int m = 0; m < 4; ++m) a += Aw[t * 4 + m] * vm[m][j];
            o[t][j] = a; s1[t] += a; s2[t] += a * a;
        }
#pragma unroll
        for (int k = 1; k < 16; k <<= 1) { s1[t] += __shfl_xor(s1[t], k); s2[t] += __shfl_xor(s2[t], k); }
        if (lane == 0) { pst[(w * 4 + t) * 2] = s1[t]; pst[(w * 4 + t) * 2 + 1] = s2[t]; }
    }
    __syncthreads();
    if (lane < 16) {
        const float* gw = C.ret_norm_w + layer * 1024 + h * 128 + e;
        const f32x4 wv = *(const f32x4*)gw;
#pragma unroll
        for (int t = 0; t < 4; ++t) {
            const float S1 = pst[(w * 4 + t) * 2] + pst[((w ^ 1) * 4 + t) * 2], S2 = pst[(w * 4 + t) * 2 + 1] + pst[((w ^ 1) * 4 + t) * 2 + 1];
            const float mu = S1 * (1.0f / 128.0f), var = fmaxf(S2 * (1.0f / 128.0f) - mu * mu, 0.f), rs = rsqrtf(var + 1e-6f);
            const size_t row = (size_t)(T + 4 * b + t);
            const u32x2 gt = *(const u32x2*)(P + row * NP + C_GB + h * 128 + e);
            u32x2 yo; yo.x = cvtpk((o[t][0] - mu) * rs * wv[0] * silu_f(bf_lo(gt.x)), (o[t][1] - mu) * rs * wv[1] * silu_f(bf_hi(gt.x)));
            yo.y = cvtpk((o[t][2] - mu) * rs * wv[2] * silu_f(bf_lo(gt.y)), (o[t][3] - mu) * rs * wv[3] * silu_f(bf_hi(gt.y)));
            *(u32x2*)(Y + row * D + 1024 + h * 128 + e) = yo;
        }
    }
    __syncthreads();
}

__device__ __forceinline__ void outproj_sample_unit(const Ctx& C, char* lds, int layer, int u, int tid, int w, int lane) {
    const bf16* Yb = (const bf16*)(C.ws + WS_Y) + (size_t)T * D; const bf16* Wt = (const bf16*)(C.ws + WS_WOUT) + (size_t)layer * D * D;
    const int m0 = (u >> 5) * 64, n0 = (u & 31) * 64, q = lane & 15, g = lane >> 4, k0 = 256 * w;
    f32x4 acc[4][4];
#pragma unroll
    for (int nt = 0; nt < 4; ++nt)
#pragma unroll
        for (int mt = 0; mt < 4; ++mt) acc[nt][mt] = (f32x4){0.f, 0.f, 0.f, 0.f};
    const int em = tid >> 3, en8 = (tid & 7) * 8;
    f32x4 rz0, rz1;
    if (layer == 0) { const float* bpz = C.x_sample + (size_t)(m0 + em) * D + n0 + en8; rz0 = *(const f32x4*)bpz; rz1 = *(const f32x4*)(bpz + 4); }
    else { const u32x4 xb = *(const u32x4*)((const bf16*)(C.ws + WS_XA) + (size_t)(T + m0 + em) * D + n0 + en8);
        rz0 = (f32x4){bf_lo(xb.x), bf_hi(xb.x), bf_lo(xb.y), bf_hi(xb.y)}; rz1 = (f32x4){bf_lo(xb.z), bf_hi(xb.z), bf_lo(xb.w), bf_hi(xb.w)}; }
    const bf16* ap = Wt + (size_t)(n0 + q) * D + k0 + 8 * g;
    const bf16* bp = Yb + (size_t)(m0 + q) * D + k0 + 8 * g;
    bf16x8 af[2][2][4], bfr[2][2][4];
#define OSU_LOAD(buf, kb) do { _Pragma("unroll") for (int ks = 0; ks < 2; ++ks) _Pragma("unroll") for (int t4 = 0; t4 < 4; ++t4) { \
        af[buf][ks][t4] = *(const bf16x8*)(ap + (size_t)(16 * t4) * D + 64 * (kb) + 32 * ks); bfr[buf][ks][t4] = *(const bf16x8*)(bp + (size_t)(16 * t4) * D + 64 * (kb) + 32 * ks); } } while (0)
    OSU_LOAD(0, 0);
#pragma unroll
    for (int kb = 0; kb < 4; ++kb) {
        if (kb + 1 < 4) { if ((kb & 1) == 0) OSU_LOAD(1, kb + 1); else OSU_LOAD(0, kb + 1); }
#pragma unroll
        for (int ks = 0; ks < 2; ++ks)
#pragma unroll
            for (int nt = 0; nt < 4; ++nt)
#pragma unroll
                for (int mt = 0; mt < 4; ++mt) acc[nt][mt] = __builtin_amdgcn_mfma_f32_16x16x32_bf16(af[kb & 1][ks][nt], bfr[kb & 1][ks][mt], acc[nt][mt], 0, 0, 0);
    }
#undef OSU_LOAD
    float* part = (float*)lds + w * (64 * 68);
#pragma unroll
    for (int nt = 0; nt < 4; ++nt)
#pragma unroll
        for (int mt = 0; mt < 4; ++mt) *(f32x4*)(part + (16 * mt + q) * 68 + 16 * nt + 4 * g) = acc[nt][mt];
    __syncthreads();
    {
        const int m = tid >> 3, n8 = (tid & 7) * 8;
        f32x4 v0 = (f32x4){0.f, 0.f, 0.f, 0.f}, v1 = v0;
#pragma unroll
        for (int ww = 0; ww < 8; ++ww) { const float* pp = (const float*)lds + ww * (64 * 68) + m * 68 + n8; v0 += *(const f32x4*)pp; v1 += *(const f32x4*)(pp + 4); }
        const int rs_ = m0 + m;
        v0 += rz0; v1 += rz1;
        if (layer != 0) { float* op = C.out + (size_t)(T + rs_) * D + n0 + n8; *(f32x4*)op = v0; *(f32x4*)(op + 4) = v1; }
        if (layer == 0) { u32x4 wv; wv.x = cvtpk(v0[0], v0[1]); wv.y = cvtpk(v0[2], v0[3]); wv.z = cvtpk(v1[0], v1[1]); wv.w = cvtpk(v1[2], v1[3]);
            *(u32x4*)((bf16*)(C.ws + WS_XA) + (size_t)(T + rs_) * D + n0 + n8) = wv; }
        float ss = (v0[0] * v0[0] + v0[1] * v0[1]) + (v0[2] * v0[2] + v0[3] * v0[3]) + (v1[0] * v1[0] + v1[1] * v1[1]) + (v1[2] * v1[2] + v1[3] * v1[3]);
        ss += __shfl_xor(ss, 1); ss += __shfl_xor(ss, 2); ss += __shfl_xor(ss, 4);
        if ((tid & 7) == 0) atomicAdd((float*)(C.ws + WS_CTL) + (layer + 1) * M + T + rs_, ss);
    }
    __syncthreads();
}

#ifndef SKIPM
#define SKIPM 0
#endif
#ifndef REPU
#define REPU 0
#endif
#ifndef REP_P0
#define REP_P0 1
#endif
#ifndef REP_G1
#define REP_G1 1
#endif
#ifndef REP_MX1
#define REP_MX1 1
#endif
#ifndef REP_RP
#define REP_RP 1
#endif
#ifndef REP_G2
#define REP_G2 1
#endif

#define GAS __attribute__((address_space(1)))
typedef GAS unsigned gu32;
#define XB_TMO      128
#define XB_XCNT(j)  (256  + 64 * (j))
#define XB_XSUB(j)  (1280 + 64 * (j))
#define XB_XGEN(j)  (2304 + 64 * (j))
#define XB_TOP      3328
#define XB_TOPGEN   3392
#define XCD_BAR_WORDS 3456
#define XB_SPIN_CAP (1u << 18)

__device__ __forceinline__ unsigned xb_ld(unsigned* p)              { return __hip_atomic_load(p, __ATOMIC_RELAXED, __HIP_MEMORY_SCOPE_AGENT); }
__device__ __forceinline__ unsigned xb_add(unsigned* p, unsigned v) { return __hip_atomic_fetch_add(p, v, __ATOMIC_RELAXED, __HIP_MEMORY_SCOPE_AGENT); }
__device__ __forceinline__ unsigned xb_xcc_id() { return (unsigned)__builtin_amdgcn_s_getreg((3 << 11) | 20) & 0xFu; }
#define XB_SPIN(cond, bar) do { unsigned _sp = 0; while (cond) { __builtin_amdgcn_s_sleep(1); \
    if ((++_sp & 255u) == 0u) { if (xb_ld(&(bar)[XB_TMO])) break; if (_sp > XB_SPIN_CAP) { atomicAdd(&(bar)[XB_TMO], 1u); break; } } } } while (0)

struct XcdBarrier {
    unsigned* bar; unsigned x;
    volatile LAS unsigned* st;
};

__device__ __forceinline__ XcdBarrier xcd_barrier_post(unsigned* bar, volatile LAS unsigned* st) {
    XcdBarrier b; b.bar = bar; b.x = xb_xcc_id(); b.st = st;
    if (threadIdx.x == 0) (void)xb_add(&bar[XB_XCNT(b.x)], 1u);
    return b;
}
__device__ __forceinline__ void xcd_barrier_complete(unsigned* bar, unsigned x, unsigned& nloc, unsigned& nx) {
    const unsigned G = gridDim.x * gridDim.y * gridDim.z;
    unsigned sum, cnt, mine, sp = 0u;
    for (;;) {
        sum = 0u; cnt = 0u; mine = 0u;
#pragma unroll
        for (unsigned j = 0; j < 16; ++j) { const unsigned c = xb_ld(&bar[XB_XCNT(j)]); sum += c; cnt += (c > 0u) ? 1u : 0u; mine = (j == x) ? c : mine; }
        if (sum == G) break;
        __builtin_amdgcn_s_sleep(1);
        if ((++sp & 255u) == 0u) { if (xb_ld(&bar[XB_TMO])) break; if (sp > XB_SPIN_CAP) { atomicAdd(&bar[XB_TMO], 1u); break; } }
    }
    nloc = mine > 0u ? mine : 1u; nx = cnt > 0u ? cnt : 1u;
}

__device__ __forceinline__ void xcd_barrier(const XcdBarrier& b) {
    asm volatile("s_waitcnt vmcnt(0)" ::: "memory");
    __syncthreads();
    if (threadIdx.x == 0) {
        unsigned* bar = b.bar;
        __builtin_amdgcn_s_waitcnt(0);
        unsigned nloc = b.st[0], nx = b.st[1];
        if (nloc == 0u) { xcd_barrier_complete(bar, b.x, nloc, nx); b.st[0] = nloc; b.st[1] = nx; }
        const unsigned old = xb_add(&bar[XB_XSUB(b.x)], 1u);
        const unsigned gen = old / nloc;
        if (old + 1u == (gen + 1u) * nloc) {
            __builtin_amdgcn_fence(__ATOMIC_RELEASE, "agent");
            asm volatile("s_waitcnt vmcnt(0)" ::: "memory");
            const unsigned og = xb_add(&bar[XB_TOP], 1u);
            const unsigned tg = og / nx;
            if (og + 1u == (tg + 1u) * nx) xb_add(&bar[XB_TOPGEN], 1u);
            else XB_SPIN(xb_ld(&bar[XB_TOPGEN]) == tg, bar);
            __builtin_amdgcn_fence(__ATOMIC_ACQUIRE, "agent");
            xb_add(&bar[XB_XGEN(b.x)], 1u);
            asm volatile("s_waitcnt vmcnt(0)" ::: "memory");
        } else {
            XB_SPIN(xb_ld(&bar[XB_XGEN(b.x)]) == gen, bar);
            __builtin_amdgcn_fence(__ATOMIC_ACQUIRE, "agent");
            asm volatile("s_waitcnt vmcnt(0)" ::: "memory");
        }
    }
    __syncthreads();
}

constexpr size_t WS_BAR = WS_CTL + 768 * 1024;
constexpr int LDS_BARST = LDS_BYTES - 64;
__global__ void __launch_bounds__(NTHREADS, 2) hymba_fwd(Ctx C) {
    extern __shared__ __attribute__((aligned(16))) unsigned char lds_raw[];
    cg::grid_group grid = cg::this_grid();
    if (threadIdx.x < 2) ((volatile LAS unsigned*)((LAS unsigned char*)lds_raw + LDS_BARST))[threadIdx.x] = 0u;
    __syncthreads();
    (void)xcd_barrier_post((unsigned*)(C.ws + WS_BAR), (volatile LAS unsigned*)((LAS unsigned char*)lds_raw + LDS_BARST));
    int ph = 0;
#define PHASE_LOCALS2 int tid = threadIdx.x; LAUNDER_V(tid); const int lane = tid & 63, wave = __builtin_amdgcn_readfirstlane(tid >> 6); char* lds = (char*)lds_raw; Ctx Cc = C; LAUNDER_S(Cc.ws); (void)lane; (void)wave; (void)lds
#define TAIL_OK(G_) ((G_) * 4 >= 850 && 850 - 3 * (G_) > 0 && 850 - 3 * (G_) < (G_))
#define PHASE_BEGIN (C.ph_lo <= ph && ph < C.ph_hi)
#define PHASE_END do { if (C.ph_lo <= ph && ph + 1 < C.ph_hi) { if (C.ph_lo < 0) grid.sync(); else { XcdBarrier xb_; xb_.bar = (unsigned*)(C.ws + WS_BAR); xb_.x = xb_xcc_id(); xb_.st = (volatile LAS unsigned*)((LAS unsigned char*)lds_raw + LDS_BARST); xcd_barrier(xb_); } } ++ph; } while (0)
#define PHASE_LOCALS int tid = threadIdx.x; LAUNDER_V(tid); const int lane = tid & 63, wave = __builtin_amdgcn_readfirstlane(tid >> 6); \
    int G = gridDim.x, bid = blockIdx.x; LAUNDER_S(G); LAUNDER_S(bid); char* lds = (char*)lds_raw; Ctx Cc = C; LAUNDER_S(Cc.ws); (void)lane; (void)wave; (void)lds

    if (PHASE_BEGIN) { PHASE_LOCALS; for (int rep = 0; rep < REP_P0; ++rep) { p0_prologue(Cc, lds, tid, wave, lane, G); __syncthreads(); } }
    PHASE_END;

    {
        constexpr int layer = 0;
        if (PHASE_BEGIN) {
            unsigned char* ws = C.ws; const int G = gridDim.x, bid = blockIdx.x;
            float* rss = (float*)(ws + WS_CTL); float* cosA = (float*)(ws + WS_TAB); float* sinA = cosA + NPOS * 32; float* cosB = sinA + NPOS * 32; float* sinB = cosB + NPOS * 64;
            pg8::Gemm g{(const bf16*)(ws + WS_XA), (const bf16*)(ws + WS_WIN) + (size_t)layer * NP * D, M, NP, D};
            pg8::EpiProj E{layer};
            unsigned* scnt = (unsigned*)(ws + WS_CTL) + 28672 + 64 * layer;
            {
                pg8::SampleFirstOrder S{G, bid, scnt};
                pg8::gemm_phase<pg8::EpiProj, pg8::SampleFirstOrder, true, true>((LAS unsigned char*)lds_raw, g, S, E);
                const bool tail = TAIL_OK(G);
                const int nfull = tail ? 850 - 3 * G : 0;
                if (bid >= nfull) {
                    PHASE_LOCALS2; int ly = layer; LAUNDER_S(ly);
                    if (ly == 0) convert_weights(Cc, (float*)(lds + wave * 16640), 1, (bid - nfull) * 8 + wave, (G - nfull) * 8, lane);
                    if (tail) {
                        __syncthreads();
                        if (tid == 0) { unsigned sp = 0u; while (__hip_atomic_load(scnt, __ATOMIC_RELAXED, __HIP_MEMORY_SCOPE_AGENT) < 50u && ++sp < (1u << 24)) __builtin_amdgcn_s_sleep(8);
                            __builtin_amdgcn_fence(__ATOMIC_ACQUIRE, "agent"); asm volatile("s_waitcnt vmcnt(0)" ::: "memory"); }
                        __syncthreads();
                        for (int ug = bid - nfull; ug < 256; ug += G - nfull) { int tu = tid; LAUNDER_V(tu); ret_sample_group(Cc, lds, ly, ug, tu, wave, tu & 63); }
                    }
                }
            }
        }
        PHASE_END;
        if (PHASE_BEGIN) {
            PHASE_LOCALS; int ly = layer; LAUNDER_S(ly);
            const int nunits = TAIL_OK(G) ? 1024 : 1280; const int tid_p = tid;
            unsigned* ucnt = (unsigned*)(Cc.ws + WS_CTL) + 28672 + 128 + 64 * ly;
            for (int rep = 0; rep < REP_MX1; ++rep) for (int u = bid; u < nunits; u += G) {
                int tid = tid_p; LAUNDER_V(tid); const int lane = tid & 63;
                if (u < 512) { for (int r2 = 0; r2 < 1 + (REPU & 1); ++r2) ret_u_unit(Cc, lds, u >> 3, u & 7, tid, wave, lane, ucnt); }
                else if (u < 768) { const int a = u - 512; for (int r2 = 0; r2 < 1 + ((REPU >> 1) & 1); ++r2) attn_prompt_unit(Cc, lds, ly, a >> 2, (a >> 1) & 1, a & 1, tid, wave, lane); }
                else if (u < 1024) { const int a = u - 768; for (int r2 = 0; r2 < 1 + ((REPU >> 2) & 1); ++r2) attn_sample_unit(Cc, lds, ly, a >> 1, a & 1, tid); }
                else { const int a = u - 1024; ret_sample_group(Cc, lds, ly, a, tid, wave, lane); }
            }
            {
                if (tid_p == 0) { unsigned sp = 0u; while (__hip_atomic_load(ucnt, __ATOMIC_RELAXED, __HIP_MEMORY_SCOPE_AGENT) < 512u * REP_MX1 * (1 + (REPU & 1)) && ++sp < (1u << 24)) __builtin_amdgcn_s_sleep(4);
                    __builtin_amdgcn_fence(__ATOMIC_ACQUIRE, "agent"); asm volatile("s_waitcnt vmcnt(0)" ::: "memory"); }
                __syncthreads();
                int tid = tid_p; LAUNDER_V(tid);
                ret_scan(Cc, ly, tid, G);
            }
        }
        PHASE_END;
        if (PHASE_BEGIN) { PHASE_LOCALS; int ly = layer; LAUNDER_S(ly); for (int u = bid; u < 256; u += G) outproj_sample_unit(Cc, lds, ly, u, tid, wave, lane); for (int rep = 0; rep < REP_RP; ++rep) for (int u = bid; u < 512; u += G) if (!(SKIPM & 16)) ret_prompt_unit(Cc, lds, ly, u >> 3, u & 7, tid, wave, lane); }
        PHASE_END;
        if (PHASE_BEGIN) {
            unsigned char* ws = C.ws; const int G = gridDim.x, bid = blockIdx.x;
            float* rss = (float*)(ws + WS_CTL); float* XR = (float*)(ws + WS_XR);
            pg8::Gemm g{(const bf16*)(ws + WS_Y), (const bf16*)(ws + WS_WOUT) + (size_t)layer * D * D, T, D, D}; pg8::StaticOrder S; S.init(T, D, G, bid);
            pg8::EpiRes E{layer};
            pg8::gemm_phase<pg8::EpiRes, pg8::StaticOrder, true, true>((LAS unsigned char*)lds_raw, g, S, E);
        }
        PHASE_END;
    }
    {
        constexpr int layer = 1;
        if (PHASE_BEGIN) {
            unsigned char* ws = C.ws; const int G = gridDim.x, bid = blockIdx.x;
            float* rss = (float*)(ws + WS_CTL); float* cosA = (float*)(ws + WS_TAB); float* sinA = cosA + NPOS * 32; float* cosB = sinA + NPOS * 32; float* sinB = cosB + NPOS * 64;
            pg8::Gemm g{(const bf16*)(ws + WS_XA), (const bf16*)(ws + WS_WIN) + (size_t)layer * NP * D, M, NP, D};
            pg8::EpiProj E{layer};
            unsigned* scnt = (unsigned*)(ws + WS_CTL) + 28672 + 64 * layer;
            {
                pg8::SampleFirstOrder S{G, bid, scnt};
                pg8::gemm_phase<pg8::EpiProj, pg8::SampleFirstOrder, true, true>((LAS unsigned char*)lds_raw, g, S, E);
                const bool tail = TAIL_OK(G);
                const int nfull = tail ? 850 - 3 * G : 0;
                if (bid >= nfull) {
                    PHASE_LOCALS2; int ly = layer; LAUNDER_S(ly);
                    if (ly == 0) convert_weights(Cc, (float*)(lds + wave * 16640), 1, (bid - nfull) * 8 + wave, (G - nfull) * 8, lane);
                    if (tail) {
                        __syncthreads();
                        if (tid == 0) { unsigned sp = 0u; while (__hip_atomic_load(scnt, __ATOMIC_RELAXED, __HIP_MEMORY_SCOPE_AGENT) < 50u && ++sp < (1u << 24)) __builtin_amdgcn_s_sleep(8);
                            __builtin_amdgcn_fence(__ATOMIC_ACQUIRE, "agent"); asm volatile("s_waitcnt vmcnt(0)" ::: "memory"); }
                        __syncthreads();
                        for (int ug = bid - nfull; ug < 256; ug += G - nfull) { int tu = tid; LAUNDER_V(tu); ret_sample_group(Cc, lds, ly, ug, tu, wave, tu & 63); }
                    }
                }
            }
        }
        PHASE_END;
        if (PHASE_BEGIN) {
            PHASE_LOCALS; int ly = layer; LAUNDER_S(ly);
            const int nunits = TAIL_OK(G) ? 1024 : 1280; const int tid_p = tid;
            unsigned* ucnt = (unsigned*)(Cc.ws + WS_CTL) + 28672 + 128 + 64 * ly;
            for (int rep = 0; rep < REP_MX1; ++rep) for (int u = bid; u < nunits; u += G) {
                int tid = tid_p; LAUNDER_V(tid); const int lane = tid & 63;
                if (u < 512) { for (int r2 = 0; r2 < 1 + (REPU & 1); ++r2) ret_u_unit(Cc, lds, u >> 3, u & 7, tid, wave, lane, ucnt); }
                else if (u < 768) { const int a = u - 512; for (int r2 = 0; r2 < 1 + ((REPU >> 1) & 1); ++r2) attn_prompt_unit(Cc, lds, ly, a >> 2, (a >> 1) & 1, a & 1, tid, wave, lane); }
                else if (u < 1024) { const int a = u - 768; for (int r2 = 0; r2 < 1 + ((REPU >> 2) & 1); ++r2) attn_sample_unit(Cc, lds, ly, a >> 1, a & 1, tid); }
                else { const int a = u - 1024; ret_sample_group(Cc, lds, ly, a, tid, wave, lane); }
            }
            {
                if (tid_p == 0) { unsigned sp = 0u; while (__hip_atomic_load(ucnt, __ATOMIC_RELAXED, __HIP_MEMORY_SCOPE_AGENT) < 512u * REP_MX1 * (1 + (REPU & 1)) && ++sp < (1u << 24)) __builtin_amdgcn_s_sleep(4);
                    __builtin_amdgcn_fence(__ATOMIC_ACQUIRE, "agent"); asm volatile("s_waitcnt vmcnt(0)" ::: "memory"); }
                __syncthreads();
                int tid = tid_p; LAUNDER_V(tid);
                ret_scan(Cc, ly, tid, G);
            }
        }
        PHASE_END;
        if (PHASE_BEGIN) { PHASE_LOCALS; int ly = layer; LAUNDER_S(ly); for (int u = bid; u < 256; u += G) outproj_sample_unit(Cc, lds, ly, u, tid, wave, lane); for (int rep = 0; rep < REP_RP; ++rep) for (int u = bid; u < 512; u += G) if (!(SKIPM & 16)) ret_prompt_unit(Cc, lds, ly, u >> 3, u & 7, tid, wave, lane); }
        PHASE_END;
        if (PHASE_BEGIN) {
            unsigned char* ws = C.ws; const int G = gridDim.x, bid = blockIdx.x;
            float* rss = (float*)(ws + WS_CTL); float* XR = (float*)(ws + WS_XR);
            pg8::Gemm g{(const bf16*)(ws + WS_Y), (const bf16*)(ws + WS_WOUT) + (size_t)layer * D * D, T, D, D}; pg8::StaticOrder S; S.init(T, D, G, bid);
            if (G == 256) {
                pg8::EpiResFinal EF;
                pg8::gemm_phase<pg8::EpiResFinal, pg8::StaticOrder, true, true>((LAS unsigned char*)lds_raw, g, S, EF);
                PHASE_LOCALS2;
                const float* rf = (const float*)(Cc.ws + WS_CTL) + 2 * M;
                for (int m = T + bid * 8 + wave; m < M; m += G * 8) {
                    const float rv = rsqrtf(rf[m] * (1.0f / 2048.0f) + 1e-6f);
                    f32x4* xr = (f32x4*)(Cc.out + (size_t)m * D);
#pragma unroll
                    for (int j = 0; j < 8; ++j) { const f32x4 wv = *((const f32x4*)Cc.final_w + lane + 64 * j); xr[lane + 64 * j] = xr[lane + 64 * j] * rv * wv; }
                }
            } else {
                pg8::EpiRes E{layer};
                pg8::gemm_phase<pg8::EpiRes, pg8::StaticOrder, true, true>((LAS unsigned char*)lds_raw, g, S, E);
            }
        }
        if (gridDim.x != 256) { PHASE_END; } else ++ph;
    }
#ifdef REP_SYNC
    for (int rep = 0; rep < REP_SYNC; ++rep) { XcdBarrier xb_; xb_.bar = (unsigned*)(C.ws + WS_BAR); xb_.x = xb_xcc_id(); xb_.st = (volatile LAS unsigned*)((LAS unsigned char*)lds_raw + LDS_BARST); xcd_barrier(xb_); }
#endif
    if (PHASE_BEGIN && gridDim.x != 256) {
        PHASE_LOCALS;
        const float* rf = (const float*)(Cc.ws + WS_CTL) + 2 * M;
        for (int m = bid * 8 + wave; m < M; m += G * 8) {
            const float rv = rsqrtf(rf[m] * (1.0f / 2048.0f) + 1e-6f);
            f32x4* xr = (f32x4*)(Cc.out + (size_t)m * D);
#pragma unroll
            for (int j = 0; j < 8; ++j) { const f32x4 wv = *((const f32x4*)Cc.final_w + lane + 64 * j); xr[lane + 64 * j] = xr[lane + 64 * j] * rv * wv; }
        }
    }
}

constexpr int N_PHASES = 1 + DEPTH * 4 + 1;
#ifndef MK_MULTI
#define MK_MULTI 0
#endif
extern "C" void kernel_launch(void* const* d_in, const int* in_sizes, int n_in, void* d_out, int out_size, void* d_ws, size_t ws_size, hipStream_t stream) {
    static int grid = 0;
    if (grid == 0) {
        if (n_in != 11 || ws_size < WS_END) { fprintf(stderr, "kernel_launch: unexpected inputs (n_in %d, ws %zu)\n", n_in, ws_size); grid = -1; return; }
        int dev = 0, cus = 0, per_cu = 0;
        hipGetDevice(&dev); hipDeviceGetAttribute(&cus, hipDeviceAttributeMultiprocessorCount, dev);
        if (hipFuncSetAttribute((const void*)hymba_fwd, hipFuncAttributeMaxDynamicSharedMemorySize, LDS_BYTES) != hipSuccess) { fprintf(stderr, "kernel_launch: hipFuncSetAttribute failed\n"); grid = -1; return; }
        if (hipOccupancyMaxActiveBlocksPerMultiprocessor(&per_cu, (const void*)hymba_fwd, NTHREADS, LDS_BYTES) != hipSuccess || per_cu < 1) { fprintf(stderr, "kernel_launch: occupancy query says %d\n", per_cu); (void)hipGetLastError(); per_cu = 1; }
        grid = cus;
    }
    if (grid < 0) return;
    hipMemsetAsync((char*)d_ws + WS_CTL, 0, CTL_BYTES, stream);
    Ctx c{};
    c.x_prompt = (const float*)d_in[0]; c.x_sample = (const float*)d_in[1]; c.cache_k = (const float*)d_in[2]; c.cache_v = (const float*)d_in[3]; c.state = (const float*)d_in[4];
    c.norm_w = (const float*)d_in[5]; c.w_in = (const float*)d_in[6]; c.sinks = (const float*)d_in[7]; c.ret_norm_w = (const float*)d_in[8]; c.w_out = (const float*)d_in[9]; c.final_w = (const float*)d_in[10];
    c.out = (float*)d_out; c.ws = (unsigned char*)d_ws;
#if MK_MULTI
    for (int p = 0; p < N_PHASES; ++p) { c.ph_lo = p; c.ph_hi = p + 1; void* args[] = {&c};
        hipError_t e = hipLaunchCooperativeKernel((const void*)hymba_fwd, dim3(grid), dim3(NTHREADS), args, LDS_BYTES, stream);
        if (e != hipSuccess) { fprintf(stderr, "launch %d failed: %s\n", p, hipGetErrorString(e)); break; } }
#else
    c.ph_lo = 0; c.ph_hi = N_PHASES; void* args[] = {&c};
    hipError_t e = hipLaunchCooperativeKernel((const void*)hymba_fwd, dim3(grid), dim3(NTHREADS), args, LDS_BYTES, stream);
    if (e != hipSuccess) fprintf(stderr, "cooperative launch failed: %s (grid %d)\n", hipGetErrorString(e), grid);
#endif
}
```

```cpp
#include <hip/hip_runtime.h>
#include <hip/hip_cooperative_groups.h>
#include <cstdio>
#include <cstdint>
namespace cg = cooperative_groups;
namespace pg8 {
#define PG8_LAS __attribute__((address_space(3)))
typedef unsigned short bf16_t;
typedef short bf16x8 __attribute__((ext_vector_type(8)));
typedef float f32x4 __attribute__((ext_vector_type(4)));
typedef unsigned u32x4 __attribute__((ext_vector_type(4)));
constexpr int BM = 256, BK = 64, HALF = 128, HTB = HALF * BK * 2  , STAGE_BYTES = 8 * HTB, NXCD = 8, WGM = 8;

__host__ __device__ __forceinline__ int lds_byte(int r, int c) { const int st = (r >> 4) * 2 + (c >> 5), rr = r & 15, cc = c & 31, ob = rr * 64 + cc * 2; return st * 1024 + (ob ^ (((ob >> 9) & 1) << 5)); }
__host__ __device__ __forceinline__ void stage_rc(int b, int& R, int& C) { const int st = b / 1024, sb = b % 1024, swz = sb ^ (((sb >> 9) & 1) << 5); R = (st >> 1) * 16 + swz / 64; C = (st & 1) * 32 + (swz % 64) / 2; }
__host__ __device__ __forceinline__ int perm32(int rho) { const int n = rho >> 4, i = rho & 15; return 8 * (i >> 2) + 4 * n + (i & 3); }

struct Unit { int pm, pn; };
struct Gemm { const bf16_t* A; const bf16_t* Bt; int M, N, K; };

struct StaticOrder {
    int nM, nN, nwg, G, c;
    __host__ __device__ void init(int M, int N, int G_, int c_) { nM = M / BM; nN = N / BM; nwg = nM * nN; G = G_; c = c_; }
    __host__ __device__ bool next(int i, Unit& u) const {
        const long L = (long)i * G + c; if (L >= nwg) return false;
        int wgid = (int)L; { const int q = nwg / NXCD, r = nwg % NXCD, xcd = wgid % NXCD, off = wgid / NXCD; wgid = (xcd < r ? xcd * (q + 1) : r * (q + 1) + (xcd - r) * q) + off; }
        const int nig = WGM * nN, gid = wgid / nig, fm = gid * WGM, gsz = (nM - fm) < WGM ? (nM - fm) : WGM;
        u.pm = fm + ((wgid % nig) % gsz); u.pn = (wgid % nig) / gsz; return true;
    }
    __device__ __forceinline__ void a_ready(const Unit&) const {}
    __device__ __forceinline__ void done(const Unit&) const {}
};


struct SampleFirstOrder {
    int G, c; unsigned* cnt;
    __device__ __forceinline__ bool next(int i, Unit& u) const {
        const int L = i * G + c; if (L >= 850) return false;
        if (L < 50) { u.pm = 32 + L / 25; u.pn = L % 25; return true; }
        int wgid = L - 50; wgid = (wgid % NXCD) * 100 + wgid / NXCD;
        const int r = wgid % 200; u.pm = (wgid / 200) * WGM + (r % WGM); u.pn = r / WGM; return true;
    }
    __device__ __forceinline__ void a_ready(const Unit&) const {}
    __device__ __forceinline__ void done(const Unit& u) const {
        if (u.pm >= 32) {
            asm volatile("s_waitcnt vmcnt(0)" ::: "memory");
            __syncthreads();
            if (threadIdx.x == 0) { __builtin_amdgcn_fence(__ATOMIC_RELEASE, "agent"); asm volatile("s_waitcnt vmcnt(0)" ::: "memory");
                __hip_atomic_fetch_add(cnt, 1u, __ATOMIC_RELAXED, __HIP_MEMORY_SCOPE_AGENT); }
        }
    }
};
__device__ __forceinline__ unsigned cvt_pk_bf16(float lo, float hi) { unsigned r; asm volatile("v_cvt_pk_bf16_f32 %0, %1, %2" : "=v"(r) : "v"(lo), "v"(hi)); return r; }
constexpr int T_ = 8192, NPROJ = 6400, DMODEL = 2048;
struct KArgs { const float* in[11]; float* out; unsigned char* ws; int ph_lo, ph_hi; };
constexpr size_t EMiB = 1u << 20, EWS_XA = 68 * EMiB, EWS_P = 102 * EMiB, EWS_XR = 243 * EMiB, EWS_TAB = 359 * EMiB;
constexpr size_t O_KP = (size_t)8704 * 2048, O_VP = O_KP + 32768, O_RP = O_VP + 32768, O_KS = O_RP + 262144, O_VS = O_KS + 4194304, O_RS = O_VS + 4194304;

struct EpiProj {
    static constexpr bool PERM = true, AFTER_DRAIN = false;
    int layer;
    __device__ __forceinline__ void operator()(const f32x4 (&acc)[2][2][4][2], const Unit& u, int wr, int wc, int fr, int fq) const {
        const KArgs* kp = (const KArgs*)__builtin_amdgcn_kernarg_segment_ptr(); asm volatile("" : "+s"(kp));
        unsigned char* ws = kp->ws; float* out = kp->out;
        bf16_t* P = (bf16_t*)(ws + EWS_P); const float* rss = (const float*)ws + layer * 8704;
        const float* cosA = (const float*)(ws + EWS_TAB); const float* sinA = cosA + 8196 * 32; const float* cosB = sinA + 8196 * 32; const float* sinB = cosB + 8196 * 64;
        float rv[2][4];
#pragma unroll
        for (int ai = 0; ai < 2; ++ai)
#pragma unroll
            for (int m = 0; m < 4; ++m) rv[ai][m] = rsqrtf(rss[u.pm * BM + ai * HALF + wr * 64 + m * 16 + fr] * (1.0f / 2048.0f) + 1e-6f);
#pragma unroll
        for (int bj = 0; bj < 2; ++bj) {
            const int cb = u.pn * BM + bj * HALF;
            const int c0 = cb + wc * 32 + 8 * fq;
            const int mode = (cb < 1152) ? 1 : ((cb >= 2304 && cb < 4352) ? 2 : 0);
            const int kvmode = (cb == 1024) ? 1 : ((cb == 1152) ? 2 : 0);
#pragma unroll
            for (int ai = 0; ai < 2; ++ai)
#pragma unroll
                for (int m = 0; m < 4; ++m) {
                    const int row = u.pm * BM + ai * HALF + wr * 64 + m * 16 + fr;
                    f32x4 v0 = acc[ai][bj][m][0] * rv[ai][m], v1 = acc[ai][bj][m][1] * rv[ai][m];
                    if (mode) {
                        const int pos = row < T_ ? row : T_ + ((row - T_) & 3);
                        f32x4 c, s;
                        if (mode == 1) { const int i = (c0 & 63) >> 3; c = *(const f32x4*)(cosA + pos * 32 + 4 * i); s = *(const f32x4*)(sinA + pos * 32 + 4 * i); }
                        else { const int i = (c0 & 127) >> 3; c = *(const f32x4*)(cosB + pos * 64 + 4 * i); s = *(const f32x4*)(sinB + pos * 64 + 4 * i); }
                        const f32x4 y0 = v0 * c - v1 * s, y1 = v1 * c + v0 * s; v0 = y0; v1 = y1;
                    }
                    u32x4 w; w.x = cvt_pk_bf16(v0[0], v0[1]); w.y = cvt_pk_bf16(v0[2], v0[3]); w.z = cvt_pk_bf16(v1[0], v1[1]); w.w = cvt_pk_bf16(v1[2], v1[3]);
                    *(u32x4*)(P + (size_t)row * NPROJ + c0) = w;
                    if (kvmode && row >= T_ - 128) {
                        const int kvh = (c0 - cb) >> 6, g0 = c0 & 63;
                        float* dst;
                        if (row < T_) dst = out + (kvmode == 1 ? O_KP : O_VP) + ((size_t)(layer * 128 + (row - (T_ - 128))) * 2 + kvh) * 64;
                        else { const int b = (row - T_) >> 2, t = (row - T_) & 3; dst = out + (kvmode == 1 ? O_KS : O_VS) + ((((size_t)layer * 128 + b) * 128 + 124 + t) * 2 + kvh) * 64; }
                        if (kvmode == 1) { const int i = g0 >> 3; *(f32x4*)(dst + 4 * i) = v0; *(f32x4*)(dst + 4 * i + 32) = v1; }
                        else { *(f32x4*)(dst + g0) = v0; *(f32x4*)(dst + g0 + 4) = v1; }
                    }
                }
        }
    }
};

struct EpiRes {
    static constexpr bool PERM = true, AFTER_DRAIN = false;
    int layer;
    __device__ __forceinline__ void operator()(const f32x4 (&acc)[2][2][4][2], const Unit& u, int wr, int wc, int fr, int fq) const {
        const KArgs* kp = (const KArgs*)__builtin_amdgcn_kernarg_segment_ptr(); asm volatile("" : "+s"(kp));
        unsigned char* ws = kp->ws; bf16_t* xa = (bf16_t*)(ws + EWS_XA); float* rss = (float*)ws + (layer + 1) * 8704;
#pragma unroll
        for (int ai = 0; ai < 2; ++ai)
#pragma unroll
            for (int m = 0; m < 4; ++m) {
                const int row = u.pm * BM + ai * HALF + wr * 64 + m * 16 + fr;
                float ss = 0.f;
#pragma unroll
                for (int bj = 0; bj < 2; ++bj) {
                    const int c0 = u.pn * BM + bj * HALF + wc * 32 + 8 * fq;
                    f32x4 b0, b1;
                    if (layer == 0) { const float* bp = (row < T_ ? kp->in[0] + (size_t)row * DMODEL : kp->in[1] + (size_t)(row - T_) * DMODEL) + c0; b0 = *(const f32x4*)bp; b1 = *(const f32x4*)(bp + 4); }
                    else { const u32x4 xb = *(const u32x4*)(xa + (size_t)row * DMODEL + c0);
                        b0 = (f32x4){__uint_as_float(xb.x << 16), __uint_as_float(xb.x & 0xffff0000u), __uint_as_float(xb.y << 16), __uint_as_float(xb.y & 0xffff0000u)};
                        b1 = (f32x4){__uint_as_float(xb.z << 16), __uint_as_float(xb.z & 0xffff0000u), __uint_as_float(xb.w << 16), __uint_as_float(xb.w & 0xffff0000u)}; }
                    const f32x4 v0 = acc[ai][bj][m][0] + b0, v1 = acc[ai][bj][m][1] + b1;
                    if (layer == 0) { u32x4 w; w.x = cvt_pk_bf16(v0[0], v0[1]); w.y = cvt_pk_bf16(v0[2], v0[3]); w.z = cvt_pk_bf16(v1[0], v1[1]); w.w = cvt_pk_bf16(v1[2], v1[3]);
                        *(u32x4*)(xa + (size_t)row * DMODEL + c0) = w; }
                    else { float* op = kp->out + (size_t)row * DMODEL + c0; *(f32x4*)op = v0; *(f32x4*)(op + 4) = v1; }
                    ss += (v0[0] * v0[0] + v0[1] * v0[1]) + (v0[2] * v0[2] + v0[3] * v0[3]) + (v1[0] * v1[0] + v1[1] * v1[1]) + (v1[2] * v1[2] + v1[3] * v1[3]);
                }
                ss += __shfl_xor(ss, 16); ss += __shfl_xor(ss, 32);
                if (fq == 0) atomicAdd(rss + row, ss);
            }
    }
};


struct EpiResFinal {
    static constexpr bool PERM = true, AFTER_DRAIN = true;
    __device__ __forceinline__ void operator()(const f32x4 (&)[2][2][4][2], const Unit&, int, int, int, int) const {}
    __device__ __forceinline__ void fused(f32x4 (&acc)[2][2][4][2], const Unit& u, int wr, int wc, int fr, int fq, PG8_LAS unsigned char* lds, int wid, int lane) const {
        asm volatile("" : "+v"(fr), "+v"(fq));
        const KArgs* kp = (const KArgs*)__builtin_amdgcn_kernarg_segment_ptr(); asm volatile("" : "+s"(kp));
        unsigned char* ws = kp->ws; const bf16_t* xa = (const bf16_t*)(ws + EWS_XA);
        PG8_LAS float* P4 = (PG8_LAS float*)lds;
        PG8_LAS float* S = (PG8_LAS float*)(lds + 4096);
        PG8_LAS unsigned* flag = (PG8_LAS unsigned*)(lds + 8192);
        unsigned* slots = (unsigned*)(ws + EWS_XR);
        unsigned* cnt = (unsigned*)ws + 32768 + 64 * u.pm;
#pragma unroll
        for (int ai = 0; ai < 2; ++ai)
#pragma unroll
            for (int m = 0; m < 4; ++m) {
                const int rl = ai * HALF + wr * 64 + m * 16 + fr, row = u.pm * BM + rl;
                float ss = 0.f;
#pragma unroll
                for (int bj = 0; bj < 2; ++bj) {
                    const int c0 = u.pn * BM + bj * HALF + wc * 32 + 8 * fq;
                    const u32x4 xb = *(const u32x4*)(xa + (size_t)row * DMODEL + c0);
                    const f32x4 b0 = (f32x4){__uint_as_float(xb.x << 16), __uint_as_float(xb.x & 0xffff0000u), __uint_as_float(xb.y << 16), __uint_as_float(xb.y & 0xffff0000u)};
                    const f32x4 b1 = (f32x4){__uint_as_float(xb.z << 16), __uint_as_float(xb.z & 0xffff0000u), __uint_as_float(xb.w << 16), __uint_as_float(xb.w & 0xffff0000u)};
                    const f32x4 v0 = acc[ai][bj][m][0] + b0, v1 = acc[ai][bj][m][1] + b1;
                    acc[ai][bj][m][0] = v0; acc[ai][bj][m][1] = v1;
                    ss += (v0[0] * v0[0] + v0[1] * v0[1]) + (v0[2] * v0[2] + v0[3] * v0[3]) + (v1[0] * v1[0] + v1[1] * v1[1]) + (v1[2] * v1[2] + v1[3] * v1[3]);
                }
                ss += __shfl_xor(ss, 16); ss += __shfl_xor(ss, 32);
                if (fq == 0) P4[rl * 4 + wc] = ss;
            }
        asm volatile("s_waitcnt lgkmcnt(0)" ::: "memory"); __builtin_amdgcn_s_barrier(); asm volatile("" ::: "memory");
        const int tid = wid * 64 + lane;
        if (tid < 256) { const float t = (P4[tid * 4] + P4[tid * 4 + 1]) + (P4[tid * 4 + 2] + P4[tid * 4 + 3]);
            __hip_atomic_store(slots + ((size_t)(u.pm * BM + tid)) * 8 + u.pn, __float_as_uint(t), __ATOMIC_RELAXED, __HIP_MEMORY_SCOPE_AGENT); }
        asm volatile("s_waitcnt vmcnt(0)" ::: "memory");
        if (lane == 0) __hip_atomic_fetch_add(cnt, 1u, __ATOMIC_RELAXED, __HIP_MEMORY_SCOPE_AGENT);
        if (wid == 0) {
            unsigned sp = 0u; bool dead = false;
            while ((unsigned)__builtin_amdgcn_readfirstlane(__hip_atomic_load(cnt, __ATOMIC_RELAXED, __HIP_MEMORY_SCOPE_AGENT)) < 64u) { __builtin_amdgcn_s_sleep(2); if (++sp > (1u << 22)) { dead = true; break; } }
            __builtin_amdgcn_fence(__ATOMIC_ACQUIRE, "agent");
            if (lane == 0) flag[0] = dead ? 1u : 0u;
        }
        asm volatile("s_waitcnt vmcnt(0) lgkmcnt(0)" ::: "memory"); __builtin_amdgcn_s_barrier(); asm volatile("" ::: "memory");
        if (tid < 256) { const unsigned* sl = slots + ((size_t)(u.pm * BM + tid)) * 8; float t = 0.f;
#pragma unroll
            for (int k = 0; k < 8; ++k) t += __uint_as_float(__hip_atomic_load(sl + k, __ATOMIC_RELAXED, __HIP_MEMORY_SCOPE_AGENT));
            S[tid] = flag[0] ? __builtin_nanf("") : rsqrtf(t * (1.0f / 2048.0f) + 1e-6f); }
        asm volatile("s_waitcnt lgkmcnt(0)" ::: "memory"); __builtin_amdgcn_s_barrier(); asm volatile("" ::: "memory");
        const float* fw = kp->in[10];
#pragma unroll
        for (int bj = 0; bj < 2; ++bj) {
            const int c0 = u.pn * BM + bj * HALF + wc * 32 + 8 * fq;
            const f32x4 w0 = *(const f32x4*)(fw + c0), w1 = *(const f32x4*)(fw + c0 + 4);
#pragma unroll
            for (int ai = 0; ai < 2; ++ai)
#pragma unroll
                for (int m = 0; m < 4; ++m) {
                    const int rl = ai * HALF + wr * 64 + m * 16 + fr; const float rv = S[rl];
                    float* op = kp->out + (size_t)(u.pm * BM + rl) * DMODEL + c0;
                    __builtin_nontemporal_store(acc[ai][bj][m][0] * rv * w0, (f32x4*)op); __builtin_nontemporal_store(acc[ai][bj][m][1] * rv * w1, (f32x4*)(op + 4));
                }
        }
    }
};

template <class Epi, class Sched, bool ALIGN_EPI = false, bool SP2 = false>
__device__ __forceinline__ void gemm_phase(PG8_LAS unsigned char* lds, const Gemm g, const Sched& S, const Epi& E) {
    int tid_ = threadIdx.x; asm volatile("" : "+v"(tid_));
    const int tid = tid_, wid = __builtin_amdgcn_readfirstlane(tid >> 6), lane = tid & 63, wr = wid >> 2, wc = wid & 3, fr = lane & 15, fq = lane >> 4;
    const int K = g.K, nt = K / BK;
    unsigned voffA[2], voffB[2];
#pragma unroll
    for (int i = 0; i < 2; ++i) { int R, C; stage_rc(tid * 16 + i * 8192, R, C); const int Rb = Epi::PERM ? ((R & ~31) + perm32(R & 31)) : R;
        voffA[i] = (unsigned)(R * K + C) * 2u; voffB[i] = (unsigned)(Rb * K + C) * 2u; }
    const size_t kstep = (size_t)(BK * 2);
    const size_t hstep = (size_t)HALF * K * 2;
    const size_t tstep = 2 * hstep;
    const unsigned ldsw = (unsigned)wid * 1024u;
    const int aoff = lds_byte(wr * 64 + fr, fq * 8), boff = lds_byte(wc * 32 + fr, fq * 8);
#define PG8_SA(b, h) (((b) * 2 + (h)) * HTB)
#define PG8_SB(b, h) ((4 + (b) * 2 + (h)) * HTB)
#define PG8_STAGE(bufoff, gbase, voff) do { _Pragma("unroll") for (int _i = 0; _i < 2; ++_i) \
        __builtin_amdgcn_global_load_lds((const unsigned*)((const char*)(gbase) + (voff)[_i]), (PG8_LAS unsigned*)(lds + (bufoff) + ldsw + _i * 8192), 16, 0, 0); } while (0)
#define PG8_LDA(dst, b, h) do { _Pragma("unroll") for (int m = 0; m < 4; ++m) _Pragma("unroll") for (int k = 0; k < 2; ++k) dst[m][k] = *(const PG8_LAS bf16x8*)(lds + PG8_SA(b, h) + aoff + m * 2048 + k * 1024); } while (0)
#define PG8_LDB(dst, b, h) do { _Pragma("unroll") for (int n = 0; n < 2; ++n) _Pragma("unroll") for (int k = 0; k < 2; ++k) dst[n][k] = *(const PG8_LAS bf16x8*)(lds + PG8_SB(b, h) + boff + n * 2048 + k * 1024); } while (0)
#define PG8_MMA(ai, bj, At, Bt) do { __builtin_amdgcn_s_setprio(1); _Pragma("unroll") for (int m = 0; m < 4; ++m) _Pragma("unroll") for (int n = 0; n < 2; ++n) _Pragma("unroll") for (int k = 0; k < 2; ++k) \
        acc[ai][bj][m][n] = __builtin_amdgcn_mfma_f32_16x16x32_bf16(Bt[n][k], At[m][k], acc[ai][bj][m][n], 0, 0, 0); __builtin_amdgcn_s_setprio(0); } while (0)
#define PG8_WAIT_V(n) asm volatile("s_waitcnt vmcnt(" #n ")" ::: "memory")
#define PG8_WAIT_L(n) asm volatile("s_waitcnt lgkmcnt(" #n ")" ::: "memory")
#define PG8_BAR __builtin_amdgcn_s_barrier()
#define PG8_SCHED __builtin_amdgcn_sched_barrier(0)
    Unit cur, nxt; int ui = 0;
    if (!S.next(0, cur)) return;
    f32x4 acc[2][2][4][2];
#pragma unroll
    for (int a = 0; a < 2; ++a)
#pragma unroll
        for (int b = 0; b < 2; ++b)
#pragma unroll
            for (int m = 0; m < 4; ++m)
#pragma unroll
                for (int n = 0; n < 2; ++n) acc[a][b][m][n] = (f32x4){0.f, 0.f, 0.f, 0.f};
    bf16x8 At[4][2], B0[2][2], B1[2][2];
    const char* cA = (const char*)g.A + (size_t)cur.pm * tstep; const char* cB = (const char*)g.Bt + (size_t)cur.pn * tstep;
    S.a_ready(cur);
    if constexpr (SP2) {
        PG8_STAGE(PG8_SB(0, 0), cB, voffB); PG8_STAGE(PG8_SB(0, 1), cB + hstep, voffB); PG8_STAGE(PG8_SA(0, 0), cA, voffA); PG8_STAGE(PG8_SA(0, 1), cA + hstep, voffA);
        if (wr == 1) PG8_BAR;
        PG8_WAIT_V(2); PG8_BAR;
        PG8_STAGE(PG8_SB(1, 0), cB + kstep, voffB); PG8_STAGE(PG8_SA(1, 0), cA + kstep, voffA); PG8_STAGE(PG8_SB(1, 1), cB + hstep + kstep, voffB);
        PG8_WAIT_V(6); PG8_BAR;
    } else {
        PG8_STAGE(PG8_SB(0, 0), cB, voffB); PG8_STAGE(PG8_SA(0, 0), cA, voffA); PG8_STAGE(PG8_SB(0, 1), cB + hstep, voffB); PG8_STAGE(PG8_SA(0, 1), cA + hstep, voffA);
        if (wr == 1) PG8_BAR;
        PG8_WAIT_V(4); PG8_BAR;
        PG8_STAGE(PG8_SB(1, 0), cB + kstep, voffB); PG8_STAGE(PG8_SA(1, 0), cA + kstep, voffA); PG8_STAGE(PG8_SB(1, 1), cB + hstep + kstep, voffB);
        PG8_WAIT_V(6); PG8_BAR;
    }
    for (;;) {
        const bool has_next = S.next(ui + 1, nxt);
        const char* nA = has_next ? (const char*)g.A + (size_t)nxt.pm * tstep : cA; const char* nB = has_next ? (const char*)g.Bt + (size_t)nxt.pn * tstep : cB;
        for (int t = 0; t < nt; t += 2) {
            const bool last = (t == nt - 2);
            const char* a1 = cA + (size_t)(t + 1) * kstep;
            const char* a2 = last ? nA : cA + (size_t)(t + 2) * kstep; const char* b2 = last ? nB : cB + (size_t)(t + 2) * kstep;
            const char* a3 = a2 + kstep; const char* b3 = b2 + kstep;
            if (last && has_next) S.a_ready(nxt);
            if constexpr (SP2) {
            PG8_LDB(B0, 0, 0); PG8_LDB(B1, 0, 1); PG8_SCHED; PG8_LDA(At, 0, 0); PG8_STAGE(PG8_SA(1, 1), a1 + hstep, voffA);
            PG8_WAIT_V(8); PG8_WAIT_L(0); PG8_BAR; PG8_MMA(0, 0, At, B0); PG8_MMA(0, 1, At, B1); PG8_BAR; PG8_SCHED;
            PG8_LDA(At, 0, 1); PG8_STAGE(PG8_SB(0, 0), b2, voffB); PG8_STAGE(PG8_SB(0, 1), b2 + hstep, voffB); PG8_STAGE(PG8_SA(0, 0), a2, voffA);
            PG8_WAIT_V(8); PG8_WAIT_L(0); PG8_BAR; PG8_MMA(1, 0, At, B0); PG8_MMA(1, 1, At, B1); PG8_BAR; PG8_SCHED;
            PG8_LDB(B0, 1, 0); PG8_LDB(B1, 1, 1); PG8_SCHED; PG8_LDA(At, 1, 0); PG8_STAGE(PG8_SA(0, 1), a2 + hstep, voffA);
            PG8_WAIT_V(8); PG8_WAIT_L(0); PG8_BAR; PG8_MMA(0, 0, At, B0); PG8_MMA(0, 1, At, B1); PG8_BAR; PG8_SCHED;
            PG8_LDA(At, 1, 1); PG8_STAGE(PG8_SB(1, 0), b3, voffB); PG8_STAGE(PG8_SB(1, 1), b3 + hstep, voffB); PG8_STAGE(PG8_SA(1, 0), a3, voffA);
            PG8_WAIT_V(8); PG8_WAIT_L(0); PG8_BAR; PG8_MMA(1, 0, At, B0); PG8_MMA(1, 1, At, B1); PG8_BAR; PG8_SCHED;
            } else {
            PG8_LDB(B0, 0, 0); PG8_SCHED; PG8_LDA(At, 0, 0); PG8_STAGE(PG8_SA(1, 1), a1 + hstep, voffA);
            PG8_WAIT_L(8); PG8_BAR; PG8_WAIT_L(0); PG8_MMA(0, 0, At, B0); PG8_BAR; PG8_SCHED;
            PG8_LDB(B1, 0, 1); PG8_STAGE(PG8_SB(0, 0), b2, voffB);
            PG8_BAR; PG8_WAIT_L(0); PG8_MMA(0, 1, At, B1); PG8_BAR;
            PG8_LDA(At, 0, 1); PG8_STAGE(PG8_SA(0, 0), a2, voffA);
            PG8_BAR; PG8_WAIT_L(0); PG8_MMA(1, 0, At, B0); PG8_BAR; PG8_SCHED;
            PG8_STAGE(PG8_SB(0, 1), b2 + hstep, voffB);
            PG8_WAIT_V(6); PG8_BAR; PG8_MMA(1, 1, At, B1); PG8_BAR;
            PG8_LDB(B0, 1, 0); PG8_SCHED; PG8_LDA(At, 1, 0); PG8_STAGE(PG8_SA(0, 1), a2 + hstep, voffA);
            PG8_WAIT_L(8); PG8_BAR; PG8_WAIT_L(0); PG8_MMA(0, 0, At, B0); PG8_BAR; PG8_SCHED;
            PG8_LDB(B1, 1, 1); PG8_STAGE(PG8_SB(1, 0), b3, voffB);
            PG8_BAR; PG8_WAIT_L(0); PG8_MMA(0, 1, At, B1); PG8_BAR;
            PG8_LDA(At, 1, 1); PG8_STAGE(PG8_SA(1, 0), a3, voffA);
            PG8_BAR; PG8_WAIT_L(0); PG8_MMA(1, 0, At, B0); PG8_BAR; PG8_SCHED;
            PG8_STAGE(PG8_SB(1, 1), b3 + hstep, voffB);
            PG8_WAIT_V(6); PG8_BAR; PG8_MMA(1, 1, At, B1); PG8_BAR;
            }
        }
        if constexpr (ALIGN_EPI) { if (wr == 0) PG8_BAR; }
        if constexpr (!Epi::AFTER_DRAIN) { E(acc, cur, wr, wc, fr, fq); S.done(cur); }
        if (!has_next) break;
#pragma unroll
        for (int a = 0; a < 2; ++a)
#pragma unroll
            for (int b = 0; b < 2; ++b)
#pragma unroll
                for (int m = 0; m < 4; ++m)
#pragma unroll
                    for (int n = 0; n < 2; ++n) acc[a][b][m][n] = (f32x4){0.f, 0.f, 0.f, 0.f};
        cur = nxt; cA = nA; cB = nB; ++ui;
        if constexpr (ALIGN_EPI) { if (wr == 1) PG8_BAR; }
    }
    PG8_WAIT_V(0);
    if constexpr (!ALIGN_EPI) { if (wr == 0) PG8_BAR; }
    PG8_BAR;
    if constexpr (Epi::AFTER_DRAIN) { E.fused(acc, cur, wr, wc, fr, fq, lds, wid, lane); S.done(cur); }
#undef PG8_SA
#undef PG8_SB
#undef PG8_STAGE
#undef PG8_LDA
#undef PG8_LDB
#undef PG8_MMA
#undef PG8_WAIT_V
#undef PG8_WAIT_L
#undef PG8_BAR
#undef PG8_SCHED
}
}

typedef unsigned short bf16;
typedef float f32x4 __attribute__((ext_vector_type(4)));
typedef short bf16x8 __attribute__((ext_vector_type(8)));
typedef short s16x4 __attribute__((ext_vector_type(4)));
typedef unsigned u32x4 __attribute__((ext_vector_type(4)));
typedef unsigned u32x2 __attribute__((ext_vector_type(2)));
typedef float f32x2 __attribute__((ext_vector_type(2)));
typedef __bf16 bf16x2_t __attribute__((ext_vector_type(2)));
#define LAS __attribute__((address_space(3)))

constexpr int T = 8192, NS = 512, M = 8704, D = 2048, NP = 6400, DEPTH = 2;
constexpr int C_QA = 0, C_KA = 1024, C_VA = 1152, C_GA = 1280, C_QB = 2304, C_KB = 3328, C_VB = 4352, C_GB = 5376;
constexpr int NPOS = 8196;
constexpr int LDS_BYTES = 147456;
constexpr int NTHREADS = 512;
using pg8::O_KP; using pg8::O_VP; using pg8::O_RP; using pg8::O_KS; using pg8::O_VS; using pg8::O_RS;

constexpr size_t MiB = 1u << 20;
constexpr size_t WS_CTL = 0, CTL_BYTES = 1 * MiB;
constexpr size_t WS_WIN = 2 * MiB;
constexpr size_t WS_WOUT = WS_WIN + 50 * MiB;
constexpr size_t WS_XA = WS_WOUT + 16 * MiB;
constexpr size_t WS_P = WS_XA + 34 * MiB;
constexpr size_t WS_Y = WS_P + 107 * MiB;
constexpr size_t WS_XR = WS_Y + 34 * MiB;
constexpr size_t WS_U = WS_XR + 68 * MiB;
constexpr size_t WS_RT = WS_U + 32 * MiB;
constexpr size_t WS_TAB = WS_RT + 16 * MiB;
constexpr size_t WS_END = WS_TAB + 8 * MiB;
static_assert(WS_XA == pg8::EWS_XA && WS_P == pg8::EWS_P && WS_XR == pg8::EWS_XR && WS_TAB == pg8::EWS_TAB && WS_CTL == 0, "d_ws map vs the epilogues' copy");

static_assert(true, "");
struct Ctx {
    const float *x_prompt, *x_sample, *cache_k, *cache_v, *state, *norm_w, *w_in, *sinks, *ret_norm_w, *w_out, *final_w;
    float* out; unsigned char* ws;
    int ph_lo, ph_hi;
};

__device__ __forceinline__ unsigned cvtpk(float lo, float hi) { f32x2 v = {lo, hi}; bf16x2_t b = __builtin_convertvector(v, bf16x2_t); return __builtin_bit_cast(unsigned, b); }
__device__ __forceinline__ float bf_lo(unsigned u) { return __uint_as_float(u << 16); }
__device__ __forceinline__ float bf_hi(unsigned u) { return __uint_as_float(u & 0xffff0000u); }
__device__ __forceinline__ float silu_f(float x) { return x * __builtin_amdgcn_rcpf(1.0f + __expf(-x)); }
__device__ __forceinline__ s16x4 vtr(const char* p) { typedef short v4i16_t __attribute__((ext_vector_type(4)));
    return __builtin_bit_cast(s16x4, __builtin_amdgcn_ds_read_tr16_b64_v4i16((LAS v4i16_t*)p)); }
__device__ __forceinline__ bf16x8 cat8(s16x4 lo, s16x4 hi) { return (bf16x8){lo[0], lo[1], lo[2], lo[3], hi[0], hi[1], hi[2], hi[3]}; }
__device__ __forceinline__ float ln_gamma(int h) {
    const double x = __builtin_ldexp(1.0, -5 - h);
    double s = 0.0, p = x;
#pragma unroll
    for (int k = 1; k <= 9; ++k) { s += p / (double)k; p *= x; }
    return (float)(-s);
}
#define LDS_WAIT() asm volatile("s_waitcnt lgkmcnt(0)" ::: "memory")
#define LAUNDER_V(x) asm volatile("" : "+v"(x))
#define LAUNDER_S(x) asm volatile("" : "+s"(x))

__device__ __forceinline__ int perm_src_col(int np, float& sc) {
    sc = 1.0f;
    if (np < 1152) { const int hb = np & ~63, g = np & 63; if (np < 1024) sc = 0.125f; return hb + 4 * (g >> 3) + (g & 3) + 32 * ((g >> 2) & 1); }
    if (np >= C_QB && np < C_VB) { const int hb = np & ~127, g = np & 127; if (np >= C_KB) sc = 0.08838834764831845f; return hb + 4 * (g >> 3) + (g & 3) + 64 * ((g >> 2) & 1); }
    return np;
}

template <bool WIN>
__device__ __forceinline__ void transpose_item(const float* W, int N, const float* nw, bf16* WT, float* scr, int kb, int nb, int lane) {
    const int k0 = 64 * kb, n0 = 64 * nb, l16 = lane & 15, r4 = lane >> 4;
    float sc = 1.0f; int srcc = n0 + 4 * l16;
    if (WIN) srcc = perm_src_col(n0 + 4 * l16, sc);
    f32x4 v[16]; float nwv[16];
#pragma unroll
    for (int i = 0; i < 16; ++i) { const int kk = 4 * i + r4; v[i] = __builtin_nontemporal_load((const f32x4*)(W + (size_t)(k0 + kk) * N + srcc)); nwv[i] = WIN ? nw[k0 + kk] : 1.0f; }
#pragma unroll
    for (int i = 0; i < 16; ++i) {
        const int kk = 4 * i + r4; const float s2 = sc * nwv[i];
        float* d = scr + kk * 65 + 4 * l16;
        d[0] = v[i][0] * s2; d[1] = v[i][1] * s2; d[2] = v[i][2] * s2; d[3] = v[i][3] * s2;
    }
    LDS_WAIT();
    const int c = lane & 7;
#pragma unroll
    for (int j = 0; j < 8; ++j) {
        const int n = (lane >> 3) + 8 * j; const float* s = scr + (8 * c) * 65 + n;
        u32x4 o; o.x = cvtpk(s[0], s[65]); o.y = cvtpk(s[130], s[195]); o.z = cvtpk(s[260], s[325]); o.w = cvtpk(s[390], s[455]);
        *(u32x4*)(WT + (size_t)(n0 + n) * 2048 + k0 + 8 * c) = o;
    }
    LDS_WAIT();
}

__device__ __forceinline__ void convert_weights(const Ctx& C, float* scr, int l, int gw, int NGW, int lane) {
    bf16* WIN = (bf16*)(C.ws + WS_WIN); bf16* WOUT = (bf16*)(C.ws + WS_WOUT);
    constexpr int I_IN = 32 * 100, I_OUT = 32 * 32;
    for (int it = gw; it < I_IN + I_OUT; it += NGW) {
        int r = it;
        if (r < I_IN) { const int nb = r % 100, kb = r / 100;
            transpose_item<true>(C.w_in + (size_t)l * D * NP, NP, C.norm_w + l * D, WIN + (size_t)l * NP * D, scr, kb, nb, lane); }
        else { r -= I_IN; const int nb = r & 31, kb = r >> 5;
            transpose_item<false>(C.w_out + (size_t)l * D * D, D, nullptr, WOUT + (size_t)l * D * D, scr, kb, nb, lane); }
    }
}

__device__ __forceinline__ void p0_prologue(const Ctx& C, char* lds, int tid, int wave, int lane, int G) {
    float* scr = (float*)(lds + wave * 16640);
    const int gw = blockIdx.x * 8 + wave, NGW = G * 8;
    convert_weights(C, scr, 0, gw, NGW, lane);
    bf16* XA = (bf16*)(C.ws + WS_XA); float* rss = (float*)(C.ws + WS_CTL);
    for (int m = gw; m < M; m += 2 * NGW) {
        const int m2 = m + NGW; const bool has2 = m2 < M;
        const float* xr = m < T ? C.x_prompt + (size_t)m * D : C.x_sample + (size_t)(m - T) * D;
        const int m2c = has2 ? m2 : m;
        const float* xr2 = m2c < T ? C.x_prompt + (size_t)m2c * D : C.x_sample + (size_t)(m2c - T) * D;
        f32x4 va[8], vb[8];
#pragma unroll
        for (int j = 0; j < 8; ++j) { va[j] = __builtin_nontemporal_load((const f32x4*)xr + lane + 64 * j); vb[j] = __builtin_nontemporal_load((const f32x4*)xr2 + lane + 64 * j); }
        float ss = 0.f, ss2 = 0.f;
#pragma unroll
        for (int j = 0; j < 8; ++j) {
            ss += (va[j][0] * va[j][0] + va[j][1] * va[j][1]) + (va[j][2] * va[j][2] + va[j][3] * va[j][3]);
            ss2 += (vb[j][0] * vb[j][0] + vb[j][1] * vb[j][1]) + (vb[j][2] * vb[j][2] + vb[j][3] * vb[j][3]);
            u32x2 o; o.x = cvtpk(va[j][0], va[j][1]); o.y = cvtpk(va[j][2], va[j][3]);
            *((u32x2*)(XA + (size_t)m * D) + lane + 64 * j) = o;
            if (has2) { u32x2 o2; o2.x = cvtpk(vb[j][0], vb[j][1]); o2.y = cvtpk(vb[j][2], vb[j][3]); *((u32x2*)(XA + (size_t)m2 * D) + lane + 64 * j) = o2; }
        }
#pragma unroll
        for (int o = 1; o < 64; o <<= 1) { ss += __shfl_xor(ss, o); ss2 += __shfl_xor(ss2, o); }
        if (lane == 0) { rss[m] = ss; if (has2) rss[m2] = ss2; }
    }
    float* cosA = (float*)(C.ws + WS_TAB); float* sinA = cosA + NPOS * 32; float* cosB = sinA + NPOS * 32; float* sinB = cosB + NPOS * 64;
    for (int i = blockIdx.x * NTHREADS + tid; i < NPOS * 96; i += G * NTHREADS) {
        int pos, f, half; float *pc, *ps;
        if (i < NPOS * 32) { pos = i >> 5; f = i & 31; half = 32; pc = cosA + i; ps = sinA + i; }
        else { const int k = i - NPOS * 32; pos = k >> 6; f = k & 63; half = 64; pc = cosB + k; ps = sinB + k; }
        const double rr = half == 32 ? 0.7498942093324559 : 0.8659643233600653;
        double inv = 1.0; for (int k = 0; k < f; ++k) inv *= rr;
        const float ang = (float)pos * (float)inv;
        const double a = (double)ang;
        const double qd = __builtin_rint(a * 0.6366197723675814);
        double r = __builtin_fma(-qd, 1.5707963267948966, a); r = __builtin_fma(-qd, 6.123233995736766e-17, r);
        const double r2 = r * r;
        double sp = -1.0 / 39916800.0; sp = sp * r2 + 1.0 / 362880.0; sp = sp * r2 - 1.0 / 5040.0; sp = sp * r2 + 1.0 / 120.0; sp = sp * r2 - 1.0 / 6.0; sp = sp * r2 + 1.0; sp *= r;
        double cp = 1.0 / 479001600.0; cp = cp * r2 - 1.0 / 3628800.0; cp = cp * r2 + 1.0 / 40320.0; cp = cp * r2 - 1.0 / 720.0; cp = cp * r2 + 1.0 / 24.0; cp = cp * r2 - 0.5; cp = cp * r2 + 1.0;
        const int qi = ((int)qd) & 3;
        const double sv = (qi == 0) ? sp : (qi == 1) ? cp : (qi == 2) ? -sp : -cp;
        const double cv = (qi == 0) ? cp : (qi == 1) ? -sp : (qi == 2) ? -cp : sp;
        *pc = (float)cv; *ps = (float)sv;
    }
}

__device__ __forceinline__ void attn_prompt_unit(const Ctx& C, char* lds, int layer, int blk, int kvh, int hq, int tid, int w, int lane) {
    const bf16* P = (const bf16*)(C.ws + WS_P); bf16* Y = (bf16*)(C.ws + WS_Y);
    char* Ks = lds; char* Vs = lds + 36864;
    const int q = lane & 15, g = lane >> 4;
    const int jt0 = w < 6 ? w : 6;
    const int iq = 16 * w + q, row = blk * 128 + iq;
    bf16x8 qfa[4][2]; u32x2 gta[4][4];
#pragma unroll
    for (int hh = 0; hh < 4; ++hh) {
        const int h = kvh * 8 + hq * 4 + hh;
#pragma unroll
        for (int ks = 0; ks < 2; ++ks) qfa[hh][ks] = *(const bf16x8*)(P + (size_t)row * NP + C_QA + h * 64 + 32 * ks + 8 * g);
#pragma unroll
        for (int dt = 0; dt < 4; ++dt) gta[hh][dt] = *(const u32x2*)(P + (size_t)row * NP + C_GA + h * 64 + 16 * dt + 4 * g);
    }
#pragma unroll
    for (int it = 0; it < 4; ++it) {
        const int r = (tid >> 3) + 64 * it, ch = tid & 7, krow = blk * 128 - 128 + r;
        u32x4 kv = (u32x4){0u, 0u, 0u, 0u}, vv = kv;
        if (krow >= 0) { kv = *(const u32x4*)(P + (size_t)krow * NP + C_KA + kvh * 64 + ch * 8); vv = *(const u32x4*)(P + (size_t)krow * NP + C_VA + kvh * 64 + ch * 8); }
        *(u32x4*)(Ks + r * 144 + ch * 16) = kv; *(u32x4*)(Vs + r * 144 + ch * 16) = vv;
    }
    __syncthreads();
#pragma unroll
    for (int hp = 0; hp < 2; ++hp) {
        const int h0 = kvh * 8 + hq * 4 + 2 * hp;
        f32x4 s0[10], s1[10];
        float mx0 = -INFINITY, mx1 = -INFINITY;
        int lo = (blk > 0 || iq + 1 >= 128) ? iq + 1 : 128; LAUNDER_V(lo);
        const unsigned span = (unsigned)(iq + 128 - lo);
#pragma unroll
        for (int tt = 0; tt < 10; ++tt) {
            const int jt = jt0 + tt;
            const bf16x8 kf0 = *(const bf16x8*)(Ks + (16 * jt + q) * 144 + (8 * g) * 2), kf1 = *(const bf16x8*)(Ks + (16 * jt + q) * 144 + (32 + 8 * g) * 2);
            f32x4 a0 = (f32x4){0.f, 0.f, 0.f, 0.f}, a1 = a0;
            a0 = __builtin_amdgcn_mfma_f32_16x16x32_bf16(kf0, qfa[2 * hp][0], a0, 0, 0, 0); a1 = __builtin_amdgcn_mfma_f32_16x16x32_bf16(kf0, qfa[2 * hp + 1][0], a1, 0, 0, 0);
            a0 = __builtin_amdgcn_mfma_f32_16x16x32_bf16(kf1, qfa[2 * hp][1], a0, 0, 0, 0); a1 = __builtin_amdgcn_mfma_f32_16x16x32_bf16(kf1, qfa[2 * hp + 1][1], a1, 0, 0, 0);
#pragma unroll
            for (int j = 0; j < 4; ++j) {
                const int jj = 16 * jt + 4 * g + j; const bool ok = ((unsigned)(jj - lo) <= span);
                a0[j] = ok ? a0[j] : -INFINITY; a1[j] = ok ? a1[j] : -INFINITY; mx0 = fmaxf(mx0, a0[j]); mx1 = fmaxf(mx1, a1[j]);
            }
            s0[tt] = a0; s1[tt] = a1;
        }
        mx0 = fmaxf(mx0, __shfl_xor(mx0, 16)); mx0 = fmaxf(mx0, __shfl_xor(mx0, 32));
        mx1 = fmaxf(mx1, __shfl_xor(mx1, 16)); mx1 = fmaxf(mx1, __shfl_xor(mx1, 32));
        const float sink0 = C.sinks[layer * 16 + h0], sink1 = C.sinks[layer * 16 + h0 + 1];
        const float mm0 = fmaxf(mx0, sink0), mm1 = fmaxf(mx1, sink1);
        float sum0 = 0.f, sum1 = 0.f;
#pragma unroll
        for (int tt = 0; tt < 10; ++tt)
#pragma unroll
            for (int j = 0; j < 4; ++j) { const float e0 = __expf(s0[tt][j] - mm0), e1 = __expf(s1[tt][j] - mm1); s0[tt][j] = e0; s1[tt][j] = e1; sum0 += e0; sum1 += e1; }
        sum0 += __shfl_xor(sum0, 16); sum0 += __shfl_xor(sum0, 32); sum1 += __shfl_xor(sum1, 16); sum1 += __shfl_xor(sum1, 32);
        const float inv0 = 1.0f / (sum0 + __expf(sink0 - mm0)), inv1 = 1.0f / (sum1 + __expf(sink1 - mm1));
        f32x4 o0[4], o1[4];
#pragma unroll
        for (int dt = 0; dt < 4; ++dt) { o0[dt] = (f32x4){0.f, 0.f, 0.f, 0.f}; o1[dt] = o0[dt]; }
#pragma unroll
        for (int pr = 0; pr < 5; ++pr) {
            const int jt = jt0 + 2 * pr;
            u32x4 pw; pw.x = cvtpk(s0[2 * pr][0], s0[2 * pr][1]); pw.y = cvtpk(s0[2 * pr][2], s0[2 * pr][3]); pw.z = cvtpk(s0[2 * pr + 1][0], s0[2 * pr + 1][1]); pw.w = cvtpk(s0[2 * pr + 1][2], s0[2 * pr + 1][3]);
            const bf16x8 pf0 = __builtin_bit_cast(bf16x8, pw);
            pw.x = cvtpk(s1[2 * pr][0], s1[2 * pr][1]); pw.y = cvtpk(s1[2 * pr][2], s1[2 * pr][3]); pw.z = cvtpk(s1[2 * pr + 1][0], s1[2 * pr + 1][1]); pw.w = cvtpk(s1[2 * pr + 1][2], s1[2 * pr + 1][3]);
            const bf16x8 pf1 = __builtin_bit_cast(bf16x8, pw);
            bf16x8 vf[4];
#pragma unroll
            for (int dt = 0; dt < 4; ++dt) { const char* a0 = Vs + (16 * jt + 4 * g + (q >> 2)) * 144 + (16 * dt + 4 * (q & 3)) * 2; vf[dt] = cat8(vtr(a0), vtr(a0 + 16 * 144)); }
#pragma unroll
            for (int dt = 0; dt < 4; ++dt) { o0[dt] = __builtin_amdgcn_mfma_f32_16x16x32_bf16(vf[dt], pf0, o0[dt], 0, 0, 0); o1[dt] = __builtin_amdgcn_mfma_f32_16x16x32_bf16(vf[dt], pf1, o1[dt], 0, 0, 0); }
        }
#pragma unroll
        for (int dt = 0; dt < 4; ++dt) {
            const int dcol = h0 * 64 + 16 * dt + 4 * g;
            const u32x2 gt0 = gta[2 * hp][dt], gt1 = gta[2 * hp + 1][dt];
            u32x2 yo; yo.x = cvtpk(o0[dt][0] * inv0 * silu_f(bf_lo(gt0.x)), o0[dt][1] * inv0 * silu_f(bf_hi(gt0.x)));
            yo.y = cvtpk(o0[dt][2] * inv0 * silu_f(bf_lo(gt0.y)), o0[dt][3] * inv0 * silu_f(bf_hi(gt0.y)));
            *(u32x2*)(Y + (size_t)row * D + dcol) = yo;
            yo.x = cvtpk(o1[dt][0] * inv1 * silu_f(bf_lo(gt1.x)), o1[dt][1] * inv1 * silu_f(bf_hi(gt1.x)));
            yo.y = cvtpk(o1[dt][2] * inv1 * silu_f(bf_lo(gt1.y)), o1[dt][3] * inv1 * silu_f(bf_hi(gt1.y)));
            *(u32x2*)(Y + (size_t)row * D + dcol + 64) = yo;
        }
    }
    __syncthreads();
}

__device__ __forceinline__ void stage128_load(u32x4 (&v)[4], const bf16* src, size_t src_pitch, int tid) {
#pragma unroll
    for (int it = 0; it < 4; ++it) { const int r = (tid >> 4) + 32 * it, ch = tid & 15; v[it] = *(const u32x4*)(src + (size_t)r * src_pitch + ch * 8); }
}
template <bool SCALE>
__device__ __forceinline__ void stage128_store(char* dst, const u32x4 (&vin)[4], int tid, float lng) {
#pragma unroll
    for (int it = 0; it < 4; ++it) {
        const int r = (tid >> 4) + 32 * it, ch = tid & 15;
        u32x4 v = vin[it];
        if (SCALE) { const float sc = __expf((float)(127 - r) * lng);
            v.x = cvtpk(bf_lo(v.x) * sc, bf_hi(v.x) * sc); v.y = cvtpk(bf_lo(v.y) * sc, bf_hi(v.y) * sc); v.z = cvtpk(bf_lo(v.z) * sc, bf_hi(v.z) * sc); v.w = cvtpk(bf_lo(v.w) * sc, bf_hi(v.w) * sc); }
        *(u32x4*)(dst + r * 272 + ch * 16) = v;
    }
}

__device__ __forceinline__ void ret_u_unit(const Ctx& C, char* lds, int c, int h, int tid, int w, int lane, unsigned* ucnt) {
    const bf16* P = (const bf16*)(C.ws + WS_P); float* U = (float*)(C.ws + WS_U);
    char* Ks = lds; char* Vs = lds + 34816;
    const float lng = ln_gamma(h);
    { u32x4 sk[4], sv[4];
      stage128_load(sk, P + (size_t)(c * 128) * NP + C_KB + h * 128, NP, tid); stage128_load(sv, P + (size_t)(c * 128) * NP + C_VB + h * 128, NP, tid);
      stage128_store<false>(Ks, sk, tid, lng); stage128_store<true>(Vs, sv, tid, lng); }
    __syncthreads();
    const int q = lane & 15, g = lane >> 4;
    f32x4 acc[8];
#pragma unroll
    for (int dt = 0; dt < 8; ++dt) acc[dt] = (f32x4){0.f, 0.f, 0.f, 0.f};
#pragma unroll
    for (int ks = 0; ks < 4; ++ks) {
        const int rbase = (32 * ks + 8 * g + (q >> 2)) * 272 + 4 * (q & 3) * 2;
        const bf16x8 vf = cat8(vtr(Vs + rbase + 32 * w), vtr(Vs + rbase + 32 * w + 4 * 272));
#pragma unroll
        for (int dt = 0; dt < 8; ++dt) {
            const bf16x8 kf = cat8(vtr(Ks + rbase + 32 * dt), vtr(Ks + rbase + 32 * dt + 4 * 272));
            acc[dt] = __builtin_amdgcn_mfma_f32_16x16x32_bf16(vf, kf, acc[dt], 0, 0, 0);
        }
    }
    float* Ub = U + (size_t)(c * 8 + h) * 16384;
#pragma unroll
    for (int dt = 0; dt < 8; ++dt)
#pragma unroll
        for (int j = 0; j < 4; ++j) __hip_atomic_store(Ub + (16 * w + 4 * g + j) * 128 + 16 * dt + q, acc[dt][j], __ATOMIC_RELAXED, __HIP_MEMORY_SCOPE_AGENT);
    asm volatile("s_waitcnt vmcnt(0)" ::: "memory");
    __syncthreads();
    if (tid == 0) __hip_atomic_fetch_add(ucnt, 1u, __ATOMIC_RELAXED, __HIP_MEMORY_SCOPE_AGENT);
}

__device__ __forceinline__ void ret_scan(const Ctx& C, int layer, int tid, int G) {
    const float* U = (const float*)(C.ws + WS_U); bf16* Rt = (bf16*)(C.ws + WS_RT);
    for (int i = blockIdx.x * NTHREADS + tid; i < 8 * 16384; i += G * NTHREADS) {
        const int h = i >> 14, e = (i >> 7) & 127, d = i & 127;
        const float gc = __expf(128.0f * ln_gamma(h));
        float r = 0.f;
#pragma unroll 1
        for (int c0 = 0; c0 < 64; c0 += 32) {
            float u[32];
#pragma unroll
            for (int k = 0; k < 32; ++k) u[k] = __builtin_nontemporal_load(U + (size_t)((c0 + k) * 8) * 16384 + i);
#pragma unroll
            for (int k = 0; k < 32; ++k) { Rt[(size_t)((c0 + k) * 8) * 16384 + i] = (bf16)(cvtpk(r, 0.f) & 0xffffu); r = gc * r + u[k]; }
        }
        const int dorig = 4 * (d >> 3) + (d & 3) + 64 * ((d >> 2) & 1);
        C.out[O_RP + ((size_t)(layer * 8 + h) * 128 + dorig) * 128 + e] = r;
    }
}

__device__ __forceinline__ void ret_prompt_unit(const Ctx& C, char* lds, int layer, int c, int h, int tid, int w, int lane) {
    const bf16* P = (const bf16*)(C.ws + WS_P); bf16* Y = (bf16*)(C.ws + WS_Y); const bf16* Rt = (const bf16*)(C.ws + WS_RT);
    char* Ks = lds; char* Vs = lds + 34816; char* Rs = lds + 69632;
    const float lng = ln_gamma(h);
    const int q = lane & 15, g = lane >> 4;
    const int n = 16 * w + q, row = c * 128 + n;
    bf16x8 qf[4]; u32x2 gta[8];
#pragma unroll
    for (int ks = 0; ks < 4; ++ks) qf[ks] = *(const bf16x8*)(P + (size_t)row * NP + C_QB + h * 128 + 32 * ks + 8 * g);
#pragma unroll
    for (int et = 0; et < 8; ++et) gta[et] = *(const u32x2*)(P + (size_t)row * NP + C_GB + h * 128 + 16 * et + 4 * g);
    { u32x4 sk[4], sv[4], sr[4];
      stage128_load(sk, P + (size_t)(c * 128) * NP + C_KB + h * 128, NP, tid); stage128_load(sv, P + (size_t)(c * 128) * NP + C_VB + h * 128, NP, tid);
      stage128_load(sr, Rt + (size_t)(c * 8 + h) * 16384, 128, tid);
      stage128_store<false>(Ks, sk, tid, lng); stage128_store<false>(Vs, sv, tid, lng); stage128_store<false>(Rs, sr, tid, lng); }
    __syncthreads();
    unsigned pk[8][2];
#pragma unroll
    for (int mt = 0; mt < 8; ++mt) {
        pk[mt][0] = 0u; pk[mt][1] = 0u;
        if (mt <= w) {
            f32x4 a = (f32x4){0.f, 0.f, 0.f, 0.f};
#pragma unroll
            for (int ks = 0; ks < 4; ++ks) { const bf16x8 kf = *(const bf16x8*)(Ks + (16 * mt + q) * 272 + (32 * ks + 8 * g) * 2); a = __builtin_amdgcn_mfma_f32_16x16x32_bf16(kf, qf[ks], a, 0, 0, 0); }
            float v[4];
#pragma unroll
            for (int j = 0; j < 4; ++j) { const int dl = n - (16 * mt + 4 * g + j); v[j] = dl >= 0 ? a[j] * __expf((float)dl * lng) : 0.f; }
            pk[mt][0] = cvtpk(v[0], v[1]); pk[mt][1] = cvtpk(v[2], v[3]);
        }
    }
    f32x4 oi[8], ox[8];
#pragma unroll
    for (int et = 0; et < 8; ++et) { oi[et] = (f32x4){0.f, 0.f, 0.f, 0.f}; ox[et] = oi[et]; }
#pragma unroll
    for (int pr = 0; pr < 4; ++pr) {
        if (2 * pr <= w) {
            u32x4 pw; pw.x = pk[2 * pr][0]; pw.y = pk[2 * pr][1]; pw.z = pk[2 * pr + 1][0]; pw.w = pk[2 * pr + 1][1];
            const bf16x8 pf = __builtin_bit_cast(bf16x8, pw);
#pragma unroll
            for (int et = 0; et < 8; ++et) {
                const char* a0 = Vs + (32 * pr + 4 * g + (q >> 2)) * 272 + (16 * et + 4 * (q & 3)) * 2;
                oi[et] = __builtin_amdgcn_mfma_f32_16x16x32_bf16(cat8(vtr(a0), vtr(a0 + 16 * 272)), pf, oi[et], 0, 0, 0);
            }
        }
    }
#pragma unroll
    for (int et = 0; et < 8; ++et)
#pragma unroll
        for (int ks = 0; ks < 4; ++ks) { const bf16x8 rf = *(const bf16x8*)(Rs + (16 * et + q) * 272 + (32 * ks + 8 * g) * 2); ox[et] = __builtin_amdgcn_mfma_f32_16x16x32_bf16(rf, qf[ks], ox[et], 0, 0, 0); }
    const float qdec = __expf((float)(n + 1) * lng);
    float sum = 0.f;
#pragma unroll
    for (int et = 0; et < 8; ++et) { oi[et] = oi[et] + ox[et] * qdec; sum += (oi[et][0] + oi[et][1]) + (oi[et][2] + oi[et][3]); }
    sum += __shfl_xor(sum, 16); sum += __shfl_xor(sum, 32);
    const float mu = sum * (1.0f / 128.0f);
    float var = 0.f;
#pragma unroll
    for (int et = 0; et < 8; ++et) { oi[et] = oi[et] - mu; var += (oi[et][0] * oi[et][0] + oi[et][1] * oi[et][1]) + (oi[et][2] * oi[et][2] + oi[et][3] * oi[et][3]); }
    var += __shfl_xor(var, 16); var += __shfl_xor(var, 32);
    const float rs = rsqrtf(var * (1.0f / 128.0f) + 1e-6f);
    const float* gw = C.ret_norm_w + layer * 1024 + h * 128;
#pragma unroll
    for (int et = 0; et < 8; ++et) {
        const int e0 = 16 * et + 4 * g;
        const u32x2 gt = gta[et];
        const f32x4 wv = *(const f32x4*)(gw + e0);
        u32x2 yo; yo.x = cvtpk(oi[et][0] * rs * wv[0] * silu_f(bf_lo(gt.x)), oi[et][1] * rs * wv[1] * silu_f(bf_hi(gt.x)));
        yo.y = cvtpk(oi[et][2] * rs * wv[2] * silu_f(bf_lo(gt.y)), oi[et][3] * rs * wv[3] * silu_f(bf_hi(gt.y)));
        *(u32x2*)(Y + (size_t)row * D + 1024 + h * 128 + e0) = yo;
    }
    __syncthreads();
}

__device__ __forceinline__ void attn_sample_unit(const Ctx& C, char* lds, int layer, int b, int kvh, int tid) {
    const bf16* P = (const bf16*)(C.ws + WS_P); bf16* Y = (bf16*)(C.ws + WS_Y);
    float* Qs = (float*)lds;
    float* Kl = Qs + 32 * 65;
    float* Vl = Kl + 132 * 68;
    float* Pm = Vl + 132 * 68;
    const float* ck = C.cache_k + ((size_t)(layer * 128 + b) * 128) * 128 + kvh * 64;
    const float* cv = C.cache_v + ((size_t)(layer * 128 + b) * 128) * 128 + kvh * 64;
    float* ok = C.out + O_KS + ((size_t)(layer * 128 + b) * 128) * 128 + kvh * 64;
    float* ov = C.out + O_VS + ((size_t)(layer * 128 + b) * 128) * 128 + kvh * 64;
    {
        f32x4 kq[4], vq[4];
#pragma unroll
        for (int it = 0; it < 4; ++it) { const int i = tid + NTHREADS * it, r = i >> 4, c4 = i & 15;
            kq[it] = __builtin_nontemporal_load((const f32x4*)(ck + (size_t)r * 128 + 4 * c4)); vq[it] = __builtin_nontemporal_load((const f32x4*)(cv + (size_t)r * 128 + 4 * c4)); }
#pragma unroll
        for (int it = 0; it < 4; ++it) { const int i = tid + NTHREADS * it, r = i >> 4, c4 = i & 15;
            *(f32x4*)(Kl + r * 68 + 4 * c4) = kq[it]; *(f32x4*)(Vl + r * 68 + 4 * c4) = vq[it];
            if (r >= 4) { __builtin_nontemporal_store(kq[it], (f32x4*)(ok + (size_t)(r - 4) * 128 + 4 * c4)); __builtin_nontemporal_store(vq[it], (f32x4*)(ov + (size_t)(r - 4) * 128 + 4 * c4)); } }
    }
    if (tid < 256) { const int t = tid >> 6, g = tid & 63; const size_t ro = (size_t)(T + 4 * b + t) * NP;
        const int dk = 4 * (g >> 3) + (g & 3) + 32 * ((g >> 2) & 1);
        Kl[(128 + t) * 68 + dk] = __uint_as_float((unsigned)P[ro + C_KA + kvh * 64 + g] << 16);
        Vl[(128 + t) * 68 + g] = __uint_as_float((unsigned)P[ro + C_VA + kvh * 64 + g] << 16); }
    for (int i = tid; i < 32 * 64; i += NTHREADS) {
        const int r = i >> 6, g = i & 63, hg = r >> 2, t = r & 3;
        const int dk = 4 * (g >> 3) + (g & 3) + 32 * ((g >> 2) & 1);
        Qs[r * 65 + dk] = __uint_as_float((unsigned)P[(size_t)(T + 4 * b + t) * NP + C_QA + (kvh * 8 + hg) * 64 + g] << 16);
    }
    __syncthreads();
    {
        const int r = tid >> 4, kg = tid & 15, t = r & 3, h = kvh * 8 + (r >> 2);
        float mx = -INFINITY;
        f32x4 qr[16];
#pragma unroll
        for (int i = 0; i < 16; ++i) qr[i] = (f32x4){Qs[r * 65 + 4 * i], Qs[r * 65 + 4 * i + 1], Qs[r * 65 + 4 * i + 2], Qs[r * 65 + 4 * i + 3]};
#pragma unroll 1
        for (int it = 0; it < 9; ++it) {
            const int kk = kg + 16 * it;
            float a = -INFINITY;
            if (kk < 132) {
                const bool valid = kk < 128 ? (kk > t) : (kk - 128 <= t);
                if (valid) { f32x4 a4 = (f32x4){0.f, 0.f, 0.f, 0.f};
#pragma unroll
                    for (int i = 0; i < 16; ++i) a4 += qr[i] * *(const f32x4*)(Kl + kk * 68 + 4 * i);
                    a = (a4[0] + a4[1]) + (a4[2] + a4[3]); }
                Pm[r * 133 + kk] = a;
            }
            mx = fmaxf(mx, a);
        }
#pragma unroll
        for (int o = 1; o < 16; o <<= 1) mx = fmaxf(mx, __shfl_xor(mx, o));
        const float sink = C.sinks[layer * 16 + h];
        const float mm = fmaxf(mx, sink);
        float sum = 0.f;
#pragma unroll 1
        for (int it = 0; it < 9; ++it) { const int kk = kg + 16 * it; if (kk < 132) { const float e = __expf(Pm[r * 133 + kk] - mm); Pm[r * 133 + kk] = e; sum += e; } }
#pragma unroll
        for (int o = 1; o < 16; o <<= 1) sum += __shfl_xor(sum, o);
        const float inv = 1.0f / (sum + __expf(sink - mm));
#pragma unroll 1
        for (int it = 0; it < 9; ++it) { const int kk = kg + 16 * it; if (kk < 132) Pm[r * 133 + kk] *= inv; }
    }
    __syncthreads();
    {
        const int r = tid >> 4, dq = tid & 15, t = r & 3, h = kvh * 8 + (r >> 2);
        f32x4 o = (f32x4){0.f, 0.f, 0.f, 0.f};
        for (int kk = 0; kk < 132; ++kk) { const float p = Pm[r * 133 + kk]; const f32x4 v = *(const f32x4*)(Vl + kk * 68 + 4 * dq); o += v * p; }
        const size_t row = (size_t)(T + 4 * b + t);
        const u32x2 gt = *(const u32x2*)(P + row * NP + C_GA + h * 64 + 4 * dq);
        u32x2 yo; yo.x = cvtpk(o[0] * silu_f(bf_lo(gt.x)), o[1] * silu_f(bf_hi(gt.x))); yo.y = cvtpk(o[2] * silu_f(bf_lo(gt.y)), o[3] * silu_f(bf_hi(gt.y)));
        *(u32x2*)(Y + row * D + h * 64 + 4 * dq) = yo;
    }
    __syncthreads();
}

__device__ __forceinline__ void attn_sample_mfma(const Ctx& C, char* lds, int layer, int b, int kvh, int tid, int w, int lane) {
    const bf16* P = (const bf16*)(C.ws + WS_P); bf16* Y = (bf16*)(C.ws + WS_Y);
    char* Ks = lds; char* Vs = lds + 20736;
    const int q = lane & 15, g = lane >> 4, qt = w & 1, dtl = w >> 1;
    const int r = 16 * qt + q, t = r & 3, h = kvh * 8 + (r >> 2);
    const size_t row = (size_t)(T + 4 * b + t);
    bf16x8 qf[2];
#pragma unroll
    for (int ks = 0; ks < 2; ++ks) qf[ks] = *(const bf16x8*)(P + row * NP + C_QA + h * 64 + 32 * ks + 8 * g);
    const u32x2 gt = *(const u32x2*)(P + row * NP + C_GA + h * 64 + 16 * dtl + 4 * g);
    const float sink = C.sinks[layer * 16 + h];
    const float* ck = C.cache_k + ((size_t)(layer * 128 + b) * 128) * 128 + kvh * 64;
    const float* cv = C.cache_v + ((size_t)(layer * 128 + b) * 128) * 128 + kvh * 64;
    float* ok = C.out + O_KS + ((size_t)(layer * 128 + b) * 128) * 128 + kvh * 64;
    float* ov = C.out + O_VS + ((size_t)(layer * 128 + b) * 128) * 128 + kvh * 64;
    {
        f32x4 kq[4], vq[4];
#pragma unroll
        for (int it = 0; it < 4; ++it) { const int i = tid + NTHREADS * it, rr = i >> 4, c4 = i & 15;
            kq[it] = __builtin_nontemporal_load((const f32x4*)(ck + (size_t)rr * 128 + 4 * c4)); vq[it] = __builtin_nontemporal_load((const f32x4*)(cv + (size_t)rr * 128 + 4 * c4)); }
        u32x4 nk = (u32x4){0u, 0u, 0u, 0u}, nv = nk;
        if (tid < 32) { const int tt = tid >> 3, ch = tid & 7; const size_t ro = (size_t)(T + 4 * b + tt) * NP;
            nk = *(const u32x4*)(P + ro + C_KA + kvh * 64 + 8 * ch); nv = *(const u32x4*)(P + ro + C_VA + kvh * 64 + 8 * ch); }
#pragma unroll
        for (int it = 0; it < 4; ++it) { const int i = tid + NTHREADS * it, rr = i >> 4, c4 = i & 15;
            u32x2 kb; kb.x = cvtpk(kq[it][0], kq[it][1]); kb.y = cvtpk(kq[it][2], kq[it][3]);
            u32x2 vb; vb.x = cvtpk(vq[it][0], vq[it][1]); vb.y = cvtpk(vq[it][2], vq[it][3]);
            *(u32x2*)(Ks + rr * 144 + (8 * (c4 & 7) + 4 * (c4 >> 3)) * 2) = kb;
            *(u32x2*)(Vs + rr * 144 + 8 * c4) = vb;
            if (rr >= 4) { __builtin_nontemporal_store(kq[it], (f32x4*)(ok + (size_t)(rr - 4) * 128 + 4 * c4)); __builtin_nontemporal_store(vq[it], (f32x4*)(ov + (size_t)(rr - 4) * 128 + 4 * c4)); } }
        if (tid < 32) { const int tt = tid >> 3, ch = tid & 7; *(u32x4*)(Ks + (128 + tt) * 144 + 16 * ch) = nk; *(u32x4*)(Vs + (128 + tt) * 144 + 16 * ch) = nv; }
        else if (tid < 32 + 28 * 8) { const int z = tid - 32, zr = 132 + (z >> 3), ch = z & 7;
            const u32x4 zz = (u32x4){0u, 0u, 0u, 0u};
            if (zr < 144) *(u32x4*)(Ks + zr * 144 + 16 * ch) = zz;
            *(u32x4*)(Vs + zr * 144 + 16 * ch) = zz; }
    }
    __syncthreads();
    f32x4 s[10];
    float mx = -INFINITY;
#pragma unroll
    for (int tt = 0; tt < 9; ++tt) {
        f32x4 a = (f32x4){0.f, 0.f, 0.f, 0.f};
#pragma unroll
        for (int ks = 0; ks < 2; ++ks) { const bf16x8 kf = *(const bf16x8*)(Ks + (16 * tt + q) * 144 + (32 * ks + 8 * g) * 2); a = __builtin_amdgcn_mfma_f32_16x16x32_bf16(kf, qf[ks], a, 0, 0, 0); }
#pragma unroll
        for (int j = 0; j < 4; ++j) {
            const int kk = 16 * tt + 4 * g + j;
            const bool valid = kk < 128 ? (kk > t) : (kk - 128 <= t);
            a[j] = valid ? a[j] : -INFINITY; mx = fmaxf(mx, a[j]);
        }
        s[tt] = a;
    }
    s[9] = (f32x4){0.f, 0.f, 0.f, 0.f};
    mx = fmaxf(mx, __shfl_xor(mx, 16)); mx = fmaxf(mx, __shfl_xor(mx, 32));
    const float mm = fmaxf(mx, sink);
    float sum = 0.f;
#pragma unroll
    for (int tt = 0; tt < 9; ++tt)
#pragma unroll
        for (int j = 0; j < 4; ++j) { const float e = __expf(s[tt][j] - mm); s[tt][j] = e; sum += e; }
    sum += __shfl_xor(sum, 16); sum += __shfl_xor(sum, 32);
    const float inv = __builtin_amdgcn_rcpf(sum + __expf(sink - mm));
    f32x4 o = (f32x4){0.f, 0.f, 0.f, 0.f};
#pragma unroll
    for (int pr = 0; pr < 5; ++pr) {
        u32x4 pw; pw.x = cvtpk(s[2 * pr][0], s[2 * pr][1]); pw.y = cvtpk(s[2 * pr][2], s[2 * pr][3]); pw.z = cvtpk(s[2 * pr + 1][0], s[2 * pr + 1][1]); pw.w = cvtpk(s[2 * pr + 1][2], s[2 * pr + 1][3]);
        const char* a0 = Vs + (32 * pr + 4 * g + (q >> 2)) * 144 + (16 * dtl + 4 * (q & 3)) * 2;
        o = __builtin_amdgcn_mfma_f32_16x16x32_bf16(cat8(vtr(a0), vtr(a0 + 16 * 144)), __builtin_bit_cast(bf16x8, pw), o, 0, 0, 0);
    }
    u32x2 yo; yo.x = cvtpk(o[0] * inv * silu_f(bf_lo(gt.x)), o[1] * inv * silu_f(bf_hi(gt.x))); yo.y = cvtpk(o[2] * inv * silu_f(bf_lo(gt.y)), o[3] * inv * silu_f(bf_hi(gt.y)));
    *(u32x2*)(Y + row * D + h * 64 + 16 * dtl + 4 * g) = yo;
    __syncthreads();
}

__device__ __forceinline__ void ret_sample_group(const Ctx& C, char* lds, int layer, int ug, int tid, int w, int lane) {
    const bf16* P = (const bf16*)(C.ws + WS_P); bf16* Y = (bf16*)(C.ws + WS_Y);
    const int idx = 4 * ug + (w >> 1), b = idx >> 3, h = idx & 7, eh = w & 1;
    float* qs = (float*)(lds + w * 4096);
    float* ksm = qs + 512;
    float* pst = (float*)(lds + 32768);
    const float lng = ln_gamma(h);
    const size_t ro = (size_t)(T + 4 * b) * NP;
    float qv[4][2], kv[4][2];
    {
        const int g0 = 2 * lane, g1 = g0 + 1;
        const int d0 = 4 * (g0 >> 3) + (g0 & 3) + 64 * ((g0 >> 2) & 1), d1 = 4 * (g1 >> 3) + (g1 & 3) + 64 * ((g1 >> 2) & 1);
#pragma unroll
        for (int t = 0; t < 4; ++t) {
            const unsigned qq = *(const unsigned*)(P + ro + (size_t)t * NP + C_QB + h * 128 + g0), kk = *(const unsigned*)(P + ro + (size_t)t * NP + C_KB + h * 128 + g0);
            qv[t][0] = bf_lo(qq); qv[t][1] = bf_hi(qq); kv[t][0] = bf_lo(kk); kv[t][1] = bf_hi(kk);
            const float kd = __expf((float)(3 - t) * lng);
            qs[t * 128 + d0] = qv[t][0]; qs[t * 128 + d1] = qv[t][1]; ksm[t * 128 + d0] = kv[t][0] * kd; ksm[t * 128 + d1] = kv[t][1] * kd;
        }
    }
    const int e4 = lane & 15, dq = lane >> 4, e = eh * 64 + 4 * e4;
    f32x4 vm[4];
#pragma unroll
    for (int m = 0; m < 4; ++m) { const u32x2 vv = *(const u32x2*)(P + ro + (size_t)m * NP + C_VB + h * 128 + e); vm[m] = (f32x4){bf_lo(vv.x), bf_hi(vv.x), bf_lo(vv.y), bf_hi(vv.y)}; }
    float* Aw = (float*)(lds + 33024) + w * 16;
#pragma unroll
    for (int t = 0; t < 4; ++t)
#pragma unroll
        for (int m = 0; m < 4; ++m) {
            float a = 0.f;
            if (m <= t) { a = qv[t][0] * kv[m][0] + qv[t][1] * kv[m][1];
#pragma unroll
                for (int o = 1; o < 64; o <<= 1) a += __shfl_xor(a, o);
                a *= __expf((float)(t - m) * lng); }
            if (lane == 0) Aw[t * 4 + m] = a;
        }
    LDS_WAIT();
    const float* r0 = C.state + ((size_t)(layer * 128 + b) * 8 + h) * 16384 + e;
    float* rout = C.out + O_RS + ((size_t)(layer * 128 + b) * 8 + h) * 16384 + e;
    const float g4 = __expf(4.0f * lng);
    f32x4 acc[4];
#pragma unroll
    for (int t = 0; t < 4; ++t) acc[t] = (f32x4){0.f, 0.f, 0.f, 0.f};
#pragma unroll 1
    for (int i0 = 0; i0 < 32; i0 += 8) {
        f32x4 r[8];
#pragma unroll
        for (int k = 0; k < 8; ++k) r[k] = __builtin_nontemporal_load((const f32x4*)(r0 + (4 * (i0 + k) + dq) * 128));
#pragma unroll
        for (int k = 0; k < 8; ++k) {
            const int d = 4 * (i0 + k) + dq;
            const f32x4 rn = r[k] * g4 + vm[0] * ksm[d] + vm[1] * ksm[128 + d] + vm[2] * ksm[256 + d] + vm[3] * ksm[384 + d];
            __builtin_nontemporal_store(rn, (f32x4*)(rout + d * 128));
#pragma unroll
            for (int t = 0; t < 4; ++t) acc[t] += r[k] * qs[t * 128 + d];
        }
    }
    float o[4][4]; float s1[4], s2[4];
#pragma unroll
    for (int t = 0; t < 4; ++t) {
        const float qd = __expf((float)(t + 1) * lng);
        s1[t] = 0.f; s2[t] = 0.f;
#pragma unroll
        for (int j = 0; j < 4; ++j) {
            float a = acc[t][j]; a += __shfl_xor(a, 16); a += __shfl_xor(a, 32);
            a *= qd;
#pragma unroll
            for (int m = 0; m < 4; ++m) a += Aw[t * 4 + m] * vm[m][j];
            o[t][j] = a; s1[t] += a; s2[t] += a * a;
        }
#pragma unroll
        for (int k = 1; k < 16; k <<= 1) { s1[t] += __shfl_xor(s1[t], k); s2[t] += __shfl_xor(s2[t], k); }
        if (lane == 0) { pst[(w * 4 + t) * 2] = s1[t]; pst[(w * 4 + t) * 2 + 1] = s2[t]; }
    }
    __syncthreads();
    if (lane < 16) {
        const float* gw = C.ret_norm_w + layer * 1024 + h * 128 + e;
        const f32x4 wv = *(const f32x4*)gw;
#pragma unroll
        for (int t = 0; t < 4; ++t) {
            const float S1 = pst[(w * 4 + t) * 2] + pst[((w ^ 1) * 4 + t) * 2], S2 = pst[(w * 4 + t) * 2 + 1] + pst[((w ^ 1) * 4 + t) * 2 + 1];
            const float mu = S1 * (1.0f / 128.0f), var = fmaxf(S2 * (1.0f / 128.0f) - mu * mu, 0.f), rs = rsqrtf(var + 1e-6f);
            const size_t row = (size_t)(T + 4 * b + t);
            const u32x2 gt = *(const u32x2*)(P + row * NP + C_GB + h * 128 + e);
            u32x2 yo; yo.x = cvtpk((o[t][0] - mu) * rs * wv[0] * silu_f(bf_lo(gt.x)), (o[t][1] - mu) * rs * wv[1] * silu_f(bf_hi(gt.x)));
            yo.y = cvtpk((o[t][2] - mu) * rs * wv[2] * silu_f(bf_lo(gt.y)), (o[t][3] - mu) * rs * wv[3] * silu_f(bf_hi(gt.y)));
            *(u32x2*)(Y + row * D + 1024 + h * 128 + e) = yo;
        }
    }
    __syncthreads();
}

__device__ __forceinline__ void outproj_sample_unit(const Ctx& C, char* lds, int layer, int u, int tid, int w, int lane) {
    const bf16* Yb = (const bf16*)(C.ws + WS_Y) + (size_t)T * D; const bf16* Wt = (const bf16*)(C.ws + WS_WOUT) + (size_t)layer * D * D;
    const int m0 = (u >> 5) * 64, n0 = (u & 31) * 64, q = lane & 15, g = lane >> 4, k0 = 256 * w;
    f32x4 acc[4][4];
#pragma unroll
    for (int nt = 0; nt < 4; ++nt)
#pragma unroll
        for (int mt = 0; mt < 4; ++mt) acc[nt][mt] = (f32x4){0.f, 0.f, 0.f, 0.f};
    const int em = tid >> 3, en8 = (tid & 7) * 8;
    f32x4 rz0, rz1;
    if (layer == 0) { const float* bpz = C.x_sample + (size_t)(m0 + em) * D + n0 + en8; rz0 = *(const f32x4*)bpz; rz1 = *(const f32x4*)(bpz + 4); }
    else { const u32x4 xb = *(const u32x4*)((const bf16*)(C.ws + WS_XA) + (size_t)(T + m0 + em) * D + n0 + en8);
        rz0 = (f32x4){bf_lo(xb.x), bf_hi(xb.x), bf_lo(xb.y), bf_hi(xb.y)}; rz1 = (f32x4){bf_lo(xb.z), bf_hi(xb.z), bf_lo(xb.w), bf_hi(xb.w)}; }
    const bf16* ap = Wt + (size_t)(n0 + q) * D + k0 + 8 * g;
    const bf16* bp = Yb + (size_t)(m0 + q) * D + k0 + 8 * g;
    bf16x8 af[2][2][4], bfr[2][2][4];
#define OSU_LOAD(buf, kb) do { _Pragma("unroll") for (int ks = 0; ks < 2; ++ks) _Pragma("unroll") for (int t4 = 0; t4 < 4; ++t4) { \
        af[buf][ks][t4] = *(const bf16x8*)(ap + (size_t)(16 * t4) * D + 64 * (kb) + 32 * ks); bfr[buf][ks][t4] = *(const bf16x8*)(bp + (size_t)(16 * t4) * D + 64 * (kb) + 32 * ks); } } while (0)
    OSU_LOAD(0, 0);
#pragma unroll
    for (int kb = 0; kb < 4; ++kb) {
        if (kb + 1 < 4) { if ((kb & 1) == 0) OSU_LOAD(1, kb + 1); else OSU_LOAD(0, kb + 1); }
#pragma unroll
        for (int ks = 0; ks < 2; ++ks)
#pragma unroll
            for (int nt = 0; nt < 4; ++nt)
#pragma unroll
                for (int mt = 0; mt < 4; ++mt) acc[nt][mt] = __builtin_amdgcn_mfma_f32_16x16x32_bf16(af[kb & 1][ks][nt], bfr[kb & 1][ks][mt], acc[nt][mt], 0, 0, 0);
    }
#undef OSU_LOAD
    float* part = (float*)lds + w * (64 * 68);
#pragma unroll
    for (int nt = 0; nt < 4; ++nt)
#pragma unroll
        for (int mt = 0; mt < 4; ++mt) *(f32x4*)(part + (16 * mt + q) * 68 + 16 * nt + 4 * g) = acc[nt][mt];
    __syncthreads();
    {
        const int m = tid >> 3, n8 = (tid & 7) * 8;
        f32x4 v0 = (f32x4){0.f, 0.f, 0.f, 0.f}, v1 = v0;
#pragma unroll
        for (int ww = 0; ww < 8; ++ww) { const float* pp = (const float*)lds + ww * (64 * 68) + m * 68 + n8; v0 += *(const f32x4*)pp; v1 += *(const f32x4*)(pp + 4); }
        const int rs_ = m0 + m;
        v0 += rz0; v1 += rz1;
        if (layer != 0) { float* op = C.out + (size_t)(T + rs_) * D + n0 + n8; *(f32x4*)op = v0; *(f32x4*)(op + 4) = v1; }
        if (layer == 0) { u32x4 wv; wv.x = cvtpk(v0[0], v0[1]); wv.y = cvtpk(v0[2], v0[3]); wv.z = cvtpk(v1[0], v1[1]); wv.w = cvtpk(v1[2], v1[3]);
            *(u32x4*)((bf16*)(C.ws + WS_XA) + (size_t)(T + rs_) * D + n0 + n8) = wv; }
        float ss = (v0[0] * v0[0] + v0[1] * v0[1]) + (v0[2] * v0[2] + v0[3] * v0[3]) + (v1[0] * v1[0] + v1[1] * v1[1]) + (v1[2] * v1[2] + v1[3] * v1[3]);
        ss += __shfl_xor(ss, 1); ss += __shfl_xor(ss, 2); ss += __shfl_xor(ss, 4);
        if ((tid & 7) == 0) atomicAdd((float*)(C.ws + WS_CTL) + (layer + 1) * M + T + rs_, ss);
    }
    __syncthreads();
}

#ifndef SKIPM
#define SKIPM 0
#endif
#ifndef REPU
#define REPU 0
#endif
#ifndef REP_P0
#define REP_P0 1
#endif
#ifndef REP_G1
#define REP_G1 1
#endif
#ifndef REP_MX1
#define REP_MX1 1
#endif
#ifndef REP_RP
#define REP_RP 1
#endif
#ifndef REP_G2
#define REP_G2 1
#endif

#define GAS __attribute__((address_space(1)))
typedef GAS unsigned gu32;
#define XB_TMO      128
#define XB_XCNT(j)  (256  + 64 * (j))
#define XB_XSUB(j)  (1280 + 64 * (j))
#define XB_XGEN(j)  (2304 + 64 * (j))
#define XB_TOP      3328
#define XB_TOPGEN   3392
#define XCD_BAR_WORDS 3456
#define XB_SPIN_CAP (1u << 18)

__device__ __forceinline__ unsigned xb_ld(unsigned* p)              { return __hip_atomic_load(p, __ATOMIC_RELAXED, __HIP_MEMORY_SCOPE_AGENT); }
__device__ __forceinline__ unsigned xb_add(unsigned* p, unsigned v) { return __hip_atomic_fetch_add(p, v, __ATOMIC_RELAXED, __HIP_MEMORY_SCOPE_AGENT); }
__device__ __forceinline__ unsigned xb_xcc_id() { return (unsigned)__builtin_amdgcn_s_getreg((3 << 11) | 20) & 0xFu; }
#define XB_SPIN(cond, bar) do { unsigned _sp = 0; while (cond) { __builtin_amdgcn_s_sleep(1); \
    if ((++_sp & 255u) == 0u) { if (xb_ld(&(bar)[XB_TMO])) break; if (_sp > XB_SPIN_CAP) { atomicAdd(&(bar)[XB_TMO], 1u); break; } } } } while (0)

struct XcdBarrier {
    unsigned* bar; unsigned x;
    volatile LAS unsigned* st;
};

__device__ __forceinline__ XcdBarrier xcd_barrier_post(unsigned* bar, volatile LAS unsigned* st) {
    XcdBarrier b; b.bar = bar; b.x = xb_xcc_id(); b.st = st;
    if (threadIdx.x == 0) (void)xb_add(&bar[XB_XCNT(b.x)], 1u);
    return b;
}
__device__ __forceinline__ void xcd_barrier_complete(unsigned* bar, unsigned x, unsigned& nloc, unsigned& nx) {
    const unsigned G = gridDim.x * gridDim.y * gridDim.z;
    unsigned sum, cnt, mine, sp = 0u;
    for (;;) {
        sum = 0u; cnt = 0u; mine = 0u;
#pragma unroll
        for (unsigned j = 0; j < 16; ++j) { const unsigned c = xb_ld(&bar[XB_XCNT(j)]); sum += c; cnt += (c > 0u) ? 1u : 0u; mine = (j == x) ? c : mine; }
        if (sum == G) break;
        __builtin_amdgcn_s_sleep(1);
        if ((++sp & 255u) == 0u) { if (xb_ld(&bar[XB_TMO])) break; if (sp > XB_SPIN_CAP) { atomicAdd(&bar[XB_TMO], 1u); break; } }
    }
    nloc = mine > 0u ? mine : 1u; nx = cnt > 0u ? cnt : 1u;
}

__device__ __forceinline__ void xcd_barrier(const XcdBarrier& b) {
    asm volatile("s_waitcnt vmcnt(0)" ::: "memory");
    __syncthreads();
    if (threadIdx.x == 0) {
        unsigned* bar = b.bar;
        __builtin_amdgcn_s_waitcnt(0);
        unsigned nloc = b.st[0], nx = b.st[1];
        if (nloc == 0u) { xcd_barrier_complete(bar, b.x, nloc, nx); b.st[0] = nloc; b.st[1] = nx; }
        const unsigned old = xb_add(&bar[XB_XSUB(b.x)], 1u);
        const unsigned gen = old / nloc;
        if (old + 1u == (gen + 1u) * nloc) {
            __builtin_amdgcn_fence(__ATOMIC_RELEASE, "agent");
            asm volatile("s_waitcnt vmcnt(0)" ::: "memory");
            const unsigned og = xb_add(&bar[XB_TOP], 1u);
            const unsigned tg = og / nx;
            if (og + 1u == (tg + 1u) * nx) xb_add(&bar[XB_TOPGEN], 1u);
            else XB_SPIN(xb_ld(&bar[XB_TOPGEN]) == tg, bar);
            __builtin_amdgcn_fence(__ATOMIC_ACQUIRE, "agent");
            xb_add(&bar[XB_XGEN(b.x)], 1u);
            asm volatile("s_waitcnt vmcnt(0)" ::: "memory");
        } else {
            XB_SPIN(xb_ld(&bar[XB_XGEN(b.x)]) == gen, bar);
            __builtin_amdgcn_fence(__ATOMIC_ACQUIRE, "agent");
            asm volatile("s_waitcnt vmcnt(0)" ::: "memory");
        }
    }
    __syncthreads();
}

constexpr size_t WS_BAR = WS_CTL + 768 * 1024;
constexpr int LDS_BARST = LDS_BYTES - 64;
__global__ void __launch_bounds__(NTHREADS, 2) hymba_fwd(Ctx C) {
    extern __shared__ __attribute__((aligned(16))) unsigned char lds_raw[];
    cg::grid_group grid = cg::this_grid();
    if (threadIdx.x < 2) ((volatile LAS unsigned*)((LAS unsigned char*)lds_raw + LDS_BARST))[threadIdx.x] = 0u;
    __syncthreads();
    (void)xcd_barrier_post((unsigned*)(C.ws + WS_BAR), (volatile LAS unsigned*)((LAS unsigned char*)lds_raw + LDS_BARST));
    int ph = 0;
#define PHASE_LOCALS2 int tid = threadIdx.x; LAUNDER_V(tid); const int lane = tid & 63, wave = __builtin_amdgcn_readfirstlane(tid >> 6); char* lds = (char*)lds_raw; Ctx Cc = C; LAUNDER_S(Cc.ws); (void)lane; (void)wave; (void)lds
#define TAIL_OK(G_) ((G_) * 4 >= 850 && 850 - 3 * (G_) > 0 && 850 - 3 * (G_) < (G_))
#define PHASE_BEGIN (C.ph_lo <= ph && ph < C.ph_hi)
#define PHASE_END do { if (C.ph_lo <= ph && ph + 1 < C.ph_hi) { if (C.ph_lo < 0) grid.sync(); else { XcdBarrier xb_; xb_.bar = (unsigned*)(C.ws + WS_BAR); xb_.x = xb_xcc_id(); xb_.st = (volatile LAS unsigned*)((LAS unsigned char*)lds_raw + LDS_BARST); xcd_barrier(xb_); } } ++ph; } while (0)
#define PHASE_LOCALS int tid = threadIdx.x; LAUNDER_V(tid); const int lane = tid & 63, wave = __builtin_amdgcn_readfirstlane(tid >> 6); \
    int G = gridDim.x, bid = blockIdx.x; LAUNDER_S(G); LAUNDER_S(bid); char* lds = (char*)lds_raw; Ctx Cc = C; LAUNDER_S(Cc.ws); (void)lane; (void)wave; (void)lds

    if (PHASE_BEGIN) { PHASE_LOCALS; for (int rep = 0; rep < REP_P0; ++rep) { p0_prologue(Cc, lds, tid, wave, lane, G); __syncthreads(); } }
    PHASE_END;

    {
        constexpr int layer = 0;
        if (PHASE_BEGIN) {
            unsigned char* ws = C.ws; const int G = gridDim.x, bid = blockIdx.x;
            float* rss = (float*)(ws + WS_CTL); float* cosA = (float*)(ws + WS_TAB); float* sinA = cosA + NPOS * 32; float* cosB = sinA + NPOS * 32; float* sinB = cosB + NPOS * 64;
            pg8::Gemm g{(const bf16*)(ws + WS_XA), (const bf16*)(ws + WS_WIN) + (size_t)layer * NP * D, M, NP, D};
            pg8::EpiProj E{layer};
            unsigned* scnt = (unsigned*)(ws + WS_CTL) + 28672 + 64 * layer;
            {
                pg8::SampleFirstOrder S{G, bid, scnt};
                pg8::gemm_phase<pg8::EpiProj, pg8::SampleFirstOrder, true, true>((LAS unsigned char*)lds_raw, g, S, E);
                const bool tail = TAIL_OK(G);
                const int nfull = tail ? 850 - 3 * G : 0;
                if (bid >= nfull) {
                    PHASE_LOCALS2; int ly = layer; LAUNDER_S(ly);
                    if (ly == 0) convert_weights(Cc, (float*)(lds + wave * 16640), 1, (bid - nfull) * 8 + wave, (G - nfull) * 8, lane);
                    if (tail) {
                        __syncthreads();
                        if (tid == 0) { unsigned sp = 0u; while (__hip_atomic_load(scnt, __ATOMIC_RELAXED, __HIP_MEMORY_SCOPE_AGENT) < 50u && ++sp < (1u << 24)) __builtin_amdgcn_s_sleep(8);
                            __builtin_amdgcn_fence(__ATOMIC_ACQUIRE, "agent"); asm volatile("s_waitcnt vmcnt(0)" ::: "memory"); }
                        __syncthreads();
                        for (int ug = bid - nfull; ug < 256; ug += G - nfull) { int tu = tid; LAUNDER_V(tu); ret_sample_group(Cc, lds, ly, ug, tu, wave, tu & 63); }
                    }
                }
            }
        }
        PHASE_END;
        if (PHASE_BEGIN) {
            PHASE_LOCALS; int ly = layer; LAUNDER_S(ly);
            const int nunits = TAIL_OK(G) ? 1024 : 1280; const int tid_p = tid;
            unsigned* ucnt = (unsigned*)(Cc.ws + WS_CTL) + 28672 + 128 + 64 * ly;
            for (int rep = 0; rep < REP_MX1; ++rep) for (int u = bid; u < nunits; u += G) {
                int tid = tid_p; LAUNDER_V(tid); const int lane = tid & 63;
                if (u < 512) { for (int r2 = 0; r2 < 1 + (REPU & 1); ++r2) ret_u_unit(Cc, lds, u >> 3, u & 7, tid, wave, lane, ucnt); }
                else if (u < 768) { const int a = u - 512; for (int r2 = 0; r2 < 1 + ((REPU >> 1) & 1); ++r2) attn_prompt_unit(Cc, lds, ly, a >> 2, (a >> 1) & 1, a & 1, tid, wave, lane); }
                else if (u < 1024) { const int a = u - 768; for (int r2 = 0; r2 < 1 + ((REPU >> 2) & 1); ++r2) attn_sample_mfma(Cc, lds, ly, a >> 1, a & 1, tid, wave, lane); }
                else { const int a = u - 1024; ret_sample_group(Cc, lds, ly, a, tid, wave, lane); }
            }
            {
                if (tid_p == 0) { unsigned sp = 0u; while (__hip_atomic_load(ucnt, __ATOMIC_RELAXED, __HIP_MEMORY_SCOPE_AGENT) < 512u * REP_MX1 * (1 + (REPU & 1)) && ++sp < (1u << 24)) __builtin_amdgcn_s_sleep(4);
                    __builtin_amdgcn_fence(__ATOMIC_ACQUIRE, "agent"); asm volatile("s_waitcnt vmcnt(0)" ::: "memory"); }
                __syncthreads();
                int tid = tid_p; LAUNDER_V(tid);
                ret_scan(Cc, ly, tid, G);
            }
        }
        PHASE_END;
        if (PHASE_BEGIN) { PHASE_LOCALS; int ly = layer; LAUNDER_S(ly); for (int u = bid; u < 256; u += G) outproj_sample_unit(Cc, lds, ly, u, tid, wave, lane); for (int rep = 0; rep < REP_RP; ++rep) for (int u = bid; u < 512; u += G) if (!(SKIPM & 16)) ret_prompt_unit(Cc, lds, ly, u >> 3, u & 7, tid, wave, lane); }
        PHASE_END;
        if (PHASE_BEGIN) {
            unsigned char* ws = C.ws; const int G = gridDim.x, bid = blockIdx.x;
            float* rss = (float*)(ws + WS_CTL); float* XR = (float*)(ws + WS_XR);
            pg8::Gemm g{(const bf16*)(ws + WS_Y), (const bf16*)(ws + WS_WOUT) + (size_t)layer * D * D, T, D, D}; pg8::StaticOrder S; S.init(T, D, G, bid);
            pg8::EpiRes E{layer};
            pg8::gemm_phase<pg8::EpiRes, pg8::StaticOrder, true, true>((LAS unsigned char*)lds_raw, g, S, E);
        }
        PHASE_END;
    }
    {
        constexpr int layer = 1;
        if (PHASE_BEGIN) {
            unsigned char* ws = C.ws; const int G = gridDim.x, bid = blockIdx.x;
            float* rss = (float*)(ws + WS_CTL); float* cosA = (float*)(ws + WS_TAB); float* sinA = cosA + NPOS * 32; float* cosB = sinA + NPOS * 32; float* sinB = cosB + NPOS * 64;
            pg8::Gemm g{(const bf16*)(ws + WS_XA), (const bf16*)(ws + WS_WIN) + (size_t)layer * NP * D, M, NP, D};
            pg8::EpiProj E{layer};
            unsigned* scnt = (unsigned*)(ws + WS_CTL) + 28672 + 64 * layer;
            {
                pg8::SampleFirstOrder S{G, bid, scnt};
                pg8::gemm_phase<pg8::EpiProj, pg8::SampleFirstOrder, true, true>((LAS unsigned char*)lds_raw, g, S, E);
                const bool tail = TAIL_OK(G);
                const int nfull = tail ? 850 - 3 * G : 0;
                if (bid >= nfull) {
                    PHASE_LOCALS2; int ly = layer; LAUNDER_S(ly);
                    if (ly == 0) convert_weights(Cc, (float*)(lds + wave * 16640), 1, (bid - nfull) * 8 + wave, (G - nfull) * 8, lane);
                    if (tail) {
                        __syncthreads();
                        if (tid == 0) { unsigned sp = 0u; while (__hip_atomic_load(scnt, __ATOMIC_RELAXED, __HIP_MEMORY_SCOPE_AGENT) < 50u && ++sp < (1u << 24)) __builtin_amdgcn_s_sleep(8);
                            __builtin_amdgcn_fence(__ATOMIC_ACQUIRE, "agent"); asm volatile("s_waitcnt vmcnt(0)" ::: "memory"); }
                        __syncthreads();
                        for (int ug = bid - nfull; ug < 256; ug += G - nfull) { int tu = tid; LAUNDER_V(tu); ret_sample_group(Cc, lds, ly, ug, tu, wave, tu & 63); }
                    }
                }
            }
        }
        PHASE_END;
        if (PHASE_BEGIN) {
            PHASE_LOCALS; int ly = layer; LAUNDER_S(ly);
            const int nunits = TAIL_OK(G) ? 1024 : 1280; const int tid_p = tid;
            unsigned* ucnt = (unsigned*)(Cc.ws + WS_CTL) + 28672 + 128 + 64 * ly;
            for (int rep = 0; rep < REP_MX1; ++rep) for (int u = bid; u < nunits; u += G) {
                int tid = tid_p; LAUNDER_V(tid); const int lane = tid & 63;
                if (u < 512) { for (int r2 = 0; r2 < 1 + (REPU & 1); ++r2) ret_u_unit(Cc, lds, u >> 3, u & 7, tid, wave, lane, ucnt); }
                else if (u < 768) { const int a = u - 512; for (int r2 = 0; r2 < 1 + ((REPU >> 1) & 1); ++r2) attn_prompt_unit(Cc, lds, ly, a >> 2, (a >> 1) & 1, a & 1, tid, wave, lane); }
                else if (u < 1024) { const int a = u - 768; for (int r2 = 0; r2 < 1 + ((REPU >> 2) & 1); ++r2) attn_sample_mfma(Cc, lds, ly, a >> 1, a & 1, tid, wave, lane); }
                else { const int a = u - 1024; ret_sample_group(Cc, lds, ly, a, tid, wave, lane); }
            }
            {
                if (tid_p == 0) { unsigned sp = 0u; while (__hip_atomic_load(ucnt, __ATOMIC_RELAXED, __HIP_MEMORY_SCOPE_AGENT) < 512u * REP_MX1 * (1 + (REPU & 1)) && ++sp < (1u << 24)) __builtin_amdgcn_s_sleep(4);
                    __builtin_amdgcn_fence(__ATOMIC_ACQUIRE, "agent"); asm volatile("s_waitcnt vmcnt(0)" ::: "memory"); }
                __syncthreads();
                int tid = tid_p; LAUNDER_V(tid);
                ret_scan(Cc, ly, tid, G);
            }
        }
        PHASE_END;
        if (PHASE_BEGIN) { PHASE_LOCALS; int ly = layer; LAUNDER_S(ly); for (int u = bid; u < 256; u += G) outproj_sample_unit(Cc, lds, ly, u, tid, wave, lane); for (int rep = 0; rep < REP_RP; ++rep) for (int u = bid; u < 512; u += G) if (!(SKIPM & 16)) ret_prompt_unit(Cc, lds, ly, u >> 3, u & 7, tid, wave, lane); }
        PHASE_END;
        if (PHASE_BEGIN) {
            unsigned char* ws = C.ws; const int G = gridDim.x, bid = blockIdx.x;
            float* rss = (float*)(ws + WS_CTL); float* XR = (float*)(ws + WS_XR);
            pg8::Gemm g{(const bf16*)(ws + WS_Y), (const bf16*)(ws + WS_WOUT) + (size_t)layer * D * D, T, D, D}; pg8::StaticOrder S; S.init(T, D, G, bid);
            if (G == 256) {
                pg8::EpiResFinal EF;
                pg8::gemm_phase<pg8::EpiResFinal, pg8::StaticOrder, true, true>((LAS unsigned char*)lds_raw, g, S, EF);
                PHASE_LOCALS2;
                const float* rf = (const float*)(Cc.ws + WS_CTL) + 2 * M;
                for (int m = T + bid * 8 + wave; m < M; m += G * 8) {
                    const float rv = rsqrtf(rf[m] * (1.0f / 2048.0f) + 1e-6f);
                    f32x4* xr = (f32x4*)(Cc.out + (size_t)m * D);
#pragma unroll
                    for (int j = 0; j < 8; ++j) { const f32x4 wv = *((const f32x4*)Cc.final_w + lane + 64 * j); xr[lane + 64 * j] = xr[lane + 64 * j] * rv * wv; }
                }
            } else {
                pg8::EpiRes E{layer};
                pg8::gemm_phase<pg8::EpiRes, pg8::StaticOrder, true, true>((LAS unsigned char*)lds_raw, g, S, E);
            }
        }
        if (gridDim.x != 256) { PHASE_END; } else ++ph;
    }
#ifdef REP_SYNC
    for (int rep = 0; rep < REP_SYNC; ++rep) { XcdBarrier xb_; xb_.bar = (unsigned*)(C.ws + WS_BAR); xb_.x = xb_xcc_id(); xb_.st = (volatile LAS unsigned*)((LAS unsigned char*)lds_raw + LDS_BARST); xcd_barrier(xb_); }
#endif
    if (PHASE_BEGIN && gridDim.x != 256) {
        PHASE_LOCALS;
        const float* rf = (const float*)(Cc.ws + WS_CTL) + 2 * M;
        for (int m = bid * 8 + wave; m < M; m += G * 8) {
            const float rv = rsqrtf(rf[m] * (1.0f / 2048.0f) + 1e-6f);
            f32x4* xr = (f32x4*)(Cc.out + (size_t)m * D);
#pragma unroll
            for (int j = 0; j < 8; ++j) { const f32x4 wv = *((const f32x4*)Cc.final_w + lane + 64 * j); xr[lane + 64 * j] = xr[lane + 64 * j] * rv * wv; }
        }
    }
}

constexpr int N_PHASES = 1 + DEPTH * 4 + 1;
#ifndef MK_MULTI
#define MK_MULTI 0
#endif
extern "C" void kernel_launch(void* const* d_in, const int* in_sizes, int n_in, void* d_out, int out_size, void* d_ws, size_t ws_size, hipStream_t stream) {
    static int grid = 0;
    if (grid == 0) {
        if (n_in != 11 || ws_size < WS_END) { fprintf(stderr, "kernel_launch: unexpected inputs (n_in %d, ws %zu)\n", n_in, ws_size); grid = -1; return; }
        int dev = 0, cus = 0, per_cu = 0;
        hipGetDevice(&dev); hipDeviceGetAttribute(&cus, hipDeviceAttributeMultiprocessorCount, dev);
        if (hipFuncSetAttribute((const void*)hymba_fwd, hipFuncAttributeMaxDynamicSharedMemorySize, LDS_BYTES) != hipSuccess) { fprintf(stderr, "kernel_launch: hipFuncSetAttribute failed\n"); grid = -1; return; }
        if (hipOccupancyMaxActiveBlocksPerMultiprocessor(&per_cu, (const void*)hymba_fwd, NTHREADS, LDS_BYTES) != hipSuccess || per_cu < 1) { fprintf(stderr, "kernel_launch: occupancy query says %d\n", per_cu); (void)hipGetLastError(); per_cu = 1; }
        grid = cus;
    }
    if (grid < 0) return;
    hipMemsetAsync((char*)d_ws + WS_CTL, 0, CTL_BYTES, stream);
    Ctx c{};
    c.x_prompt = (const float*)d_in[0]; c.x_sample = (const float*)d_in[1]; c.cache_k = (const float*)d_in[2]; c.cache_v = (const float*)d_in[3]; c.state = (const float*)d_in[4];
    c.norm_w = (const float*)d_in[5]; c.w_in = (const float*)d_in[6]; c.sinks = (const float*)d_in[7]; c.ret_norm_w = (const float*)d_in[8]; c.w_out = (const float*)d_in[9]; c.final_w = (const float*)d_in[10];
    c.out = (float*)d_out; c.ws = (unsigned char*)d_ws;
#if MK_MULTI
    for (int p = 0; p < N_PHASES; ++p) { c.ph_lo = p; c.ph_hi = p + 1; void* args[] = {&c};
        hipError_t e = hipLaunchCooperativeKernel((const void*)hymba_fwd, dim3(grid), dim3(NTHREADS), args, LDS_BYTES, stream);
        if (e != hipSuccess) { fprintf(stderr, "launch %d failed: %s\n", p, hipGetErrorString(e)); break; } }
#else
    c.ph_lo = 0; c.ph_hi = N_PHASES; void* args[] = {&c};
    hipError_t e = hipLaunchCooperativeKernel((const void*)hymba_fwd, dim3(grid), dim3(NTHREADS), args, LDS_BYTES, stream);
    if (e != hipSuccess) fprintf(stderr, "cooperative launch failed: %s (grid %d)\n", hipGetErrorString(e), grid);
#endif
}
```

```cpp
#include <hip/hip_runtime.h>
#include <hip/hip_cooperative_groups.h>
#include <cstdio>
#include <cstdint>
namespace cg = cooperative_groups;
namespace pg8 {
#define PG8_LAS __attribute__((address_space(3)))
typedef unsigned short bf16_t;
typedef short bf16x8 __attribute__((ext_vector_type(8)));
typedef float f32x4 __attribute__((ext_vector_type(4)));
typedef unsigned u32x4 __attribute__((ext_vector_type(4)));
constexpr int BM = 256, BK = 64, HALF = 128, HTB = HALF * BK * 2  , STAGE_BYTES = 8 * HTB, NXCD = 8, WGM = 8;

__host__ __device__ __forceinline__ int lds_byte(int r, int c) { const int st = (r >> 4) * 2 + (c >> 5), rr = r & 15, cc = c & 31, ob = rr * 64 + cc * 2; return st * 1024 + (ob ^ (((ob >> 9) & 1) << 5)); }
__host__ __device__ __forceinline__ void stage_rc(int b, int& R, int& C) { const int st = b / 1024, sb = b % 1024, swz = sb ^ (((sb >> 9) & 1) << 5); R = (st >> 1) * 16 + swz / 64; C = (st & 1) * 32 + (swz % 64) / 2; }
__host__ __device__ __forceinline__ int perm32(int rho) { const int n = rho >> 4, i = rho & 15; return 8 * (i >> 2) + 4 * n + (i & 3); }

struct Unit { int pm, pn; };
struct Gemm { const bf16_t* A; const bf16_t* Bt; int M, N, K; };

struct StaticOrder {
    int nM, nN, nwg, G, c;
    __host__ __device__ void init(int M, int N, int G_, int c_) { nM = M / BM; nN = N / BM; nwg = nM * nN; G = G_; c = c_; }
    __host__ __device__ bool next(int i, Unit& u) const {
        const long L = (long)i * G + c; if (L >= nwg) return false;
        int wgid = (int)L; { const int q = nwg / NXCD, r = nwg % NXCD, xcd = wgid % NXCD, off = wgid / NXCD; wgid = (xcd < r ? xcd * (q + 1) : r * (q + 1) + (xcd - r) * q) + off; }
        const int nig = WGM * nN, gid = wgid / nig, fm = gid * WGM, gsz = (nM - fm) < WGM ? (nM - fm) : WGM;
        u.pm = fm + ((wgid % nig) % gsz); u.pn = (wgid % nig) / gsz; return true;
    }
    __device__ __forceinline__ void a_ready(const Unit&) const {}
    __device__ __forceinline__ void done(const Unit&) const {}
};


struct SampleFirstOrder {
    int G, c; unsigned* cnt;
    __device__ __forceinline__ bool next(int i, Unit& u) const {
        const int L = i * G + c; if (L >= 850) return false;
        if (L < 50) { u.pm = 32 + L / 25; u.pn = L % 25; return true; }
        int wgid = L - 50; wgid = (wgid % NXCD) * 100 + wgid / NXCD;
        const int r = wgid % 200; u.pm = (wgid / 200) * WGM + (r % WGM); u.pn = r / WGM; return true;
    }
    __device__ __forceinline__ void a_ready(const Unit&) const {}
    __device__ __forceinline__ void done(const Unit& u) const {
        if (u.pm >= 32) {
            asm volatile("s_waitcnt vmcnt(0)" ::: "memory");
            __syncthreads();
            if (threadIdx.x == 0) { __builtin_amdgcn_fence(__ATOMIC_RELEASE, "agent"); asm volatile("s_waitcnt vmcnt(0)" ::: "memory");
                __hip_atomic_fetch_add(cnt, 1u, __ATOMIC_RELAXED, __HIP_MEMORY_SCOPE_AGENT); }
        }
    }
};
__device__ __forceinline__ unsigned cvt_pk_bf16(float lo, float hi) { unsigned r; asm volatile("v_cvt_pk_bf16_f32 %0, %1, %2" : "=v"(r) : "v"(lo), "v"(hi)); return r; }
constexpr int T_ = 8192, NPROJ = 6400, DMODEL = 2048;
struct KArgs { const float* in[11]; float* out; unsigned char* ws; int ph_lo, ph_hi; };
constexpr size_t EMiB = 1u << 20, EWS_XA = 68 * EMiB, EWS_P = 102 * EMiB, EWS_XR = 243 * EMiB, EWS_TAB = 359 * EMiB;
constexpr size_t O_KP = (size_t)8704 * 2048, O_VP = O_KP + 32768, O_RP = O_VP + 32768, O_KS = O_RP + 262144, O_VS = O_KS + 4194304, O_RS = O_VS + 4194304;

struct EpiProj {
    static constexpr bool PERM = true, AFTER_DRAIN = false;
    int layer;
    __device__ __forceinline__ void operator()(const f32x4 (&acc)[2][2][4][2], const Unit& u, int wr, int wc, int fr, int fq) const {
        const KArgs* kp = (const KArgs*)__builtin_amdgcn_kernarg_segment_ptr(); asm volatile("" : "+s"(kp));
        unsigned char* ws = kp->ws; float* out = kp->out;
        bf16_t* P = (bf16_t*)(ws + EWS_P); const float* rss = (const float*)ws + layer * 8704;
        const float* cosA = (const float*)(ws + EWS_TAB); const float* sinA = cosA + 8196 * 32; const float* cosB = sinA + 8196 * 32; const float* sinB = cosB + 8196 * 64;
        float rv[2][4];
#pragma unroll
        for (int ai = 0; ai < 2; ++ai)
#pragma unroll
            for (int m = 0; m < 4; ++m) rv[ai][m] = rsqrtf(rss[u.pm * BM + ai * HALF + wr * 64 + m * 16 + fr] * (1.0f / 2048.0f) + 1e-6f);
#pragma unroll
        for (int bj = 0; bj < 2; ++bj) {
            const int cb = u.pn * BM + bj * HALF;
            const int c0 = cb + wc * 32 + 8 * fq;
            const int mode = (cb < 1152) ? 1 : ((cb >= 2304 && cb < 4352) ? 2 : 0);
            const int kvmode = (cb == 1024) ? 1 : ((cb == 1152) ? 2 : 0);
#pragma unroll
            for (int ai = 0; ai < 2; ++ai)
#pragma unroll
                for (int m = 0; m < 4; ++m) {
                    const int row = u.pm * BM + ai * HALF + wr * 64 + m * 16 + fr;
                    f32x4 v0 = acc[ai][bj][m][0] * rv[ai][m], v1 = acc[ai][bj][m][1] * rv[ai][m];
                    if (mode) {
                        const int pos = row < T_ ? row : T_ + ((row - T_) & 3);
                        f32x4 c, s;
                        if (mode == 1) { const int i = (c0 & 63) >> 3; c = *(const f32x4*)(cosA + pos * 32 + 4 * i); s = *(const f32x4*)(sinA + pos * 32 + 4 * i); }
                        else { const int i = (c0 & 127) >> 3; c = *(const f32x4*)(cosB + pos * 64 + 4 * i); s = *(const f32x4*)(sinB + pos * 64 + 4 * i); }
                        const f32x4 y0 = v0 * c - v1 * s, y1 = v1 * c + v0 * s; v0 = y0; v1 = y1;
                    }
                    u32x4 w; w.x = cvt_pk_bf16(v0[0], v0[1]); w.y = cvt_pk_bf16(v0[2], v0[3]); w.z = cvt_pk_bf16(v1[0], v1[1]); w.w = cvt_pk_bf16(v1[2], v1[3]);
                    *(u32x4*)(P + (size_t)row * NPROJ + c0) = w;
                    if (kvmode && row >= T_ - 128) {
                        const int kvh = (c0 - cb) >> 6, g0 = c0 & 63;
                        float* dst;
                        if (row < T_) dst = out + (kvmode == 1 ? O_KP : O_VP) + ((size_t)(layer * 128 + (row - (T_ - 128))) * 2 + kvh) * 64;
                        else { const int b = (row - T_) >> 2, t = (row - T_) & 3; dst = out + (kvmode == 1 ? O_KS : O_VS) + ((((size_t)layer * 128 + b) * 128 + 124 + t) * 2 + kvh) * 64; }
                        if (kvmode == 1) { const int i = g0 >> 3; *(f32x4*)(dst + 4 * i) = v0; *(f32x4*)(dst + 4 * i + 32) = v1; }
                        else { *(f32x4*)(dst + g0) = v0; *(f32x4*)(dst + g0 + 4) = v1; }
                    }
                }
        }
    }
};

struct EpiRes {
    static constexpr bool PERM = true, AFTER_DRAIN = false;
    int layer;
    __device__ __forceinline__ void operator()(const f32x4 (&acc)[2][2][4][2], const Unit& u, int wr, int wc, int fr, int fq) const {
        const KArgs* kp = (const KArgs*)__builtin_amdgcn_kernarg_segment_ptr(); asm volatile("" : "+s"(kp));
        unsigned char* ws = kp->ws; bf16_t* xa = (bf16_t*)(ws + EWS_XA); float* rss = (float*)ws + (layer + 1) * 8704;
#pragma unroll
        for (int ai = 0; ai < 2; ++ai)
#pragma unroll
            for (int m = 0; m < 4; ++m) {
                const int row = u.pm * BM + ai * HALF + wr * 64 + m * 16 + fr;
                float ss = 0.f;
#pragma unroll
                for (int bj = 0; bj < 2; ++bj) {
                    const int c0 = u.pn * BM + bj * HALF + wc * 32 + 8 * fq;
                    f32x4 b0, b1;
                    { const u32x4 xb = *(const u32x4*)(xa + (size_t)row * DMODEL + c0);
                        b0 = (f32x4){__uint_as_float(xb.x << 16), __uint_as_float(xb.x & 0xffff0000u), __uint_as_float(xb.y << 16), __uint_as_float(xb.y & 0xffff0000u)};
                        b1 = (f32x4){__uint_as_float(xb.z << 16), __uint_as_float(xb.z & 0xffff0000u), __uint_as_float(xb.w << 16), __uint_as_float(xb.w & 0xffff0000u)}; }
                    const f32x4 v0 = acc[ai][bj][m][0] + b0, v1 = acc[ai][bj][m][1] + b1;
                    if (layer == 0) { u32x4 w; w.x = cvt_pk_bf16(v0[0], v0[1]); w.y = cvt_pk_bf16(v0[2], v0[3]); w.z = cvt_pk_bf16(v1[0], v1[1]); w.w = cvt_pk_bf16(v1[2], v1[3]);
                        *(u32x4*)(xa + (size_t)row * DMODEL + c0) = w; }
                    else { float* op = kp->out + (size_t)row * DMODEL + c0; *(f32x4*)op = v0; *(f32x4*)(op + 4) = v1; }
                    ss += (v0[0] * v0[0] + v0[1] * v0[1]) + (v0[2] * v0[2] + v0[3] * v0[3]) + (v1[0] * v1[0] + v1[1] * v1[1]) + (v1[2] * v1[2] + v1[3] * v1[3]);
                }
                ss += __shfl_xor(ss, 16); ss += __shfl_xor(ss, 32);
                if (fq == 0) atomicAdd(rss + row, ss);
            }
    }
};


struct EpiResFinal {
    static constexpr bool PERM = true, AFTER_DRAIN = true;
    __device__ __forceinline__ void operator()(const f32x4 (&)[2][2][4][2], const Unit&, int, int, int, int) const {}
    __device__ __forceinline__ void fused(f32x4 (&acc)[2][2][4][2], const Unit& u, int wr, int wc, int fr, int fq, PG8_LAS unsigned char* lds, int wid, int lane) const {
        asm volatile("" : "+v"(fr), "+v"(fq));
        const KArgs* kp = (const KArgs*)__builtin_amdgcn_kernarg_segment_ptr(); asm volatile("" : "+s"(kp));
        unsigned char* ws = kp->ws; const bf16_t* xa = (const bf16_t*)(ws + EWS_XA);
        PG8_LAS float* P4 = (PG8_LAS float*)lds;
        PG8_LAS float* S = (PG8_LAS float*)(lds + 4096);
        PG8_LAS unsigned* flag = (PG8_LAS unsigned*)(lds + 8192);
        unsigned* slots = (unsigned*)(ws + EWS_XR);
        unsigned* cnt = (unsigned*)ws + 32768 + 64 * u.pm;
#pragma unroll
        for (int ai = 0; ai < 2; ++ai)
#pragma unroll
            for (int m = 0; m < 4; ++m) {
                const int rl = ai * HALF + wr * 64 + m * 16 + fr, row = u.pm * BM + rl;
                float ss = 0.f;
#pragma unroll
                for (int bj = 0; bj < 2; ++bj) {
                    const int c0 = u.pn * BM + bj * HALF + wc * 32 + 8 * fq;
                    const u32x4 xb = *(const u32x4*)(xa + (size_t)row * DMODEL + c0);
                    const f32x4 b0 = (f32x4){__uint_as_float(xb.x << 16), __uint_as_float(xb.x & 0xffff0000u), __uint_as_float(xb.y << 16), __uint_as_float(xb.y & 0xffff0000u)};
                    const f32x4 b1 = (f32x4){__uint_as_float(xb.z << 16), __uint_as_float(xb.z & 0xffff0000u), __uint_as_float(xb.w << 16), __uint_as_float(xb.w & 0xffff0000u)};
                    const f32x4 v0 = acc[ai][bj][m][0] + b0, v1 = acc[ai][bj][m][1] + b1;
                    acc[ai][bj][m][0] = v0; acc[ai][bj][m][1] = v1;
                    ss += (v0[0] * v0[0] + v0[1] * v0[1]) + (v0[2] * v0[2] + v0[3] * v0[3]) + (v1[0] * v1[0] + v1[1] * v1[1]) + (v1[2] * v1[2] + v1[3] * v1[3]);
                }
                ss += __shfl_xor(ss, 16); ss += __shfl_xor(ss, 32);
                if (fq == 0) P4[rl * 4 + wc] = ss;
            }
        asm volatile("s_waitcnt lgkmcnt(0)" ::: "memory"); __builtin_amdgcn_s_barrier(); asm volatile("" ::: "memory");
        const int tid = wid * 64 + lane;
        if (tid < 256) { const float t = (P4[tid * 4] + P4[tid * 4 + 1]) + (P4[tid * 4 + 2] + P4[tid * 4 + 3]);
            __hip_atomic_store(slots + ((size_t)(u.pm * BM + tid)) * 8 + u.pn, __float_as_uint(t), __ATOMIC_RELAXED, __HIP_MEMORY_SCOPE_AGENT); }
        asm volatile("s_waitcnt vmcnt(0)" ::: "memory");
        if (lane == 0) __hip_atomic_fetch_add(cnt, 1u, __ATOMIC_RELAXED, __HIP_MEMORY_SCOPE_AGENT);
        if (wid == 0) {
            unsigned sp = 0u; bool dead = false;
            while ((unsigned)__builtin_amdgcn_readfirstlane(__hip_atomic_load(cnt, __ATOMIC_RELAXED, __HIP_MEMORY_SCOPE_AGENT)) < 64u) { __builtin_amdgcn_s_sleep(2); if (++sp > (1u << 22)) { dead = true; break; } }
            __builtin_amdgcn_fence(__ATOMIC_ACQUIRE, "agent");
            if (lane == 0) flag[0] = dead ? 1u : 0u;
        }
        asm volatile("s_waitcnt vmcnt(0) lgkmcnt(0)" ::: "memory"); __builtin_amdgcn_s_barrier(); asm volatile("" ::: "memory");
        if (tid < 256) { const unsigned* sl = slots + ((size_t)(u.pm * BM + tid)) * 8; float t = 0.f;
#pragma unroll
            for (int k = 0; k < 8; ++k) t += __uint_as_float(__hip_atomic_load(sl + k, __ATOMIC_RELAXED, __HIP_MEMORY_SCOPE_AGENT));
            S[tid] = flag[0] ? __builtin_nanf("") : rsqrtf(t * (1.0f / 2048.0f) + 1e-6f); }
        asm volatile("s_waitcnt lgkmcnt(0)" ::: "memory"); __builtin_amdgcn_s_barrier(); asm volatile("" ::: "memory");
        const float* fw = kp->in[10];
#pragma unroll
        for (int bj = 0; bj < 2; ++bj) {
            const int c0 = u.pn * BM + bj * HALF + wc * 32 + 8 * fq;
            const f32x4 w0 = *(const f32x4*)(fw + c0), w1 = *(const f32x4*)(fw + c0 + 4);
#pragma unroll
            for (int ai = 0; ai < 2; ++ai)
#pragma unroll
                for (int m = 0; m < 4; ++m) {
                    const int rl = ai * HALF + wr * 64 + m * 16 + fr; const float rv = S[rl];
                    float* op = kp->out + (size_t)(u.pm * BM + rl) * DMODEL + c0;
                    __builtin_nontemporal_store(acc[ai][bj][m][0] * rv * w0, (f32x4*)op); __builtin_nontemporal_store(acc[ai][bj][m][1] * rv * w1, (f32x4*)(op + 4));
                }
        }
    }
};

template <class Epi, class Sched, bool ALIGN_EPI = false, bool SP2 = false>
__device__ __forceinline__ void gemm_phase(PG8_LAS unsigned char* lds, const Gemm g, const Sched& S, const Epi& E) {
    int tid_ = threadIdx.x; asm volatile("" : "+v"(tid_));
    const int tid = tid_, wid = __builtin_amdgcn_readfirstlane(tid >> 6), lane = tid & 63, wr = wid >> 2, wc = wid & 3, fr = lane & 15, fq = lane >> 4;
    const int K = g.K, nt = K / BK;
    unsigned voffA[2], voffB[2];
#pragma unroll
    for (int i = 0; i < 2; ++i) { int R, C; stage_rc(tid * 16 + i * 8192, R, C); const int Rb = Epi::PERM ? ((R & ~31) + perm32(R & 31)) : R;
        voffA[i] = (unsigned)(R * K + C) * 2u; voffB[i] = (unsigned)(Rb * K + C) * 2u; }
    const size_t kstep = (size_t)(BK * 2);
    const size_t hstep = (size_t)HALF * K * 2;
    const size_t tstep = 2 * hstep;
    const unsigned ldsw = (unsigned)wid * 1024u;
    const int aoff = lds_byte(wr * 64 + fr, fq * 8), boff = lds_byte(wc * 32 + fr, fq * 8);
#define PG8_SA(b, h) (((b) * 2 + (h)) * HTB)
#define PG8_SB(b, h) ((4 + (b) * 2 + (h)) * HTB)
#define PG8_STAGE(bufoff, gbase, voff) do { _Pragma("unroll") for (int _i = 0; _i < 2; ++_i) \
        __builtin_amdgcn_global_load_lds((const unsigned*)((const char*)(gbase) + (voff)[_i]), (PG8_LAS unsigned*)(lds + (bufoff) + ldsw + _i * 8192), 16, 0, 0); } while (0)
#define PG8_LDA(dst, b, h) do { _Pragma("unroll") for (int m = 0; m < 4; ++m) _Pragma("unroll") for (int k = 0; k < 2; ++k) dst[m][k] = *(const PG8_LAS bf16x8*)(lds + PG8_SA(b, h) + aoff + m * 2048 + k * 1024); } while (0)
#define PG8_LDB(dst, b, h) do { _Pragma("unroll") for (int n = 0; n < 2; ++n) _Pragma("unroll") for (int k = 0; k < 2; ++k) dst[n][k] = *(const PG8_LAS bf16x8*)(lds + PG8_SB(b, h) + boff + n * 2048 + k * 1024); } while (0)
#define PG8_MMA(ai, bj, At, Bt) do { __builtin_amdgcn_s_setprio(1); _Pragma("unroll") for (int m = 0; m < 4; ++m) _Pragma("unroll") for (int n = 0; n < 2; ++n) _Pragma("unroll") for (int k = 0; k < 2; ++k) \
        acc[ai][bj][m][n] = __builtin_amdgcn_mfma_f32_16x16x32_bf16(Bt[n][k], At[m][k], acc[ai][bj][m][n], 0, 0, 0); __builtin_amdgcn_s_setprio(0); } while (0)
#define PG8_WAIT_V(n) asm volatile("s_waitcnt vmcnt(" #n ")" ::: "memory")
#define PG8_WAIT_L(n) asm volatile("s_waitcnt lgkmcnt(" #n ")" ::: "memory")
#define PG8_BAR __builtin_amdgcn_s_barrier()
#define PG8_SCHED __builtin_amdgcn_sched_barrier(0)
    Unit cur, nxt; int ui = 0;
    if (!S.next(0, cur)) return;
    f32x4 acc[2][2][4][2];
#pragma unroll
    for (int a = 0; a < 2; ++a)
#pragma unroll
        for (int b = 0; b < 2; ++b)
#pragma unroll
            for (int m = 0; m < 4; ++m)
#pragma unroll
                for (int n = 0; n < 2; ++n) acc[a][b][m][n] = (f32x4){0.f, 0.f, 0.f, 0.f};
    bf16x8 At[4][2], B0[2][2], B1[2][2];
    const char* cA = (const char*)g.A + (size_t)cur.pm * tstep; const char* cB = (const char*)g.Bt + (size_t)cur.pn * tstep;
    S.a_ready(cur);
    if constexpr (SP2) {
        PG8_STAGE(PG8_SB(0, 0), cB, voffB); PG8_STAGE(PG8_SB(0, 1), cB + hstep, voffB); PG8_STAGE(PG8_SA(0, 0), cA, voffA); PG8_STAGE(PG8_SA(0, 1), cA + hstep, voffA);
        if (wr == 1) PG8_BAR;
        PG8_WAIT_V(2); PG8_BAR;
        PG8_STAGE(PG8_SB(1, 0), cB + kstep, voffB); PG8_STAGE(PG8_SA(1, 0), cA + kstep, voffA); PG8_STAGE(PG8_SB(1, 1), cB + hstep + kstep, voffB);
        PG8_WAIT_V(6); PG8_BAR;
    } else {
        PG8_STAGE(PG8_SB(0, 0), cB, voffB); PG8_STAGE(PG8_SA(0, 0), cA, voffA); PG8_STAGE(PG8_SB(0, 1), cB + hstep, voffB); PG8_STAGE(PG8_SA(0, 1), cA + hstep, voffA);
        if (wr == 1) PG8_BAR;
        PG8_WAIT_V(4); PG8_BAR;
        PG8_STAGE(PG8_SB(1, 0), cB + kstep, voffB); PG8_STAGE(PG8_SA(1, 0), cA + kstep, voffA); PG8_STAGE(PG8_SB(1, 1), cB + hstep + kstep, voffB);
        PG8_WAIT_V(6); PG8_BAR;
    }
    for (;;) {
        const bool has_next = S.next(ui + 1, nxt);
        const char* nA = has_next ? (const char*)g.A + (size_t)nxt.pm * tstep : cA; const char* nB = has_next ? (const char*)g.Bt + (size_t)nxt.pn * tstep : cB;
        for (int t = 0; t < nt; t += 2) {
            const bool last = (t == nt - 2);
            const char* a1 = cA + (size_t)(t + 1) * kstep;
            const char* a2 = last ? nA : cA + (size_t)(t + 2) * kstep; const char* b2 = last ? nB : cB + (size_t)(t + 2) * kstep;
            const char* a3 = a2 + kstep; const char* b3 = b2 + kstep;
            if (last && has_next) S.a_ready(nxt);
            if constexpr (SP2) {
            PG8_LDB(B0, 0, 0); PG8_LDB(B1, 0, 1); PG8_SCHED; PG8_LDA(At, 0, 0); PG8_STAGE(PG8_SA(1, 1), a1 + hstep, voffA);
            PG8_WAIT_V(8); PG8_WAIT_L(0); PG8_BAR; PG8_MMA(0, 0, At, B0); PG8_MMA(0, 1, At, B1); PG8_BAR; PG8_SCHED;
            PG8_LDA(At, 0, 1); PG8_STAGE(PG8_SB(0, 0), b2, voffB); PG8_STAGE(PG8_SB(0, 1), b2 + hstep, voffB); PG8_STAGE(PG8_SA(0, 0), a2, voffA);
            PG8_WAIT_V(8); PG8_WAIT_L(0); PG8_BAR; PG8_MMA(1, 0, At, B0); PG8_MMA(1, 1, At, B1); PG8_BAR; PG8_SCHED;
            PG8_LDB(B0, 1, 0); PG8_LDB(B1, 1, 1); PG8_SCHED; PG8_LDA(At, 1, 0); PG8_STAGE(PG8_SA(0, 1), a2 + hstep, voffA);
            PG8_WAIT_V(8); PG8_WAIT_L(0); PG8_BAR; PG8_MMA(0, 0, At, B0); PG8_MMA(0, 1, At, B1); PG8_BAR; PG8_SCHED;
            PG8_LDA(At, 1, 1); PG8_STAGE(PG8_SB(1, 0), b3, voffB); PG8_STAGE(PG8_SB(1, 1), b3 + hstep, voffB); PG8_STAGE(PG8_SA(1, 0), a3, voffA);
            PG8_WAIT_V(8); PG8_WAIT_L(0); PG8_BAR; PG8_MMA(1, 0, At, B0); PG8_MMA(1, 1, At, B1); PG8_BAR; PG8_SCHED;
            } else {
            PG8_LDB(B0, 0, 0); PG8_SCHED; PG8_LDA(At, 0, 0); PG8_STAGE(PG8_SA(1, 1), a1 + hstep, voffA);
            PG8_WAIT_L(8); PG8_BAR; PG8_WAIT_L(0); PG8_MMA(0, 0, At, B0); PG8_BAR; PG8_SCHED;
            PG8_LDB(B1, 0, 1); PG8_STAGE(PG8_SB(0, 0), b2, voffB);
            PG8_BAR; PG8_WAIT_L(0); PG8_MMA(0, 1, At, B1); PG8_BAR;
            PG8_LDA(At, 0, 1); PG8_STAGE(PG8_SA(0, 0), a2, voffA);
            PG8_BAR; PG8_WAIT_L(0); PG8_MMA(1, 0, At, B0); PG8_BAR; PG8_SCHED;
            PG8_STAGE(PG8_SB(0, 1), b2 + hstep, voffB);
            PG8_WAIT_V(6); PG8_BAR; PG8_MMA(1, 1, At, B1); PG8_BAR;
            PG8_LDB(B0, 1, 0); PG8_SCHED; PG8_LDA(At, 1, 0); PG8_STAGE(PG8_SA(0, 1), a2 + hstep, voffA);
            PG8_WAIT_L(8); PG8_BAR; PG8_WAIT_L(0); PG8_MMA(0, 0, At, B0); PG8_BAR; PG8_SCHED;
            PG8_LDB(B1, 1, 1); PG8_STAGE(PG8_SB(1, 0), b3, voffB);
            PG8_BAR; PG8_WAIT_L(0); PG8_MMA(0, 1, At, B1); PG8_BAR;
            PG8_LDA(At, 1, 1); PG8_STAGE(PG8_SA(1, 0), a3, voffA);
            PG8_BAR; PG8_WAIT_L(0); PG8_MMA(1, 0, At, B0); PG8_BAR; PG8_SCHED;
            PG8_STAGE(PG8_SB(1, 1), b3 + hstep, voffB);
            PG8_WAIT_V(6); PG8_BAR; PG8_MMA(1, 1, At, B1); PG8_BAR;
            }
        }
        if constexpr (ALIGN_EPI) { if (wr == 0) PG8_BAR; }
        if constexpr (!Epi::AFTER_DRAIN) { E(acc, cur, wr, wc, fr, fq); S.done(cur); }
        if (!has_next) break;
#pragma unroll
        for (int a = 0; a < 2; ++a)
#pragma unroll
            for (int b = 0; b < 2; ++b)
#pragma unroll
                for (int m = 0; m < 4; ++m)
#pragma unroll
                    for (int n = 0; n < 2; ++n) acc[a][b][m][n] = (f32x4){0.f, 0.f, 0.f, 0.f};
        cur = nxt; cA = nA; cB = nB; ++ui;
        if constexpr (ALIGN_EPI) { if (wr == 1) PG8_BAR; }
    }
    PG8_WAIT_V(0);
    if constexpr (!ALIGN_EPI) { if (wr == 0) PG8_BAR; }
    PG8_BAR;
    if constexpr (Epi::AFTER_DRAIN) { E.fused(acc, cur, wr, wc, fr, fq, lds, wid, lane); S.done(cur); }
#undef PG8_SA
#undef PG8_SB
#undef PG8_STAGE
#undef PG8_LDA
#undef PG8_LDB
#undef PG8_MMA
#undef PG8_WAIT_V
#undef PG8_WAIT_L
#undef PG8_BAR
#undef PG8_SCHED
}
}

typedef unsigned short bf16;
typedef float f32x4 __attribute__((ext_vector_type(4)));
typedef short bf16x8 __attribute__((ext_vector_type(8)));
typedef short s16x4 __attribute__((ext_vector_type(4)));
typedef unsigned u32x4 __attribute__((ext_vector_type(4)));
typedef unsigned u32x2 __attribute__((ext_vector_type(2)));
typedef float f32x2 __attribute__((ext_vector_type(2)));
typedef __bf16 bf16x2_t __attribute__((ext_vector_type(2)));
#define LAS __attribute__((address_space(3)))

constexpr int T = 8192, NS = 512, M = 8704, D = 2048, NP = 6400, DEPTH = 2;
constexpr int C_QA = 0, C_KA = 1024, C_VA = 1152, C_GA = 1280, C_QB = 2304, C_KB = 3328, C_VB = 4352, C_GB = 5376;
constexpr int NPOS = 8196;
constexpr int LDS_BYTES = 147456;
constexpr int NTHREADS = 512;
using pg8::O_KP; using pg8::O_VP; using pg8::O_RP; using pg8::O_KS; using pg8::O_VS; using pg8::O_RS;

constexpr size_t MiB = 1u << 20;
constexpr size_t WS_CTL = 0, CTL_BYTES = 1 * MiB;
constexpr size_t WS_WIN = 2 * MiB;
constexpr size_t WS_WOUT = WS_WIN + 50 * MiB;
constexpr size_t WS_XA = WS_WOUT + 16 * MiB;
constexpr size_t WS_P = WS_XA + 34 * MiB;
constexpr size_t WS_Y = WS_P + 107 * MiB;
constexpr size_t WS_XR = WS_Y + 34 * MiB;
constexpr size_t WS_U = WS_XR + 68 * MiB;
constexpr size_t WS_RT = WS_U + 32 * MiB;
constexpr size_t WS_TAB = WS_RT + 16 * MiB;
constexpr size_t WS_END = WS_TAB + 8 * MiB;
static_assert(WS_XA == pg8::EWS_XA && WS_P == pg8::EWS_P && WS_XR == pg8::EWS_XR && WS_TAB == pg8::EWS_TAB && WS_CTL == 0, "d_ws map vs the epilogues' copy");

static_assert(true, "");
struct Ctx {
    const float *x_prompt, *x_sample, *cache_k, *cache_v, *state, *norm_w, *w_in, *sinks, *ret_norm_w, *w_out, *final_w;
    float* out; unsigned char* ws;
    int ph_lo, ph_hi;
};

__device__ __forceinline__ unsigned cvtpk(float lo, float hi) { f32x2 v = {lo, hi}; bf16x2_t b = __builtin_convertvector(v, bf16x2_t); return __builtin_bit_cast(unsigned, b); }
__device__ __forceinline__ float bf_lo(unsigned u) { return __uint_as_float(u << 16); }
__device__ __forceinline__ float bf_hi(unsigned u) { return __uint_as_float(u & 0xffff0000u); }
__device__ __forceinline__ float silu_f(float x) { return x * __builtin_amdgcn_rcpf(1.0f + __expf(-x)); }
__device__ __forceinline__ s16x4 vtr(const char* p) { typedef short v4i16_t __attribute__((ext_vector_type(4)));
    return __builtin_bit_cast(s16x4, __builtin_amdgcn_ds_read_tr16_b64_v4i16((LAS v4i16_t*)p)); }
__device__ __forceinline__ bf16x8 cat8(s16x4 lo, s16x4 hi) { return (bf16x8){lo[0], lo[1], lo[2], lo[3], hi[0], hi[1], hi[2], hi[3]}; }
__device__ __forceinline__ float ln_gamma(int h) {
    const double x = __builtin_ldexp(1.0, -5 - h);
    double s = 0.0, p = x;
#pragma unroll
    for (int k = 1; k <= 9; ++k) { s += p / (double)k; p *= x; }
    return (float)(-s);
}
#define LDS_WAIT() asm volatile("s_waitcnt lgkmcnt(0)" ::: "memory")
#define LAUNDER_V(x) asm volatile("" : "+v"(x))
#define LAUNDER_S(x) asm volatile("" : "+s"(x))

__device__ __forceinline__ int perm_src_col(int np, float& sc) {
    sc = 1.0f;
    if (np < 1152) { const int hb = np & ~63, g = np & 63; if (np < 1024) sc = 0.125f; return hb + 4 * (g >> 3) + (g & 3) + 32 * ((g >> 2) & 1); }
    if (np >= C_QB && np < C_VB) { const int hb = np & ~127, g = np & 127; if (np >= C_KB) sc = 0.08838834764831845f; return hb + 4 * (g >> 3) + (g & 3) + 64 * ((g >> 2) & 1); }
    return np;
}

template <bool WIN>
__device__ __forceinline__ void transpose_item(const float* W, int N, const float* nw, bf16* WT, float* scr, int kb, int nb, int lane) {
    const int k0 = 64 * kb, n0 = 64 * nb, l16 = lane & 15, r4 = lane >> 4;
    float sc = 1.0f; int srcc = n0 + 4 * l16;
    if (WIN) srcc = perm_src_col(n0 + 4 * l16, sc);
    f32x4 v[16]; float nwv[16];
#pragma unroll
    for (int i = 0; i < 16; ++i) { const int kk = 4 * i + r4; v[i] = __builtin_nontemporal_load((const f32x4*)(W + (size_t)(k0 + kk) * N + srcc)); nwv[i] = WIN ? nw[k0 + kk] : 1.0f; }
#pragma unroll
    for (int i = 0; i < 16; ++i) {
        const int kk = 4 * i + r4; const float s2 = sc * nwv[i];
        float* d = scr + kk * 65 + 4 * l16;
        d[0] = v[i][0] * s2; d[1] = v[i][1] * s2; d[2] = v[i][2] * s2; d[3] = v[i][3] * s2;
    }
    LDS_WAIT();
    const int c = lane & 7;
#pragma unroll
    for (int j = 0; j < 8; ++j) {
        const int n = (lane >> 3) + 8 * j; const float* s = scr + (8 * c) * 65 + n;
        u32x4 o; o.x = cvtpk(s[0], s[65]); o.y = cvtpk(s[130], s[195]); o.z = cvtpk(s[260], s[325]); o.w = cvtpk(s[390], s[455]);
        *(u32x4*)(WT + (size_t)(n0 + n) * 2048 + k0 + 8 * c) = o;
    }
    LDS_WAIT();
}

__device__ __forceinline__ void convert_weights(const Ctx& C, float* scr, int l, int gw, int NGW, int lane) {
    bf16* WIN = (bf16*)(C.ws + WS_WIN); bf16* WOUT = (bf16*)(C.ws + WS_WOUT);
    constexpr int I_IN = 32 * 100, I_OUT = 32 * 32;
    for (int it = gw; it < I_IN + I_OUT; it += NGW) {
        int r = it;
        if (r < I_IN) { const int nb = r % 100, kb = r / 100;
            transpose_item<true>(C.w_in + (size_t)l * D * NP, NP, C.norm_w + l * D, WIN + (size_t)l * NP * D, scr, kb, nb, lane); }
        else { r -= I_IN; const int nb = r & 31, kb = r >> 5;
            transpose_item<false>(C.w_out + (size_t)l * D * D, D, nullptr, WOUT + (size_t)l * D * D, scr, kb, nb, lane); }
    }
}

__device__ __forceinline__ void p0_prologue(const Ctx& C, char* lds, int tid, int wave, int lane, int G) {
    float* scr = (float*)(lds + wave * 16640);
    const int gw = blockIdx.x * 8 + wave, NGW = G * 8;
    convert_weights(C, scr, 0, gw, NGW, lane);
    bf16* XA = (bf16*)(C.ws + WS_XA); float* rss = (float*)(C.ws + WS_CTL);
    for (int m = gw; m < M; m += 2 * NGW) {
        const int m2 = m + NGW; const bool has2 = m2 < M;
        const float* xr = m < T ? C.x_prompt + (size_t)m * D : C.x_sample + (size_t)(m - T) * D;
        const int m2c = has2 ? m2 : m;
        const float* xr2 = m2c < T ? C.x_prompt + (size_t)m2c * D : C.x_sample + (size_t)(m2c - T) * D;
        f32x4 va[8], vb[8];
#pragma unroll
        for (int j = 0; j < 8; ++j) { va[j] = __builtin_nontemporal_load((const f32x4*)xr + lane + 64 * j); vb[j] = __builtin_nontemporal_load((const f32x4*)xr2 + lane + 64 * j); }
        float ss = 0.f, ss2 = 0.f;
#pragma unroll
        for (int j = 0; j < 8; ++j) {
            ss += (va[j][0] * va[j][0] + va[j][1] * va[j][1]) + (va[j][2] * va[j][2] + va[j][3] * va[j][3]);
            ss2 += (vb[j][0] * vb[j][0] + vb[j][1] * vb[j][1]) + (vb[j][2] * vb[j][2] + vb[j][3] * vb[j][3]);
            u32x2 o; o.x = cvtpk(va[j][0], va[j][1]); o.y = cvtpk(va[j][2], va[j][3]);
            *((u32x2*)(XA + (size_t)m * D) + lane + 64 * j) = o;
            if (has2) { u32x2 o2; o2.x = cvtpk(vb[j][0], vb[j][1]); o2.y = cvtpk(vb[j][2], vb[j][3]); *((u32x2*)(XA + (size_t)m2 * D) + lane + 64 * j) = o2; }
        }
#pragma unroll
        for (int o = 1; o < 64; o <<= 1) { ss += __shfl_xor(ss, o); ss2 += __shfl_xor(ss2, o); }
        if (lane == 0) { rss[m] = ss; if (has2) rss[m2] = ss2; }
    }
    float* cosA = (float*)(C.ws + WS_TAB); float* sinA = cosA + NPOS * 32; float* cosB = sinA + NPOS * 32; float* sinB = cosB + NPOS * 64;
    for (int i = blockIdx.x * NTHREADS + tid; i < NPOS * 96; i += G * NTHREADS) {
        int pos, f, half; float *pc, *ps;
        if (i < NPOS * 32) { pos = i >> 5; f = i & 31; half = 32; pc = cosA + i; ps = sinA + i; }
        else { const int k = i - NPOS * 32; pos = k >> 6; f = k & 63; half = 64; pc = cosB + k; ps = sinB + k; }
        const double rr = half == 32 ? 0.7498942093324559 : 0.8659643233600653;
        double inv = 1.0; for (int k = 0; k < f; ++k) inv *= rr;
        const float ang = (float)pos * (float)inv;
        const double a = (double)ang;
        const double qd = __builtin_rint(a * 0.6366197723675814);
        double r = __builtin_fma(-qd, 1.5707963267948966, a); r = __builtin_fma(-qd, 6.123233995736766e-17, r);
        const double r2 = r * r;
        double sp = -1.0 / 39916800.0; sp = sp * r2 + 1.0 / 362880.0; sp = sp * r2 - 1.0 / 5040.0; sp = sp * r2 + 1.0 / 120.0; sp = sp * r2 - 1.0 / 6.0; sp = sp * r2 + 1.0; sp *= r;
        double cp = 1.0 / 479001600.0; cp = cp * r2 - 1.0 / 3628800.0; cp = cp * r2 + 1.0 / 40320.0; cp = cp * r2 - 1.0 / 720.0; cp = cp * r2 + 1.0 / 24.0; cp = cp * r2 - 0.5; cp = cp * r2 + 1.0;
        const int qi = ((int)qd) & 3;
        const double sv = (qi == 0) ? sp : (qi == 1) ? cp : (qi == 2) ? -sp : -cp;
        const double cv = (qi == 0) ? cp : (qi == 1) ? -sp : (qi == 2) ? -cp : sp;
        *pc = (float)cv; *ps = (float)sv;
    }
}

__device__ __forceinline__ void attn_prompt_unit(const Ctx& C, char* lds, int layer, int blk, int kvh, int hq, int tid, int w, int lane) {
    const bf16* P = (const bf16*)(C.ws + WS_P); bf16* Y = (bf16*)(C.ws + WS_Y);
    char* Ks = lds; char* Vs = lds + 36864;
    const int q = lane & 15, g = lane >> 4;
    const int jt0 = w < 6 ? w : 6;
    const int iq = 16 * w + q, row = blk * 128 + iq;
    bf16x8 qfa[4][2]; u32x2 gta[4][4];
#pragma unroll
    for (int hh = 0; hh < 4; ++hh) {
        const int h = kvh * 8 + hq * 4 + hh;
#pragma unroll
        for (int ks = 0; ks < 2; ++ks) qfa[hh][ks] = *(const bf16x8*)(P + (size_t)row * NP + C_QA + h * 64 + 32 * ks + 8 * g);
#pragma unroll
        for (int dt = 0; dt < 4; ++dt) gta[hh][dt] = *(const u32x2*)(P + (size_t)row * NP + C_GA + h * 64 + 16 * dt + 4 * g);
    }
#pragma unroll
    for (int it = 0; it < 4; ++it) {
        const int r = (tid >> 3) + 64 * it, ch = tid & 7, krow = blk * 128 - 128 + r;
        u32x4 kv = (u32x4){0u, 0u, 0u, 0u}, vv = kv;
        if (krow >= 0) { kv = *(const u32x4*)(P + (size_t)krow * NP + C_KA + kvh * 64 + ch * 8); vv = *(const u32x4*)(P + (size_t)krow * NP + C_VA + kvh * 64 + ch * 8); }
        *(u32x4*)(Ks + r * 144 + ch * 16) = kv; *(u32x4*)(Vs + r * 144 + ch * 16) = vv;
    }
    __syncthreads();
#pragma unroll
    for (int hp = 0; hp < 2; ++hp) {
        const int h0 = kvh * 8 + hq * 4 + 2 * hp;
        f32x4 s0[10], s1[10];
        float mx0 = -INFINITY, mx1 = -INFINITY;
        int lo = (blk > 0 || iq + 1 >= 128) ? iq + 1 : 128; LAUNDER_V(lo);
        const unsigned span = (unsigned)(iq + 128 - lo);
#pragma unroll
        for (int tt = 0; tt < 10; ++tt) {
            const int jt = jt0 + tt;
            const bf16x8 kf0 = *(const bf16x8*)(Ks + (16 * jt + q) * 144 + (8 * g) * 2), kf1 = *(const bf16x8*)(Ks + (16 * jt + q) * 144 + (32 + 8 * g) * 2);
            f32x4 a0 = (f32x4){0.f, 0.f, 0.f, 0.f}, a1 = a0;
            a0 = __builtin_amdgcn_mfma_f32_16x16x32_bf16(kf0, qfa[2 * hp][0], a0, 0, 0, 0); a1 = __builtin_amdgcn_mfma_f32_16x16x32_bf16(kf0, qfa[2 * hp + 1][0], a1, 0, 0, 0);
            a0 = __builtin_amdgcn_mfma_f32_16x16x32_bf16(kf1, qfa[2 * hp][1], a0, 0, 0, 0); a1 = __builtin_amdgcn_mfma_f32_16x16x32_bf16(kf1, qfa[2 * hp + 1][1], a1, 0, 0, 0);
#pragma unroll
            for (int j = 0; j < 4; ++j) {
                const int jj = 16 * jt + 4 * g + j; const bool ok = ((unsigned)(jj - lo) <= span);
                a0[j] = ok ? a0[j] : -INFINITY; a1[j] = ok ? a1[j] : -INFINITY; mx0 = fmaxf(mx0, a0[j]); mx1 = fmaxf(mx1, a1[j]);
            }
            s0[tt] = a0; s1[tt] = a1;
        }
        mx0 = fmaxf(mx0, __shfl_xor(mx0, 16)); mx0 = fmaxf(mx0, __shfl_xor(mx0, 32));
        mx1 = fmaxf(mx1, __shfl_xor(mx1, 16)); mx1 = fmaxf(mx1, __shfl_xor(mx1, 32));
        const float sink0 = C.sinks[layer * 16 + h0], sink1 = C.sinks[layer * 16 + h0 + 1];
        const float mm0 = fmaxf(mx0, sink0), mm1 = fmaxf(mx1, sink1);
        float sum0 = 0.f, sum1 = 0.f;
#pragma unroll
        for (int tt = 0; tt < 10; ++tt)
#pragma unroll
            for (int j = 0; j < 4; ++j) { const float e0 = __expf(s0[tt][j] - mm0), e1 = __expf(s1[tt][j] - mm1); s0[tt][j] = e0; s1[tt][j] = e1; sum0 += e0; sum1 += e1; }
        sum0 += __shfl_xor(sum0, 16); sum0 += __shfl_xor(sum0, 32); sum1 += __shfl_xor(sum1, 16); sum1 += __shfl_xor(sum1, 32);
        const float inv0 = 1.0f / (sum0 + __expf(sink0 - mm0)), inv1 = 1.0f / (sum1 + __expf(sink1 - mm1));
        f32x4 o0[4], o1[4];
#pragma unroll
        for (int dt = 0; dt < 4; ++dt) { o0[dt] = (f32x4){0.f, 0.f, 0.f, 0.f}; o1[dt] = o0[dt]; }
#pragma unroll
        for (int pr = 0; pr < 5; ++pr) {
            const int jt = jt0 + 2 * pr;
            u32x4 pw; pw.x = cvtpk(s0[2 * pr][0], s0[2 * pr][1]); pw.y = cvtpk(s0[2 * pr][2], s0[2 * pr][3]); pw.z = cvtpk(s0[2 * pr + 1][0], s0[2 * pr + 1][1]); pw.w = cvtpk(s0[2 * pr + 1][2], s0[2 * pr + 1][3]);
            const bf16x8 pf0 = __builtin_bit_cast(bf16x8, pw);
            pw.x = cvtpk(s1[2 * pr][0], s1[2 * pr][1]); pw.y = cvtpk(s1[2 * pr][2], s1[2 * pr][3]); pw.z = cvtpk(s1[2 * pr + 1][0], s1[2 * pr + 1][1]); pw.w = cvtpk(s1[2 * pr + 1][2], s1[2 * pr + 1][3]);
            const bf16x8 pf1 = __builtin_bit_cast(bf16x8, pw);
            bf16x8 vf[4];
#pragma unroll
            for (int dt = 0; dt < 4; ++dt) { const char* a0 = Vs + (16 * jt + 4 * g + (q >> 2)) * 144 + (16 * dt + 4 * (q & 3)) * 2; vf[dt] = cat8(vtr(a0), vtr(a0 + 16 * 144)); }
#pragma unroll
            for (int dt = 0; dt < 4; ++dt) { o0[dt] = __builtin_amdgcn_mfma_f32_16x16x32_bf16(vf[dt], pf0, o0[dt], 0, 0, 0); o1[dt] = __builtin_amdgcn_mfma_f32_16x16x32_bf16(vf[dt], pf1, o1[dt], 0, 0, 0); }
        }
#pragma unroll
        for (int dt = 0; dt < 4; ++dt) {
            const int dcol = h0 * 64 + 16 * dt + 4 * g;
            const u32x2 gt0 = gta[2 * hp][dt], gt1 = gta[2 * hp + 1][dt];
            u32x2 yo; yo.x = cvtpk(o0[dt][0] * inv0 * silu_f(bf_lo(gt0.x)), o0[dt][1] * inv0 * silu_f(bf_hi(gt0.x)));
            yo.y = cvtpk(o0[dt][2] * inv0 * silu_f(bf_lo(gt0.y)), o0[dt][3] * inv0 * silu_f(bf_hi(gt0.y)));
            *(u32x2*)(Y + (size_t)row * D + dcol) = yo;
            yo.x = cvtpk(o1[dt][0] * inv1 * silu_f(bf_lo(gt1.x)), o1[dt][1] * inv1 * silu_f(bf_hi(gt1.x)));
            yo.y = cvtpk(o1[dt][2] * inv1 * silu_f(bf_lo(gt1.y)), o1[dt][3] * inv1 * silu_f(bf_hi(gt1.y)));
            *(u32x2*)(Y + (size_t)row * D + dcol + 64) = yo;
        }
    }
    __syncthreads();
}

__device__ __forceinline__ void stage128_load(u32x4 (&v)[4], const bf16* src, size_t src_pitch, int tid) {
#pragma unroll
    for (int it = 0; it < 4; ++it) { const int r = (tid >> 4) + 32 * it, ch = tid & 15; v[it] = *(const u32x4*)(src + (size_t)r * src_pitch + ch * 8); }
}
template <bool SCALE>
__device__ __forceinline__ void stage128_store(char* dst, const u32x4 (&vin)[4], int tid, float lng) {
#pragma unroll
    for (int it = 0; it < 4; ++it) {
        const int r = (tid >> 4) + 32 * it, ch = tid & 15;
        u32x4 v = vin[it];
        if (SCALE) { const float sc = __expf((float)(127 - r) * lng);
            v.x = cvtpk(bf_lo(v.x) * sc, bf_hi(v.x) * sc); v.y = cvtpk(bf_lo(v.y) * sc, bf_hi(v.y) * sc); v.z = cvtpk(bf_lo(v.z) * sc, bf_hi(v.z) * sc); v.w = cvtpk(bf_lo(v.w) * sc, bf_hi(v.w) * sc); }
        *(u32x4*)(dst + r * 272 + ch * 16) = v;
    }
}

__device__ __forceinline__ void ret_u_unit(const Ctx& C, char* lds, int c, int h, int tid, int w, int lane, unsigned* ucnt) {
    const bf16* P = (const bf16*)(C.ws + WS_P); float* U = (float*)(C.ws + WS_U);
    char* Ks = lds; char* Vs = lds + 34816;
    const float lng = ln_gamma(h);
    { u32x4 sk[4], sv[4];
      stage128_load(sk, P + (size_t)(c * 128) * NP + C_KB + h * 128, NP, tid); stage128_load(sv, P + (size_t)(c * 128) * NP + C_VB + h * 128, NP, tid);
      stage128_store<false>(Ks, sk, tid, lng); stage128_store<true>(Vs, sv, tid, lng); }
    __syncthreads();
    const int q = lane & 15, g = lane >> 4;
    f32x4 acc[8];
#pragma unroll
    for (int dt = 0; dt < 8; ++dt) acc[dt] = (f32x4){0.f, 0.f, 0.f, 0.f};
#pragma unroll
    for (int ks = 0; ks < 4; ++ks) {
        const int rbase = (32 * ks + 8 * g + (q >> 2)) * 272 + 4 * (q & 3) * 2;
        const bf16x8 vf = cat8(vtr(Vs + rbase + 32 * w), vtr(Vs + rbase + 32 * w + 4 * 272));
#pragma unroll
        for (int dt = 0; dt < 8; ++dt) {
            const bf16x8 kf = cat8(vtr(Ks + rbase + 32 * dt), vtr(Ks + rbase + 32 * dt + 4 * 272));
            acc[dt] = __builtin_amdgcn_mfma_f32_16x16x32_bf16(vf, kf, acc[dt], 0, 0, 0);
        }
    }
    float* Ub = U + (size_t)(c * 8 + h) * 16384;
#pragma unroll
    for (int dt = 0; dt < 8; ++dt)
#pragma unroll
        for (int j = 0; j < 4; ++j) __hip_atomic_store(Ub + (16 * w + 4 * g + j) * 128 + 16 * dt + q, acc[dt][j], __ATOMIC_RELAXED, __HIP_MEMORY_SCOPE_AGENT);
    asm volatile("s_waitcnt vmcnt(0)" ::: "memory");
    __syncthreads();
    if (tid == 0) __hip_atomic_fetch_add(ucnt, 1u, __ATOMIC_RELAXED, __HIP_MEMORY_SCOPE_AGENT);
}

__device__ __forceinline__ void ret_scan(const Ctx& C, int layer, int tid, int G) {
    const float* U = (const float*)(C.ws + WS_U); bf16* Rt = (bf16*)(C.ws + WS_RT);
    for (int i = blockIdx.x * NTHREADS + tid; i < 8 * 16384; i += G * NTHREADS) {
        const int h = i >> 14, e = (i >> 7) & 127, d = i & 127;
        const float gc = __expf(128.0f * ln_gamma(h));
        float r = 0.f;
#pragma unroll 1
        for (int c0 = 0; c0 < 64; c0 += 32) {
            float u[32];
#pragma unroll
            for (int k = 0; k < 32; ++k) u[k] = __builtin_nontemporal_load(U + (size_t)((c0 + k) * 8) * 16384 + i);
#pragma unroll
            for (int k = 0; k < 32; ++k) { Rt[(size_t)((c0 + k) * 8) * 16384 + i] = (bf16)(cvtpk(r, 0.f) & 0xffffu); r = gc * r + u[k]; }
        }
        const int dorig = 4 * (d >> 3) + (d & 3) + 64 * ((d >> 2) & 1);
        C.out[O_RP + ((size_t)(layer * 8 + h) * 128 + dorig) * 128 + e] = r;
    }
}

__device__ __forceinline__ void ret_prompt_unit(const Ctx& C, char* lds, int layer, int c, int h, int tid, int w, int lane) {
    const bf16* P = (const bf16*)(C.ws + WS_P); bf16* Y = (bf16*)(C.ws + WS_Y); const bf16* Rt = (const bf16*)(C.ws + WS_RT);
    char* Ks = lds; char* Vs = lds + 34816; char* Rs = lds + 69632;
    const float lng = ln_gamma(h);
    const int q = lane & 15, g = lane >> 4;
    const int n = 16 * w + q, row = c * 128 + n;
    bf16x8 qf[4]; u32x2 gta[8];
#pragma unroll
    for (int ks = 0; ks < 4; ++ks) qf[ks] = *(const bf16x8*)(P + (size_t)row * NP + C_QB + h * 128 + 32 * ks + 8 * g);
#pragma unroll
    for (int et = 0; et < 8; ++et) gta[et] = *(const u32x2*)(P + (size_t)row * NP + C_GB + h * 128 + 16 * et + 4 * g);
    { u32x4 sk[4], sv[4], sr[4];
      stage128_load(sk, P + (size_t)(c * 128) * NP + C_KB + h * 128, NP, tid); stage128_load(sv, P + (size_t)(c * 128) * NP + C_VB + h * 128, NP, tid);
      stage128_load(sr, Rt + (size_t)(c * 8 + h) * 16384, 128, tid);
      stage128_store<false>(Ks, sk, tid, lng); stage128_store<false>(Vs, sv, tid, lng); stage128_store<false>(Rs, sr, tid, lng); }
    __syncthreads();
    unsigned pk[8][2];
#pragma unroll
    for (int mt = 0; mt < 8; ++mt) {
        pk[mt][0] = 0u; pk[mt][1] = 0u;
        if (mt <= w) {
            f32x4 a = (f32x4){0.f, 0.f, 0.f, 0.f};
#pragma unroll
            for (int ks = 0; ks < 4; ++ks) { const bf16x8 kf = *(const bf16x8*)(Ks + (16 * mt + q) * 272 + (32 * ks + 8 * g) * 2); a = __builtin_amdgcn_mfma_f32_16x16x32_bf16(kf, qf[ks], a, 0, 0, 0); }
            float v[4];
#pragma unroll
            for (int j = 0; j < 4; ++j) { const int dl = n - (16 * mt + 4 * g + j); v[j] = dl >= 0 ? a[j] * __expf((float)dl * lng) : 0.f; }
            pk[mt][0] = cvtpk(v[0], v[1]); pk[mt][1] = cvtpk(v[2], v[3]);
        }
    }
    f32x4 oi[8], ox[8];
#pragma unroll
    for (int et = 0; et < 8; ++et) { oi[et] = (f32x4){0.f, 0.f, 0.f, 0.f}; ox[et] = oi[et]; }
#pragma unroll
    for (int pr = 0; pr < 4; ++pr) {
        if (2 * pr <= w) {
            u32x4 pw; pw.x = pk[2 * pr][0]; pw.y = pk[2 * pr][1]; pw.z = pk[2 * pr + 1][0]; pw.w = pk[2 * pr + 1][1];
            const bf16x8 pf = __builtin_bit_cast(bf16x8, pw);
#pragma unroll
            for (int et = 0; et < 8; ++et) {
                const char* a0 = Vs + (32 * pr + 4 * g + (q >> 2)) * 272 + (16 * et + 4 * (q & 3)) * 2;
                oi[et] = __builtin_amdgcn_mfma_f32_16x16x32_bf16(cat8(vtr(a0), vtr(a0 + 16 * 272)), pf, oi[et], 0, 0, 0);
            }
        }
    }
#pragma unroll
    for (int et = 0; et < 8; ++et)
#pragma unroll
        for (int ks = 0; ks < 4; ++ks) { const bf16x8 rf = *(const bf16x8*)(Rs + (16 * et + q) * 272 + (32 * ks + 8 * g) * 2); ox[et] = __builtin_amdgcn_mfma_f32_16x16x32_bf16(rf, qf[ks], ox[et], 0, 0, 0); }
    const float qdec = __expf((float)(n + 1) * lng);
    float sum = 0.f;
#pragma unroll
    for (int et = 0; et < 8; ++et) { oi[et] = oi[et] + ox[et] * qdec; sum += (oi[et][0] + oi[et][1]) + (oi[et][2] + oi[et][3]); }
    sum += __shfl_xor(sum, 16); sum += __shfl_xor(sum, 32);
    const float mu = sum * (1.0f / 128.0f);
    float var = 0.f;
#pragma unroll
    for (int et = 0; et < 8; ++et) { oi[et] = oi[et] - mu; var += (oi[et][0] * oi[et][0] + oi[et][1] * oi[et][1]) + (oi[et][2] * oi[et][2] + oi[et][3] * oi[et][3]); }
    var += __shfl_xor(var, 16); var += __shfl_xor(var, 32);
    const float rs = rsqrtf(var * (1.0f / 128.0f) + 1e-6f);
    const float* gw = C.ret_norm_w + layer * 1024 + h * 128;
#pragma unroll
    for (int et = 0; et < 8; ++et) {
        const int e0 = 16 * et + 4 * g;
        const u32x2 gt = gta[et];
        const f32x4 wv = *(const f32x4*)(gw + e0);
        u32x2 yo; yo.x = cvtpk(oi[et][0] * rs * wv[0] * silu_f(bf_lo(gt.x)), oi[et][1] * rs * wv[1] * silu_f(bf_hi(gt.x)));
        yo.y = cvtpk(oi[et][2] * rs * wv[2] * silu_f(bf_lo(gt.y)), oi[et][3] * rs * wv[3] * silu_f(bf_hi(gt.y)));
        *(u32x2*)(Y + (size_t)row * D + 1024 + h * 128 + e0) = yo;
    }
    __syncthreads();
}

__device__ __forceinline__ void attn_sample_unit(const Ctx& C, char* lds, int layer, int b, int kvh, int tid) {
    const bf16* P = (const bf16*)(C.ws + WS_P); bf16* Y = (bf16*)(C.ws + WS_Y);
    float* Qs = (float*)lds;
    float* Kl = Qs + 32 * 65;
    float* Vl = Kl + 132 * 68;
    float* Pm = Vl + 132 * 68;
    const float* ck = C.cache_k + ((size_t)(layer * 128 + b) * 128) * 128 + kvh * 64;
    const float* cv = C.cache_v + ((size_t)(layer * 128 + b) * 128) * 128 + kvh * 64;
    float* ok = C.out + O_KS + ((size_t)(layer * 128 + b) * 128) * 128 + kvh * 64;
    float* ov = C.out + O_VS + ((size_t)(layer * 128 + b) * 128) * 128 + kvh * 64;
    {
        f32x4 kq[4], vq[4];
#pragma unroll
        for (int it = 0; it < 4; ++it) { const int i = tid + NTHREADS * it, r = i >> 4, c4 = i & 15;
            kq[it] = __builtin_nontemporal_load((const f32x4*)(ck + (size_t)r * 128 + 4 * c4)); vq[it] = __builtin_nontemporal_load((const f32x4*)(cv + (size_t)r * 128 + 4 * c4)); }
#pragma unroll
        for (int it = 0; it < 4; ++it) { const int i = tid + NTHREADS * it, r = i >> 4, c4 = i & 15;
            *(f32x4*)(Kl + r * 68 + 4 * c4) = kq[it]; *(f32x4*)(Vl + r * 68 + 4 * c4) = vq[it];
            if (r >= 4) { __builtin_nontemporal_store(kq[it], (f32x4*)(ok + (size_t)(r - 4) * 128 + 4 * c4)); __builtin_nontemporal_store(vq[it], (f32x4*)(ov + (size_t)(r - 4) * 128 + 4 * c4)); } }
    }
    if (tid < 256) { const int t = tid >> 6, g = tid & 63; const size_t ro = (size_t)(T + 4 * b + t) * NP;
        const int dk = 4 * (g >> 3) + (g & 3) + 32 * ((g >> 2) & 1);
        Kl[(128 + t) * 68 + dk] = __uint_as_float((unsigned)P[ro + C_KA + kvh * 64 + g] << 16);
        Vl[(128 + t) * 68 + g] = __uint_as_float((unsigned)P[ro + C_VA + kvh * 64 + g] << 16); }
    for (int i = tid; i < 32 * 64; i += NTHREADS) {
        const int r = i >> 6, g = i & 63, hg = r >> 2, t = r & 3;
        const int dk = 4 * (g >> 3) + (g & 3) + 32 * ((g >> 2) & 1);
        Qs[r * 65 + dk] = __uint_as_float((unsigned)P[(size_t)(T + 4 * b + t) * NP + C_QA + (kvh * 8 + hg) * 64 + g] << 16);
    }
    __syncthreads();
    {
        const int r = tid >> 4, kg = tid & 15, t = r & 3, h = kvh * 8 + (r >> 2);
        float mx = -INFINITY;
        f32x4 qr[16];
#pragma unroll
        for (int i = 0; i < 16; ++i) qr[i] = (f32x4){Qs[r * 65 + 4 * i], Qs[r * 65 + 4 * i + 1], Qs[r * 65 + 4 * i + 2], Qs[r * 65 + 4 * i + 3]};
#pragma unroll 1
        for (int it = 0; it < 9; ++it) {
            const int kk = kg + 16 * it;
            float a = -INFINITY;
            if (kk < 132) {
                const bool valid = kk < 128 ? (kk > t) : (kk - 128 <= t);
                if (valid) { f32x4 a4 = (f32x4){0.f, 0.f, 0.f, 0.f};
#pragma unroll
                    for (int i = 0; i < 16; ++i) a4 += qr[i] * *(const f32x4*)(Kl + kk * 68 + 4 * i);
                    a = (a4[0] + a4[1]) + (a4[2] + a4[3]); }
                Pm[r * 133 + kk] = a;
            }
            mx = fmaxf(mx, a);
        }
#pragma unroll
        for (int o = 1; o < 16; o <<= 1) mx = fmaxf(mx, __shfl_xor(mx, o));
        const float sink = C.sinks[layer * 16 + h];
        const float mm = fmaxf(mx, sink);
        float sum = 0.f;
#pragma unroll 1
        for (int it = 0; it < 9; ++it) { const int kk = kg + 16 * it; if (kk < 132) { const float e = __expf(Pm[r * 133 + kk] - mm); Pm[r * 133 + kk] = e; sum += e; } }
#pragma unroll
        for (int o = 1; o < 16; o <<= 1) sum += __shfl_xor(sum, o);
        const float inv = 1.0f / (sum + __expf(sink - mm));
#pragma unroll 1
        for (int it = 0; it < 9; ++it) { const int kk = kg + 16 * it; if (kk < 132) Pm[r * 133 + kk] *= inv; }
    }
    __syncthreads();
    {
        const int r = tid >> 4, dq = tid & 15, t = r & 3, h = kvh * 8 + (r >> 2);
        f32x4 o = (f32x4){0.f, 0.f, 0.f, 0.f};
        for (int kk = 0; kk < 132; ++kk) { const float p = Pm[r * 133 + kk]; const f32x4 v = *(const f32x4*)(Vl + kk * 68 + 4 * dq); o += v * p; }
        const size_t row = (size_t)(T + 4 * b + t);
        const u32x2 gt = *(const u32x2*)(P + row * NP + C_GA + h * 64 + 4 * dq);
        u32x2 yo; yo.x = cvtpk(o[0] * silu_f(bf_lo(gt.x)), o[1] * silu_f(bf_hi(gt.x))); yo.y = cvtpk(o[2] * silu_f(bf_lo(gt.y)), o[3] * silu_f(bf_hi(gt.y)));
        *(u32x2*)(Y + row * D + h * 64 + 4 * dq) = yo;
    }
    __syncthreads();
}

__device__ __forceinline__ void attn_sample_mfma(const Ctx& C, char* lds, int layer, int b, int kvh, int tid, int w, int lane) {
    const bf16* P = (const bf16*)(C.ws + WS_P); bf16* Y = (bf16*)(C.ws + WS_Y);
    char* Ks = lds; char* Vs = lds + 20736;
    const int q = lane & 15, g = lane >> 4, qt = w & 1, dtl = w >> 1;
    const int r = 16 * qt + q, t = r & 3, h = kvh * 8 + (r >> 2);
    const size_t row = (size_t)(T + 4 * b + t);
    bf16x8 qf[2];
#pragma unroll
    for (int ks = 0; ks < 2; ++ks) qf[ks] = *(const bf16x8*)(P + row * NP + C_QA + h * 64 + 32 * ks + 8 * g);
    const u32x2 gt = *(const u32x2*)(P + row * NP + C_GA + h * 64 + 16 * dtl + 4 * g);
    const float sink = C.sinks[layer * 16 + h];
    const float* ck = C.cache_k + ((size_t)(layer * 128 + b) * 128) * 128 + kvh * 64;
    const float* cv = C.cache_v + ((size_t)(layer * 128 + b) * 128) * 128 + kvh * 64;
    float* ok = C.out + O_KS + ((size_t)(layer * 128 + b) * 128) * 128 + kvh * 64;
    float* ov = C.out + O_VS + ((size_t)(layer * 128 + b) * 128) * 128 + kvh * 64;
    {
        f32x4 kq[4], vq[4];
#pragma unroll
        for (int it = 0; it < 4; ++it) { const int i = tid + NTHREADS * it, rr = i >> 4, c4 = i & 15;
            kq[it] = __builtin_nontemporal_load((const f32x4*)(ck + (size_t)rr * 128 + 4 * c4)); vq[it] = __builtin_nontemporal_load((const f32x4*)(cv + (size_t)rr * 128 + 4 * c4)); }
        u32x4 nk = (u32x4){0u, 0u, 0u, 0u}, nv = nk;
        if (tid < 32) { const int tt = tid >> 3, ch = tid & 7; const size_t ro = (size_t)(T + 4 * b + tt) * NP;
            nk = *(const u32x4*)(P + ro + C_KA + kvh * 64 + 8 * ch); nv = *(const u32x4*)(P + ro + C_VA + kvh * 64 + 8 * ch); }
#pragma unroll
        for (int it = 0; it < 4; ++it) { const int i = tid + NTHREADS * it, rr = i >> 4, c4 = i & 15;
            u32x2 kb; kb.x = cvtpk(kq[it][0], kq[it][1]); kb.y = cvtpk(kq[it][2], kq[it][3]);
            u32x2 vb; vb.x = cvtpk(vq[it][0], vq[it][1]); vb.y = cvtpk(vq[it][2], vq[it][3]);
            *(u32x2*)(Ks + rr * 144 + (8 * (c4 & 7) + 4 * (c4 >> 3)) * 2) = kb;
            *(u32x2*)(Vs + rr * 144 + 8 * c4) = vb;
            if (rr >= 4) { __builtin_nontemporal_store(kq[it], (f32x4*)(ok + (size_t)(rr - 4) * 128 + 4 * c4)); __builtin_nontemporal_store(vq[it], (f32x4*)(ov + (size_t)(rr - 4) * 128 + 4 * c4)); } }
        if (tid < 32) { const int tt = tid >> 3, ch = tid & 7; *(u32x4*)(Ks + (128 + tt) * 144 + 16 * ch) = nk; *(u32x4*)(Vs + (128 + tt) * 144 + 16 * ch) = nv; }
        else if (tid < 32 + 28 * 8) { const int z = tid - 32, zr = 132 + (z >> 3), ch = z & 7;
            const u32x4 zz = (u32x4){0u, 0u, 0u, 0u};
            if (zr < 144) *(u32x4*)(Ks + zr * 144 + 16 * ch) = zz;
            *(u32x4*)(Vs + zr * 144 + 16 * ch) = zz; }
    }
    __syncthreads();
    f32x4 s[10];
    float mx = -INFINITY;
#pragma unroll
    for (int tt = 0; tt < 9; ++tt) {
        f32x4 a = (f32x4){0.f, 0.f, 0.f, 0.f};
#pragma unroll
        for (int ks = 0; ks < 2; ++ks) { const bf16x8 kf = *(const bf16x8*)(Ks + (16 * tt + q) * 144 + (32 * ks + 8 * g) * 2); a = __builtin_amdgcn_mfma_f32_16x16x32_bf16(kf, qf[ks], a, 0, 0, 0); }
#pragma unroll
        for (int j = 0; j < 4; ++j) {
            const int kk = 16 * tt + 4 * g + j;
            const bool valid = kk < 128 ? (kk > t) : (kk - 128 <= t);
            a[j] = valid ? a[j] : -INFINITY; mx = fmaxf(mx, a[j]);
        }
        s[tt] = a;
    }
    s[9] = (f32x4){0.f, 0.f, 0.f, 0.f};
    mx = fmaxf(mx, __shfl_xor(mx, 16)); mx = fmaxf(mx, __shfl_xor(mx, 32));
    const float mm = fmaxf(mx, sink);
    float sum = 0.f;
#pragma unroll
    for (int tt = 0; tt < 9; ++tt)
#pragma unroll
        for (int j = 0; j < 4; ++j) { const float e = __expf(s[tt][j] - mm); s[tt][j] = e; sum += e; }
    sum += __shfl_xor(sum, 16); sum += __shfl_xor(sum, 32);
    const float inv = __builtin_amdgcn_rcpf(sum + __expf(sink - mm));
    f32x4 o = (f32x4){0.f, 0.f, 0.f, 0.f};
#pragma unroll
    for (int pr = 0; pr < 5; ++pr) {
        u32x4 pw; pw.x = cvtpk(s[2 * pr][0], s[2 * pr][1]); pw.y = cvtpk(s[2 * pr][2], s[2 * pr][3]); pw.z = cvtpk(s[2 * pr + 1][0], s[2 * pr + 1][1]); pw.w = cvtpk(s[2 * pr + 1][2], s[2 * pr + 1][3]);
        const char* a0 = Vs + (32 * pr + 4 * g + (q >> 2)) * 144 + (16 * dtl + 4 * (q & 3)) * 2;
        o = __builtin_amdgcn_mfma_f32_16x16x32_bf16(cat8(vtr(a0), vtr(a0 + 16 * 144)), __builtin_bit_cast(bf16x8, pw), o, 0, 0, 0);
    }
    u32x2 yo; yo.x = cvtpk(o[0] * inv * silu_f(bf_lo(gt.x)), o[1] * inv * silu_f(bf_hi(gt.x))); yo.y = cvtpk(o[2] * inv * silu_f(bf_lo(gt.y)), o[3] * inv * silu_f(bf_hi(gt.y)));
    *(u32x2*)(Y + row * D + h * 64 + 16 * dtl + 4 * g) = yo;
    __syncthreads();
}

__device__ __forceinline__ void ret_sample_group(const Ctx& C, char* lds, int layer, int ug, int tid, int w, int lane) {
    const bf16* P = (const bf16*)(C.ws + WS_P); bf16* Y = (bf16*)(C.ws + WS_Y);
    const int idx = 4 * ug + (w >> 1), b = idx >> 3, h = idx & 7, eh = w & 1;
    float* qs = (float*)(lds + w * 4096);
    float* ksm = qs + 512;
    float* pst = (float*)(lds + 32768);
    const float lng = ln_gamma(h);
    const size_t ro = (size_t)(T + 4 * b) * NP;
    float qv[4][2], kv[4][2];
    {
        const int g0 = 2 * lane, g1 = g0 + 1;
        const int d0 = 4 * (g0 >> 3) + (g0 & 3) + 64 * ((g0 >> 2) & 1), d1 = 4 * (g1 >> 3) + (g1 & 3) + 64 * ((g1 >> 2) & 1);
#pragma unroll
        for (int t = 0; t < 4; ++t) {
            const unsigned qq = *(const unsigned*)(P + ro + (size_t)t * NP + C_QB + h * 128 + g0), kk = *(const unsigned*)(P + ro + (size_t)t * NP + C_KB + h * 128 + g0);
            qv[t][0] = bf_lo(qq); qv[t][1] = bf_hi(qq); kv[t][0] = bf_lo(kk); kv[t][1] = bf_hi(kk);
            const float kd = __expf((float)(3 - t) * lng);
            qs[t * 128 + d0] = qv[t][0]; qs[t * 128 + d1] = qv[t][1]; ksm[t * 128 + d0] = kv[t][0] * kd; ksm[t * 128 + d1] = kv[t][1] * kd;
        }
    }
    const int e4 = lane & 15, dq = lane >> 4, e = eh * 64 + 4 * e4;
    f32x4 vm[4];
#pragma unroll
    for (int m = 0; m < 4; ++m) { const u32x2 vv = *(const u32x2*)(P + ro + (size_t)m * NP + C_VB + h * 128 + e); vm[m] = (f32x4){bf_lo(vv.x), bf_hi(vv.x), bf_lo(vv.y), bf_hi(vv.y)}; }
    float* Aw = (float*)(lds + 33024) + w * 16;
#pragma unroll
    for (int t = 0; t < 4; ++t)
#pragma unroll
        for (int m = 0; m < 4; ++m) {
            float a = 0.f;
            if (m <= t) { a = qv[t][0] * kv[m][0] + qv[t][1] * kv[m][1];
#pragma unroll
                for (int o = 1; o < 64; o <<= 1) a += __shfl_xor(a, o);
                a *= __expf((float)(t - m) * lng); }
            if (lane == 0) Aw[t * 4 + m] = a;
        }
    LDS_WAIT();
    const float* r0 = C.state + ((size_t)(layer * 128 + b) * 8 + h) * 16384 + e;
    float* rout = C.out + O_RS + ((size_t)(layer * 128 + b) * 8 + h) * 16384 + e;
    const float g4 = __expf(4.0f * lng);
    f32x4 acc[4];
#pragma unroll
    for (int t = 0; t < 4; ++t) acc[t] = (f32x4){0.f, 0.f, 0.f, 0.f};
#pragma unroll 1
    for (int i0 = 0; i0 < 32; i0 += 8) {
        f32x4 r[8];
#pragma unroll
        for (int k = 0; k < 8; ++k) r[k] = __builtin_nontemporal_load((const f32x4*)(r0 + (4 * (i0 + k) + dq) * 128));
#pragma unroll
        for (int k = 0; k < 8; ++k) {
            const int d = 4 * (i0 + k) + dq;
            const f32x4 rn = r[k] * g4 + vm[0] * ksm[d] + vm[1] * ksm[128 + d] + vm[2] * ksm[256 + d] + vm[3] * ksm[384 + d];
            __builtin_nontemporal_store(rn, (f32x4*)(rout + d * 128));
#pragma unroll
            for (int t = 0; t < 4; ++t) acc[t] += r[k] * qs[t * 128 + d];
        }
    }
    float o[4][4]; float s1[4], s2[4];
#pragma unroll
    for (int t = 0; t < 4; ++t) {
        const float qd = __expf((float)(t + 1) * lng);
        s1[t] = 0.f; s2[t] = 0.f;
#pragma unroll
        for (int j = 0; j < 4; ++j) {
            float a = acc[t][j]; a += __shfl_xor(a, 16); a += __shfl_xor(a, 32);
            a *= qd;
#pragma unroll
            for (int m = 0; m < 4; ++m) a += Aw[t * 4 + m] * vm[m][j];
            o[t][j] = a; s1[t] += a; s2[t] += a * a;
        }
#pragma unroll
        for (int k = 1; k < 16; k <<= 1) { s1[t] += __shfl_xor(s1[t], k); s2[t] += __shfl_xor(s2[t], k); }
        if (lane == 0) { pst[(w * 4 + t) * 2] = s1[t]; pst[(w * 4 + t) * 2 + 1] = s2[t]; }
    }
    __syncthreads();
    if (lane < 16) {
        const float* gw = C.ret_norm_w + layer * 1024 + h * 128 + e;
        const f32x4 wv = *(const f32x4*)gw;
#pragma unroll
        for (int t = 0; t < 4; ++t) {
            const float S1 = pst[(w * 4 + t) * 2] + pst[((w ^ 1) * 4 + t) * 2], S2 = pst[(w * 4 + t) * 2 + 1] + pst[((w ^ 1) * 4 + t) * 2 + 1];
            const float mu = S1 * (1.0f / 128.0f), var = fmaxf(S2 * (1.0f / 128.0f) - mu * mu, 0.f), rs = rsqrtf(var + 1e-6f);
            const size_t row = (size_t)(T + 4 * b + t);
            const u32x2 gt = *(const u32x2*)(P + row * NP + C_GB + h * 128 + e);
            u32x2 yo; yo.x = cvtpk((o[t][0] - mu) * rs * wv[0] * silu_f(bf_lo(gt.x)), (o[t][1] - mu) * rs * wv[1] * silu_f(bf_hi(gt.x)));
            yo.y = cvtpk((o[t][2] - mu) * rs * wv[2] * silu_f(bf_lo(gt.y)), (o[t][3] - mu) * rs * wv[3] * silu_f(bf_hi(gt.y)));
            *(u32x2*)(Y + row * D + 1024 + h * 128 + e) = yo;
        }
    }
    __syncthreads();
}

__device__ __forceinline__ void outproj_sample_unit(const Ctx& C, char* lds, int layer, int u, int tid, int w, int lane) {
    const bf16* Yb = (const bf16*)(C.ws + WS_Y) + (size_t)T * D; const bf16* Wt = (const bf16*)(C.ws + WS_WOUT) + (size_t)layer * D * D;
    const int m0 = (u >> 5) * 64, n0 = (u & 31) * 64, q = lane & 15, g = lane >> 4, k0 = 256 * w;
    f32x4 acc[4][4];
#pragma unroll
    for (int nt = 0; nt < 4; ++nt)
#pragma unroll
        for (int mt = 0; mt < 4; ++mt) acc[nt][mt] = (f32x4){0.f, 0.f, 0.f, 0.f};
    const int em = tid >> 3, en8 = (tid & 7) * 8;
    f32x4 rz0, rz1;
    { const u32x4 xb = *(const u32x4*)((const bf16*)(C.ws + WS_XA) + (size_t)(T + m0 + em) * D + n0 + en8);
        rz0 = (f32x4){bf_lo(xb.x), bf_hi(xb.x), bf_lo(xb.y), bf_hi(xb.y)}; rz1 = (f32x4){bf_lo(xb.z), bf_hi(xb.z), bf_lo(xb.w), bf_hi(xb.w)}; }
    const bf16* ap = Wt + (size_t)(n0 + q) * D + k0 + 8 * g;
    const bf16* bp = Yb + (size_t)(m0 + q) * D + k0 + 8 * g;
    bf16x8 af[2][2][4], bfr[2][2][4];
#define OSU_LOAD(buf, kb) do { _Pragma("unroll") for (int ks = 0; ks < 2; ++ks) _Pragma("unroll") for (int t4 = 0; t4 < 4; ++t4) { \
        af[buf][ks][t4] = *(const bf16x8*)(ap + (size_t)(16 * t4) * D + 64 * (kb) + 32 * ks); bfr[buf][ks][t4] = *(const bf16x8*)(bp + (size_t)(16 * t4) * D + 64 * (kb) + 32 * ks); } } while (0)
    OSU_LOAD(0, 0);
#pragma unroll
    for (int kb = 0; kb < 4; ++kb) {
        if (kb + 1 < 4) { if ((kb & 1) == 0) OSU_LOAD(1, kb + 1); else OSU_LOAD(0, kb + 1); }
#pragma unroll
        for (int ks = 0; ks < 2; ++ks)
#pragma unroll
            for (int nt = 0; nt < 4; ++nt)
#pragma unroll
                for (int mt = 0; mt < 4; ++mt) acc[nt][mt] = __builtin_amdgcn_mfma_f32_16x16x32_bf16(af[kb & 1][ks][nt], bfr[kb & 1][ks][mt], acc[nt][mt], 0, 0, 0);
    }
#undef OSU_LOAD
    float* part = (float*)lds + w * (64 * 68);
#pragma unroll
    for (int nt = 0; nt < 4; ++nt)
#pragma unroll
        for (int mt = 0; mt < 4; ++mt) *(f32x4*)(part + (16 * mt + q) * 68 + 16 * nt + 4 * g) = acc[nt][mt];
    __syncthreads();
    {
        const int m = tid >> 3, n8 = (tid & 7) * 8;
        f32x4 v0 = (f32x4){0.f, 0.f, 0.f, 0.f}, v1 = v0;
#pragma unroll
        for (int ww = 0; ww < 8; ++ww) { const float* pp = (const float*)lds + ww * (64 * 68) + m * 68 + n8; v0 += *(const f32x4*)pp; v1 += *(const f32x4*)(pp + 4); }
        const int rs_ = m0 + m;
        v0 += rz0; v1 += rz1;
        if (layer != 0) { float* op = C.out + (size_t)(T + rs_) * D + n0 + n8; *(f32x4*)op = v0; *(f32x4*)(op + 4) = v1; }
        if (layer == 0) { u32x4 wv; wv.x = cvtpk(v0[0], v0[1]); wv.y = cvtpk(v0[2], v0[3]); wv.z = cvtpk(v1[0], v1[1]); wv.w = cvtpk(v1[2], v1[3]);
            *(u32x4*)((bf16*)(C.ws + WS_XA) + (size_t)(T + rs_) * D + n0 + n8) = wv; }
        float ss = (v0[0] * v0[0] + v0[1] * v0[1]) + (v0[2] * v0[2] + v0[3] * v0[3]) + (v1[0] * v1[0] + v1[1] * v1[1]) + (v1[2] * v1[2] + v1[3] * v1[3]);
        ss += __shfl_xor(ss, 1); ss += __shfl_xor(ss, 2); ss += __shfl_xor(ss, 4);
        if ((tid & 7) == 0) atomicAdd((float*)(C.ws + WS_CTL) + (layer + 1) * M + T + rs_, ss);
    }
    __syncthreads();
}

#ifndef SKIPM
#define SKIPM 0
#endif
#ifndef REPU
#define REPU 0
#endif
#ifndef REP_P0
#define REP_P0 1
#endif
#ifndef REP_G1
#define REP_G1 1
#endif
#ifndef REP_MX1
#define REP_MX1 1
#endif
#ifndef REP_RP
#define REP_RP 1
#endif
#ifndef REP_G2
#define REP_G2 1
#endif

#define GAS __attribute__((address_space(1)))
typedef GAS unsigned gu32;
#define XB_TMO      128
#define XB_XCNT(j)  (256  + 64 * (j))
#define XB_XSUB(j)  (1280 + 64 * (j))
#define XB_XGEN(j)  (2304 + 64 * (j))
#define XB_TOP      3328
#define XB_TOPGEN   3392
#define XCD_BAR_WORDS 3456
#define XB_SPIN_CAP (1u << 18)

__device__ __forceinline__ unsigned xb_ld(unsigned* p)              { return __hip_atomic_load(p, __ATOMIC_RELAXED, __HIP_MEMORY_SCOPE_AGENT); }
__device__ __forceinline__ unsigned xb_add(unsigned* p, unsigned v) { return __hip_atomic_fetch_add(p, v, __ATOMIC_RELAXED, __HIP_MEMORY_SCOPE_AGENT); }
__device__ __forceinline__ unsigned xb_xcc_id() { return (unsigned)__builtin_amdgcn_s_getreg((3 << 11) | 20) & 0xFu; }
#define XB_SPIN(cond, bar) do { unsigned _sp = 0; while (cond) { __builtin_amdgcn_s_sleep(1); \
    if ((++_sp & 255u) == 0u) { if (xb_ld(&(bar)[XB_TMO])) break; if (_sp > XB_SPIN_CAP) { atomicAdd(&(bar)[XB_TMO], 1u); break; } } } } while (0)

struct XcdBarrier {
    unsigned* bar; unsigned x;
    volatile LAS unsigned* st;
};

__device__ __forceinline__ XcdBarrier xcd_barrier_post(unsigned* bar, volatile LAS unsigned* st) {
    XcdBarrier b; b.bar = bar; b.x = xb_xcc_id(); b.st = st;
    if (threadIdx.x == 0) (void)xb_add(&bar[XB_XCNT(b.x)], 1u);
    return b;
}
__device__ __forceinline__ void xcd_barrier_complete(unsigned* bar, unsigned x, unsigned& nloc, unsigned& nx) {
    const unsigned G = gridDim.x * gridDim.y * gridDim.z;
    unsigned sum, cnt, mine, sp = 0u;
    for (;;) {
        sum = 0u; cnt = 0u; mine = 0u;
#pragma unroll
        for (unsigned j = 0; j < 16; ++j) { const unsigned c = xb_ld(&bar[XB_XCNT(j)]); sum += c; cnt += (c > 0u) ? 1u : 0u; mine = (j == x) ? c : mine; }
        if (sum == G) break;
        __builtin_amdgcn_s_sleep(1);
        if ((++sp & 255u) == 0u) { if (xb_ld(&bar[XB_TMO])) break; if (sp > XB_SPIN_CAP) { atomicAdd(&bar[XB_TMO], 1u); break; } }
    }
    nloc = mine > 0u ? mine : 1u; nx = cnt > 0u ? cnt : 1u;
}

__device__ __forceinline__ void xcd_barrier(const XcdBarrier& b) {
    asm volatile("s_waitcnt vmcnt(0)" ::: "memory");
    __syncthreads();
    if (threadIdx.x == 0) {
        unsigned* bar = b.bar;
        __builtin_amdgcn_s_waitcnt(0);
        unsigned nloc = b.st[0], nx = b.st[1];
        if (nloc == 0u) { xcd_barrier_complete(bar, b.x, nloc, nx); b.st[0] = nloc; b.st[1] = nx; }
        const unsigned old = xb_add(&bar[XB_XSUB(b.x)], 1u);
        const unsigned gen = old / nloc;
        if (old + 1u == (gen + 1u) * nloc) {
            __builtin_amdgcn_fence(__ATOMIC_RELEASE, "agent");
            asm volatile("s_waitcnt vmcnt(0)" ::: "memory");
            const unsigned og = xb_add(&bar[XB_TOP], 1u);
            const unsigned tg = og / nx;
            if (og + 1u == (tg + 1u) * nx) xb_add(&bar[XB_TOPGEN], 1u);
            else XB_SPIN(xb_ld(&bar[XB_TOPGEN]) == tg, bar);
            __builtin_amdgcn_fence(__ATOMIC_ACQUIRE, "agent");
            xb_add(&bar[XB_XGEN(b.x)], 1u);
            asm volatile("s_waitcnt vmcnt(0)" ::: "memory");
        } else {
            XB_SPIN(xb_ld(&bar[XB_XGEN(b.x)]) == gen, bar);
            __builtin_amdgcn_fence(__ATOMIC_ACQUIRE, "agent");
            asm volatile("s_waitcnt vmcnt(0)" ::: "memory");
        }
    }
    __syncthreads();
}

constexpr size_t WS_BAR = WS_CTL + 768 * 1024;
constexpr int LDS_BARST = LDS_BYTES - 64;
__global__ void __launch_bounds__(NTHREADS, 2) hymba_fwd(Ctx C) {
    extern __shared__ __attribute__((aligned(16))) unsigned char lds_raw[];
    cg::grid_group grid = cg::this_grid();
    if (threadIdx.x < 2) ((volatile LAS unsigned*)((LAS unsigned char*)lds_raw + LDS_BARST))[threadIdx.x] = 0u;
    __syncthreads();
    (void)xcd_barrier_post((unsigned*)(C.ws + WS_BAR), (volatile LAS unsigned*)((LAS unsigned char*)lds_raw + LDS_BARST));
    int ph = 0;
#define PHASE_LOCALS2 int tid = threadIdx.x; LAUNDER_V(tid); const int lane = tid & 63, wave = __builtin_amdgcn_readfirstlane(tid >> 6); char* lds = (char*)lds_raw; Ctx Cc = C; LAUNDER_S(Cc.ws); (void)lane; (void)wave; (void)lds
#define TAIL_OK(G_) ((G_) * 4 >= 850 && 850 - 3 * (G_) > 0 && 850 - 3 * (G_) < (G_))
#define PHASE_BEGIN (C.ph_lo <= ph && ph < C.ph_hi)
#define PHASE_END do { if (C.ph_lo <= ph && ph + 1 < C.ph_hi) { if (C.ph_lo < 0) grid.sync(); else { XcdBarrier xb_; xb_.bar = (unsigned*)(C.ws + WS_BAR); xb_.x = xb_xcc_id(); xb_.st = (volatile LAS unsigned*)((LAS unsigned char*)lds_raw + LDS_BARST); xcd_barrier(xb_); } } ++ph; } while (0)
#define PHASE_LOCALS int tid = threadIdx.x; LAUNDER_V(tid); const int lane = tid & 63, wave = __builtin_amdgcn_readfirstlane(tid >> 6); \
    int G = gridDim.x, bid = blockIdx.x; LAUNDER_S(G); LAUNDER_S(bid); char* lds = (char*)lds_raw; Ctx Cc = C; LAUNDER_S(Cc.ws); (void)lane; (void)wave; (void)lds

    if (PHASE_BEGIN) { PHASE_LOCALS; for (int rep = 0; rep < REP_P0; ++rep) { p0_prologue(Cc, lds, tid, wave, lane, G); __syncthreads(); } }
    PHASE_END;

    {
        constexpr int layer = 0;
        if (PHASE_BEGIN) {
            unsigned char* ws = C.ws; const int G = gridDim.x, bid = blockIdx.x;
            float* rss = (float*)(ws + WS_CTL); float* cosA = (float*)(ws + WS_TAB); float* sinA = cosA + NPOS * 32; float* cosB = sinA + NPOS * 32; float* sinB = cosB + NPOS * 64;
            pg8::Gemm g{(const bf16*)(ws + WS_XA), (const bf16*)(ws + WS_WIN) + (size_t)layer * NP * D, M, NP, D};
            pg8::EpiProj E{layer};
            unsigned* scnt = (unsigned*)(ws + WS_CTL) + 28672 + 64 * layer;
            {
                pg8::SampleFirstOrder S{G, bid, scnt};
                pg8::gemm_phase<pg8::EpiProj, pg8::SampleFirstOrder, true, true>((LAS unsigned char*)lds_raw, g, S, E);
                const bool tail = TAIL_OK(G);
                const int nfull = tail ? 850 - 3 * G : 0;
                if (bid >= nfull) {
                    PHASE_LOCALS2; int ly = layer; LAUNDER_S(ly);
                    if (ly == 0) convert_weights(Cc, (float*)(lds + wave * 16640), 1, (bid - nfull) * 8 + wave, (G - nfull) * 8, lane);
                    if (tail) {
                        __syncthreads();
                        if (tid == 0) { unsigned sp = 0u; while (__hip_atomic_load(scnt, __ATOMIC_RELAXED, __HIP_MEMORY_SCOPE_AGENT) < 50u && ++sp < (1u << 24)) __builtin_amdgcn_s_sleep(8);
                            __builtin_amdgcn_fence(__ATOMIC_ACQUIRE, "agent"); asm volatile("s_waitcnt vmcnt(0)" ::: "memory"); }
                        __syncthreads();
                        for (int ug = bid - nfull; ug < 256; ug += G - nfull) { int tu = tid; LAUNDER_V(tu); ret_sample_group(Cc, lds, ly, ug, tu, wave, tu & 63); }
                    }
                }
            }
        }
        PHASE_END;
        if (PHASE_BEGIN) {
            PHASE_LOCALS; int ly = layer; LAUNDER_S(ly);
            const int nunits = TAIL_OK(G) ? 1024 : 1280; const int tid_p = tid;
            unsigned* ucnt = (unsigned*)(Cc.ws + WS_CTL) + 28672 + 128 + 64 * ly;
            for (int rep = 0; rep < REP_MX1; ++rep) for (int u = bid; u < nunits; u += G) {
                int tid = tid_p; LAUNDER_V(tid); const int lane = tid & 63;
                if (u < 512) { for (int r2 = 0; r2 < 1 + (REPU & 1); ++r2) ret_u_unit(Cc, lds, u >> 3, u & 7, tid, wave, lane, ucnt); }
                else if (u < 768) { const int a = u - 512; for (int r2 = 0; r2 < 1 + ((REPU >> 1) & 1); ++r2) attn_prompt_unit(Cc, lds, ly, a >> 2, (a >> 1) & 1, a & 1, tid, wave, lane); }
                else if (u < 1024) { const int a = u - 768; for (int r2 = 0; r2 < 1 + ((REPU >> 2) & 1); ++r2) attn_sample_mfma(Cc, lds, ly, a >> 1, a & 1, tid, wave, lane); }
                else { const int a = u - 1024; ret_sample_group(Cc, lds, ly, a, tid, wave, lane); }
            }
            {
                if (tid_p == 0) { unsigned sp = 0u; while (__hip_atomic_load(ucnt, __ATOMIC_RELAXED, __HIP_MEMORY_SCOPE_AGENT) < 512u * REP_MX1 * (1 + (REPU & 1)) && ++sp < (1u << 24)) __builtin_amdgcn_s_sleep(4);
                    __builtin_amdgcn_fence(__ATOMIC_ACQUIRE, "agent"); asm volatile("s_waitcnt vmcnt(0)" ::: "memory"); }
                __syncthreads();
                int tid = tid_p; LAUNDER_V(tid);
                ret_scan(Cc, ly, tid, G);
            }
        }
        PHASE_END;
        if (PHASE_BEGIN) { PHASE_LOCALS; int ly = layer; LAUNDER_S(ly); for (int u = bid; u < 256; u += G) outproj_sample_unit(Cc, lds, ly, u, tid, wave, lane); for (int rep = 0; rep < REP_RP; ++rep) for (int u = bid; u < 512; u += G) if (!(SKIPM & 16)) ret_prompt_unit(Cc, lds, ly, u >> 3, u & 7, tid, wave, lane); }
        PHASE_END;
        if (PHASE_BEGIN) {
            unsigned char* ws = C.ws; const int G = gridDim.x, bid = blockIdx.x;
            float* rss = (float*)(ws + WS_CTL); float* XR = (float*)(ws + WS_XR);
            pg8::Gemm g{(const bf16*)(ws + WS_Y), (const bf16*)(ws + WS_WOUT) + (size_t)layer * D * D, T, D, D}; pg8::StaticOrder S; S.init(T, D, G, bid);
            pg8::EpiRes E{layer};
            pg8::gemm_phase<pg8::EpiRes, pg8::StaticOrder, true, true>((LAS unsigned char*)lds_raw, g, S, E);
        }
        PHASE_END;
    }
    {
        constexpr int layer = 1;
        if (PHASE_BEGIN) {
            unsigned char* ws = C.ws; const int G = gridDim.x, bid = blockIdx.x;
            float* rss = (float*)(ws + WS_CTL); float* cosA = (float*)(ws + WS_TAB); float* sinA = cosA + NPOS * 32; float* cosB = sinA + NPOS * 32; float* sinB = cosB + NPOS * 64;
            pg8::Gemm g{(const bf16*)(ws + WS_XA), (const bf16*)(ws + WS_WIN) + (size_t)layer * NP * D, M, NP, D};
            pg8::EpiProj E{layer};
            unsigned* scnt = (unsigned*)(ws + WS_CTL) + 28672 + 64 * layer;
            {
                pg8::SampleFirstOrder S{G, bid, scnt};
                pg8::gemm_phase<pg8::EpiProj, pg8::SampleFirstOrder, true, true>((LAS unsigned char*)lds_raw, g, S, E);
                const bool tail = TAIL_OK(G);
                const int nfull = tail ? 850 - 3 * G : 0;
                if (bid >= nfull) {
                    PHASE_LOCALS2; int ly = layer; LAUNDER_S(ly);
                    if (ly == 0) convert_weights(Cc, (float*)(lds + wave * 16640), 1, (bid - nfull) * 8 + wave, (G - nfull) * 8, lane);
                    if (tail) {
                        __syncthreads();
                        if (tid == 0) { unsigned sp = 0u; while (__hip_atomic_load(scnt, __ATOMIC_RELAXED, __HIP_MEMORY_SCOPE_AGENT) < 50u && ++sp < (1u << 24)) __builtin_amdgcn_s_sleep(8);
                            __builtin_amdgcn_fence(__ATOMIC_ACQUIRE, "agent"); asm volatile("s_waitcnt vmcnt(0)" ::: "memory"); }
                        __syncthreads();
                        for (int ug = bid - nfull; ug < 256; ug += G - nfull) { int tu = tid; LAUNDER_V(tu); ret_sample_group(Cc, lds, ly, ug, tu, wave, tu & 63); }
                    }
                }
            }
        }
        PHASE_END;
        if (PHASE_BEGIN) {
            PHASE_LOCALS; int ly = layer; LAUNDER_S(ly);
            const int nunits = TAIL_OK(G) ? 1024 : 1280; const int tid_p = tid;
            unsigned* ucnt = (unsigned*)(Cc.ws + WS_CTL) + 28672 + 128 + 64 * ly;
            for (int rep = 0; rep < REP_MX1; ++rep) for (int u = bid; u < nunits; u += G) {
                int tid = tid_p; LAUNDER_V(tid); const int lane = tid & 63;
                if (u < 512) { for (int r2 = 0; r2 < 1 + (REPU & 1); ++r2) ret_u_unit(Cc, lds, u >> 3, u & 7, tid, wave, lane, ucnt); }
                else if (u < 768) { const int a = u - 512; for (int r2 = 0; r2 < 1 + ((REPU >> 1) & 1); ++r2) attn_prompt_unit(Cc, lds, ly, a >> 2, (a >> 1) & 1, a & 1, tid, wave, lane); }
                else if (u < 1024) { const int a = u - 768; for (int r2 = 0; r2 < 1 + ((REPU >> 2) & 1); ++r2) attn_sample_mfma(Cc, lds, ly, a >> 1, a & 1, tid, wave, lane); }
                else { const int a = u - 1024; ret_sample_group(Cc, lds, ly, a, tid, wave, lane); }
            }
            {
                if (tid_p == 0) { unsigned sp = 0u; while (__hip_atomic_load(ucnt, __ATOMIC_RELAXED, __HIP_MEMORY_SCOPE_AGENT) < 512u * REP_MX1 * (1 + (REPU & 1)) && ++sp < (1u << 24)) __builtin_amdgcn_s_sleep(4);
                    __builtin_amdgcn_fence(__ATOMIC_ACQUIRE, "agent"); asm volatile("s_waitcnt vmcnt(0)" ::: "memory"); }
                __syncthreads();
                int tid = tid_p; LAUNDER_V(tid);
                ret_scan(Cc, ly, tid, G);
            }
        }
        PHASE_END;
        if (PHASE_BEGIN) { PHASE_LOCALS; int ly = layer; LAUNDER_S(ly); for (int u = bid; u < 256; u += G) outproj_sample_unit(Cc, lds, ly, u, tid, wave, lane); for (int rep = 0; rep < REP_RP; ++rep) for (int u = bid; u < 512; u += G) if (!(SKIPM & 16)) ret_prompt_unit(Cc, lds, ly, u >> 3, u & 7, tid, wave, lane); }
        PHASE_END;
        if (PHASE_BEGIN) {
            unsigned char* ws = C.ws; const int G = gridDim.x, bid = blockIdx.x;
            float* rss = (float*)(ws + WS_CTL); float* XR = (float*)(ws + WS_XR);
            pg8::Gemm g{(const bf16*)(ws + WS_Y), (const bf16*)(ws + WS_WOUT) + (size_t)layer * D * D, T, D, D}; pg8::StaticOrder S; S.init(T, D, G, bid);
            if (G == 256) {
                pg8::EpiResFinal EF;
                pg8::gemm_phase<pg8::EpiResFinal, pg8::StaticOrder, true, true>((LAS unsigned char*)lds_raw, g, S, EF);
                PHASE_LOCALS2;
                const float* rf = (const float*)(Cc.ws + WS_CTL) + 2 * M;
                for (int m = T + bid * 8 + wave; m < M; m += G * 8) {
                    const float rv = rsqrtf(rf[m] * (1.0f / 2048.0f) + 1e-6f);
                    f32x4* xr = (f32x4*)(Cc.out + (size_t)m * D);
#pragma unroll
                    for (int j = 0; j < 8; ++j) { const f32x4 wv = *((const f32x4*)Cc.final_w + lane + 64 * j); xr[lane + 64 * j] = xr[lane + 64 * j] * rv * wv; }
                }
            } else {
                pg8::EpiRes E{layer};
                pg8::gemm_phase<pg8::EpiRes, pg8::StaticOrder, true, true>((LAS unsigned char*)lds_raw, g, S, E);
            }
        }
        if (gridDim.x != 256) { PHASE_END; } else ++ph;
    }
#ifdef REP_SYNC
    for (int rep = 0; rep < REP_SYNC; ++rep) { XcdBarrier xb_; xb_.bar = (unsigned*)(C.ws + WS_BAR); xb_.x = xb_xcc_id(); xb_.st = (volatile LAS unsigned*)((LAS unsigned char*)lds_raw + LDS_BARST); xcd_barrier(xb_); }
#endif
    if (PHASE_BEGIN && gridDim.x != 256) {
        PHASE_LOCALS;
        const float* rf = (const float*)(Cc.ws + WS_CTL) + 2 * M;
        for (int m = bid * 8 + wave; m < M; m += G * 8) {
            const float rv = rsqrtf(rf[m] * (1.0f / 2048.0f) + 1e-6f);
            f32x4* xr = (f32x4*)(Cc.out + (size_t)m * D);
#pragma unroll
            for (int j = 0; j < 8; ++j) { const f32x4 wv = *((const f32x4*)Cc.final_w + lane + 64 * j); xr[lane + 64 * j] = xr[lane + 64 * j] * rv * wv; }
        }
    }
}

constexpr int N_PHASES = 1 + DEPTH * 4 + 1;
#ifndef MK_MULTI
#define MK_MULTI 0
#endif
extern "C" void kernel_launch(void* const* d_in, const int* in_sizes, int n_in, void* d_out, int out_size, void* d_ws, size_t ws_size, hipStream_t stream) {
    static int grid = 0;
    if (grid == 0) {
        if (n_in != 11 || ws_size < WS_END) { fprintf(stderr, "kernel_launch: unexpected inputs (n_in %d, ws %zu)\n", n_in, ws_size); grid = -1; return; }
        int dev = 0, cus = 0, per_cu = 0;
        hipGetDevice(&dev); hipDeviceGetAttribute(&cus, hipDeviceAttributeMultiprocessorCount, dev);
        if (hipFuncSetAttribute((const void*)hymba_fwd, hipFuncAttributeMaxDynamicSharedMemorySize, LDS_BYTES) != hipSuccess) { fprintf(stderr, "kernel_launch: hipFuncSetAttribute failed\n"); grid = -1; return; }
        if (hipOccupancyMaxActiveBlocksPerMultiprocessor(&per_cu, (const void*)hymba_fwd, NTHREADS, LDS_BYTES) != hipSuccess || per_cu < 1) { fprintf(stderr, "kernel_launch: occupancy query says %d\n", per_cu); (void)hipGetLastError(); per_cu = 1; }
        grid = cus;
    }
    if (grid < 0) return;
    hipMemsetAsync((char*)d_ws + WS_CTL, 0, CTL_BYTES, stream);
    Ctx c{};
    c.x_prompt = (const float*)d_in[0]; c.x_sample = (const float*)d_in[1]; c.cache_k = (const float*)d_in[2]; c.cache_v = (const float*)d_in[3]; c.state = (const float*)d_in[4];
    c.norm_w = (const float*)d_in[5]; c.w_in = (const float*)d_in[6]; c.sinks = (const float*)d_in[7]; c.ret_norm_w = (const float*)d_in[8]; c.w_out = (const float*)d_in[9]; c.final_w = (const float*)d_in[10];
    c.out = (float*)d_out; c.ws = (unsigned char*)d_ws;
#if MK_MULTI
    for (int p = 0; p < N_PHASES; ++p) { c.ph_lo = p; c.ph_hi = p + 1; void* args[] = {&c};
        hipError_t e = hipLaunchCooperativeKernel((const void*)hymba_fwd, dim3(grid), dim3(NTHREADS), args, LDS_BYTES, stream);
        if (e != hipSuccess) { fprintf(stderr, "launch %d failed: %s\n", p, hipGetErrorString(e)); break; } }
#else
    c.ph_lo = 0; c.ph_hi = N_PHASES; void* args[] = {&c};
    hipError_t e = hipLaunchCooperativeKernel((const void*)hymba_fwd, dim3(grid), dim3(NTHREADS), args, LDS_BYTES, stream);
    if (e != hipSuccess) fprintf(stderr, "cooperative launch failed: %s (grid %d)\n", hipGetErrorString(e), grid);
#endif
}
```
